# Optimizing an MI355X kernel written in HIP

```python
import jax, jax.numpy as jnp
from jax import lax
import numpy as np

D_MODEL = 1024
BATCH = 32
SEQ = 256
DEPTH = 1
DEC_BATCH = 8
DEC_SEQ = 4096
PAST_LEN = 256

GRID_W = 64
MIX_WIDTH = D_MODEL
LRU_WIDTH = MIX_WIDTH // 2
LRU_BLOCKS = 8
LRU_BLOCK_W = LRU_WIDTH // LRU_BLOCKS
LRU_CONV_WIDTH = 4
LRU_CONV_PAD_LEFT = 2
LRU_C = 8.0
RET_WIDTH = MIX_WIDTH - LRU_WIDTH
RET_HEADS = 4
RET_HEAD_DIM = RET_WIDTH // RET_HEADS
RET_CHUNK = 128
IN_WIDTH = 2 * LRU_WIDTH + 4 * RET_WIDTH
FFN_HIDDEN = ((8 * D_MODEL // 3 + 127) // 128) * 128
FFN_CONV_WIDTH = 3
N_MOD = 6
EPS = 1e-6

kernel_name = 'hymba_rglru_retention_convffn_dit_step'


def _rmsnorm(x, w):
    x32 = x.astype(jnp.float32)
    y = x32 * lax.rsqrt(jnp.mean(x32 * x32, axis=-1, keepdims=True) + EPS)
    return (y * w.astype(jnp.float32)).astype(x.dtype)


def _group_norm_heads(o):
    mu = jnp.mean(o, axis=-1, keepdims=True)
    var = jnp.mean(jnp.square(o - mu), axis=-1, keepdims=True)
    return (o - mu) * lax.rsqrt(var + EPS)


def _modulation(cvec, w, b):
    return (jax.nn.silu(cvec) @ w + b)[:, None, :]


def _dwconv1d(x, w, b, pad_left):
    width = w.shape[0]
    t = x.shape[1]
    xp = jnp.pad(x, ((0, 0), (pad_left, width - 1 - pad_left), (0, 0)))
    return sum(xp[:, j:j + t] * w[j] for j in range(width)) + b


def _dwconv2d_grid(x, w, b):
    bsz, t, ch = x.shape
    rows = t // GRID_W
    g = x.reshape(bsz, rows, GRID_W, ch)
    y = lax.conv_general_dilated(g, w[:, :, None, :], (1, 1), 'SAME',
                                 dimension_numbers=('NHWC', 'HWIO', 'NHWC'),
                                 feature_group_count=ch)
    return y.reshape(bsz, t, ch) + b


def _linear_combine(e1, e2):
    a1, b1 = e1
    a2, b2 = e2
    return a1 * a2, a2 * b1 + b2


def _rglru_dir(x, w_a, b_a, w_x, b_x, lam, h0, reverse):
    bsz, t, wdt = x.shape
    xb = x.reshape(bsz, t, LRU_BLOCKS, LRU_BLOCK_W)
    r = jax.nn.sigmoid(jnp.einsum('btnc,ncd->btnd', xb, w_a).reshape(bsz, t, wdt) + b_a)
    i = jax.nn.sigmoid(jnp.einsum('btnc,ncd->btnd', xb, w_x).reshape(bsz, t, wdt) + b_x)
    log_a = -LRU_C * r * jax.nn.softplus(-lam.astype(jnp.float32))
    a = jnp.exp(log_a)
    u = jnp.sqrt(-jnp.expm1(2.0 * log_a)) * (i * x)
    edge = -1 if reverse else 0
    u = u.at[:, edge].add(a[:, edge] * h0)
    _, h = lax.associative_scan(_linear_combine, (a, u), axis=1, reverse=reverse)
    return h, h[:, edge]


def _retention_dir(q, k, v, log_gamma, s0):
    bsz, t, nh, dh = q.shape
    n = t // RET_CHUNK
    q = q.reshape(bsz, n, RET_CHUNK, nh, dh)
    k = k.reshape(bsz, n, RET_CHUNK, nh, dh)
    v = v.reshape(bsz, n, RET_CHUNK, nh, dh)
    pos = jnp.arange(RET_CHUNK, dtype=jnp.float32)
    rel = pos[:, None] - pos[None, :]
    lg = log_gamma[:, None, None]
    intra_decay = jnp.where(rel >= 0, jnp.exp(lg * jnp.maximum(rel, 0.0)), 0.0)
    scores = jnp.einsum('bnihd,bnjhd->bnhij', q, k) * intra_decay
    intra = jnp.einsum('bnhij,bnjhe->bnihe', scores, v)
    tail = jnp.exp(log_gamma[:, None] * (RET_CHUNK - 1 - pos))
    head = jnp.exp(log_gamma[:, None] * (pos + 1.0))
    chunk_kv = jnp.einsum('bnjhd,bnjhe,hj->nbhde', k, v, tail)
    g_chunk = jnp.exp(log_gamma * RET_CHUNK)[:, None, None]

    def step(s, kv):
        return g_chunk * s + kv, s

    s_final, s_before = lax.scan(step, s0, chunk_kv)
    cross = jnp.einsum('bnihd,nbhde,hi->bnihe', q, s_before, head)
    return (intra + cross).reshape(bsz, t, nh, dh), s_final


def _retention_bidir(q, k, v, lg_fw, lg_bw, s_fw, s_bw):
    o_fw, sf = _retention_dir(q, k, v, lg_fw, s_fw)
    o_bw, sb = _retention_dir(q[:, ::-1], k[:, ::-1], v[:, ::-1], lg_bw, s_bw)
    return o_fw + o_bw[:, ::-1], sf, sb


def _layer(x, mod, p, st, latent):
    bsz, t, _ = x.shape
    shift1, scale1, gate1, shift2, scale2, gate2 = jnp.split(mod, N_MOD, axis=-1)
    h = _rmsnorm(x, p['norm1_w']) * (1.0 + scale1) + shift1
    proj = h @ p['w_in']
    L, R = LRU_WIDTH, RET_WIDTH
    lru_x, lru_g, q, k, v, ret_g = jnp.split(
        proj, [L, 2 * L, 2 * L + R, 2 * L + 2 * R, 2 * L + 3 * R], axis=-1)
    xc = _dwconv1d(lru_x, p['lru_conv_w'], p['lru_conv_b'], LRU_CONV_PAD_LEFT).astype(jnp.float32)
    h_fw, s_lru_fw = _rglru_dir(xc, p['lru_wa_fw'], p['lru_ba_fw'], p['lru_wx_fw'], p['lru_bx_fw'],
                                p['lru_lambda_fw'], st[0], False)
    h_bw, s_lru_bw = _rglru_dir(xc, p['lru_wa_bw'], p['lru_ba_bw'], p['lru_wx_bw'], p['lru_bx_bw'],
                                p['lru_lambda_bw'], st[1], True)
    y_lru = (h_fw + h_bw).astype(x.dtype) * jax.nn.gelu(lru_g)
    qh = q.reshape(bsz, t, RET_HEADS, RET_HEAD_DIM).astype(jnp.float32)
    kh = k.reshape(bsz, t, RET_HEADS, RET_HEAD_DIM).astype(jnp.float32) * (RET_HEAD_DIM ** -0.5)
    vh = v.reshape(bsz, t, RET_HEADS, RET_HEAD_DIM).astype(jnp.float32)
    lg_fw = jax.nn.log_sigmoid(p['ret_decay_fw'].astype(jnp.float32))
    lg_bw = jax.nn.log_sigmoid(p['ret_decay_bw'].astype(jnp.float32))
    o, s_ret_fw, s_ret_bw = _retention_bidir(qh, kh, vh, lg_fw, lg_bw, st[2], st[3])
    o = _group_norm_heads(o).reshape(bsz, t, RET_WIDTH) * p['ret_gn_w'].astype(jnp.float32)
    y_ret = o.astype(x.dtype) * jax.nn.silu(ret_g)
    x = x + gate1 * (jnp.concatenate([y_lru, y_ret], axis=-1) @ p['w_out'])
    h = _rmsnorm(x, p['norm2_w']) * (1.0 + scale2) + shift2
    g = h @ p['ffn_w_gate']
    if latent:
        g = _dwconv2d_grid(g, p['ffn_conv_w'], p['ffn_conv_b'])
    else:
        g = _dwconv1d(g, p['ffn_conv_w'][1], p['ffn_conv_b'], 1)
    x = x + gate2 * ((jax.nn.gelu(g) * (h @ p['ffn_w_up'])) @ p['ffn_w_down'])
    finals = (s_lru_fw.astype(x.dtype), s_lru_bw.astype(x.dtype),
              s_ret_fw.astype(x.dtype), s_ret_bw.astype(x.dtype))
    return x, finals


def setup_inputs(seed: int = 0) -> dict:
    key = jax.random.key(seed)
    ks = iter(jax.random.split(key, 48))

    def nrm(shape, scale):
        return scale * jax.random.normal(next(ks), shape, jnp.float32)

    def lru_lambda():
        a = jax.random.uniform(next(ks), (DEPTH, LRU_WIDTH), jnp.float32, 0.9, 0.999)
        pr = a ** (1.0 / LRU_C)
        return jnp.log(pr) - jnp.log1p(-pr)

    ret_base = jnp.log(2.0 ** (5.0 + jnp.arange(RET_HEADS, dtype=jnp.float32)) - 1.0)
    return {
        'x_prompt': nrm((BATCH, SEQ, D_MODEL), 1.0),
        'x_sample': nrm((DEC_BATCH, DEC_SEQ, D_MODEL), 1.0),
        'state_lru_fw': nrm((DEC_BATCH, DEPTH, LRU_WIDTH), 0.5),
        'state_lru_bw': nrm((DEC_BATCH, DEPTH, LRU_WIDTH), 0.5),
        'state_ret_fw': nrm((DEC_BATCH, DEPTH, RET_HEADS, RET_HEAD_DIM, RET_HEAD_DIM), 0.3),
        'state_ret_bw': nrm((DEC_BATCH, DEPTH, RET_HEADS, RET_HEAD_DIM, RET_HEAD_DIM), 0.3),
        'c': nrm((DEC_BATCH, D_MODEL), 1.0),
        'c_ctx': nrm((D_MODEL,), 1.0),
        'norm1_w': 1.0 + nrm((DEPTH, D_MODEL), 0.02),
        'w_mod': nrm((DEPTH, D_MODEL, N_MOD * D_MODEL), 0.5 * D_MODEL ** -0.5),
        'b_mod': nrm((DEPTH, N_MOD * D_MODEL), 0.02),
        'w_in': nrm((DEPTH, D_MODEL, IN_WIDTH), D_MODEL ** -0.5),
        'lru_conv_w': nrm((DEPTH, LRU_CONV_WIDTH, LRU_WIDTH), LRU_CONV_WIDTH ** -0.5),
        'lru_conv_b': nrm((DEPTH, LRU_WIDTH), 0.02),
        'lru_wa_fw': nrm((DEPTH, LRU_BLOCKS, LRU_BLOCK_W, LRU_BLOCK_W), LRU_BLOCK_W ** -0.5),
        'lru_ba_fw': nrm((DEPTH, LRU_WIDTH), 0.02),
        'lru_wx_fw': nrm((DEPTH, LRU_BLOCKS, LRU_BLOCK_W, LRU_BLOCK_W), LRU_BLOCK_W ** -0.5),
        'lru_bx_fw': nrm((DEPTH, LRU_WIDTH), 0.02),
        'lru_lambda_fw': lru_lambda(),
        'lru_wa_bw': nrm((DEPTH, LRU_BLOCKS, LRU_BLOCK_W, LRU_BLOCK_W), LRU_BLOCK_W ** -0.5),
        'lru_ba_bw': nrm((DEPTH, LRU_WIDTH), 0.02),
        'lru_wx_bw': nrm((DEPTH, LRU_BLOCKS, LRU_BLOCK_W, LRU_BLOCK_W), LRU_BLOCK_W ** -0.5),
        'lru_bx_bw': nrm((DEPTH, LRU_WIDTH), 0.02),
        'lru_lambda_bw': lru_lambda(),
        'ret_decay_fw': ret_base[None, :] + nrm((DEPTH, RET_HEADS), 0.1),
        'ret_decay_bw': ret_base[None, :] + nrm((DEPTH, RET_HEADS), 0.1),
        'ret_gn_w': 1.0 + nrm((DEPTH, RET_WIDTH), 0.02),
        'w_out': nrm((DEPTH, MIX_WIDTH, D_MODEL), MIX_WIDTH ** -0.5),
        'norm2_w': 1.0 + nrm((DEPTH, D_MODEL), 0.02),
        'ffn_w_gate': nrm((DEPTH, D_MODEL, FFN_HIDDEN), D_MODEL ** -0.5),
        'ffn_w_up': nrm((DEPTH, D_MODEL, FFN_HIDDEN), D_MODEL ** -0.5),
        'ffn_conv_w': nrm((DEPTH, FFN_CONV_WIDTH, FFN_CONV_WIDTH, FFN_HIDDEN), 1.0 / FFN_CONV_WIDTH),
        'ffn_conv_b': nrm((DEPTH, FFN_HIDDEN), 0.02),
        'ffn_w_down': nrm((DEPTH, FFN_HIDDEN, D_MODEL), FFN_HIDDEN ** -0.5),
        'final_norm_w': 1.0 + nrm((D_MODEL,), 0.02),
    }


def reference(x_prompt, x_sample, state_lru_fw, state_lru_bw, state_ret_fw, state_ret_bw, c, c_ctx,
              norm1_w, w_mod, b_mod, w_in, lru_conv_w, lru_conv_b,
              lru_wa_fw, lru_ba_fw, lru_wx_fw, lru_bx_fw, lru_lambda_fw,
              lru_wa_bw, lru_ba_bw, lru_wx_bw, lru_bx_bw, lru_lambda_bw,
              ret_decay_fw, ret_decay_bw, ret_gn_w, w_out, norm2_w,
              ffn_w_gate, ffn_w_up, ffn_conv_w, ffn_conv_b, ffn_w_down, final_norm_w):
    x_p = x_prompt
    x_s = x_sample
    bp = x_prompt.shape[0]
    lru_fw_list, lru_bw_list, ret_fw_list, ret_bw_list = [], [], [], []
    for l in range(DEPTH):
        p = dict(norm1_w=norm1_w[l], w_in=w_in[l], lru_conv_w=lru_conv_w[l], lru_conv_b=lru_conv_b[l],
                 lru_wa_fw=lru_wa_fw[l], lru_ba_fw=lru_ba_fw[l], lru_wx_fw=lru_wx_fw[l],
                 lru_bx_fw=lru_bx_fw[l], lru_lambda_fw=lru_lambda_fw[l],
                 lru_wa_bw=lru_wa_bw[l], lru_ba_bw=lru_ba_bw[l], lru_wx_bw=lru_wx_bw[l],
                 lru_bx_bw=lru_bx_bw[l], lru_lambda_bw=lru_lambda_bw[l],
                 ret_decay_fw=ret_decay_fw[l], ret_decay_bw=ret_decay_bw[l], ret_gn_w=ret_gn_w[l],
                 w_out=w_out[l], norm2_w=norm2_w[l], ffn_w_gate=ffn_w_gate[l], ffn_w_up=ffn_w_up[l],
                 ffn_conv_w=ffn_conv_w[l], ffn_conv_b=ffn_conv_b[l], ffn_w_down=ffn_w_down[l])
        mod_ctx = _modulation(c_ctx[None, :], w_mod[l], b_mod[l])
        mod_lat = _modulation(c, w_mod[l], b_mod[l])
        init_ctx = (jnp.zeros((bp, LRU_WIDTH), jnp.float32),
                    jnp.zeros((bp, LRU_WIDTH), jnp.float32),
                    jnp.zeros((bp, RET_HEADS, RET_HEAD_DIM, RET_HEAD_DIM), jnp.float32),
                    jnp.zeros((bp, RET_HEADS, RET_HEAD_DIM, RET_HEAD_DIM), jnp.float32))
        x_p, finals = _layer(x_p, mod_ctx, p, init_ctx, False)
        lru_fw_list.append(finals[0])
        lru_bw_list.append(finals[1])
        ret_fw_list.append(finals[2])
        ret_bw_list.append(finals[3])
        init_lat = (state_lru_fw[:, l].astype(jnp.float32), state_lru_bw[:, l].astype(jnp.float32),
                    state_ret_fw[:, l].astype(jnp.float32), state_ret_bw[:, l].astype(jnp.float32))
        x_s, _ = _layer(x_s, mod_lat, p, init_lat, True)
    y_prompt = _rmsnorm(x_p, final_norm_w)
    y_sample = _rmsnorm(x_s, final_norm_w)
    new_lru_fw = jnp.stack(lru_fw_list, axis=1)
    new_lru_bw = jnp.stack(lru_bw_list, axis=1)
    new_ret_fw = jnp.stack(ret_fw_list, axis=1)
    new_ret_bw = jnp.stack(ret_bw_list, axis=1)
    return (y_prompt, y_sample, new_lru_fw, new_lru_bw, new_ret_fw, new_ret_bw)
```

```cpp
#include <hip/hip_runtime.h>
#include <hip/hip_cooperative_groups.h>
#include <cstdio>
#include <cstdint>
namespace cg = cooperative_groups;
namespace pg8 {
#define PG8_LAS __attribute__((address_space(3)))
typedef unsigned short bf16_t;
typedef short bf16x8 __attribute__((ext_vector_type(8)));
typedef float f32x4 __attribute__((ext_vector_type(4)));
typedef unsigned u32x4 __attribute__((ext_vector_type(4)));
constexpr int BM = 256, BK = 64, HALF = 128, HTB = HALF * BK * 2  , STAGE_BYTES = 8 * HTB, NXCD = 8, WGM = 8;

__host__ __device__ __forceinline__ int lds_byte(int r, int c) { const int st = (r >> 4) * 2 + (c >> 5), rr = r & 15, cc = c & 31, ob = rr * 64 + cc * 2; return st * 1024 + (ob ^ (((ob >> 9) & 1) << 5)); }
__host__ __device__ __forceinline__ void stage_rc(int b, int& R, int& C) { const int st = b / 1024, sb = b % 1024, swz = sb ^ (((sb >> 9) & 1) << 5); R = (st >> 1) * 16 + swz / 64; C = (st & 1) * 32 + (swz % 64) / 2; }
__host__ __device__ __forceinline__ int perm32(int rho) { const int n = rho >> 4, i = rho & 15; return 8 * (i >> 2) + 4 * n + (i & 3); }

struct Unit { int pm, pn; };
struct Gemm { const bf16_t* A; const bf16_t* Bt; int M, N, K; };

struct StaticOrder {
    int nM, nN, nwg, G, c;
    __host__ __device__ void init(int M, int N, int G_, int c_) { nM = M / BM; nN = N / BM; nwg = nM * nN; G = G_; c = c_; }
    __host__ __device__ bool next(int i, Unit& u) const {
        const long L = (long)i * G + c; if (L >= nwg) return false;
        int wgid = (int)L; { const int q = nwg / NXCD, r = nwg % NXCD, xcd = wgid % NXCD, off = wgid / NXCD; wgid = (xcd < r ? xcd * (q + 1) : r * (q + 1) + (xcd - r) * q) + off; }
        const int nig = WGM * nN, gid = wgid / nig, fm = gid * WGM, gsz = (nM - fm) < WGM ? (nM - fm) : WGM;
        u.pm = fm + ((wgid % nig) % gsz); u.pn = (wgid % nig) / gsz; return true;
    }
    __device__ __forceinline__ void a_ready(const Unit&) const {}
    __device__ __forceinline__ void done(const Unit&) const {}
};

__device__ __forceinline__ unsigned cvt_pk_bf16(float lo, float hi) { unsigned r; asm volatile("v_cvt_pk_bf16_f32 %0, %1, %2" : "=v"(r) : "v"(lo), "v"(hi)); return r; }
typedef float f32x2 __attribute__((ext_vector_type(2)));
__device__ __forceinline__ f32x2 gelu_pk(f32x2 v) {
    const f32x2 av = __builtin_elementwise_abs(v), d = av * 0.2316418882f + 1.0f;
    f32x2 t; t.x = __builtin_amdgcn_rcpf(d.x); t.y = __builtin_amdgcn_rcpf(d.y);
    f32x2 q = t * 0.5307027145f + (-0.7265760135f); q = q * t + 0.7107068705f; q = q * t + (-0.142248368f); q = q * t + 0.127414796f; q = q * t;
    const f32x2 s = (v * v) * (-0.72134752044f);
    f32x2 e; e.x = __builtin_amdgcn_exp2f(s.x); e.y = __builtin_amdgcn_exp2f(s.y);
    const f32x2 m = v * (q * e), r = v - m;
    f32x2 o; o.x = v.x < 0.f ? m.x : r.x; o.y = v.y < 0.f ? m.y : r.y; return o;
}

template <int ACT  > struct EpiBf16 {
    static constexpr bool PERM = true, AFTER_DRAIN = false; static_assert(ACT == 0 || ACT == 1, "EpiBf16: ACT is 0 (none) or 1 (gelu_pk)");
    bf16_t* O; int ldc; const float* bias; int split_cols; size_t split_stride; float scale0;
    __device__ __forceinline__ void operator()(const f32x4 (&acc)[2][2][4][2], const Unit& u, int wr, int wc, int fr, int fq) const {
        const int row0 = u.pm * BM + wr * 64 + fr; int colt = u.pn * BM; bf16_t* base = O;
        float sc = 1.f; if (split_cols) { const int t = colt / split_cols; base += (size_t)t * split_stride; colt -= t * split_cols; if (t == 0) sc = scale0; }
        const int col0 = colt + wc * 32 + 8 * fq, bcol0 = u.pn * BM + wc * 32 + 8 * fq;
        f32x4 bv[2][2];
#pragma unroll
        for (int bj = 0; bj < 2; ++bj)
#pragma unroll
            for (int n = 0; n < 2; ++n) bv[bj][n] = bias ? *(const f32x4*)(bias + bcol0 + bj * HALF + 4 * n) : (f32x4){0.f, 0.f, 0.f, 0.f};
#pragma unroll
        for (int ai = 0; ai < 2; ++ai)
#pragma unroll
            for (int m = 0; m < 4; ++m) { bf16_t* rowp = base + (size_t)(row0 + ai * HALF + m * 16) * ldc + col0;
#pragma unroll
                for (int bj = 0; bj < 2; ++bj) { f32x4 v0 = acc[ai][bj][m][0] + bv[bj][0], v1 = acc[ai][bj][m][1] + bv[bj][1];
                    if (ACT == 1) { f32x2 a = gelu_pk((f32x2){v0[0], v0[1]}), b = gelu_pk((f32x2){v0[2], v0[3]}), c = gelu_pk((f32x2){v1[0], v1[1]}), d = gelu_pk((f32x2){v1[2], v1[3]});
                        v0 = (f32x4){a.x, a.y, b.x, b.y}; v1 = (f32x4){c.x, c.y, d.x, d.y}; }
                    v0 = v0 * sc; v1 = v1 * sc; u32x4 w; w.x = cvt_pk_bf16(v0[0], v0[1]); w.y = cvt_pk_bf16(v0[2], v0[3]); w.z = cvt_pk_bf16(v1[0], v1[1]); w.w = cvt_pk_bf16(v1[2], v1[3]);
                    *(u32x4*)(rowp + bj * HALF) = w; } }
    }
};
template <class Epi, class Sched, bool ALIGN_EPI = false, bool SP2 = false>
__device__ __forceinline__ void gemm_phase(PG8_LAS unsigned char* lds, const Gemm g, const Sched& S, const Epi& E) {
    int tid_ = threadIdx.x; asm volatile("" : "+v"(tid_));
    const int tid = tid_, wid = __builtin_amdgcn_readfirstlane(tid >> 6), lane = tid & 63, wr = wid >> 2, wc = wid & 3, fr = lane & 15, fq = lane >> 4;
    const int K = g.K, nt = K / BK;
    unsigned voffA[2], voffB[2];
#pragma unroll
    for (int i = 0; i < 2; ++i) { int R, C; stage_rc(tid * 16 + i * 8192, R, C); const int Rb = Epi::PERM ? ((R & ~31) + perm32(R & 31)) : R;
        voffA[i] = (unsigned)(R * K + C) * 2u; voffB[i] = (unsigned)(Rb * K + C) * 2u; }
    const size_t kstep = (size_t)(BK * 2);
    const size_t hstep = (size_t)HALF * K * 2;
    const size_t tstep = 2 * hstep;
    const unsigned ldsw = (unsigned)wid * 1024u;
    const int aoff = lds_byte(wr * 64 + fr, fq * 8), boff = lds_byte(wc * 32 + fr, fq * 8);
#define PG8_SA(b, h) (((b) * 2 + (h)) * HTB)
#define PG8_SB(b, h) ((4 + (b) * 2 + (h)) * HTB)
#define PG8_STAGE(bufoff, gbase, voff) do { _Pragma("unroll") for (int _i = 0; _i < 2; ++_i) \
        __builtin_amdgcn_global_load_lds((const unsigned*)((const char*)(gbase) + (voff)[_i]), (PG8_LAS unsigned*)(lds + (bufoff) + ldsw + _i * 8192), 16, 0, 0); } while (0)
#define PG8_LDA(dst, b, h) do { _Pragma("unroll") for (int m = 0; m < 4; ++m) _Pragma("unroll") for (int k = 0; k < 2; ++k) dst[m][k] = *(const PG8_LAS bf16x8*)(lds + PG8_SA(b, h) + aoff + m * 2048 + k * 1024); } while (0)
#define PG8_LDB(dst, b, h) do { _Pragma("unroll") for (int n = 0; n < 2; ++n) _Pragma("unroll") for (int k = 0; k < 2; ++k) dst[n][k] = *(const PG8_LAS bf16x8*)(lds + PG8_SB(b, h) + boff + n * 2048 + k * 1024); } while (0)
#define PG8_MMA(ai, bj, At, Bt) do { __builtin_amdgcn_s_setprio(1); _Pragma("unroll") for (int m = 0; m < 4; ++m) _Pragma("unroll") for (int n = 0; n < 2; ++n) _Pragma("unroll") for (int k = 0; k < 2; ++k) \
        acc[ai][bj][m][n] = __builtin_amdgcn_mfma_f32_16x16x32_bf16(Bt[n][k], At[m][k], acc[ai][bj][m][n], 0, 0, 0); __builtin_amdgcn_s_setprio(0); } while (0)
#define PG8_WAIT_V(n) asm volatile("s_waitcnt vmcnt(" #n ")" ::: "memory")
#define PG8_WAIT_L(n) asm volatile("s_waitcnt lgkmcnt(" #n ")" ::: "memory")
#define PG8_BAR __builtin_amdgcn_s_barrier()
#define PG8_SCHED __builtin_amdgcn_sched_barrier(0)
    Unit cur, nxt; int ui = 0;
    if (!S.next(0, cur)) return;
    f32x4 acc[2][2][4][2];
#pragma unroll
    for (int a = 0; a < 2; ++a)
#pragma unroll
        for (int b = 0; b < 2; ++b)
#pragma unroll
            for (int m = 0; m < 4; ++m)
#pragma unroll
                for (int n = 0; n < 2; ++n) acc[a][b][m][n] = (f32x4){0.f, 0.f, 0.f, 0.f};
    bf16x8 At[4][2], B0[2][2], B1[2][2];
    const char* cA = (const char*)g.A + (size_t)cur.pm * tstep; const char* cB = (const char*)g.Bt + (size_t)cur.pn * tstep;
    S.a_ready(cur);
    if constexpr (SP2) {
        PG8_STAGE(PG8_SB(0, 0), cB, voffB); PG8_STAGE(PG8_SB(0, 1), cB + hstep, voffB); PG8_STAGE(PG8_SA(0, 0), cA, voffA); PG8_STAGE(PG8_SA(0, 1), cA + hstep, voffA);
        if (wr == 1) PG8_BAR;
        PG8_WAIT_V(2); PG8_BAR;
        PG8_STAGE(PG8_SB(1, 0), cB + kstep, voffB); PG8_STAGE(PG8_SA(1, 0), cA + kstep, voffA); PG8_STAGE(PG8_SB(1, 1), cB + hstep + kstep, voffB);
        PG8_WAIT_V(6); PG8_BAR;
    } else {
        PG8_STAGE(PG8_SB(0, 0), cB, voffB); PG8_STAGE(PG8_SA(0, 0), cA, voffA); PG8_STAGE(PG8_SB(0, 1), cB + hstep, voffB); PG8_STAGE(PG8_SA(0, 1), cA + hstep, voffA);
        if (wr == 1) PG8_BAR;
        PG8_WAIT_V(4); PG8_BAR;
        PG8_STAGE(PG8_SB(1, 0), cB + kstep, voffB); PG8_STAGE(PG8_SA(1, 0), cA + kstep, voffA); PG8_STAGE(PG8_SB(1, 1), cB + hstep + kstep, voffB);
        PG8_WAIT_V(6); PG8_BAR;
    }
    for (;;) {
        const bool has_next = S.next(ui + 1, nxt);
        const char* nA = has_next ? (const char*)g.A + (size_t)nxt.pm * tstep : cA; const char* nB = has_next ? (const char*)g.Bt + (size_t)nxt.pn * tstep : cB;
        for (int t = 0; t < nt; t += 2) {
            const bool last = (t == nt - 2);
            const char* a1 = cA + (size_t)(t + 1) * kstep;
            const char* a2 = last ? nA : cA + (size_t)(t + 2) * kstep; const char* b2 = last ? nB : cB + (size_t)(t + 2) * kstep;
            const char* a3 = a2 + kstep; const char* b3 = b2 + kstep;
            if (last && has_next) S.a_ready(nxt);
            if constexpr (SP2) {
            PG8_LDB(B0, 0, 0); PG8_LDB(B1, 0, 1); PG8_SCHED; PG8_LDA(At, 0, 0); PG8_STAGE(PG8_SA(1, 1), a1 + hstep, voffA);
            PG8_WAIT_V(8); PG8_WAIT_L(0); PG8_BAR; PG8_MMA(0, 0, At, B0); PG8_MMA(0, 1, At, B1); PG8_BAR; PG8_SCHED;
            PG8_LDA(At, 0, 1); PG8_STAGE(PG8_SB(0, 0), b2, voffB); PG8_STAGE(PG8_SB(0, 1), b2 + hstep, voffB); PG8_STAGE(PG8_SA(0, 0), a2, voffA);
            PG8_WAIT_V(8); PG8_WAIT_L(0); PG8_BAR; PG8_MMA(1, 0, At, B0); PG8_MMA(1, 1, At, B1); PG8_BAR; PG8_SCHED;
            PG8_LDB(B0, 1, 0); PG8_LDB(B1, 1, 1); PG8_SCHED; PG8_LDA(At, 1, 0); PG8_STAGE(PG8_SA(0, 1), a2 + hstep, voffA);
            PG8_WAIT_V(8); PG8_WAIT_L(0); PG8_BAR; PG8_MMA(0, 0, At, B0); PG8_MMA(0, 1, At, B1); PG8_BAR; PG8_SCHED;
            PG8_LDA(At, 1, 1); PG8_STAGE(PG8_SB(1, 0), b3, voffB); PG8_STAGE(PG8_SB(1, 1), b3 + hstep, voffB); PG8_STAGE(PG8_SA(1, 0), a3, voffA);
            PG8_WAIT_V(8); PG8_WAIT_L(0); PG8_BAR; PG8_MMA(1, 0, At, B0); PG8_MMA(1, 1, At, B1); PG8_BAR; PG8_SCHED;
            } else {
            PG8_LDB(B0, 0, 0); PG8_SCHED; PG8_LDA(At, 0, 0); PG8_STAGE(PG8_SA(1, 1), a1 + hstep, voffA);
            PG8_WAIT_L(8); PG8_BAR; PG8_WAIT_L(0); PG8_MMA(0, 0, At, B0); PG8_BAR; PG8_SCHED;
            PG8_LDB(B1, 0, 1); PG8_STAGE(PG8_SB(0, 0), b2, voffB);
            PG8_BAR; PG8_WAIT_L(0); PG8_MMA(0, 1, At, B1); PG8_BAR;
            PG8_LDA(At, 0, 1); PG8_STAGE(PG8_SA(0, 0), a2, voffA);
            PG8_BAR; PG8_WAIT_L(0); PG8_MMA(1, 0, At, B0); PG8_BAR; PG8_SCHED;
            PG8_STAGE(PG8_SB(0, 1), b2 + hstep, voffB);
            PG8_WAIT_V(6); PG8_BAR; PG8_MMA(1, 1, At, B1); PG8_BAR;
            PG8_LDB(B0, 1, 0); PG8_SCHED; PG8_LDA(At, 1, 0); PG8_STAGE(PG8_SA(0, 1), a2 + hstep, voffA);
            PG8_WAIT_L(8); PG8_BAR; PG8_WAIT_L(0); PG8_MMA(0, 0, At, B0); PG8_BAR; PG8_SCHED;
            PG8_LDB(B1, 1, 1); PG8_STAGE(PG8_SB(1, 0), b3, voffB);
            PG8_BAR; PG8_WAIT_L(0); PG8_MMA(0, 1, At, B1); PG8_BAR;
            PG8_LDA(At, 1, 1); PG8_STAGE(PG8_SA(1, 0), a3, voffA);
            PG8_BAR; PG8_WAIT_L(0); PG8_MMA(1, 0, At, B0); PG8_BAR; PG8_SCHED;
            PG8_STAGE(PG8_SB(1, 1), b3 + hstep, voffB);
            PG8_WAIT_V(6); PG8_BAR; PG8_MMA(1, 1, At, B1); PG8_BAR;
            }
        }
        if constexpr (ALIGN_EPI) { if (wr == 0) PG8_BAR; }
        if constexpr (!Epi::AFTER_DRAIN) { E(acc, cur, wr, wc, fr, fq); S.done(cur); }
        if (!has_next) break;
#pragma unroll
        for (int a = 0; a < 2; ++a)
#pragma unroll
            for (int b = 0; b < 2; ++b)
#pragma unroll
                for (int m = 0; m < 4; ++m)
#pragma unroll
                    for (int n = 0; n < 2; ++n) acc[a][b][m][n] = (f32x4){0.f, 0.f, 0.f, 0.f};
        cur = nxt; cA = nA; cB = nB; ++ui;
        if constexpr (ALIGN_EPI) { if (wr == 1) PG8_BAR; }
    }
    PG8_WAIT_V(0);
    if constexpr (!ALIGN_EPI) { if (wr == 0) PG8_BAR; }
    PG8_BAR;
    if constexpr (Epi::AFTER_DRAIN) { E.fused(acc, cur, wr, wc, fr, fq, lds, wid, lane); S.done(cur); }
#undef PG8_SA
#undef PG8_SB
#undef PG8_STAGE
#undef PG8_LDA
#undef PG8_LDB
#undef PG8_MMA
#undef PG8_WAIT_V
#undef PG8_WAIT_L
#undef PG8_BAR
#undef PG8_SCHED
}
}
namespace pg8 {
struct EpiRes {
    static constexpr bool PERM = false, AFTER_DRAIN = false;
    const float* xp; const float* xs;
    float* out; const float* gate;
    __device__ __forceinline__ void operator()(const f32x4 (&acc)[2][2][4][2], const Unit& u, int wr, int wc, int fr, int fq) const {
        const int row0 = u.pm * BM + wr * 64 + fr, col0 = u.pn * BM + wc * 32 + 4 * fq;
        const int v = (u.pm * BM < 8192) ? 0 : 1 + ((u.pm * BM - 8192) >> 12);
        const float* g = gate + (size_t)v * 6144 + col0;
        f32x4 gv[2][2];
#pragma unroll
        for (int bj = 0; bj < 2; ++bj)
#pragma unroll
            for (int n = 0; n < 2; ++n) gv[bj][n] = *(const f32x4*)(g + bj * HALF + n * 16);
#pragma unroll
        for (int ai = 0; ai < 2; ++ai)
#pragma unroll
            for (int m = 0; m < 4; ++m) {
                const int row = row0 + ai * HALF + m * 16;
                const float* bp = (row < 8192 ? xp + (size_t)row * 1024 : xs + (size_t)(row - 8192) * 1024) + col0;
                float* op = out + (size_t)row * 1024 + col0;
#pragma unroll
                for (int bj = 0; bj < 2; ++bj)
#pragma unroll
                    for (int n = 0; n < 2; ++n) { const f32x4 b = *(const f32x4*)(bp + bj * HALF + n * 16); *(f32x4*)(op + bj * HALF + n * 16) = b + gv[bj][n] * acc[ai][bj][m][n]; }
            }
    }
};
}

constexpr int DM = 1024, TP = 8192, TSMP = 32768, TT = 40960, INW = 3072, FF = 2816, FF2 = 5632;
constexpr int NCHUNK = 320, HALF_T = 20480;
constexpr int OFF_LF = 41943040, OFF_LB = OFF_LF + 16384, OFF_RF = OFF_LB + 16384, OFF_RB = OFF_RF + 2097152;
constexpr size_t MiB = 1u << 20;
constexpr size_t WS_MOD = 0, WS_WL = 256 * 1024, WS_AGG = 1 * MiB, WS_CAR = 3 * MiB + 512 * 1024;
constexpr size_t WS_WIN = 5 * MiB, WS_WOUT = 11 * MiB, WS_WGU = 13 * MiB, WS_WD = 24 * MiB;
constexpr size_t WS_XN = 30 * MiB, WS_SB = 30 * MiB, WS_PROJ = 110 * MiB, WS_Y = 350 * MiB, WS_KVT = 430 * MiB;
constexpr size_t WS_GH = 110 * MiB, WS_U = 220 * MiB, WS_END = 510 * MiB;
constexpr int LDS_BYTES = 147456, LDSCTL_OFF = 143360;
constexpr size_t WS_BAR = 768 * 1024;
constexpr int NWAVES = 8;

#define GAS __attribute__((address_space(1)))
#define LAS __attribute__((address_space(3)))
typedef unsigned short bf16;
typedef unsigned v4u __attribute__((ext_vector_type(4)));
typedef unsigned v2u __attribute__((ext_vector_type(2)));
typedef float f32x4 __attribute__((ext_vector_type(4)));
typedef short bf16x8 __attribute__((ext_vector_type(8)));
#define LDS_WAIT() asm volatile("s_waitcnt lgkmcnt(0)" ::: "memory")
typedef float f32x2_t __attribute__((ext_vector_type(2)));
typedef __bf16 bf16x2_t __attribute__((ext_vector_type(2)));
__device__ __forceinline__ unsigned pk2(float lo, float hi) { const f32x2_t v = {lo, hi}; const bf16x2_t b = __builtin_convertvector(v, bf16x2_t); return __builtin_bit_cast(unsigned, b); }
__device__ __forceinline__ unsigned f2bf(float f) { return pk2(f, 0.f) & 0xffffu; }

__device__ __forceinline__ float bflo(unsigned w) { return __builtin_bit_cast(float, w << 16); }
__device__ __forceinline__ float bfhi(unsigned w) { return __builtin_bit_cast(float, w & 0xffff0000u); }
__device__ __forceinline__ float bf2f(unsigned short h) { return __builtin_bit_cast(float, ((unsigned)h) << 16); }
__device__ __forceinline__ float sigmoidf_(float x) { return 1.0f / (1.0f + __expf(-x)); }
__device__ __forceinline__ float siluf_(float x) { return x * __builtin_amdgcn_rcpf(1.0f + __builtin_amdgcn_exp2f(-1.4426950408889634f * x)); }
__device__ __forceinline__ float gelu_tanh(float x) { const float z = x * fmaf(0.044715f * x, x, 1.0f); return x * __builtin_amdgcn_rcpf(1.0f + __builtin_amdgcn_exp2f(-2.302208198f * z)); }

struct Args { const float* in[35]; float* out; unsigned char* ws; int ph_lo, ph_hi; };

#define XB_TMO      128
#define XB_XCNT(j)  (256  + 64 * (j))
#define XB_XSUB(j)  (1280 + 64 * (j))
#define XB_XGEN(j)  (2304 + 64 * (j))
#define XB_TOP      3328
#define XB_TOPGEN   3392
#define XCD_BAR_WORDS 3456
#define XB_SPIN_CAP (1u << 18)

__device__ __forceinline__ unsigned xb_ld(unsigned* p)              { return __hip_atomic_load(p, __ATOMIC_RELAXED, __HIP_MEMORY_SCOPE_AGENT); }
__device__ __forceinline__ unsigned xb_add(unsigned* p, unsigned v) { return __hip_atomic_fetch_add(p, v, __ATOMIC_RELAXED, __HIP_MEMORY_SCOPE_AGENT); }
__device__ __forceinline__ unsigned xb_xcc_id() { return (unsigned)__builtin_amdgcn_s_getreg((3 << 11) | 20) & 0xFu; }
#define XB_SPIN(cond, bar) do { unsigned _sp = 0; while (cond) { __builtin_amdgcn_s_sleep(1); \
    if ((++_sp & 255u) == 0u) { if (xb_ld(&(bar)[XB_TMO])) break; if (_sp > XB_SPIN_CAP) { atomicAdd(&(bar)[XB_TMO], 1u); break; } } } } while (0)

struct XcdBarrier {
    unsigned* bar; unsigned x;
    volatile LAS unsigned* st;
};

__device__ __forceinline__ XcdBarrier xcd_barrier_post(unsigned* bar, volatile LAS unsigned* st) {
    XcdBarrier b; b.bar = bar; b.x = xb_xcc_id(); b.st = st;
    if (threadIdx.x == 0) (void)xb_add(&bar[XB_XCNT(b.x)], 1u);
    return b;
}
__device__ __forceinline__ void xcd_barrier_complete(unsigned* bar, unsigned x, unsigned& nloc, unsigned& nx) {
    const unsigned G = gridDim.x * gridDim.y * gridDim.z;
    unsigned sum, cnt, mine, sp = 0u;
    for (;;) {
        sum = 0u; cnt = 0u; mine = 0u;
#pragma unroll
        for (unsigned j = 0; j < 16; ++j) { const unsigned c = xb_ld(&bar[XB_XCNT(j)]); sum += c; cnt += (c > 0u) ? 1u : 0u; mine = (j == x) ? c : mine; }
        if (sum == G) break;
        __builtin_amdgcn_s_sleep(1);
        if ((++sp & 255u) == 0u) { if (xb_ld(&bar[XB_TMO])) break; if (sp > XB_SPIN_CAP) { atomicAdd(&bar[XB_TMO], 1u); break; } }
    }
    nloc = mine > 0u ? mine : 1u; nx = cnt > 0u ? cnt : 1u;
}

__device__ __forceinline__ void xcd_barrier(const XcdBarrier& b) {
    asm volatile("s_waitcnt vmcnt(0)" ::: "memory");
    __syncthreads();
    if (threadIdx.x == 0) {
        unsigned* bar = b.bar;
        __builtin_amdgcn_s_waitcnt(0);
        unsigned nloc = b.st[0], nx = b.st[1];
        if (nloc == 0u) { xcd_barrier_complete(bar, b.x, nloc, nx); b.st[0] = nloc; b.st[1] = nx; }
        const unsigned old = xb_add(&bar[XB_XSUB(b.x)], 1u);
        const unsigned gen = old / nloc;
        if (old + 1u == (gen + 1u) * nloc) {
            __builtin_amdgcn_fence(__ATOMIC_RELEASE, "agent");
            asm volatile("s_waitcnt vmcnt(0)" ::: "memory");
            const unsigned og = xb_add(&bar[XB_TOP], 1u);
            const unsigned tg = og / nx;
            if (og + 1u == (tg + 1u) * nx) xb_add(&bar[XB_TOPGEN], 1u);
            else XB_SPIN(xb_ld(&bar[XB_TOPGEN]) == tg, bar);
            __builtin_amdgcn_fence(__ATOMIC_ACQUIRE, "agent");
            xb_add(&bar[XB_XGEN(b.x)], 1u);
            asm volatile("s_waitcnt vmcnt(0)" ::: "memory");
        } else {
            XB_SPIN(xb_ld(&bar[XB_XGEN(b.x)]) == gen, bar);
            __builtin_amdgcn_fence(__ATOMIC_ACQUIRE, "agent");
            asm volatile("s_waitcnt vmcnt(0)" ::: "memory");
        }
    }
    __syncthreads();
}
__device__ __forceinline__ float wave_sum(float v) {
#pragma unroll
    for (int o = 1; o < 64; o <<= 1) v += __shfl_xor(v, o);
    return v;
}
__device__ __forceinline__ void p0_transpose_item(const float* W, int K, int N, bf16* WT, int row_off, LAS float* scr, int item, int lane) {
    const int nblk = N / 32, kb = item / nblk, nb = item % nblk, k0 = 64 * kb, n0 = 32 * nb;
#pragma unroll 8
    for (int i = 0; i < 32; ++i) { const int kk = 2 * i + (lane >> 5); scr[kk * 33 + (lane & 31)] = W[(size_t)(k0 + kk) * N + n0 + (lane & 31)]; }
    LDS_WAIT(); asm volatile("" ::: "memory");
    const int c = lane & 7;
#pragma unroll
    for (int j = 0; j < 4; ++j) { const int n = (lane >> 3) + 8 * j; const LAS float* s = scr + (8 * c) * 33 + n;
        v4u o; o.x = pk2(s[0 * 33], s[1 * 33]); o.y = pk2(s[2 * 33], s[3 * 33]); o.z = pk2(s[4 * 33], s[5 * 33]); o.w = pk2(s[6 * 33], s[7 * 33]);
        *(v4u*)(WT + (size_t)(row_off + n0 + n) * K + k0 + 8 * c) = o; }
    LDS_WAIT(); asm volatile("" ::: "memory");
}
__device__ __forceinline__ int mod_index(int row) { return row < TP ? 0 : 1 + ((row - TP) >> 12); }

__device__ __forceinline__ void phase_prologue(const Args& a, LAS unsigned char* lds, int tid, int wave, int lane) {
    unsigned char* ws = a.ws;
    if (blockIdx.x < 96) {
        LAS float* sc = (LAS float*)lds;
        LAS float* red = (LAS float*)(lds + 9 * 1024 * 4);
        for (int i = tid; i < 9 * 1024; i += 512) { const int v = i >> 10, k = i & 1023; const float x = (v == 0) ? a.in[7][k] : a.in[6][(v - 1) * 1024 + k]; sc[i] = siluf_(x); }
        __syncthreads();
        const int col = blockIdx.x * 64 + lane;
        const float* wm = a.in[9] + col;
        float acc[9];
#pragma unroll
        for (int v = 0; v < 9; ++v) acc[v] = 0.f;
        const int kbeg = wave * 128;
#pragma unroll 8
        for (int kk = 0; kk < 128; ++kk) { const int k = kbeg + kk; const float wv = wm[(size_t)k * 6144];
#pragma unroll
            for (int v = 0; v < 9; ++v) acc[v] += sc[v * 1024 + k] * wv; }
#pragma unroll
        for (int v = 0; v < 9; ++v) red[(wave * 9 + v) * 64 + lane] = acc[v];
        __syncthreads();
        for (int i = tid; i < 9 * 64; i += 512) { const int v = i >> 6, l = i & 63; float s = 0.f;
#pragma unroll
            for (int w = 0; w < 8; ++w) s += red[(w * 9 + v) * 64 + l];
            const int cc = blockIdx.x * 64 + l; ((float*)(ws + WS_MOD))[v * 6144 + cc] = s + a.in[10][cc]; }
        __syncthreads();
    }
    LAS float* scr = (LAS float*)(lds + wave * 16384);
    const int gw = blockIdx.x * NWAVES + wave, NGW = gridDim.x * NWAVES;
    constexpr int I_IN = 16 * 96, I_OUT = 16 * 32, I_G = 16 * 88, I_D = 44 * 32, I_L = 64;
    constexpr int NITEMS = I_IN + I_OUT + 2 * I_G + I_D + I_L;
    for (int it = gw; it < NITEMS; it += NGW) {
        int r = it;
        if (r < I_IN) { p0_transpose_item(a.in[11], 1024, 3072, (bf16*)(ws + WS_WIN), 0, scr, r, lane); continue; } r -= I_IN;
        if (r < I_OUT) { p0_transpose_item(a.in[27], 1024, 1024, (bf16*)(ws + WS_WOUT), 0, scr, r, lane); continue; } r -= I_OUT;
        if (r < I_G) { p0_transpose_item(a.in[29], 1024, 2816, (bf16*)(ws + WS_WGU), 0, scr, r, lane); continue; } r -= I_G;
        if (r < I_G) { p0_transpose_item(a.in[30], 1024, 2816, (bf16*)(ws + WS_WGU), 2816, scr, r, lane); continue; } r -= I_G;
        if (r < I_D) { p0_transpose_item(a.in[33], 2816, 1024, (bf16*)(ws + WS_WD), 0, scr, r, lane); continue; } r -= I_D;
        { const int blk = r >> 1, sub = r & 1, mat = blk >> 3, nb = blk & 7;
          const float* src = (mat == 0 ? a.in[14] : mat == 1 ? a.in[16] : mat == 2 ? a.in[19] : a.in[21]) + nb * 4096;
          p0_transpose_item(src, 64, 64, (bf16*)(ws + WS_WL) + (size_t)(mat * 8 + nb) * 4096, 0, scr, sub, lane); }
    }
}

template <int MODE>
__device__ __forceinline__ void phase_rownorm(const float* xp, const float* xs, const float* w, const float* mod_scale, const float* mod_shift, bf16* obf, float* of32, int wave, int lane) {
    const int gw = blockIdx.x * NWAVES + wave, NGW = gridDim.x * NWAVES;
    f32x4 wv[4];
#pragma unroll
    for (int j = 0; j < 4; ++j) wv[j] = *(const f32x4*)(w + 4 * lane + 256 * j);
    for (int row0 = gw; row0 < TT; row0 += 2 * NGW) {
        const int row1 = row0 + NGW; const bool has1 = row1 < TT; const int r1 = has1 ? row1 : row0;
        const float* xr0 = (row0 < TP ? xp + (size_t)row0 * DM : xs + (size_t)(row0 - TP) * DM) + 4 * lane;
        const float* xr1 = (r1 < TP ? xp + (size_t)r1 * DM : xs + (size_t)(r1 - TP) * DM) + 4 * lane;
        f32x4 v0[4], v1[4]; float s0 = 0.f, s1 = 0.f;
#pragma unroll
        for (int j = 0; j < 4; ++j) { v0[j] = *(const f32x4*)(xr0 + 256 * j); v1[j] = *(const f32x4*)(xr1 + 256 * j); }
#pragma unroll
        for (int j = 0; j < 4; ++j) { s0 += (v0[j].x * v0[j].x + v0[j].y * v0[j].y) + (v0[j].z * v0[j].z + v0[j].w * v0[j].w); s1 += (v1[j].x * v1[j].x + v1[j].y * v1[j].y) + (v1[j].z * v1[j].z + v1[j].w * v1[j].w); }
        const float rs0 = 1.0f / sqrtf(wave_sum(s0) * (1.0f / DM) + 1e-6f), rs1 = 1.0f / sqrtf(wave_sum(s1) * (1.0f / DM) + 1e-6f);
#pragma unroll
        for (int k = 0; k < 2; ++k) {
            if (k == 1 && !has1) break;
            const int row = k ? row1 : row0; const float rstd = k ? rs1 : rs0;
            if (MODE == 0) {
                const int mv = mod_index(row);
                const float* sc = mod_scale + (size_t)mv * 6144 + 4 * lane; const float* sh = mod_shift + (size_t)mv * 6144 + 4 * lane;
                unsigned long long* o8 = (unsigned long long*)(obf + (size_t)row * DM) + lane;
#pragma unroll
                for (int j = 0; j < 4; ++j) { const f32x4 scv = *(const f32x4*)(sc + 256 * j), shv = *(const f32x4*)(sh + 256 * j);
                    const f32x4 y = (k ? v1[j] : v0[j]) * rstd * wv[j] * (scv + 1.0f) + shv;
                    o8[64 * j] = (unsigned long long)pk2(y.x, y.y) | ((unsigned long long)pk2(y.z, y.w) << 32); }
            } else {
                float* o = of32 + (size_t)row * DM + 4 * lane;
#pragma unroll
                for (int j = 0; j < 4; ++j) *(f32x4*)(o + 256 * j) = (k ? v1[j] : v0[j]) * rstd * wv[j];
            }
        }
    }
}
constexpr int RS = 272;
constexpr int REG = 128 * RS;
constexpr int XCS = 1040;
#define MFMA16(a, b, c) __builtin_amdgcn_mfma_f32_16x16x32_bf16((a), (b), (c), 0, 0, 0)

__device__ __forceinline__ void mm128(f32x4 (&acc)[8], const LAS unsigned char* Aimg, const LAS unsigned char* Bimg, int wave, int c, int q) {
#pragma unroll
    for (int s = 0; s < 4; ++s) {
        const bf16x8 af = *(const LAS bf16x8*)(Aimg + (16 * wave + c) * RS + (32 * s + 8 * q) * 2);
#pragma unroll
        for (int t = 0; t < 8; ++t) { const bf16x8 bfr = *(const LAS bf16x8*)(Bimg + (16 * t + c) * RS + (32 * s + 8 * q) * 2); acc[t] = MFMA16(bfr, af, acc[t]); }
    }
}
__device__ __forceinline__ void mm128x2(f32x4 (&acc1)[8], f32x4 (&acc2)[8], const LAS unsigned char* Aimg, const LAS unsigned char* B1, const LAS unsigned char* B2, int wave, int c, int q) {
#pragma unroll
    for (int s = 0; s < 4; ++s) {
        const bf16x8 af = *(const LAS bf16x8*)(Aimg + (16 * wave + c) * RS + (32 * s + 8 * q) * 2);
#pragma unroll
        for (int t = 0; t < 8; ++t) { const bf16x8 b1 = *(const LAS bf16x8*)(B1 + (16 * t + c) * RS + (32 * s + 8 * q) * 2); acc1[t] = MFMA16(b1, af, acc1[t]);
                                      const bf16x8 b2 = *(const LAS bf16x8*)(B2 + (16 * t + c) * RS + (32 * s + 8 * q) * 2); acc2[t] = MFMA16(b2, af, acc2[t]); }
    }
}
__device__ __forceinline__ void load_rm(LAS unsigned char* img, const bf16* g, int pitch, int tid) {
#pragma unroll
    for (int i = 0; i < 4; ++i) { const int p = tid + 512 * i, row = p >> 4, cp = p & 15; const v4u v = *(const v4u*)(g + (size_t)row * pitch + cp * 8); *(LAS v4u*)(img + row * RS + cp * 16) = v; }
}
#define HW(v, e) (((e) & 1) ? ((v)[(e) >> 1] >> 16) : ((v)[(e) >> 1] & 0xffffu))
__device__ __forceinline__ void load_tr(LAS unsigned char* img, const bf16* g, int pitch, int wave, int lane) {
#pragma unroll
    for (int it = 0; it < 2; ++it) { const int dg = wave + 8 * it;
        const v4u a = *(const v4u*)(g + (size_t)(2 * lane) * pitch + dg * 8), b = *(const v4u*)(g + (size_t)(2 * lane + 1) * pitch + dg * 8);
#pragma unroll
        for (int e = 0; e < 8; ++e) { const unsigned lo = HW(a, e), hi = HW(b, e); *(LAS unsigned*)(img + (dg * 8 + e) * RS + lane * 4) = lo | (hi << 16); } }
}
__device__ __forceinline__ float log_sigmoid_(float x) { return -log1pf(__expf(-x)); }

template <int PASS>
__device__ __forceinline__ void ret_item(const Args& a, LAS unsigned char* lds, int ci, int h, int tid, int wave, int lane) {
    unsigned char* ws = a.ws;
    const int c = lane & 15, q = lane >> 4;
    const bf16* PROJ = (const bf16*)(ws + WS_PROJ);
    const size_t rowbase = (size_t)ci * 128;
    const bf16* Qg = PROJ + rowbase * INW + 1024 + h * 128;
    const bf16* Kg = PROJ + rowbase * INW + 1536 + h * 128;
    const bf16* Vg = PROJ + rowbase * INW + 2048 + h * 128;
    const float lf2 = log_sigmoid_(a.in[24][h]) * 1.4426950408889634f, lb2 = log_sigmoid_(a.in[25][h]) * 1.4426950408889634f;
    const float scale = 0.08838834764831845f;
    LAS unsigned char* R1 = lds; LAS unsigned char* R2 = lds + REG; LAS unsigned char* R3 = lds + 2 * REG; LAS unsigned char* R4 = lds + 3 * REG;
    if (PASS == 1) {
        const float j0 = (float)(2 * lane), j1 = (float)(2 * lane + 1);
        const float wf0 = scale * __builtin_amdgcn_exp2f(lf2 * (127.f - j0)), wf1 = scale * __builtin_amdgcn_exp2f(lf2 * (127.f - j1)), wb0 = scale * __builtin_amdgcn_exp2f(lb2 * j0), wb1 = scale * __builtin_amdgcn_exp2f(lb2 * j1);
        load_tr(R1, Kg, INW, wave, lane);
#pragma unroll
        for (int it = 0; it < 2; ++it) { const int dg = wave + 8 * it;
            const v4u va = *(const v4u*)(Vg + (size_t)(2 * lane) * INW + dg * 8), vb = *(const v4u*)(Vg + (size_t)(2 * lane + 1) * INW + dg * 8);
#pragma unroll
            for (int e = 0; e < 8; ++e) { const float lo = bf2f((unsigned short)HW(va, e)), hi = bf2f((unsigned short)HW(vb, e));
                *(LAS unsigned*)(R2 + (dg * 8 + e) * RS + lane * 4) = pk2(lo * wf0, hi * wf1);
                *(LAS unsigned*)(R3 + (dg * 8 + e) * RS + lane * 4) = pk2(lo * wb0, hi * wb1); } }
        __syncthreads();
        f32x4 af[8], ab[8];
#pragma unroll
        for (int t = 0; t < 8; ++t) { af[t] = (f32x4){0.f, 0.f, 0.f, 0.f}; ab[t] = (f32x4){0.f, 0.f, 0.f, 0.f}; }
        mm128(af, R2, R1, wave, c, q);
        mm128(ab, R3, R1, wave, c, q);
        bf16* KVT = (bf16*)(ws + WS_KVT) + ((size_t)(ci * 4 + h) * 2) * 16384 + (16 * wave + c) * 128 + 4 * q;
#pragma unroll
        for (int t = 0; t < 8; ++t) { *(v2u*)(KVT + 16 * t) = (v2u){pk2(af[t][0], af[t][1]), pk2(af[t][2], af[t][3])};
                                      *(v2u*)(KVT + 16384 + 16 * t) = (v2u){pk2(ab[t][0], ab[t][1]), pk2(ab[t][2], ab[t][3])}; }
        __syncthreads();
    } else {
        const bf16* SB = (const bf16*)(ws + WS_SB) + ((size_t)(ci * 4 + h) * 2) * 16384;
        load_rm(R1, Qg, INW, tid);
        load_rm(R2, Kg, INW, tid);
        load_tr(R3, Vg, INW, wave, lane);
        load_rm(R4, SB, 128, tid);
        __syncthreads();
        f32x4 aS[8], aF[8];
#pragma unroll
        for (int t = 0; t < 8; ++t) { aS[t] = (f32x4){0.f, 0.f, 0.f, 0.f}; aF[t] = (f32x4){0.f, 0.f, 0.f, 0.f}; }
        mm128x2(aS, aF, R1, R2, R4, wave, c, q);
        __syncthreads();
        const int i = 16 * wave + c;
#pragma unroll
        for (int t = 0; t < 8; ++t) { float p[4];
#pragma unroll
            for (int r = 0; r < 4; ++r) { const int dl = i - (16 * t + 4 * q + r);
                const float f = dl > 0 ? __builtin_amdgcn_exp2f(lf2 * (float)dl) : (dl < 0 ? __builtin_amdgcn_exp2f(lb2 * (float)(-dl)) : 2.0f);
                p[r] = aS[t][r] * scale * f; }
            *(LAS v2u*)(R2 + i * RS + (16 * t + 4 * q) * 2) = (v2u){pk2(p[0], p[1]), pk2(p[2], p[3])}; }
        load_rm(R4, SB + 16384, 128, tid);
        __syncthreads();
        const float hf = __builtin_amdgcn_exp2f(lf2 * (float)(i + 1)), hb = __builtin_amdgcn_exp2f(lb2 * (float)(128 - i));
        f32x4 aB[8];
#pragma unroll
        for (int t = 0; t < 8; ++t) { aF[t] = aF[t] * hf; aB[t] = (f32x4){0.f, 0.f, 0.f, 0.f}; }
        mm128(aF, R2, R3, wave, c, q);
        mm128(aB, R1, R4, wave, c, q);
        f32x4 (&aO)[8] = aF;
        float s = 0.f;
#pragma unroll
        for (int t = 0; t < 8; ++t) { aO[t] = aO[t] + aB[t] * hb; s += (aO[t][0] + aO[t][1]) + (aO[t][2] + aO[t][3]); }
        s += __shfl_xor(s, 16); s += __shfl_xor(s, 32);
        const float mean = s * (1.0f / 128.0f); float v2 = 0.f;
#pragma unroll
        for (int t = 0; t < 8; ++t) { aO[t] = aO[t] - mean; v2 += (aO[t][0] * aO[t][0] + aO[t][1] * aO[t][1]) + (aO[t][2] * aO[t][2] + aO[t][3] * aO[t][3]); }
        v2 += __shfl_xor(v2, 16); v2 += __shfl_xor(v2, 32);
        const float rstd = 1.0f / sqrtf(v2 * (1.0f / 128.0f) + 1e-6f);
        const bf16* Gg = PROJ + (rowbase + i) * INW + 2560 + h * 128 + 4 * q;
        const float* gn = a.in[26] + h * 128 + 4 * q;
        bf16* Yp = (bf16*)(ws + WS_Y) + (rowbase + i) * DM + 512 + h * 128 + 4 * q;
#pragma unroll
        for (int t = 0; t < 8; ++t) { const v2u gv = *(const v2u*)(Gg + 16 * t); const f32x4 w = *(const f32x4*)(gn + 16 * t);
            const float y0 = aO[t][0] * rstd * w[0] * siluf_(bflo(gv[0])), y1 = aO[t][1] * rstd * w[1] * siluf_(bfhi(gv[0]));
            const float y2 = aO[t][2] * rstd * w[2] * siluf_(bflo(gv[1])), y3 = aO[t][3] * rstd * w[3] * siluf_(bfhi(gv[1]));
            *(v2u*)(Yp + 16 * t) = (v2u){pk2(y0, y1), pk2(y2, y3)};
            if (t & 1) asm volatile("" ::: "memory"); }
        __syncthreads();
    }
}
template <int PASS, int DIR>
__device__ __forceinline__ void lru_dir(const LAS unsigned char* xcl, const bf16x8 (&idf)[2], const bf16x8 (&wa)[2], const bf16x8 (&wx)[2], float ba, float bx, float sp8,
                                        float hc_in, float* hsp, float& Aout, float& Hout, float& edge, int c, int q, const bf16* Gp, bf16* Yp) {
    float Ac = 1.f, Hc = hc_in;
    float hn[4]; unsigned short gn[4];
    if (PASS == 3 && DIR == 1) {
#pragma unroll
        for (int r = 0; r < 4; ++r) { hn[r] = hsp[(7 * 4 + r) * 64]; gn[r] = Gp[(size_t)(16 * 7 + 4 * q + r) * INW]; }
    }
#pragma unroll 1
    for (int ti = 0; ti < 8; ++ti) {
        const int tt = DIR == 0 ? ti : 7 - ti;
        float hcur[4]; unsigned short gcur[4];
        if (PASS == 3 && DIR == 1) {
#pragma unroll
            for (int r = 0; r < 4; ++r) { hcur[r] = hn[r]; gcur[r] = gn[r]; }
            const int tn = tt > 0 ? tt - 1 : 0;
#pragma unroll
            for (int r = 0; r < 4; ++r) { hn[r] = hsp[(tn * 4 + r) * 64]; gn[r] = Gp[(size_t)(16 * tn + 4 * q + r) * INW]; }
        }
        f32x4 aI = (f32x4){0.f, 0.f, 0.f, 0.f}, aA = aI, aX = aI;
#pragma unroll
        for (int s = 0; s < 2; ++s) { const bf16x8 xf = *(const LAS bf16x8*)(xcl + (16 * tt) * XCS + 64 * s);
            aI = MFMA16(xf, idf[s], aI); aA = MFMA16(xf, wa[s], aA); aX = MFMA16(xf, wx[s], aX); }
        float av[4], uv[4];
#pragma unroll
        for (int r = 0; r < 4; ++r) {
            const float rg = __builtin_amdgcn_rcpf(1.0f + __builtin_amdgcn_exp2f(fmaf(aA[r], -1.4426950408889634f, ba)));
            const float ig = __builtin_amdgcn_rcpf(1.0f + __builtin_amdgcn_exp2f(fmaf(aX[r], -1.4426950408889634f, bx)));
            const float la = -sp8 * rg;
            const float aa = __builtin_amdgcn_exp2f(la * 1.4426950408889634f);
            const float t = -2.0f * la;
            const float ser = t * fmaf(-0.5f * t, fmaf(-0.33333334f * t, fmaf(-0.25f, t, 1.0f), 1.0f), 1.0f);
            const float om = t < 0.125f ? ser : fmaf(-aa, aa, 1.0f);
            av[r] = aa; uv[r] = __builtin_amdgcn_sqrtf(om) * (ig * aI[r]); }
        float pa[4], hl[4]; float P = 1.f, H = 0.f;
#pragma unroll
        for (int rr = 0; rr < 4; ++rr) { const int r = DIR == 0 ? rr : 3 - rr; H = av[r] * H + uv[r]; P *= av[r]; pa[r] = P; hl[r] = H; }
        float A = P, Hh = H, Ap, Hp, Ae, He, At, Ht;
        if (DIR == 0) {
            Ap = __shfl_up(A, 16); Hp = __shfl_up(Hh, 16); if (q >= 1) { Hh = A * Hp + Hh; A = Ap * A; }
            Ap = __shfl_up(A, 32); Hp = __shfl_up(Hh, 32); if (q >= 2) { Hh = A * Hp + Hh; A = Ap * A; }
            Ae = __shfl_up(A, 16); He = __shfl_up(Hh, 16); if (q == 0) { Ae = 1.f; He = 0.f; }
            At = __shfl(A, 48 + c); Ht = __shfl(Hh, 48 + c);
        } else {
            Ap = __shfl_down(A, 16); Hp = __shfl_down(Hh, 16); if (q <= 2) { Hh = A * Hp + Hh; A = Ap * A; }
            Ap = __shfl_down(A, 32); Hp = __shfl_down(Hh, 32); if (q <= 1) { Hh = A * Hp + Hh; A = Ap * A; }
            Ae = __shfl_down(A, 16); He = __shfl_down(Hh, 16); if (q == 3) { Ae = 1.f; He = 0.f; }
            At = __shfl(A, c); Ht = __shfl(Hh, c);
        }
        if (PASS == 3) {
            const float hin = Ae * Hc + He;
#pragma unroll
            for (int r = 0; r < 4; ++r) { const float hv = pa[r] * hin + hl[r];
                if (DIR == 0) hsp[(tt * 4 + r) * 64] = hv;
                else { const size_t tok = (size_t)(16 * tt + 4 * q + r); Yp[tok * DM] = (bf16)f2bf((hcur[r] + hv) * gelu_tanh(bf2f(gcur[r]))); }
                if (DIR == 0 && tt == 0 && r == 0) edge = hv;
                if (DIR == 1 && tt == 7 && r == 3) edge = hv; }
        }
        Hc = At * Hc + Ht; Ac = Ac * At;
    }
    Aout = Ac; Hout = Hc;
}

template <int PASS>
__device__ __forceinline__ void lru_item(const Args& a, LAS unsigned char* lds, int ci, int tid, int wave, int lane) {
    unsigned char* ws = a.ws;
    const int c = lane & 15, q = lane >> 4;
    const bf16* PROJ = (const bf16*)(ws + WS_PROJ);
    int seq, n, seqlen, seqtok0, nch;
    if (ci < 64) { seq = ci >> 1; n = ci & 1; seqlen = 256; seqtok0 = seq * 256; nch = 2; }
    else { seq = (ci - 64) >> 5; n = (ci - 64) & 31; seqlen = 4096; seqtok0 = TP + seq * 4096; nch = 32; }
    const bool isprompt = ci < 64;
    const int p0 = n * 128;
    {
        float w0[8], w1[8], w2[8], w3[8], bb[8];
#pragma unroll
        for (int e = 0; e < 8; ++e) { w0[e] = a.in[12][0 * 512 + 8 * lane + e]; w1[e] = a.in[12][1 * 512 + 8 * lane + e]; w2[e] = a.in[12][2 * 512 + 8 * lane + e]; w3[e] = a.in[12][3 * 512 + 8 * lane + e]; bb[e] = a.in[13][8 * lane + e]; }
        const int pb = p0 + 16 * wave;
        const bf16* base = PROJ + (size_t)seqtok0 * INW + 8 * lane;
#define LDROW(p) (((p) < 0 || (p) >= seqlen) ? (v4u){0u, 0u, 0u, 0u} : *(const v4u*)(base + (size_t)(p) * INW))
        v4u rows[19];
#pragma unroll
        for (int k = 0; k < 19; ++k) rows[k] = LDROW(pb - 2 + k);
#pragma unroll
        for (int i = 0; i < 16; ++i) {
            float o[8];
#pragma unroll
            for (int e = 0; e < 8; ++e) o[e] = bb[e] + w0[e] * bf2f((unsigned short)HW(rows[i], e)) + w1[e] * bf2f((unsigned short)HW(rows[i + 1], e)) + w2[e] * bf2f((unsigned short)HW(rows[i + 2], e)) + w3[e] * bf2f((unsigned short)HW(rows[i + 3], e));
            *(LAS v4u*)(lds + (16 * wave + i) * XCS + 16 * lane) = (v4u){pk2(o[0], o[1]), pk2(o[2], o[3]), pk2(o[4], o[5]), pk2(o[6], o[7])};
        }
#undef LDROW
    }
    __syncthreads();
    const LAS unsigned char* xcl = lds + c * XCS + (64 * wave + 8 * q) * 2;
    const bf16* WL = (const bf16*)(ws + WS_WL);
    const size_t rowbase = (size_t)seqtok0 + p0;
    for (int rt = 0; rt < 4; ++rt) {
        const int dl = 16 * rt + c, d = 64 * wave + dl;
        bf16x8 idf[2];
#pragma unroll
        for (int s = 0; s < 2; ++s)
#pragma unroll
            for (int e = 0; e < 8; ++e) idf[s][e] = (32 * s + 8 * q + e == dl) ? (short)0x3F80 : (short)0;
        float* hs = a.out + (size_t)(blockIdx.x * NWAVES + wave) * 2048 + lane;
        float Af, Hf, Ab, Hb, ef = 0.f, eb = 0.f;
        float cf = 0.f, cb = 0.f;
        if (PASS == 3) { cf = ((const float*)(ws + WS_CAR))[(size_t)(ci * 2 + 0) * 512 + d]; cb = ((const float*)(ws + WS_CAR))[(size_t)(ci * 2 + 1) * 512 + d]; }
        const bf16* Gp = PROJ + rowbase * INW + 512 + d;
        bf16* Yp = (bf16*)(ws + WS_Y) + rowbase * DM + d;
        bf16x8 waf[2], wxf[2], wab[2], wxb[2];
#pragma unroll
        for (int s2 = 0; s2 < 2; ++s2) { const int o = dl * 64 + 32 * s2 + 8 * q;
            waf[s2] = *(const bf16x8*)(WL + (size_t)(0 * 8 + wave) * 4096 + o); wxf[s2] = *(const bf16x8*)(WL + (size_t)(1 * 8 + wave) * 4096 + o);
            wab[s2] = *(const bf16x8*)(WL + (size_t)(2 * 8 + wave) * 4096 + o); wxb[s2] = *(const bf16x8*)(WL + (size_t)(3 * 8 + wave) * 4096 + o); }
        const float baf = a.in[15][d], bxf = a.in[17][d], lmf = a.in[18][d], bab = a.in[20][d], bxb = a.in[22][d], lmb = a.in[23][d];
        lru_dir<PASS, 0>(xcl, idf, waf, wxf, -1.4426950408889634f * baf, -1.4426950408889634f * bxf, 8.0f * log1pf(__expf(-lmf)), cf, hs, Af, Hf, ef, c, q, Gp, Yp);
        lru_dir<PASS, 1>(xcl, idf, wab, wxb, -1.4426950408889634f * bab, -1.4426950408889634f * bxb, 8.0f * log1pf(__expf(-lmb)), cb, hs, Ab, Hb, eb, c, q, Gp, Yp);
        if (PASS == 1) {
            if (q == 0) { float* ag = (float*)(ws + WS_AGG) + (size_t)(ci * 2) * 1024 + d; ag[0] = Af; ag[512] = Hf; ag[1024] = Ab; ag[1536] = Hb; }
        } else {
            if (isprompt && n == 0 && q == 0) a.out[OFF_LF + seq * 512 + d] = ef;
            if (isprompt && n == nch - 1 && q == 3) a.out[OFF_LB + seq * 512 + d] = eb;
        }
    }
    __syncthreads();
}

__device__ __forceinline__ void phase_carries(const Args& a, int tid) {
    unsigned char* ws = a.ws;
    const int gtid = blockIdx.x * 512 + tid, GT = gridDim.x * 512;
    for (int task = gtid; task < 655360; task += GT) {
        const int dv = task & 127, dkg = (task >> 7) & 15, dir = (task >> 11) & 1, h = (task >> 12) & 3, sq = task >> 14;
        const bool isprompt = sq >= 8; const int seq = isprompt ? sq - 8 : sq, N = isprompt ? 2 : 32, cibase = isprompt ? seq * 2 : 64 + seq * 32;
        const float g = __expf(log_sigmoid_(dir ? a.in[25][h] : a.in[24][h]) * 128.0f);
        float S[8];
        if (isprompt) {
#pragma unroll
            for (int e = 0; e < 8; ++e) S[e] = 0.f;
        } else { const float* s0 = (dir ? a.in[5] : a.in[4]) + ((size_t)(seq * 4 + h) * 128 + dkg * 8) * 128 + dv;
#pragma unroll
            for (int e = 0; e < 8; ++e) S[e] = s0[e * 128]; }
        const size_t ibase = ((size_t)h * 2 + dir) * 16384 + dv * 128 + dkg * 8;
        const bf16* kvp = (const bf16*)(ws + WS_KVT) + ibase; bf16* sbp = (bf16*)(ws + WS_SB) + ibase;
        for (int s0 = 0; s0 < N; s0 += 8) {
            v4u kv[8];
#pragma unroll
            for (int j = 0; j < 8; ++j) { const int step = s0 + j; const int n = dir ? N - 1 - step : step; const int ci = cibase + (step < N ? n : (dir ? 0 : N - 1));
                kv[j] = *(const v4u*)(kvp + (size_t)ci * 131072); }
#pragma unroll
            for (int j = 0; j < 8; ++j) { const int step = s0 + j;
                if (step < N) { const int n = dir ? N - 1 - step : step, ci = cibase + n;
                    *(v4u*)(sbp + (size_t)ci * 131072) = (v4u){pk2(S[0], S[1]), pk2(S[2], S[3]), pk2(S[4], S[5]), pk2(S[6], S[7])};
#pragma unroll
                    for (int e2 = 0; e2 < 8; ++e2) S[e2] = g * S[e2] + bf2f((unsigned short)HW(kv[j], e2)); } }
        }
        if (isprompt) { float* o = a.out + (dir ? OFF_RB : OFF_RF) + ((size_t)(seq * 4 + h) * 128 + dkg * 8) * 128 + dv;
#pragma unroll
            for (int e = 0; e < 8; ++e) o[e * 128] = S[e]; }
    }
    for (int task = gtid; task < 40960; task += GT) {
        const int d = task & 511, dir = (task >> 9) & 1, sq = task >> 10;
        const bool isprompt = sq >= 8; const int seq = isprompt ? sq - 8 : sq, N = isprompt ? 2 : 32, cibase = isprompt ? seq * 2 : 64 + seq * 32;
        float hcar = isprompt ? 0.f : (dir ? a.in[3] : a.in[2])[seq * 512 + d];
        for (int step = 0; step < N; ++step) {
            const int n = dir ? N - 1 - step : step, ci = cibase + n;
            ((float*)(ws + WS_CAR))[(size_t)(ci * 2 + dir) * 512 + d] = hcar;
            const float* ag = (const float*)(ws + WS_AGG) + ((size_t)(ci * 2 + dir) * 2) * 512 + d;
            hcar = ag[0] * hcar + ag[512];
        }
    }
}

__device__ __forceinline__ v4u ldg16(const bf16* p, bool ok) { return ok ? *(const v4u*)p : (v4u){0u, 0u, 0u, 0u}; }
__device__ __forceinline__ void phase_act(const Args& a, int half, int wave, int lane) {
    unsigned char* ws = a.ws;
    const bf16* __restrict__ GH = (const bf16*)(ws + WS_GH);
    bf16* __restrict__ U = (bf16*)(ws + WS_U);
    const int gw = blockIdx.x * NWAVES + wave, NGW = gridDim.x * NWAVES;
    const int p = lane >> 5;
    for (int wt = gw; wt < 7040; wt += NGW) {
        const int slab = wt % 11; int r = wt / 11;
        int tok0, ts, lat, steps0, nwalk;
        bool isimg;
        if (half == 1 || r >= 256) {
            if (half == 0) r -= 256;
            const int pair = r & 31, seg = (r >> 5) & 3, img = (r >> 7) + (half == 0 ? 0 : 3);
            const int gc = 2 * pair + p; steps0 = 16 * seg; nwalk = 64; ts = 64; lat = 1; isimg = true;
            tok0 = TP + img * 4096 + steps0 * 64 + gc;
        } else {
            const int sp = r & 7, seq = r >> 3; steps0 = 32 * sp + 16 * p; nwalk = 256; ts = 1; lat = 0; isimg = false;
            tok0 = seq * 256 + steps0;
        }
        const int ch0 = (slab * 32 + (lane & 31)) * 8;
        const int gcol = isimg ? (tok0 & 63) : 1;
        const bool okl = isimg && gcol > 0, okr = isimg && gcol < 63;
        float wk[9][8], bb[8];
#pragma unroll
        for (int k = 0; k < 9; ++k) { const int aa = k / 3, b = k % 3;
            const int src = isimg ? k : (3 + aa);
            const f32x4 x0 = *(const f32x4*)(a.in[31] + (size_t)src * FF + ch0), x1 = *(const f32x4*)(a.in[31] + (size_t)src * FF + ch0 + 4);
            const float z = (isimg || b == 1) ? 1.f : 0.f;
            wk[k][0] = x0[0] * z; wk[k][1] = x0[1] * z; wk[k][2] = x0[2] * z; wk[k][3] = x0[3] * z; wk[k][4] = x1[0] * z; wk[k][5] = x1[1] * z; wk[k][6] = x1[2] * z; wk[k][7] = x1[3] * z; }
        { const f32x4 x0 = *(const f32x4*)(a.in[32] + ch0), x1 = *(const f32x4*)(a.in[32] + ch0 + 4); bb[0] = x0[0]; bb[1] = x0[1]; bb[2] = x0[2]; bb[3] = x0[3]; bb[4] = x1[0]; bb[5] = x1[1]; bb[6] = x1[2]; bb[7] = x1[3]; }
        const bf16* gp = GH + (size_t)(tok0 - half * HALF_T) * FF + ch0;
        bf16* up = U + (size_t)tok0 * FF + ch0;
        const size_t gs = (size_t)ts * FF;
        v4u w0[3], w1[3], w2[3], w3[3];
        { const bool okp = steps0 > 0;
          w0[0] = ldg16(gp - gs - FF, okp && okl); w0[1] = ldg16(gp - gs, okp); w0[2] = ldg16(gp - gs + FF, okp && okr);
          w1[0] = ldg16(gp - FF, okl); w1[1] = *(const v4u*)gp; w1[2] = ldg16(gp + FF, okr); }
#pragma unroll 1
        for (int st = 0; st < 16; st += 2) {
            const bool ok2 = steps0 + st + 1 < nwalk, ok3 = steps0 + st + 2 < nwalk;
            const bf16* g2 = gp + (size_t)(st + 1) * gs; const bf16* g3 = g2 + gs;
            w2[0] = ldg16(g2 - FF, ok2 && okl); w2[1] = ldg16(g2, ok2); w2[2] = ldg16(g2 + FF, ok2 && okr);
            w3[0] = ldg16(g3 - FF, ok3 && okl); w3[1] = ldg16(g3, ok3); w3[2] = ldg16(g3 + FF, ok3 && okr);
            bf16* u0 = up + (size_t)st * gs; bf16* u1 = u0 + gs;
            const v4u uv0 = *(const v4u*)u0, uv1 = *(const v4u*)u1;
            float acc0[8], acc1[8];
#pragma unroll
            for (int e = 0; e < 8; ++e) { acc0[e] = bb[e]; acc1[e] = bb[e]; }
#pragma unroll
            for (int b = 0; b < 3; ++b)
#pragma unroll
                for (int e = 0; e < 8; ++e) {
                    acc0[e] += wk[0 + b][e] * bf2f((unsigned short)HW(w0[b], e)) + wk[3 + b][e] * bf2f((unsigned short)HW(w1[b], e)) + wk[6 + b][e] * bf2f((unsigned short)HW(w2[b], e));
                    acc1[e] += wk[0 + b][e] * bf2f((unsigned short)HW(w1[b], e)) + wk[3 + b][e] * bf2f((unsigned short)HW(w2[b], e)) + wk[6 + b][e] * bf2f((unsigned short)HW(w3[b], e)); }
            float o0[8], o1[8];
#pragma unroll
            for (int e = 0; e < 8; ++e) { o0[e] = gelu_tanh(acc0[e]) * bf2f((unsigned short)HW(uv0, e)); o1[e] = gelu_tanh(acc1[e]) * bf2f((unsigned short)HW(uv1, e)); }
            *(v4u*)u0 = (v4u){pk2(o0[0], o0[1]), pk2(o0[2], o0[3]), pk2(o0[4], o0[5]), pk2(o0[6], o0[7])};
            *(v4u*)u1 = (v4u){pk2(o1[0], o1[1]), pk2(o1[2], o1[3]), pk2(o1[4], o1[5]), pk2(o1[6], o1[7])};
#pragma unroll
            for (int b = 0; b < 3; ++b) { w0[b] = w2[b]; w1[b] = w3[b]; }
        }
    }
}
template <int PASS>
__device__ __forceinline__ void phase_mixer(const Args& a, LAS unsigned char* lds, int tid, int wave, int lane) {
    unsigned* ctr = (unsigned*)(a.ws + WS_BAR) + (PASS == 1 ? 3584 : 3648);
    volatile LAS int* slot = (volatile LAS int*)(lds + LDSCTL_OFF + 256);
    for (;;) {
        if (tid == 0) *slot = (int)__hip_atomic_fetch_add(ctr, 1u, __ATOMIC_RELAXED, __HIP_MEMORY_SCOPE_AGENT);
        __syncthreads();
        const int it = *slot;
        if (it >= NCHUNK + 4 * NCHUNK) break;
        asm volatile("" : "+v"(tid), "+v"(lane));
        if (it < NCHUNK) lru_item<PASS>(a, lds, it, tid, wave, lane);
        else { const int r = it - NCHUNK; ret_item<PASS>(a, lds, r >> 2, r & 3, tid, wave, lane); }
    }
}

__global__ void __launch_bounds__(512, 2) fwd(Args a) {
    extern __shared__ __attribute__((aligned(16))) unsigned char lds_raw[];
    LAS unsigned char* lds = (LAS unsigned char*)lds_raw;
    unsigned char* ws = a.ws;
    { cg::grid_group grid = cg::this_grid(); grid.sync(); }
    int tid = threadIdx.x, lane = tid & 63; const int wave = __builtin_amdgcn_readfirstlane(tid >> 6);
#define FRESH() do { tid = threadIdx.x; asm volatile("" : "+v"(tid)); lane = tid & 63; } while (0)
    for (int u = tid; u < (LDS_BYTES - LDSCTL_OFF) / 4; u += 512) ((LAS unsigned*)(lds + LDSCTL_OFF))[u] = 0u;
    __syncthreads();
    const XcdBarrier bar = xcd_barrier_post((unsigned*)(ws + WS_BAR), (volatile LAS unsigned*)(lds + LDSCTL_OFF + 64));
    const float* MOD = (const float*)(ws + WS_MOD);
    const int G = gridDim.x;
    const int lo = a.ph_lo, hi = a.ph_hi;
#ifndef PHMASK
#define PHMASK 0xffff
#endif
#define IN(k) ((((PHMASK) >> (k)) & 1) && lo <= (k) && (k) < hi)
#ifndef REPMASK
#define REPMASK 0u
#endif
#define NREP(k) ((((REPMASK) >> (k)) & 1u) ? 2 : 1)
#define SEAM(k) do { if (IN(k) && IN((k) + 1)) xcd_barrier(bar); } while (0)
    FRESH();
    for (int rep = 0; rep < NREP(0); ++rep) if (IN(0)) phase_prologue(a, lds, tid, wave, lane);
    SEAM(0);
    FRESH();
    for (int rep = 0; rep < NREP(1); ++rep) if (IN(1)) phase_rownorm<0>(a.in[0], a.in[1], a.in[8], MOD + 1024, MOD + 0, (bf16*)(ws + WS_XN), nullptr, wave, lane);
    SEAM(1);
    FRESH();
    for (int rep = 0; rep < NREP(2); ++rep) if (IN(2)) { pg8::Gemm g{(const bf16*)(ws + WS_XN), (const bf16*)(ws + WS_WIN), TT, INW, DM}; pg8::StaticOrder S; S.init(TT, INW, G, (int)blockIdx.x);
        pg8::EpiBf16<0> E{(bf16*)(ws + WS_PROJ), INW, nullptr, 0, 0, 1.f};
        pg8::gemm_phase<pg8::EpiBf16<0>, pg8::StaticOrder, true, true>(lds, g, S, E); }
    SEAM(2);
    FRESH();
    for (int rep = 0; rep < NREP(3); ++rep) if (IN(3)) phase_mixer<1>(a, lds, tid, wave, lane);
    SEAM(3);
    FRESH();
    for (int rep = 0; rep < NREP(4); ++rep) if (IN(4)) phase_carries(a, tid);
    SEAM(4);
    FRESH();
    for (int rep = 0; rep < NREP(5); ++rep) if (IN(5)) phase_mixer<3>(a, lds, tid, wave, lane);
    SEAM(5);
    FRESH();
    for (int rep = 0; rep < NREP(6); ++rep) if (IN(6)) { pg8::Gemm g{(const bf16*)(ws + WS_Y), (const bf16*)(ws + WS_WOUT), TT, DM, DM}; pg8::StaticOrder S; S.init(TT, DM, G, (int)blockIdx.x);
        pg8::EpiRes E{a.in[0], a.in[1], a.out, MOD + 2048};
        pg8::gemm_phase<pg8::EpiRes, pg8::StaticOrder, true, true>(lds, g, S, E); }
    SEAM(6);
    FRESH();
    for (int rep = 0; rep < NREP(7); ++rep) if (IN(7)) phase_rownorm<0>(a.out, a.out + (size_t)TP * DM, a.in[28], MOD + 4096, MOD + 3072, (bf16*)(ws + WS_XN), nullptr, wave, lane);
    SEAM(7);
#pragma unroll
    for (int half = 0; half < 2; ++half) {
        FRESH();
        if (IN(8 + 2 * half)) { pg8::Gemm g{(const bf16*)(ws + WS_XN) + (size_t)half * HALF_T * DM, (const bf16*)(ws + WS_WGU), HALF_T, FF2, DM}; pg8::StaticOrder S; S.init(HALF_T, FF2, G, (int)blockIdx.x);
            pg8::EpiBf16<0> E{(bf16*)(ws + WS_GH), FF, nullptr, FF, (size_t)((WS_U - WS_GH) / 2) + (size_t)half * HALF_T * FF, 1.f};
            pg8::gemm_phase<pg8::EpiBf16<0>, pg8::StaticOrder, true, true>(lds, g, S, E); }
        SEAM(8 + 2 * half);
        FRESH();
        if (IN(9 + 2 * half)) phase_act(a, half, wave, lane);
        SEAM(9 + 2 * half);
    }
    FRESH();
    for (int rep = 0; rep < NREP(12); ++rep) if (IN(12)) { pg8::Gemm g{(const bf16*)(ws + WS_U), (const bf16*)(ws + WS_WD), TT, DM, FF}; pg8::StaticOrder S; S.init(TT, DM, G, (int)blockIdx.x);
        pg8::EpiRes E{a.out, a.out + (size_t)TP * DM, a.out, MOD + 5120};
        pg8::gemm_phase<pg8::EpiRes, pg8::StaticOrder, true, true>(lds, g, S, E); }
    SEAM(12);
    FRESH();
    if (IN(13)) phase_rownorm<1>(a.out, a.out + (size_t)TP * DM, a.in[34], nullptr, nullptr, nullptr, a.out, wave, lane);
#undef IN
#undef SEAM
}

extern "C" void kernel_launch(void* const* d_in, const int* in_sizes, int n_in, void* d_out, int out_size,
                              void* d_ws, size_t ws_size, hipStream_t stream) {
    static int grid = 0;
    if (grid == 0) {
        int dev = 0, cus = 0, per_cu = 0;
        hipGetDevice(&dev);
        hipDeviceGetAttribute(&cus, hipDeviceAttributeMultiprocessorCount, dev);
        hipFuncSetAttribute((const void*)fwd, hipFuncAttributeMaxDynamicSharedMemorySize, LDS_BYTES);
        hipOccupancyMaxActiveBlocksPerMultiprocessor(&per_cu, (const void*)fwd, 512, LDS_BYTES);
        if (per_cu < 1) per_cu = 1;
        grid = cus * per_cu;
        if (n_in != 35 || ws_size < WS_END) fprintf(stderr, "kernel_launch: unexpected n_in %d / ws_size %zu\n", n_in, ws_size);
    }
    if (hipMemsetAsync((char*)d_ws + WS_BAR, 0, 16384, stream) != hipSuccess) fprintf(stderr, "kernel_launch: memset failed\n");
    Args a{};
    for (int i = 0; i < 35; ++i) a.in[i] = (const float*)d_in[i];
    a.out = (float*)d_out; a.ws = (unsigned char*)d_ws; a.ph_lo = 0; a.ph_hi = 14;
    void* args[] = {&a};
    hipError_t e = hipLaunchCooperativeKernel((const void*)fwd, dim3(grid), dim3(512), args, LDS_BYTES, stream);
    if (e != hipSuccess) fprintf(stderr, "cooperative launch failed: %s (grid %d)\n", hipGetErrorString(e), grid);
}
```

```cpp
#include <hip/hip_runtime.h>
#include <hip/hip_cooperative_groups.h>
#include <cstdio>
#include <cstdint>
namespace cg = cooperative_groups;
namespace pg8 {
#define PG8_LAS __attribute__((address_space(3)))
typedef unsigned short bf16_t;
typedef short bf16x8 __attribute__((ext_vector_type(8)));
typedef float f32x4 __attribute__((ext_vector_type(4)));
typedef unsigned u32x4 __attribute__((ext_vector_type(4)));
constexpr int BM = 256, BK = 64, HALF = 128, HTB = HALF * BK * 2  , STAGE_BYTES = 8 * HTB, NXCD = 8, WGM = 8;

__host__ __device__ __forceinline__ int lds_byte(int r, int c) { const int st = (r >> 4) * 2 + (c >> 5), rr = r & 15, cc = c & 31, ob = rr * 64 + cc * 2; return st * 1024 + (ob ^ (((ob >> 9) & 1) << 5)); }
__host__ __device__ __forceinline__ void stage_rc(int b, int& R, int& C) { const int st = b / 1024, sb = b % 1024, swz = sb ^ (((sb >> 9) & 1) << 5); R = (st >> 1) * 16 + swz / 64; C = (st & 1) * 32 + (swz % 64) / 2; }
__host__ __device__ __forceinline__ int perm32(int rho) { const int n = rho >> 4, i = rho & 15; return 8 * (i >> 2) + 4 * n + (i & 3); }

struct Unit { int pm, pn; };
struct Gemm { const bf16_t* A; const bf16_t* Bt; int M, N, K; };

struct StaticOrder {
    int nM, nN, nwg, G, c;
    __host__ __device__ void init(int M, int N, int G_, int c_) { nM = M / BM; nN = N / BM; nwg = nM * nN; G = G_; c = c_; }
    __host__ __device__ bool next(int i, Unit& u) const {
        const long L = (long)i * G + c; if (L >= nwg) return false;
        int wgid = (int)L; { const int q = nwg / NXCD, r = nwg % NXCD, xcd = wgid % NXCD, off = wgid / NXCD; wgid = (xcd < r ? xcd * (q + 1) : r * (q + 1) + (xcd - r) * q) + off; }
        const int nig = WGM * nN, gid = wgid / nig, fm = gid * WGM, gsz = (nM - fm) < WGM ? (nM - fm) : WGM;
        u.pm = fm + ((wgid % nig) % gsz); u.pn = (wgid % nig) / gsz; return true;
    }
    __device__ __forceinline__ void a_ready(const Unit&) const {}
    __device__ __forceinline__ void done(const Unit&) const {}
};

__device__ __forceinline__ unsigned cvt_pk_bf16(float lo, float hi) { unsigned r; asm volatile("v_cvt_pk_bf16_f32 %0, %1, %2" : "=v"(r) : "v"(lo), "v"(hi)); return r; }
typedef float f32x2 __attribute__((ext_vector_type(2)));
__device__ __forceinline__ f32x2 gelu_pk(f32x2 v) {
    const f32x2 av = __builtin_elementwise_abs(v), d = av * 0.2316418882f + 1.0f;
    f32x2 t; t.x = __builtin_amdgcn_rcpf(d.x); t.y = __builtin_amdgcn_rcpf(d.y);
    f32x2 q = t * 0.5307027145f + (-0.7265760135f); q = q * t + 0.7107068705f; q = q * t + (-0.142248368f); q = q * t + 0.127414796f; q = q * t;
    const f32x2 s = (v * v) * (-0.72134752044f);
    f32x2 e; e.x = __builtin_amdgcn_exp2f(s.x); e.y = __builtin_amdgcn_exp2f(s.y);
    const f32x2 m = v * (q * e), r = v - m;
    f32x2 o; o.x = v.x < 0.f ? m.x : r.x; o.y = v.y < 0.f ? m.y : r.y; return o;
}

template <int ACT  > struct EpiBf16 {
    static constexpr bool PERM = true, AFTER_DRAIN = false; static_assert(ACT == 0 || ACT == 1, "EpiBf16: ACT is 0 (none) or 1 (gelu_pk)");
    bf16_t* O; int ldc; const float* bias; int split_cols; size_t split_stride; float scale0;
    __device__ __forceinline__ void operator()(const f32x4 (&acc)[2][2][4][2], const Unit& u, int wr, int wc, int fr, int fq) const {
        const int row0 = u.pm * BM + wr * 64 + fr; int colt = u.pn * BM; bf16_t* base = O;
        float sc = 1.f; if (split_cols) { const int t = colt / split_cols; base += (size_t)t * split_stride; colt -= t * split_cols; if (t == 0) sc = scale0; }
        const int col0 = colt + wc * 32 + 8 * fq, bcol0 = u.pn * BM + wc * 32 + 8 * fq;
        f32x4 bv[2][2];
#pragma unroll
        for (int bj = 0; bj < 2; ++bj)
#pragma unroll
            for (int n = 0; n < 2; ++n) bv[bj][n] = bias ? *(const f32x4*)(bias + bcol0 + bj * HALF + 4 * n) : (f32x4){0.f, 0.f, 0.f, 0.f};
#pragma unroll
        for (int ai = 0; ai < 2; ++ai)
#pragma unroll
            for (int m = 0; m < 4; ++m) { bf16_t* rowp = base + (size_t)(row0 + ai * HALF + m * 16) * ldc + col0;
#pragma unroll
                for (int bj = 0; bj < 2; ++bj) { f32x4 v0 = acc[ai][bj][m][0] + bv[bj][0], v1 = acc[ai][bj][m][1] + bv[bj][1];
                    if (ACT == 1) { f32x2 a = gelu_pk((f32x2){v0[0], v0[1]}), b = gelu_pk((f32x2){v0[2], v0[3]}), c = gelu_pk((f32x2){v1[0], v1[1]}), d = gelu_pk((f32x2){v1[2], v1[3]});
                        v0 = (f32x4){a.x, a.y, b.x, b.y}; v1 = (f32x4){c.x, c.y, d.x, d.y}; }
                    v0 = v0 * sc; v1 = v1 * sc; u32x4 w; w.x = cvt_pk_bf16(v0[0], v0[1]); w.y = cvt_pk_bf16(v0[2], v0[3]); w.z = cvt_pk_bf16(v1[0], v1[1]); w.w = cvt_pk_bf16(v1[2], v1[3]);
                    *(u32x4*)(rowp + bj * HALF) = w; } }
    }
};
template <class Epi, class Sched, bool ALIGN_EPI = false, bool SP2 = false>
__device__ __forceinline__ void gemm_phase(PG8_LAS unsigned char* lds, const Gemm g, const Sched& S, const Epi& E) {
    int tid_ = threadIdx.x; asm volatile("" : "+v"(tid_));
    const int tid = tid_, wid = __builtin_amdgcn_readfirstlane(tid >> 6), lane = tid & 63, wr = wid >> 2, wc = wid & 3, fr = lane & 15, fq = lane >> 4;
    const int K = g.K, nt = K / BK;
    unsigned voffA[2], voffB[2];
#pragma unroll
    for (int i = 0; i < 2; ++i) { int R, C; stage_rc(tid * 16 + i * 8192, R, C); const int Rb = Epi::PERM ? ((R & ~31) + perm32(R & 31)) : R;
        voffA[i] = (unsigned)(R * K + C) * 2u; voffB[i] = (unsigned)(Rb * K + C) * 2u; }
    const size_t kstep = (size_t)(BK * 2);
    const size_t hstep = (size_t)HALF * K * 2;
    const size_t tstep = 2 * hstep;
    const unsigned ldsw = (unsigned)wid * 1024u;
    const int aoff = lds_byte(wr * 64 + fr, fq * 8), boff = lds_byte(wc * 32 + fr, fq * 8);
#define PG8_SA(b, h) (((b) * 2 + (h)) * HTB)
#define PG8_SB(b, h) ((4 + (b) * 2 + (h)) * HTB)
#define PG8_STAGE(bufoff, gbase, voff) do { _Pragma("unroll") for (int _i = 0; _i < 2; ++_i) \
        __builtin_amdgcn_global_load_lds((const unsigned*)((const char*)(gbase) + (voff)[_i]), (PG8_LAS unsigned*)(lds + (bufoff) + ldsw + _i * 8192), 16, 0, 0); } while (0)
#define PG8_LDA(dst, b, h) do { _Pragma("unroll") for (int m = 0; m < 4; ++m) _Pragma("unroll") for (int k = 0; k < 2; ++k) dst[m][k] = *(const PG8_LAS bf16x8*)(lds + PG8_SA(b, h) + aoff + m * 2048 + k * 1024); } while (0)
#define PG8_LDB(dst, b, h) do { _Pragma("unroll") for (int n = 0; n < 2; ++n) _Pragma("unroll") for (int k = 0; k < 2; ++k) dst[n][k] = *(const PG8_LAS bf16x8*)(lds + PG8_SB(b, h) + boff + n * 2048 + k * 1024); } while (0)
#define PG8_MMA(ai, bj, At, Bt) do { __builtin_amdgcn_s_setprio(1); _Pragma("unroll") for (int m = 0; m < 4; ++m) _Pragma("unroll") for (int n = 0; n < 2; ++n) _Pragma("unroll") for (int k = 0; k < 2; ++k) \
        acc[ai][bj][m][n] = __builtin_amdgcn_mfma_f32_16x16x32_bf16(Bt[n][k], At[m][k], acc[ai][bj][m][n], 0, 0, 0); __builtin_amdgcn_s_setprio(0); } while (0)
#define PG8_WAIT_V(n) asm volatile("s_waitcnt vmcnt(" #n ")" ::: "memory")
#define PG8_WAIT_L(n) asm volatile("s_waitcnt lgkmcnt(" #n ")" ::: "memory")
#define PG8_BAR __builtin_amdgcn_s_barrier()
#define PG8_SCHED __builtin_amdgcn_sched_barrier(0)
    Unit cur, nxt; int ui = 0;
    if (!S.next(0, cur)) return;
    f32x4 acc[2][2][4][2];
#pragma unroll
    for (int a = 0; a < 2; ++a)
#pragma unroll
        for (int b = 0; b < 2; ++b)
#pragma unroll
            for (int m = 0; m < 4; ++m)
#pragma unroll
                for (int n = 0; n < 2; ++n) acc[a][b][m][n] = (f32x4){0.f, 0.f, 0.f, 0.f};
    bf16x8 At[4][2], B0[2][2], B1[2][2];
    const char* cA = (const char*)g.A + (size_t)cur.pm * tstep; const char* cB = (const char*)g.Bt + (size_t)cur.pn * tstep;
    S.a_ready(cur);
    if constexpr (SP2) {
        PG8_STAGE(PG8_SB(0, 0), cB, voffB); PG8_STAGE(PG8_SB(0, 1), cB + hstep, voffB); PG8_STAGE(PG8_SA(0, 0), cA, voffA); PG8_STAGE(PG8_SA(0, 1), cA + hstep, voffA);
        if (wr == 1) PG8_BAR;
        PG8_WAIT_V(2); PG8_BAR;
        PG8_STAGE(PG8_SB(1, 0), cB + kstep, voffB); PG8_STAGE(PG8_SA(1, 0), cA + kstep, voffA); PG8_STAGE(PG8_SB(1, 1), cB + hstep + kstep, voffB);
        PG8_WAIT_V(6); PG8_BAR;
    } else {
        PG8_STAGE(PG8_SB(0, 0), cB, voffB); PG8_STAGE(PG8_SA(0, 0), cA, voffA); PG8_STAGE(PG8_SB(0, 1), cB + hstep, voffB); PG8_STAGE(PG8_SA(0, 1), cA + hstep, voffA);
        if (wr == 1) PG8_BAR;
        PG8_WAIT_V(4); PG8_BAR;
        PG8_STAGE(PG8_SB(1, 0), cB + kstep, voffB); PG8_STAGE(PG8_SA(1, 0), cA + kstep, voffA); PG8_STAGE(PG8_SB(1, 1), cB + hstep + kstep, voffB);
        PG8_WAIT_V(6); PG8_BAR;
    }
    for (;;) {
        const bool has_next = S.next(ui + 1, nxt);
        const char* nA = has_next ? (const char*)g.A + (size_t)nxt.pm * tstep : cA; const char* nB = has_next ? (const char*)g.Bt + (size_t)nxt.pn * tstep : cB;
        for (int t = 0; t < nt; t += 2) {
            const bool last = (t == nt - 2);
            const char* a1 = cA + (size_t)(t + 1) * kstep;
            const char* a2 = last ? nA : cA + (size_t)(t + 2) * kstep; const char* b2 = last ? nB : cB + (size_t)(t + 2) * kstep;
            const char* a3 = a2 + kstep; const char* b3 = b2 + kstep;
            if (last && has_next) S.a_ready(nxt);
            if constexpr (SP2) {
            PG8_LDB(B0, 0, 0); PG8_LDB(B1, 0, 1); PG8_SCHED; PG8_LDA(At, 0, 0); PG8_STAGE(PG8_SA(1, 1), a1 + hstep, voffA);
            PG8_WAIT_V(8); PG8_WAIT_L(0); PG8_BAR; PG8_MMA(0, 0, At, B0); PG8_MMA(0, 1, At, B1); PG8_BAR; PG8_SCHED;
            PG8_LDA(At, 0, 1); PG8_STAGE(PG8_SB(0, 0), b2, voffB); PG8_STAGE(PG8_SB(0, 1), b2 + hstep, voffB); PG8_STAGE(PG8_SA(0, 0), a2, voffA);
            PG8_WAIT_V(8); PG8_WAIT_L(0); PG8_BAR; PG8_MMA(1, 0, At, B0); PG8_MMA(1, 1, At, B1); PG8_BAR; PG8_SCHED;
            PG8_LDB(B0, 1, 0); PG8_LDB(B1, 1, 1); PG8_SCHED; PG8_LDA(At, 1, 0); PG8_STAGE(PG8_SA(0, 1), a2 + hstep, voffA);
            PG8_WAIT_V(8); PG8_WAIT_L(0); PG8_BAR; PG8_MMA(0, 0, At, B0); PG8_MMA(0, 1, At, B1); PG8_BAR; PG8_SCHED;
            PG8_LDA(At, 1, 1); PG8_STAGE(PG8_SB(1, 0), b3, voffB); PG8_STAGE(PG8_SB(1, 1), b3 + hstep, voffB); PG8_STAGE(PG8_SA(1, 0), a3, voffA);
            PG8_WAIT_V(8); PG8_WAIT_L(0); PG8_BAR; PG8_MMA(1, 0, At, B0); PG8_MMA(1, 1, At, B1); PG8_BAR; PG8_SCHED;
            } else {
            PG8_LDB(B0, 0, 0); PG8_SCHED; PG8_LDA(At, 0, 0); PG8_STAGE(PG8_SA(1, 1), a1 + hstep, voffA);
            PG8_WAIT_L(8); PG8_BAR; PG8_WAIT_L(0); PG8_MMA(0, 0, At, B0); PG8_BAR; PG8_SCHED;
            PG8_LDB(B1, 0, 1); PG8_STAGE(PG8_SB(0, 0), b2, voffB);
            PG8_BAR; PG8_WAIT_L(0); PG8_MMA(0, 1, At, B1); PG8_BAR;
            PG8_LDA(At, 0, 1); PG8_STAGE(PG8_SA(0, 0), a2, voffA);
            PG8_BAR; PG8_WAIT_L(0); PG8_MMA(1, 0, At, B0); PG8_BAR; PG8_SCHED;
            PG8_STAGE(PG8_SB(0, 1), b2 + hstep, voffB);
            PG8_WAIT_V(6); PG8_BAR; PG8_MMA(1, 1, At, B1); PG8_BAR;
            PG8_LDB(B0, 1, 0); PG8_SCHED; PG8_LDA(At, 1, 0); PG8_STAGE(PG8_SA(0, 1), a2 + hstep, voffA);
            PG8_WAIT_L(8); PG8_BAR; PG8_WAIT_L(0); PG8_MMA(0, 0, At, B0); PG8_BAR; PG8_SCHED;
            PG8_LDB(B1, 1, 1); PG8_STAGE(PG8_SB(1, 0), b3, voffB);
            PG8_BAR; PG8_WAIT_L(0); PG8_MMA(0, 1, At, B1); PG8_BAR;
            PG8_LDA(At, 1, 1); PG8_STAGE(PG8_SA(1, 0), a3, voffA);
            PG8_BAR; PG8_WAIT_L(0); PG8_MMA(1, 0, At, B0); PG8_BAR; PG8_SCHED;
            PG8_STAGE(PG8_SB(1, 1), b3 + hstep, voffB);
            PG8_WAIT_V(6); PG8_BAR; PG8_MMA(1, 1, At, B1); PG8_BAR;
            }
        }
        if constexpr (ALIGN_EPI) { if (wr == 0) PG8_BAR; }
        if constexpr (!Epi::AFTER_DRAIN) { E(acc, cur, wr, wc, fr, fq); S.done(cur); }
        if (!has_next) break;
#pragma unroll
        for (int a = 0; a < 2; ++a)
#pragma unroll
            for (int b = 0; b < 2; ++b)
#pragma unroll
                for (int m = 0; m < 4; ++m)
#pragma unroll
                    for (int n = 0; n < 2; ++n) acc[a][b][m][n] = (f32x4){0.f, 0.f, 0.f, 0.f};
        cur = nxt; cA = nA; cB = nB; ++ui;
        if constexpr (ALIGN_EPI) { if (wr == 1) PG8_BAR; }
    }
    PG8_WAIT_V(0);
    if constexpr (!ALIGN_EPI) { if (wr == 0) PG8_BAR; }
    PG8_BAR;
    if constexpr (Epi::AFTER_DRAIN) { E.fused(acc, cur, wr, wc, fr, fq, lds, wid, lane); S.done(cur); }
#undef PG8_SA
#undef PG8_SB
#undef PG8_STAGE
#undef PG8_LDA
#undef PG8_LDB
#undef PG8_MMA
#undef PG8_WAIT_V
#undef PG8_WAIT_L
#undef PG8_BAR
#undef PG8_SCHED
}
}
namespace pg8 {
struct EpiRes {
    static constexpr bool PERM = false, AFTER_DRAIN = false;
    const float* xp; const float* xs;
    float* out; const float* gate;
    __device__ __forceinline__ void operator()(const f32x4 (&acc)[2][2][4][2], const Unit& u, int wr, int wc, int fr, int fq) const {
        const int row0 = u.pm * BM + wr * 64 + fr, col0 = u.pn * BM + wc * 32 + 4 * fq;
        const int v = (u.pm * BM < 8192) ? 0 : 1 + ((u.pm * BM - 8192) >> 12);
        const float* g = gate + (size_t)v * 6144 + col0;
        f32x4 gv[2][2];
#pragma unroll
        for (int bj = 0; bj < 2; ++bj)
#pragma unroll
            for (int n = 0; n < 2; ++n) gv[bj][n] = *(const f32x4*)(g + bj * HALF + n * 16);
#pragma unroll
        for (int ai = 0; ai < 2; ++ai)
#pragma unroll
            for (int m = 0; m < 4; ++m) {
                const int row = row0 + ai * HALF + m * 16;
                const float* bp = (row < 8192 ? xp + (size_t)row * 1024 : xs + (size_t)(row - 8192) * 1024) + col0;
                float* op = out + (size_t)row * 1024 + col0;
#pragma unroll
                for (int bj = 0; bj < 2; ++bj)
#pragma unroll
                    for (int n = 0; n < 2; ++n) { const f32x4 b = *(const f32x4*)(bp + bj * HALF + n * 16); *(f32x4*)(op + bj * HALF + n * 16) = b + gv[bj][n] * acc[ai][bj][m][n]; }
            }
    }
};
}

constexpr int DM = 1024, TP = 8192, TSMP = 32768, TT = 40960, INW = 3072, FF = 2816, FF2 = 5632;
constexpr int NCHUNK = 320, HALF_T = 20480;
constexpr int OFF_LF = 41943040, OFF_LB = OFF_LF + 16384, OFF_RF = OFF_LB + 16384, OFF_RB = OFF_RF + 2097152;
constexpr size_t MiB = 1u << 20;
constexpr size_t WS_MOD = 0, WS_WL = 256 * 1024, WS_AGG = 1 * MiB, WS_CAR = 3 * MiB + 512 * 1024;
constexpr size_t WS_WIN = 5 * MiB, WS_WOUT = 11 * MiB, WS_WGU = 13 * MiB, WS_WD = 24 * MiB;
constexpr size_t WS_XN = 30 * MiB, WS_SB = 30 * MiB, WS_PROJ = 110 * MiB, WS_Y = 350 * MiB, WS_KVT = 430 * MiB;
constexpr size_t WS_GH = 110 * MiB, WS_U = 220 * MiB, WS_END = 510 * MiB;
constexpr int LDS_BYTES = 147456, LDSCTL_OFF = 143360;
constexpr size_t WS_BAR = 768 * 1024;
constexpr int NWAVES = 8;

#define GAS __attribute__((address_space(1)))
#define LAS __attribute__((address_space(3)))
typedef unsigned short bf16;
typedef unsigned v4u __attribute__((ext_vector_type(4)));
typedef unsigned v2u __attribute__((ext_vector_type(2)));
typedef float f32x4 __attribute__((ext_vector_type(4)));
typedef short bf16x8 __attribute__((ext_vector_type(8)));
#define LDS_WAIT() asm volatile("s_waitcnt lgkmcnt(0)" ::: "memory")
typedef float f32x2_t __attribute__((ext_vector_type(2)));
typedef __bf16 bf16x2_t __attribute__((ext_vector_type(2)));
__device__ __forceinline__ unsigned pk2(float lo, float hi) { const f32x2_t v = {lo, hi}; const bf16x2_t b = __builtin_convertvector(v, bf16x2_t); return __builtin_bit_cast(unsigned, b); }
__device__ __forceinline__ unsigned f2bf(float f) { return pk2(f, 0.f) & 0xffffu; }

__device__ __forceinline__ float bflo(unsigned w) { return __builtin_bit_cast(float, w << 16); }
__device__ __forceinline__ float bfhi(unsigned w) { return __builtin_bit_cast(float, w & 0xffff0000u); }
__device__ __forceinline__ float bf2f(unsigned short h) { return __builtin_bit_cast(float, ((unsigned)h) << 16); }
__device__ __forceinline__ float sigmoidf_(float x) { return 1.0f / (1.0f + __expf(-x)); }
__device__ __forceinline__ float siluf_(float x) { return x * __builtin_amdgcn_rcpf(1.0f + __builtin_amdgcn_exp2f(-1.4426950408889634f * x)); }
__device__ __forceinline__ float gelu_tanh(float x) { const float z = x * fmaf(0.044715f * x, x, 1.0f); return x * __builtin_amdgcn_rcpf(1.0f + __builtin_amdgcn_exp2f(-2.302208198f * z)); }

struct Args { const float* in[35]; float* out; unsigned char* ws; int ph_lo, ph_hi; };

#define XB_TMO      128
#define XB_XCNT(j)  (256  + 64 * (j))
#define XB_XSUB(j)  (1280 + 64 * (j))
#define XB_XGEN(j)  (2304 + 64 * (j))
#define XB_TOP      3328
#define XB_TOPGEN   3392
#define XCD_BAR_WORDS 3456
#define XB_SPIN_CAP (1u << 18)

__device__ __forceinline__ unsigned xb_ld(unsigned* p)              { return __hip_atomic_load(p, __ATOMIC_RELAXED, __HIP_MEMORY_SCOPE_AGENT); }
__device__ __forceinline__ unsigned xb_add(unsigned* p, unsigned v) { return __hip_atomic_fetch_add(p, v, __ATOMIC_RELAXED, __HIP_MEMORY_SCOPE_AGENT); }
__device__ __forceinline__ unsigned xb_xcc_id() { return (unsigned)__builtin_amdgcn_s_getreg((3 << 11) | 20) & 0xFu; }
#define XB_SPIN(cond, bar) do { unsigned _sp = 0; while (cond) { __builtin_amdgcn_s_sleep(1); \
    if ((++_sp & 255u) == 0u) { if (xb_ld(&(bar)[XB_TMO])) break; if (_sp > XB_SPIN_CAP) { atomicAdd(&(bar)[XB_TMO], 1u); break; } } } } while (0)

struct XcdBarrier {
    unsigned* bar; unsigned x;
    volatile LAS unsigned* st;
};

__device__ __forceinline__ XcdBarrier xcd_barrier_post(unsigned* bar, volatile LAS unsigned* st) {
    XcdBarrier b; b.bar = bar; b.x = xb_xcc_id(); b.st = st;
    if (threadIdx.x == 0) (void)xb_add(&bar[XB_XCNT(b.x)], 1u);
    return b;
}
__device__ __forceinline__ void xcd_barrier_complete(unsigned* bar, unsigned x, unsigned& nloc, unsigned& nx) {
    const unsigned G = gridDim.x * gridDim.y * gridDim.z;
    unsigned sum, cnt, mine, sp = 0u;
    for (;;) {
        sum = 0u; cnt = 0u; mine = 0u;
#pragma unroll
        for (unsigned j = 0; j < 16; ++j) { const unsigned c = xb_ld(&bar[XB_XCNT(j)]); sum += c; cnt += (c > 0u) ? 1u : 0u; mine = (j == x) ? c : mine; }
        if (sum == G) break;
        __builtin_amdgcn_s_sleep(1);
        if ((++sp & 255u) == 0u) { if (xb_ld(&bar[XB_TMO])) break; if (sp > XB_SPIN_CAP) { atomicAdd(&bar[XB_TMO], 1u); break; } }
    }
    nloc = mine > 0u ? mine : 1u; nx = cnt > 0u ? cnt : 1u;
}

__device__ __forceinline__ void xcd_barrier(const XcdBarrier& b) {
    asm volatile("s_waitcnt vmcnt(0)" ::: "memory");
    __syncthreads();
    if (threadIdx.x == 0) {
        unsigned* bar = b.bar;
        __builtin_amdgcn_s_waitcnt(0);
        unsigned nloc = b.st[0], nx = b.st[1];
        if (nloc == 0u) { xcd_barrier_complete(bar, b.x, nloc, nx); b.st[0] = nloc; b.st[1] = nx; }
        const unsigned old = xb_add(&bar[XB_XSUB(b.x)], 1u);
        const unsigned gen = old / nloc;
        if (old + 1u == (gen + 1u) * nloc) {
            __builtin_amdgcn_fence(__ATOMIC_RELEASE, "agent");
            asm volatile("s_waitcnt vmcnt(0)" ::: "memory");
            const unsigned og = xb_add(&bar[XB_TOP], 1u);
            const unsigned tg = og / nx;
            if (og + 1u == (tg + 1u) * nx) xb_add(&bar[XB_TOPGEN], 1u);
            else XB_SPIN(xb_ld(&bar[XB_TOPGEN]) == tg, bar);
            __builtin_amdgcn_fence(__ATOMIC_ACQUIRE, "agent");
            xb_add(&bar[XB_XGEN(b.x)], 1u);
            asm volatile("s_waitcnt vmcnt(0)" ::: "memory");
        } else {
            XB_SPIN(xb_ld(&bar[XB_XGEN(b.x)]) == gen, bar);
            __builtin_amdgcn_fence(__ATOMIC_ACQUIRE, "agent");
            asm volatile("s_waitcnt vmcnt(0)" ::: "memory");
        }
    }
    __syncthreads();
}
__device__ __forceinline__ float wave_sum(float v) {
#pragma unroll
    for (int o = 1; o < 64; o <<= 1) v += __shfl_xor(v, o);
    return v;
}
__device__ __forceinline__ void p0_transpose_item(const float* W, int K, int N, bf16* WT, int row_off, LAS float* scr, int item, int lane) {
    const int nblk = N / 32, kb = item / nblk, nb = item % nblk, k0 = 64 * kb, n0 = 32 * nb;
#pragma unroll 8
    for (int i = 0; i < 32; ++i) { const int kk = 2 * i + (lane >> 5); scr[kk * 33 + (lane & 31)] = W[(size_t)(k0 + kk) * N + n0 + (lane & 31)]; }
    LDS_WAIT(); asm volatile("" ::: "memory");
    const int c = lane & 7;
#pragma unroll
    for (int j = 0; j < 4; ++j) { const int n = (lane >> 3) + 8 * j; const LAS float* s = scr + (8 * c) * 33 + n;
        v4u o; o.x = pk2(s[0 * 33], s[1 * 33]); o.y = pk2(s[2 * 33], s[3 * 33]); o.z = pk2(s[4 * 33], s[5 * 33]); o.w = pk2(s[6 * 33], s[7 * 33]);
        *(v4u*)(WT + (size_t)(row_off + n0 + n) * K + k0 + 8 * c) = o; }
    LDS_WAIT(); asm volatile("" ::: "memory");
}
__device__ __forceinline__ int mod_index(int row) { return row < TP ? 0 : 1 + ((row - TP) >> 12); }

__device__ __forceinline__ void phase_prologue(const Args& a, LAS unsigned char* lds, int tid, int wave, int lane) {
    unsigned char* ws = a.ws;
    if (blockIdx.x < 96) {
        LAS float* sc = (LAS float*)lds;
        LAS float* red = (LAS float*)(lds + 9 * 1024 * 4);
        for (int i = tid; i < 9 * 1024; i += 512) { const int v = i >> 10, k = i & 1023; const float x = (v == 0) ? a.in[7][k] : a.in[6][(v - 1) * 1024 + k]; sc[i] = siluf_(x); }
        __syncthreads();
        const int col = blockIdx.x * 64 + lane;
        const float* wm = a.in[9] + col;
        float acc[9];
#pragma unroll
        for (int v = 0; v < 9; ++v) acc[v] = 0.f;
        const int kbeg = wave * 128;
#pragma unroll 8
        for (int kk = 0; kk < 128; ++kk) { const int k = kbeg + kk; const float wv = wm[(size_t)k * 6144];
#pragma unroll
            for (int v = 0; v < 9; ++v) acc[v] += sc[v * 1024 + k] * wv; }
#pragma unroll
        for (int v = 0; v < 9; ++v) red[(wave * 9 + v) * 64 + lane] = acc[v];
        __syncthreads();
        for (int i = tid; i < 9 * 64; i += 512) { const int v = i >> 6, l = i & 63; float s = 0.f;
#pragma unroll
            for (int w = 0; w < 8; ++w) s += red[(w * 9 + v) * 64 + l];
            const int cc = blockIdx.x * 64 + l; ((float*)(ws + WS_MOD))[v * 6144 + cc] = s + a.in[10][cc]; }
        __syncthreads();
    }
    LAS float* scr = (LAS float*)(lds + wave * 16384);
    const int gw = blockIdx.x * NWAVES + wave, NGW = gridDim.x * NWAVES;
    constexpr int I_IN = 16 * 96, I_OUT = 16 * 32, I_G = 16 * 88, I_D = 44 * 32, I_L = 64;
    constexpr int NITEMS = I_IN + I_OUT + 2 * I_G + I_D + I_L;
    for (int it = gw; it < NITEMS; it += NGW) {
        int r = it;
        if (r < I_IN) { p0_transpose_item(a.in[11], 1024, 3072, (bf16*)(ws + WS_WIN), 0, scr, r, lane); continue; } r -= I_IN;
        if (r < I_OUT) { p0_transpose_item(a.in[27], 1024, 1024, (bf16*)(ws + WS_WOUT), 0, scr, r, lane); continue; } r -= I_OUT;
        if (r < I_G) { p0_transpose_item(a.in[29], 1024, 2816, (bf16*)(ws + WS_WGU), 0, scr, r, lane); continue; } r -= I_G;
        if (r < I_G) { p0_transpose_item(a.in[30], 1024, 2816, (bf16*)(ws + WS_WGU), 2816, scr, r, lane); continue; } r -= I_G;
        if (r < I_D) { p0_transpose_item(a.in[33], 2816, 1024, (bf16*)(ws + WS_WD), 0, scr, r, lane); continue; } r -= I_D;
        { const int blk = r >> 1, sub = r & 1, mat = blk >> 3, nb = blk & 7;
          const float* src = (mat == 0 ? a.in[14] : mat == 1 ? a.in[16] : mat == 2 ? a.in[19] : a.in[21]) + nb * 4096;
          p0_transpose_item(src, 64, 64, (bf16*)(ws + WS_WL) + (size_t)(mat * 8 + nb) * 4096, 0, scr, sub, lane); }
    }
}

template <int MODE>
__device__ __forceinline__ void phase_rownorm(const float* xp, const float* xs, const float* w, const float* mod_scale, const float* mod_shift, bf16* obf, float* of32, int wave, int lane) {
    const int gw = blockIdx.x * NWAVES + wave, NGW = gridDim.x * NWAVES;
    f32x4 wv[4];
#pragma unroll
    for (int j = 0; j < 4; ++j) wv[j] = *(const f32x4*)(w + 4 * lane + 256 * j);
    for (int row0 = gw; row0 < TT; row0 += 2 * NGW) {
        const int row1 = row0 + NGW; const bool has1 = row1 < TT; const int r1 = has1 ? row1 : row0;
        const float* xr0 = (row0 < TP ? xp + (size_t)row0 * DM : xs + (size_t)(row0 - TP) * DM) + 4 * lane;
        const float* xr1 = (r1 < TP ? xp + (size_t)r1 * DM : xs + (size_t)(r1 - TP) * DM) + 4 * lane;
        f32x4 v0[4], v1[4]; float s0 = 0.f, s1 = 0.f;
#pragma unroll
        for (int j = 0; j < 4; ++j) { v0[j] = *(const f32x4*)(xr0 + 256 * j); v1[j] = *(const f32x4*)(xr1 + 256 * j); }
#pragma unroll
        for (int j = 0; j < 4; ++j) { s0 += (v0[j].x * v0[j].x + v0[j].y * v0[j].y) + (v0[j].z * v0[j].z + v0[j].w * v0[j].w); s1 += (v1[j].x * v1[j].x + v1[j].y * v1[j].y) + (v1[j].z * v1[j].z + v1[j].w * v1[j].w); }
        const float rs0 = 1.0f / sqrtf(wave_sum(s0) * (1.0f / DM) + 1e-6f), rs1 = 1.0f / sqrtf(wave_sum(s1) * (1.0f / DM) + 1e-6f);
#pragma unroll
        for (int k = 0; k < 2; ++k) {
            if (k == 1 && !has1) break;
            const int row = k ? row1 : row0; const float rstd = k ? rs1 : rs0;
            if (MODE == 0) {
                const int mv = mod_index(row);
                const float* sc = mod_scale + (size_t)mv * 6144 + 4 * lane; const float* sh = mod_shift + (size_t)mv * 6144 + 4 * lane;
                unsigned long long* o8 = (unsigned long long*)(obf + (size_t)row * DM) + lane;
#pragma unroll
                for (int j = 0; j < 4; ++j) { const f32x4 scv = *(const f32x4*)(sc + 256 * j), shv = *(const f32x4*)(sh + 256 * j);
                    const f32x4 y = (k ? v1[j] : v0[j]) * rstd * wv[j] * (scv + 1.0f) + shv;
                    o8[64 * j] = (unsigned long long)pk2(y.x, y.y) | ((unsigned long long)pk2(y.z, y.w) << 32); }
            } else {
                float* o = of32 + (size_t)row * DM + 4 * lane;
#pragma unroll
                for (int j = 0; j < 4; ++j) *(f32x4*)(o + 256 * j) = (k ? v1[j] : v0[j]) * rstd * wv[j];
            }
        }
    }
}
constexpr int RS = 272;
constexpr int REG = 128 * RS;
constexpr int XCS = 1040;
#define MFMA16(a, b, c) __builtin_amdgcn_mfma_f32_16x16x32_bf16((a), (b), (c), 0, 0, 0)

__device__ __forceinline__ void mm128(f32x4 (&acc)[8], const LAS unsigned char* Aimg, const LAS unsigned char* Bimg, int wave, int c, int q) {
#pragma unroll
    for (int s = 0; s < 4; ++s) {
        const bf16x8 af = *(const LAS bf16x8*)(Aimg + (16 * wave + c) * RS + (32 * s + 8 * q) * 2);
#pragma unroll
        for (int t = 0; t < 8; ++t) { const bf16x8 bfr = *(const LAS bf16x8*)(Bimg + (16 * t + c) * RS + (32 * s + 8 * q) * 2); acc[t] = MFMA16(bfr, af, acc[t]); }
    }
}
__device__ __forceinline__ void mm128x2(f32x4 (&acc1)[8], f32x4 (&acc2)[8], const LAS unsigned char* Aimg, const LAS unsigned char* B1, const LAS unsigned char* B2, int wave, int c, int q) {
#pragma unroll
    for (int s = 0; s < 4; ++s) {
        const bf16x8 af = *(const LAS bf16x8*)(Aimg + (16 * wave + c) * RS + (32 * s + 8 * q) * 2);
#pragma unroll
        for (int t = 0; t < 8; ++t) { const bf16x8 b1 = *(const LAS bf16x8*)(B1 + (16 * t + c) * RS + (32 * s + 8 * q) * 2); acc1[t] = MFMA16(b1, af, acc1[t]);
                                      const bf16x8 b2 = *(const LAS bf16x8*)(B2 + (16 * t + c) * RS + (32 * s + 8 * q) * 2); acc2[t] = MFMA16(b2, af, acc2[t]); }
    }
}
__device__ __forceinline__ void load_rm(LAS unsigned char* img, const bf16* g, int pitch, int tid) {
#pragma unroll
    for (int i = 0; i < 4; ++i) { const int p = tid + 512 * i, row = p >> 4, cp = p & 15; const v4u v = *(const v4u*)(g + (size_t)row * pitch + cp * 8); *(LAS v4u*)(img + row * RS + cp * 16) = v; }
}
#define HW(v, e) (((e) & 1) ? ((v)[(e) >> 1] >> 16) : ((v)[(e) >> 1] & 0xffffu))
__device__ __forceinline__ void load_tr(LAS unsigned char* img, const bf16* g, int pitch, int wave, int lane) {
#pragma unroll
    for (int it = 0; it < 2; ++it) { const int dg = wave + 8 * it;
        const v4u a = *(const v4u*)(g + (size_t)(2 * lane) * pitch + dg * 8), b = *(const v4u*)(g + (size_t)(2 * lane + 1) * pitch + dg * 8);
#pragma unroll
        for (int e = 0; e < 8; ++e) { const unsigned lo = HW(a, e), hi = HW(b, e); *(LAS unsigned*)(img + (dg * 8 + e) * RS + lane * 4) = lo | (hi << 16); } }
}
__device__ __forceinline__ float log_sigmoid_(float x) { return -log1pf(__expf(-x)); }

template <int PASS>
__device__ __forceinline__ void ret_item(const Args& a, LAS unsigned char* lds, int ci, int h, int tid, int wave, int lane) {
    unsigned char* ws = a.ws;
    const int c = lane & 15, q = lane >> 4;
    const bf16* PROJ = (const bf16*)(ws + WS_PROJ);
    const size_t rowbase = (size_t)ci * 128;
    const bf16* Qg = PROJ + rowbase * INW + 1024 + h * 128;
    const bf16* Kg = PROJ + rowbase * INW + 1536 + h * 128;
    const bf16* Vg = PROJ + rowbase * INW + 2048 + h * 128;
    const float lf2 = log_sigmoid_(a.in[24][h]) * 1.4426950408889634f, lb2 = log_sigmoid_(a.in[25][h]) * 1.4426950408889634f;
    const float scale = 0.08838834764831845f;
    LAS unsigned char* R1 = lds; LAS unsigned char* R2 = lds + REG; LAS unsigned char* R3 = lds + 2 * REG; LAS unsigned char* R4 = lds + 3 * REG;
    if (PASS == 1) {
        const float j0 = (float)(2 * lane), j1 = (float)(2 * lane + 1);
        const float wf0 = scale * __builtin_amdgcn_exp2f(lf2 * (127.f - j0)), wf1 = scale * __builtin_amdgcn_exp2f(lf2 * (127.f - j1)), wb0 = scale * __builtin_amdgcn_exp2f(lb2 * j0), wb1 = scale * __builtin_amdgcn_exp2f(lb2 * j1);
        load_tr(R1, Kg, INW, wave, lane);
#pragma unroll
        for (int it = 0; it < 2; ++it) { const int dg = wave + 8 * it;
            const v4u va = *(const v4u*)(Vg + (size_t)(2 * lane) * INW + dg * 8), vb = *(const v4u*)(Vg + (size_t)(2 * lane + 1) * INW + dg * 8);
#pragma unroll
            for (int e = 0; e < 8; ++e) { const float lo = bf2f((unsigned short)HW(va, e)), hi = bf2f((unsigned short)HW(vb, e));
                *(LAS unsigned*)(R2 + (dg * 8 + e) * RS + lane * 4) = pk2(lo * wf0, hi * wf1);
                *(LAS unsigned*)(R3 + (dg * 8 + e) * RS + lane * 4) = pk2(lo * wb0, hi * wb1); } }
        __syncthreads();
        f32x4 af[8], ab[8];
#pragma unroll
        for (int t = 0; t < 8; ++t) { af[t] = (f32x4){0.f, 0.f, 0.f, 0.f}; ab[t] = (f32x4){0.f, 0.f, 0.f, 0.f}; }
        mm128(af, R2, R1, wave, c, q);
        mm128(ab, R3, R1, wave, c, q);
        bf16* KVT = (bf16*)(ws + WS_KVT) + ((size_t)(ci * 4 + h) * 2) * 16384 + (16 * wave + c) * 128 + 4 * q;
#pragma unroll
        for (int t = 0; t < 8; ++t) { *(v2u*)(KVT + 16 * t) = (v2u){pk2(af[t][0], af[t][1]), pk2(af[t][2], af[t][3])};
                                      *(v2u*)(KVT + 16384 + 16 * t) = (v2u){pk2(ab[t][0], ab[t][1]), pk2(ab[t][2], ab[t][3])}; }
        __syncthreads();
    } else {
        const bf16* SB = (const bf16*)(ws + WS_SB) + ((size_t)(ci * 4 + h) * 2) * 16384;
        load_rm(R1, Qg, INW, tid);
        load_rm(R2, Kg, INW, tid);
        load_tr(R3, Vg, INW, wave, lane);
        load_rm(R4, SB, 128, tid);
        __syncthreads();
        f32x4 aS[8], aF[8];
#pragma unroll
        for (int t = 0; t < 8; ++t) { aS[t] = (f32x4){0.f, 0.f, 0.f, 0.f}; aF[t] = (f32x4){0.f, 0.f, 0.f, 0.f}; }
        mm128x2(aS, aF, R1, R2, R4, wave, c, q);
        __syncthreads();
        const int i = 16 * wave + c;
#pragma unroll
        for (int t = 0; t < 8; ++t) { float p[4];
#pragma unroll
            for (int r = 0; r < 4; ++r) { const int dl = i - (16 * t + 4 * q + r);
                const float f = dl > 0 ? __builtin_amdgcn_exp2f(lf2 * (float)dl) : (dl < 0 ? __builtin_amdgcn_exp2f(lb2 * (float)(-dl)) : 2.0f);
                p[r] = aS[t][r] * scale * f; }
            *(LAS v2u*)(R2 + i * RS + (16 * t + 4 * q) * 2) = (v2u){pk2(p[0], p[1]), pk2(p[2], p[3])}; }
        load_rm(R4, SB + 16384, 128, tid);
        __syncthreads();
        const float hf = __builtin_amdgcn_exp2f(lf2 * (float)(i + 1)), hb = __builtin_amdgcn_exp2f(lb2 * (float)(128 - i));
        f32x4 aB[8];
#pragma unroll
        for (int t = 0; t < 8; ++t) { aF[t] = aF[t] * hf; aB[t] = (f32x4){0.f, 0.f, 0.f, 0.f}; }
        mm128(aF, R2, R3, wave, c, q);
        mm128(aB, R1, R4, wave, c, q);
        f32x4 (&aO)[8] = aF;
        float s = 0.f;
#pragma unroll
        for (int t = 0; t < 8; ++t) { aO[t] = aO[t] + aB[t] * hb; s += (aO[t][0] + aO[t][1]) + (aO[t][2] + aO[t][3]); }
        s += __shfl_xor(s, 16); s += __shfl_xor(s, 32);
        const float mean = s * (1.0f / 128.0f); float v2 = 0.f;
#pragma unroll
        for (int t = 0; t < 8; ++t) { aO[t] = aO[t] - mean; v2 += (aO[t][0] * aO[t][0] + aO[t][1] * aO[t][1]) + (aO[t][2] * aO[t][2] + aO[t][3] * aO[t][3]); }
        v2 += __shfl_xor(v2, 16); v2 += __shfl_xor(v2, 32);
        const float rstd = 1.0f / sqrtf(v2 * (1.0f / 128.0f) + 1e-6f);
        const bf16* Gg = PROJ + (rowbase + i) * INW + 2560 + h * 128 + 4 * q;
        const float* gn = a.in[26] + h * 128 + 4 * q;
        bf16* Yp = (bf16*)(ws + WS_Y) + (rowbase + i) * DM + 512 + h * 128 + 4 * q;
#pragma unroll
        for (int t = 0; t < 8; ++t) { const v2u gv = *(const v2u*)(Gg + 16 * t); const f32x4 w = *(const f32x4*)(gn + 16 * t);
            const float y0 = aO[t][0] * rstd * w[0] * siluf_(bflo(gv[0])), y1 = aO[t][1] * rstd * w[1] * siluf_(bfhi(gv[0]));
            const float y2 = aO[t][2] * rstd * w[2] * siluf_(bflo(gv[1])), y3 = aO[t][3] * rstd * w[3] * siluf_(bfhi(gv[1]));
            *(v2u*)(Yp + 16 * t) = (v2u){pk2(y0, y1), pk2(y2, y3)};
            if (t & 1) asm volatile("" ::: "memory"); }
        __syncthreads();
    }
}
template <int PASS, int DIR>
__device__ __forceinline__ void lru_dir(const LAS unsigned char* xcl, const bf16x8 (&idf)[2], const bf16x8 (&wa)[2], const bf16x8 (&wx)[2], float ba, float bx, float sp8,
                                        float hc_in, float* hsp, float& Aout, float& Hout, float& edge, int c, int q, const bf16* Gp, bf16* Yp) {
    float Ac = 1.f, Hc = hc_in;
    float hn[4]; unsigned short gn[4];
    if (PASS == 3 && DIR == 1) {
#pragma unroll
        for (int r = 0; r < 4; ++r) { hn[r] = hsp[(7 * 4 + r) * 64]; gn[r] = Gp[(size_t)(16 * 7 + 4 * q + r) * INW]; }
    }
#pragma unroll 1
    for (int ti = 0; ti < 8; ++ti) {
        const int tt = DIR == 0 ? ti : 7 - ti;
        float hcur[4]; unsigned short gcur[4];
        if (PASS == 3 && DIR == 1) {
#pragma unroll
            for (int r = 0; r < 4; ++r) { hcur[r] = hn[r]; gcur[r] = gn[r]; }
            const int tn = tt > 0 ? tt - 1 : 0;
#pragma unroll
            for (int r = 0; r < 4; ++r) { hn[r] = hsp[(tn * 4 + r) * 64]; gn[r] = Gp[(size_t)(16 * tn + 4 * q + r) * INW]; }
        }
        f32x4 aI = (f32x4){0.f, 0.f, 0.f, 0.f}, aA = aI, aX = aI;
#pragma unroll
        for (int s = 0; s < 2; ++s) { const bf16x8 xf = *(const LAS bf16x8*)(xcl + (16 * tt) * XCS + 64 * s);
            aI = MFMA16(xf, idf[s], aI); aA = MFMA16(xf, wa[s], aA); aX = MFMA16(xf, wx[s], aX); }
        float av[4], uv[4];
#pragma unroll
        for (int r = 0; r < 4; ++r) {
            const float rg = __builtin_amdgcn_rcpf(1.0f + __builtin_amdgcn_exp2f(fmaf(aA[r], -1.4426950408889634f, ba)));
            const float ig = __builtin_amdgcn_rcpf(1.0f + __builtin_amdgcn_exp2f(fmaf(aX[r], -1.4426950408889634f, bx)));
            const float la = -sp8 * rg;
            const float aa = __builtin_amdgcn_exp2f(la * 1.4426950408889634f);
            const float t = -2.0f * la;
            const float ser = t * fmaf(-0.5f * t, fmaf(-0.33333334f * t, fmaf(-0.25f, t, 1.0f), 1.0f), 1.0f);
            const float om = t < 0.125f ? ser : fmaf(-aa, aa, 1.0f);
            av[r] = aa; uv[r] = __builtin_amdgcn_sqrtf(om) * (ig * aI[r]); }
        float pa[4], hl[4]; float P = 1.f, H = 0.f;
#pragma unroll
        for (int rr = 0; rr < 4; ++rr) { const int r = DIR == 0 ? rr : 3 - rr; H = av[r] * H + uv[r]; P *= av[r]; pa[r] = P; hl[r] = H; }
        float A = P, Hh = H, Ap, Hp, Ae, He, At, Ht;
        if (DIR == 0) {
            Ap = __shfl_up(A, 16); Hp = __shfl_up(Hh, 16); if (q >= 1) { Hh = A * Hp + Hh; A = Ap * A; }
            Ap = __shfl_up(A, 32); Hp = __shfl_up(Hh, 32); if (q >= 2) { Hh = A * Hp + Hh; A = Ap * A; }
            Ae = __shfl_up(A, 16); He = __shfl_up(Hh, 16); if (q == 0) { Ae = 1.f; He = 0.f; }
            At = __shfl(A, 48 + c); Ht = __shfl(Hh, 48 + c);
        } else {
            Ap = __shfl_down(A, 16); Hp = __shfl_down(Hh, 16); if (q <= 2) { Hh = A * Hp + Hh; A = Ap * A; }
            Ap = __shfl_down(A, 32); Hp = __shfl_down(Hh, 32); if (q <= 1) { Hh = A * Hp + Hh; A = Ap * A; }
            Ae = __shfl_down(A, 16); He = __shfl_down(Hh, 16); if (q == 3) { Ae = 1.f; He = 0.f; }
            At = __shfl(A, c); Ht = __shfl(Hh, c);
        }
        if (PASS == 3) {
            const float hin = Ae * Hc + He;
#pragma unroll
            for (int r = 0; r < 4; ++r) { const float hv = pa[r] * hin + hl[r];
                if (DIR == 0) hsp[(tt * 4 + r) * 64] = hv;
                else { const size_t tok = (size_t)(16 * tt + 4 * q + r); Yp[tok * DM] = (bf16)f2bf((hcur[r] + hv) * gelu_tanh(bf2f(gcur[r]))); }
                if (DIR == 0 && tt == 0 && r == 0) edge = hv;
                if (DIR == 1 && tt == 7 && r == 3) edge = hv; }
        }
        Hc = At * Hc + Ht; Ac = Ac * At;
    }
    Aout = Ac; Hout = Hc;
}

template <int PASS>
__device__ __forceinline__ void lru_item(const Args& a, LAS unsigned char* lds, int ci, int tid, int wave, int lane) {
    unsigned char* ws = a.ws;
    const int c = lane & 15, q = lane >> 4;
    const bf16* PROJ = (const bf16*)(ws + WS_PROJ);
    int seq, n, seqlen, seqtok0, nch;
    if (ci < 64) { seq = ci >> 1; n = ci & 1; seqlen = 256; seqtok0 = seq * 256; nch = 2; }
    else { seq = (ci - 64) >> 5; n = (ci - 64) & 31; seqlen = 4096; seqtok0 = TP + seq * 4096; nch = 32; }
    const bool isprompt = ci < 64;
    const int p0 = n * 128;
    {
        float w0[8], w1[8], w2[8], w3[8], bb[8];
#pragma unroll
        for (int e = 0; e < 8; ++e) { w0[e] = a.in[12][0 * 512 + 8 * lane + e]; w1[e] = a.in[12][1 * 512 + 8 * lane + e]; w2[e] = a.in[12][2 * 512 + 8 * lane + e]; w3[e] = a.in[12][3 * 512 + 8 * lane + e]; bb[e] = a.in[13][8 * lane + e]; }
        const int pb = p0 + 16 * wave;
        const bf16* base = PROJ + (size_t)seqtok0 * INW + 8 * lane;
#define LDROW(p) (((p) < 0 || (p) >= seqlen) ? (v4u){0u, 0u, 0u, 0u} : *(const v4u*)(base + (size_t)(p) * INW))
        v4u rows[19];
#pragma unroll
        for (int k = 0; k < 19; ++k) rows[k] = LDROW(pb - 2 + k);
#pragma unroll
        for (int i = 0; i < 16; ++i) {
            float o[8];
#pragma unroll
            for (int e = 0; e < 8; ++e) o[e] = bb[e] + w0[e] * bf2f((unsigned short)HW(rows[i], e)) + w1[e] * bf2f((unsigned short)HW(rows[i + 1], e)) + w2[e] * bf2f((unsigned short)HW(rows[i + 2], e)) + w3[e] * bf2f((unsigned short)HW(rows[i + 3], e));
            *(LAS v4u*)(lds + (16 * wave + i) * XCS + 16 * lane) = (v4u){pk2(o[0], o[1]), pk2(o[2], o[3]), pk2(o[4], o[5]), pk2(o[6], o[7])};
        }
#undef LDROW
    }
    __syncthreads();
    const LAS unsigned char* xcl = lds + c * XCS + (64 * wave + 8 * q) * 2;
    const bf16* WL = (const bf16*)(ws + WS_WL);
    const size_t rowbase = (size_t)seqtok0 + p0;
    for (int rt = 0; rt < 4; ++rt) {
        const int dl = 16 * rt + c, d = 64 * wave + dl;
        bf16x8 idf[2];
#pragma unroll
        for (int s = 0; s < 2; ++s)
#pragma unroll
            for (int e = 0; e < 8; ++e) idf[s][e] = (32 * s + 8 * q + e == dl) ? (short)0x3F80 : (short)0;
        float* hs = a.out + (size_t)(blockIdx.x * NWAVES + wave) * 2048 + lane;
        float Af, Hf, Ab, Hb, ef = 0.f, eb = 0.f;
        float cf = 0.f, cb = 0.f;
        if (PASS == 3) { cf = ((const float*)(ws + WS_CAR))[(size_t)(ci * 2 + 0) * 512 + d]; cb = ((const float*)(ws + WS_CAR))[(size_t)(ci * 2 + 1) * 512 + d]; }
        const bf16* Gp = PROJ + rowbase * INW + 512 + d;
        bf16* Yp = (bf16*)(ws + WS_Y) + rowbase * DM + d;
        bf16x8 waf[2], wxf[2], wab[2], wxb[2];
#pragma unroll
        for (int s2 = 0; s2 < 2; ++s2) { const int o = dl * 64 + 32 * s2 + 8 * q;
            waf[s2] = *(const bf16x8*)(WL + (size_t)(0 * 8 + wave) * 4096 + o); wxf[s2] = *(const bf16x8*)(WL + (size_t)(1 * 8 + wave) * 4096 + o);
            wab[s2] = *(const bf16x8*)(WL + (size_t)(2 * 8 + wave) * 4096 + o); wxb[s2] = *(const bf16x8*)(WL + (size_t)(3 * 8 + wave) * 4096 + o); }
        const float baf = a.in[15][d], bxf = a.in[17][d], lmf = a.in[18][d], bab = a.in[20][d], bxb = a.in[22][d], lmb = a.in[23][d];
        lru_dir<PASS, 0>(xcl, idf, waf, wxf, -1.4426950408889634f * baf, -1.4426950408889634f * bxf, 8.0f * log1pf(__expf(-lmf)), cf, hs, Af, Hf, ef, c, q, Gp, Yp);
        lru_dir<PASS, 1>(xcl, idf, wab, wxb, -1.4426950408889634f * bab, -1.4426950408889634f * bxb, 8.0f * log1pf(__expf(-lmb)), cb, hs, Ab, Hb, eb, c, q, Gp, Yp);
        if (PASS == 1) {
            if (q == 0) { float* ag = (float*)(ws + WS_AGG) + (size_t)(ci * 2) * 1024 + d; ag[0] = Af; ag[512] = Hf; ag[1024] = Ab; ag[1536] = Hb; }
        } else {
            if (isprompt && n == 0 && q == 0) a.out[OFF_LF + seq * 512 + d] = ef;
            if (isprompt && n == nch - 1 && q == 3) a.out[OFF_LB + seq * 512 + d] = eb;
        }
    }
    __syncthreads();
}

__device__ __forceinline__ void phase_carries(const Args& a, int tid) {
    unsigned char* ws = a.ws;
    const int gtid = blockIdx.x * 512 + tid, GT = gridDim.x * 512;
    for (int task = gtid; task < 655360; task += GT) {
        const int dv = task & 127, dkg = (task >> 7) & 15, dir = (task >> 11) & 1, h = (task >> 12) & 3, sq = task >> 14;
        const bool isprompt = sq >= 8; const int seq = isprompt ? sq - 8 : sq, N = isprompt ? 2 : 32, cibase = isprompt ? seq * 2 : 64 + seq * 32;
        const float g = __expf(log_sigmoid_(dir ? a.in[25][h] : a.in[24][h]) * 128.0f);
        float S[8];
        if (isprompt) {
#pragma unroll
            for (int e = 0; e < 8; ++e) S[e] = 0.f;
        } else { const float* s0 = (dir ? a.in[5] : a.in[4]) + ((size_t)(seq * 4 + h) * 128 + dkg * 8) * 128 + dv;
#pragma unroll
            for (int e = 0; e < 8; ++e) S[e] = s0[e * 128]; }
        const size_t ibase = ((size_t)h * 2 + dir) * 16384 + dv * 128 + dkg * 8;
        const bf16* kvp = (const bf16*)(ws + WS_KVT) + ibase; bf16* sbp = (bf16*)(ws + WS_SB) + ibase;
        for (int s0 = 0; s0 < N; s0 += 8) {
            v4u kv[8];
#pragma unroll
            for (int j = 0; j < 8; ++j) { const int step = s0 + j; const int n = dir ? N - 1 - step : step; const int ci = cibase + (step < N ? n : (dir ? 0 : N - 1));
                kv[j] = *(const v4u*)(kvp + (size_t)ci * 131072); }
#pragma unroll
            for (int j = 0; j < 8; ++j) { const int step = s0 + j;
                if (step < N) { const int n = dir ? N - 1 - step : step, ci = cibase + n;
                    *(v4u*)(sbp + (size_t)ci * 131072) = (v4u){pk2(S[0], S[1]), pk2(S[2], S[3]), pk2(S[4], S[5]), pk2(S[6], S[7])};
#pragma unroll
                    for (int e2 = 0; e2 < 8; ++e2) S[e2] = g * S[e2] + bf2f((unsigned short)HW(kv[j], e2)); } }
        }
        if (isprompt) { float* o = a.out + (dir ? OFF_RB : OFF_RF) + ((size_t)(seq * 4 + h) * 128 + dkg * 8) * 128 + dv;
#pragma unroll
            for (int e = 0; e < 8; ++e) o[e * 128] = S[e]; }
    }
    for (int task = gtid; task < 40960; task += GT) {
        const int d = task & 511, dir = (task >> 9) & 1, sq = task >> 10;
        const bool isprompt = sq >= 8; const int seq = isprompt ? sq - 8 : sq, N = isprompt ? 2 : 32, cibase = isprompt ? seq * 2 : 64 + seq * 32;
        float hcar = isprompt ? 0.f : (dir ? a.in[3] : a.in[2])[seq * 512 + d];
        for (int step = 0; step < N; ++step) {
            const int n = dir ? N - 1 - step : step, ci = cibase + n;
            ((float*)(ws + WS_CAR))[(size_t)(ci * 2 + dir) * 512 + d] = hcar;
            const float* ag = (const float*)(ws + WS_AGG) + ((size_t)(ci * 2 + dir) * 2) * 512 + d;
            hcar = ag[0] * hcar + ag[512];
        }
    }
}

__device__ __forceinline__ v4u ldg16(const bf16* p, bool ok) { return ok ? *(const v4u*)p : (v4u){0u, 0u, 0u, 0u}; }
__device__ __forceinline__ void phase_act(const Args& a, int half, int wave, int lane) {
    unsigned char* ws = a.ws;
    const bf16* __restrict__ GH = (const bf16*)(ws + WS_GH);
    bf16* __restrict__ U = (bf16*)(ws + WS_U);
    const int gw = blockIdx.x * NWAVES + wave, NGW = gridDim.x * NWAVES;
    const int p = lane >> 5;
    for (int wt = gw; wt < 7040; wt += NGW) {
        const int slab = wt % 11; int r = wt / 11;
        int tok0, ts, lat, steps0, nwalk;
        bool isimg;
        if (half == 1 || r >= 256) {
            if (half == 0) r -= 256;
            const int pair = r & 31, seg = (r >> 5) & 3, img = (r >> 7) + (half == 0 ? 0 : 3);
            const int gc = 2 * pair + p; steps0 = 16 * seg; nwalk = 64; ts = 64; lat = 1; isimg = true;
            tok0 = TP + img * 4096 + steps0 * 64 + gc;
        } else {
            const int sp = r & 7, seq = r >> 3; steps0 = 32 * sp + 16 * p; nwalk = 256; ts = 1; lat = 0; isimg = false;
            tok0 = seq * 256 + steps0;
        }
        const int ch0 = (slab * 32 + (lane & 31)) * 8;
        const int gcol = isimg ? (tok0 & 63) : 1;
        const bool okl = isimg && gcol > 0, okr = isimg && gcol < 63;
        float wk[9][8], bb[8];
#pragma unroll
        for (int k = 0; k < 9; ++k) { const int aa = k / 3, b = k % 3;
            const int src = isimg ? k : (3 + aa);
            const f32x4 x0 = *(const f32x4*)(a.in[31] + (size_t)src * FF + ch0), x1 = *(const f32x4*)(a.in[31] + (size_t)src * FF + ch0 + 4);
            const float z = (isimg || b == 1) ? 1.f : 0.f;
            wk[k][0] = x0[0] * z; wk[k][1] = x0[1] * z; wk[k][2] = x0[2] * z; wk[k][3] = x0[3] * z; wk[k][4] = x1[0] * z; wk[k][5] = x1[1] * z; wk[k][6] = x1[2] * z; wk[k][7] = x1[3] * z; }
        { const f32x4 x0 = *(const f32x4*)(a.in[32] + ch0), x1 = *(const f32x4*)(a.in[32] + ch0 + 4); bb[0] = x0[0]; bb[1] = x0[1]; bb[2] = x0[2]; bb[3] = x0[3]; bb[4] = x1[0]; bb[5] = x1[1]; bb[6] = x1[2]; bb[7] = x1[3]; }
        const bf16* gp = GH + (size_t)(tok0 - half * HALF_T) * FF + ch0;
        bf16* up = U + (size_t)tok0 * FF + ch0;
        const size_t gs = (size_t)ts * FF;
        v4u w0[3], w1[3], w2[3], w3[3];
        { const bool okp = steps0 > 0;
          w0[0] = ldg16(gp - gs - FF, okp && okl); w0[1] = ldg16(gp - gs, okp); w0[2] = ldg16(gp - gs + FF, okp && okr);
          w1[0] = ldg16(gp - FF, okl); w1[1] = *(const v4u*)gp; w1[2] = ldg16(gp + FF, okr); }
#pragma unroll 1
        for (int st = 0; st < 16; st += 2) {
            const bool ok2 = steps0 + st + 1 < nwalk, ok3 = steps0 + st + 2 < nwalk;
            const bf16* g2 = gp + (size_t)(st + 1) * gs; const bf16* g3 = g2 + gs;
            w2[0] = ldg16(g2 - FF, ok2 && okl); w2[1] = ldg16(g2, ok2); w2[2] = ldg16(g2 + FF, ok2 && okr);
            w3[0] = ldg16(g3 - FF, ok3 && okl); w3[1] = ldg16(g3, ok3); w3[2] = ldg16(g3 + FF, ok3 && okr);
            bf16* u0 = up + (size_t)st * gs; bf16* u1 = u0 + gs;
            const v4u uv0 = *(const v4u*)u0, uv1 = *(const v4u*)u1;
            float acc0[8], acc1[8];
#pragma unroll
            for (int e = 0; e < 8; ++e) { acc0[e] = bb[e]; acc1[e] = bb[e]; }
#pragma unroll
            for (int b = 0; b < 3; ++b)
#pragma unroll
                for (int e = 0; e < 8; ++e) {
                    acc0[e] += wk[0 + b][e] * bf2f((unsigned short)HW(w0[b], e)) + wk[3 + b][e] * bf2f((unsigned short)HW(w1[b], e)) + wk[6 + b][e] * bf2f((unsigned short)HW(w2[b], e));
                    acc1[e] += wk[0 + b][e] * bf2f((unsigned short)HW(w1[b], e)) + wk[3 + b][e] * bf2f((unsigned short)HW(w2[b], e)) + wk[6 + b][e] * bf2f((unsigned short)HW(w3[b], e)); }
            float o0[8], o1[8];
#pragma unroll
            for (int e = 0; e < 8; ++e) { o0[e] = gelu_tanh(acc0[e]) * bf2f((unsigned short)HW(uv0, e)); o1[e] = gelu_tanh(acc1[e]) * bf2f((unsigned short)HW(uv1, e)); }
            *(v4u*)u0 = (v4u){pk2(o0[0], o0[1]), pk2(o0[2], o0[3]), pk2(o0[4], o0[5]), pk2(o0[6], o0[7])};
            *(v4u*)u1 = (v4u){pk2(o1[0], o1[1]), pk2(o1[2], o1[3]), pk2(o1[4], o1[5]), pk2(o1[6], o1[7])};
#pragma unroll
            for (int b = 0; b < 3; ++b) { w0[b] = w2[b]; w1[b] = w3[b]; }
        }
    }
}
template <int PASS>
__device__ __forceinline__ void phase_mixer(const Args& a, LAS unsigned char* lds, int tid, int wave, int lane) {
    unsigned* ctr = (unsigned*)(a.ws + WS_BAR) + (PASS == 1 ? 3584 : 3648);
    volatile LAS int* slot = (volatile LAS int*)(lds + LDSCTL_OFF + 256);
    for (;;) {
        if (tid == 0) *slot = (int)__hip_atomic_fetch_add(ctr, 1u, __ATOMIC_RELAXED, __HIP_MEMORY_SCOPE_AGENT);
        __syncthreads();
        const int it = *slot;
        if (it >= NCHUNK + 4 * NCHUNK) break;
        asm volatile("" : "+v"(tid), "+v"(lane));
        if (it < NCHUNK) lru_item<PASS>(a, lds, it, tid, wave, lane);
        else { const int r = it - NCHUNK; ret_item<PASS>(a, lds, r >> 2, r & 3, tid, wave, lane); }
    }
}

__global__ void __launch_bounds__(512, 2) fwd(Args a) {
    extern __shared__ __attribute__((aligned(16))) unsigned char lds_raw[];
    LAS unsigned char* lds = (LAS unsigned char*)lds_raw;
    unsigned char* ws = a.ws;
    int tid = threadIdx.x, lane = tid & 63; const int wave = __builtin_amdgcn_readfirstlane(tid >> 6);
#define FRESH() do { tid = threadIdx.x; asm volatile("" : "+v"(tid)); lane = tid & 63; } while (0)
    for (int u = tid; u < (LDS_BYTES - LDSCTL_OFF) / 4; u += 512) ((LAS unsigned*)(lds + LDSCTL_OFF))[u] = 0u;
    __syncthreads();
    const XcdBarrier bar = xcd_barrier_post((unsigned*)(ws + WS_BAR), (volatile LAS unsigned*)(lds + LDSCTL_OFF + 64));
    const float* MOD = (const float*)(ws + WS_MOD);
    const int G = gridDim.x;
    const int lo = a.ph_lo, hi = a.ph_hi;
#ifndef PHMASK
#define PHMASK 0xffff
#endif
#define IN(k) ((((PHMASK) >> (k)) & 1) && lo <= (k) && (k) < hi)
#ifndef REPMASK
#define REPMASK 0u
#endif
#define NREP(k) ((((REPMASK) >> (k)) & 1u) ? 2 : 1)
#define SEAM(k) do { if (IN(k) && IN((k) + 1)) xcd_barrier(bar); } while (0)
    FRESH();
    for (int rep = 0; rep < NREP(0); ++rep) if (IN(0)) phase_prologue(a, lds, tid, wave, lane);
    if (IN(0) && IN(1)) { cg::grid_group grid = cg::this_grid(); grid.sync(); }
    FRESH();
    for (int rep = 0; rep < NREP(1); ++rep) if (IN(1)) phase_rownorm<0>(a.in[0], a.in[1], a.in[8], MOD + 1024, MOD + 0, (bf16*)(ws + WS_XN), nullptr, wave, lane);
    SEAM(1);
    FRESH();
    for (int rep = 0; rep < NREP(2); ++rep) if (IN(2)) { pg8::Gemm g{(const bf16*)(ws + WS_XN), (const bf16*)(ws + WS_WIN), TT, INW, DM}; pg8::StaticOrder S; S.init(TT, INW, G, (int)blockIdx.x);
        pg8::EpiBf16<0> E{(bf16*)(ws + WS_PROJ), INW, nullptr, 0, 0, 1.f};
        pg8::gemm_phase<pg8::EpiBf16<0>, pg8::StaticOrder, true, true>(lds, g, S, E); }
    SEAM(2);
    FRESH();
    for (int rep = 0; rep < NREP(3); ++rep) if (IN(3)) phase_mixer<1>(a, lds, tid, wave, lane);
    SEAM(3);
    FRESH();
    for (int rep = 0; rep < NREP(4); ++rep) if (IN(4)) phase_carries(a, tid);
    SEAM(4);
    FRESH();
    for (int rep = 0; rep < NREP(5); ++rep) if (IN(5)) phase_mixer<3>(a, lds, tid, wave, lane);
    SEAM(5);
    FRESH();
    for (int rep = 0; rep < NREP(6); ++rep) if (IN(6)) { pg8::Gemm g{(const bf16*)(ws + WS_Y), (const bf16*)(ws + WS_WOUT), TT, DM, DM}; pg8::StaticOrder S; S.init(TT, DM, G, (int)blockIdx.x);
        pg8::EpiRes E{a.in[0], a.in[1], a.out, MOD + 2048};
        pg8::gemm_phase<pg8::EpiRes, pg8::StaticOrder, true, true>(lds, g, S, E); }
    SEAM(6);
    FRESH();
    for (int rep = 0; rep < NREP(7); ++rep) if (IN(7)) phase_rownorm<0>(a.out, a.out + (size_t)TP * DM, a.in[28], MOD + 4096, MOD + 3072, (bf16*)(ws + WS_XN), nullptr, wave, lane);
    SEAM(7);
#pragma unroll
    for (int half = 0; half < 2; ++half) {
        FRESH();
        if (IN(8 + 2 * half)) { pg8::Gemm g{(const bf16*)(ws + WS_XN) + (size_t)half * HALF_T * DM, (const bf16*)(ws + WS_WGU), HALF_T, FF2, DM}; pg8::StaticOrder S; S.init(HALF_T, FF2, G, (int)blockIdx.x);
            pg8::EpiBf16<0> E{(bf16*)(ws + WS_GH), FF, nullptr, FF, (size_t)((WS_U - WS_GH) / 2) + (size_t)half * HALF_T * FF, 1.f};
            pg8::gemm_phase<pg8::EpiBf16<0>, pg8::StaticOrder, true, true>(lds, g, S, E); }
        SEAM(8 + 2 * half);
        FRESH();
        if (IN(9 + 2 * half)) phase_act(a, half, wave, lane);
        SEAM(9 + 2 * half);
    }
    FRESH();
    for (int rep = 0; rep < NREP(12); ++rep) if (IN(12)) { pg8::Gemm g{(const bf16*)(ws + WS_U), (const bf16*)(ws + WS_WD), TT, DM, FF}; pg8::StaticOrder S; S.init(TT, DM, G, (int)blockIdx.x);
        pg8::EpiRes E{a.out, a.out + (size_t)TP * DM, a.out, MOD + 5120};
        pg8::gemm_phase<pg8::EpiRes, pg8::StaticOrder, true, true>(lds, g, S, E); }
    SEAM(12);
    FRESH();
    if (IN(13)) phase_rownorm<1>(a.out, a.out + (size_t)TP * DM, a.in[34], nullptr, nullptr, nullptr, a.out, wave, lane);
#undef IN
#undef SEAM
}

extern "C" void kernel_launch(void* const* d_in, const int* in_sizes, int n_in, void* d_out, int out_size,
                              void* d_ws, size_t ws_size, hipStream_t stream) {
    static int grid = 0;
    if (grid == 0) {
        int dev = 0, cus = 0, per_cu = 0;
        hipGetDevice(&dev);
        hipDeviceGetAttribute(&cus, hipDeviceAttributeMultiprocessorCount, dev);
        hipFuncSetAttribute((const void*)fwd, hipFuncAttributeMaxDynamicSharedMemorySize, LDS_BYTES);
        hipOccupancyMaxActiveBlocksPerMultiprocessor(&per_cu, (const void*)fwd, 512, LDS_BYTES);
        if (per_cu < 1) per_cu = 1;
        grid = cus * per_cu;
        if (n_in != 35 || ws_size < WS_END) fprintf(stderr, "kernel_launch: unexpected n_in %d / ws_size %zu\n", n_in, ws_size);
    }
    if (hipMemsetAsync((char*)d_ws + WS_BAR, 0, 16384, stream) != hipSuccess) fprintf(stderr, "kernel_launch: memset failed\n");
    Args a{};
    for (int i = 0; i < 35; ++i) a.in[i] = (const float*)d_in[i];
    a.out = (float*)d_out; a.ws = (unsigned char*)d_ws; a.ph_lo = 0; a.ph_hi = 14;
    void* args[] = {&a};
    hipError_t e = hipLaunchCooperativeKernel((const void*)fwd, dim3(grid), dim3(512), args, LDS_BYTES, stream);
    if (e != hipSuccess) fprintf(stderr, "cooperative launch failed: %s (grid %d)\n", hipGetErrorString(e), grid);
}
```

```cpp
#include <hip/hip_runtime.h>
#include <hip/hip_cooperative_groups.h>
#include <cstdio>
#include <cstdint>
namespace cg = cooperative_groups;
namespace pg8 {
#define PG8_LAS __attribute__((address_space(3)))
typedef unsigned short bf16_t;
typedef short bf16x8 __attribute__((ext_vector_type(8)));
typedef float f32x4 __attribute__((ext_vector_type(4)));
typedef unsigned u32x4 __attribute__((ext_vector_type(4)));
constexpr int BM = 256, BK = 64, HALF = 128, HTB = HALF * BK * 2  , STAGE_BYTES = 8 * HTB, NXCD = 8, WGM = 8;

__host__ __device__ __forceinline__ int lds_byte(int r, int c) { const int st = (r >> 4) * 2 + (c >> 5), rr = r & 15, cc = c & 31, ob = rr * 64 + cc * 2; return st * 1024 + (ob ^ (((ob >> 9) & 1) << 5)); }
__host__ __device__ __forceinline__ void stage_rc(int b, int& R, int& C) { const int st = b / 1024, sb = b % 1024, swz = sb ^ (((sb >> 9) & 1) << 5); R = (st >> 1) * 16 + swz / 64; C = (st & 1) * 32 + (swz % 64) / 2; }
__host__ __device__ __forceinline__ int perm32(int rho) { const int n = rho >> 4, i = rho & 15; return 8 * (i >> 2) + 4 * n + (i & 3); }

struct Unit { int pm, pn; };
struct Gemm { const bf16_t* A; const bf16_t* Bt; int M, N, K; };

struct StaticOrder {
    int nM, nN, nwg, G, c;
    __host__ __device__ void init(int M, int N, int G_, int c_) { nM = M / BM; nN = N / BM; nwg = nM * nN; G = G_; c = c_; }
    __host__ __device__ bool next(int i, Unit& u) const {
        const long L = (long)i * G + c; if (L >= nwg) return false;
        int wgid = (int)L; { const int q = nwg / NXCD, r = nwg % NXCD, xcd = wgid % NXCD, off = wgid / NXCD; wgid = (xcd < r ? xcd * (q + 1) : r * (q + 1) + (xcd - r) * q) + off; }
        const int nig = WGM * nN, gid = wgid / nig, fm = gid * WGM, gsz = (nM - fm) < WGM ? (nM - fm) : WGM;
        u.pm = fm + ((wgid % nig) % gsz); u.pn = (wgid % nig) / gsz; return true;
    }
    __device__ __forceinline__ void a_ready(const Unit&) const {}
    __device__ __forceinline__ void done(const Unit&) const {}
};

__device__ __forceinline__ unsigned cvt_pk_bf16(float lo, float hi) { unsigned r; asm volatile("v_cvt_pk_bf16_f32 %0, %1, %2" : "=v"(r) : "v"(lo), "v"(hi)); return r; }
typedef float f32x2 __attribute__((ext_vector_type(2)));
__device__ __forceinline__ f32x2 gelu_pk(f32x2 v) {
    const f32x2 av = __builtin_elementwise_abs(v), d = av * 0.2316418882f + 1.0f;
    f32x2 t; t.x = __builtin_amdgcn_rcpf(d.x); t.y = __builtin_amdgcn_rcpf(d.y);
    f32x2 q = t * 0.5307027145f + (-0.7265760135f); q = q * t + 0.7107068705f; q = q * t + (-0.142248368f); q = q * t + 0.127414796f; q = q * t;
    const f32x2 s = (v * v) * (-0.72134752044f);
    f32x2 e; e.x = __builtin_amdgcn_exp2f(s.x); e.y = __builtin_amdgcn_exp2f(s.y);
    const f32x2 m = v * (q * e), r = v - m;
    f32x2 o; o.x = v.x < 0.f ? m.x : r.x; o.y = v.y < 0.f ? m.y : r.y; return o;
}

template <int ACT  > struct EpiBf16 {
    static constexpr bool PERM = true, AFTER_DRAIN = false; static_assert(ACT == 0 || ACT == 1, "EpiBf16: ACT is 0 (none) or 1 (gelu_pk)");
    bf16_t* O; int ldc; const float* bias; int split_cols; size_t split_stride; float scale0;
    __device__ __forceinline__ void operator()(const f32x4 (&acc)[2][2][4][2], const Unit& u, int wr, int wc, int fr, int fq) const {
        const int row0 = u.pm * BM + wr * 64 + fr; int colt = u.pn * BM; bf16_t* base = O;
        float sc = 1.f; if (split_cols) { const int t = colt / split_cols; base += (size_t)t * split_stride; colt -= t * split_cols; if (t == 0) sc = scale0; }
        const int col0 = colt + wc * 32 + 8 * fq, bcol0 = u.pn * BM + wc * 32 + 8 * fq;
        f32x4 bv[2][2];
#pragma unroll
        for (int bj = 0; bj < 2; ++bj)
#pragma unroll
            for (int n = 0; n < 2; ++n) bv[bj][n] = bias ? *(const f32x4*)(bias + bcol0 + bj * HALF + 4 * n) : (f32x4){0.f, 0.f, 0.f, 0.f};
#pragma unroll
        for (int ai = 0; ai < 2; ++ai)
#pragma unroll
            for (int m = 0; m < 4; ++m) { bf16_t* rowp = base + (size_t)(row0 + ai * HALF + m * 16) * ldc + col0;
#pragma unroll
                for (int bj = 0; bj < 2; ++bj) { f32x4 v0 = acc[ai][bj][m][0] + bv[bj][0], v1 = acc[ai][bj][m][1] + bv[bj][1];
                    if (ACT == 1) { f32x2 a = gelu_pk((f32x2){v0[0], v0[1]}), b = gelu_pk((f32x2){v0[2], v0[3]}), c = gelu_pk((f32x2){v1[0], v1[1]}), d = gelu_pk((f32x2){v1[2], v1[3]});
                        v0 = (f32x4){a.x, a.y, b.x, b.y}; v1 = (f32x4){c.x, c.y, d.x, d.y}; }
                    v0 = v0 * sc; v1 = v1 * sc; u32x4 w; w.x = cvt_pk_bf16(v0[0], v0[1]); w.y = cvt_pk_bf16(v0[2], v0[3]); w.z = cvt_pk_bf16(v1[0], v1[1]); w.w = cvt_pk_bf16(v1[2], v1[3]);
                    *(u32x4*)(rowp + bj * HALF) = w; } }
    }
};
template <class Epi, class Sched, bool ALIGN_EPI = false, bool SP2 = false>
__device__ __forceinline__ void gemm_phase(PG8_LAS unsigned char* lds, const Gemm g, const Sched& S, const Epi& E) {
    int tid_ = threadIdx.x; asm volatile("" : "+v"(tid_));
    const int tid = tid_, wid = __builtin_amdgcn_readfirstlane(tid >> 6), lane = tid & 63, wr = wid >> 2, wc = wid & 3, fr = lane & 15, fq = lane >> 4;
    const int K = g.K, nt = K / BK;
    unsigned voffA[2], voffB[2];
#pragma unroll
    for (int i = 0; i < 2; ++i) { int R, C; stage_rc(tid * 16 + i * 8192, R, C); const int Rb = Epi::PERM ? ((R & ~31) + perm32(R & 31)) : R;
        voffA[i] = (unsigned)(R * K + C) * 2u; voffB[i] = (unsigned)(Rb * K + C) * 2u; }
    const size_t kstep = (size_t)(BK * 2);
    const size_t hstep = (size_t)HALF * K * 2;
    const size_t tstep = 2 * hstep;
    const unsigned ldsw = (unsigned)wid * 1024u;
    const int aoff = lds_byte(wr * 64 + fr, fq * 8), boff = lds_byte(wc * 32 + fr, fq * 8);
#define PG8_SA(b, h) (((b) * 2 + (h)) * HTB)
#define PG8_SB(b, h) ((4 + (b) * 2 + (h)) * HTB)
#define PG8_STAGE(bufoff, gbase, voff) do { _Pragma("unroll") for (int _i = 0; _i < 2; ++_i) \
        __builtin_amdgcn_global_load_lds((const unsigned*)((const char*)(gbase) + (voff)[_i]), (PG8_LAS unsigned*)(lds + (bufoff) + ldsw + _i * 8192), 16, 0, 0); } while (0)
#define PG8_LDA(dst, b, h) do { _Pragma("unroll") for (int m = 0; m < 4; ++m) _Pragma("unroll") for (int k = 0; k < 2; ++k) dst[m][k] = *(const PG8_LAS bf16x8*)(lds + PG8_SA(b, h) + aoff + m * 2048 + k * 1024); } while (0)
#define PG8_LDB(dst, b, h) do { _Pragma("unroll") for (int n = 0; n < 2; ++n) _Pragma("unroll") for (int k = 0; k < 2; ++k) dst[n][k] = *(const PG8_LAS bf16x8*)(lds + PG8_SB(b, h) + boff + n * 2048 + k * 1024); } while (0)
#define PG8_MMA(ai, bj, At, Bt) do { __builtin_amdgcn_s_setprio(1); _Pragma("unroll") for (int m = 0; m < 4; ++m) _Pragma("unroll") for (int n = 0; n < 2; ++n) _Pragma("unroll") for (int k = 0; k < 2; ++k) \
        acc[ai][bj][m][n] = __builtin_amdgcn_mfma_f32_16x16x32_bf16(Bt[n][k], At[m][k], acc[ai][bj][m][n], 0, 0, 0); __builtin_amdgcn_s_setprio(0); } while (0)
#define PG8_WAIT_V(n) asm volatile("s_waitcnt vmcnt(" #n ")" ::: "memory")
#define PG8_WAIT_L(n) asm volatile("s_waitcnt lgkmcnt(" #n ")" ::: "memory")
#define PG8_BAR __builtin_amdgcn_s_barrier()
#define PG8_SCHED __builtin_amdgcn_sched_barrier(0)
    Unit cur, nxt; int ui = 0;
    if (!S.next(0, cur)) return;
    f32x4 acc[2][2][4][2];
#pragma unroll
    for (int a = 0; a < 2; ++a)
#pragma unroll
        for (int b = 0; b < 2; ++b)
#pragma unroll
            for (int m = 0; m < 4; ++m)
#pragma unroll
                for (int n = 0; n < 2; ++n) acc[a][b][m][n] = (f32x4){0.f, 0.f, 0.f, 0.f};
    bf16x8 At[4][2], B0[2][2], B1[2][2];
    const char* cA = (const char*)g.A + (size_t)cur.pm * tstep; const char* cB = (const char*)g.Bt + (size_t)cur.pn * tstep;
    S.a_ready(cur);
    if constexpr (SP2) {
        PG8_STAGE(PG8_SB(0, 0), cB, voffB); PG8_STAGE(PG8_SB(0, 1), cB + hstep, voffB); PG8_STAGE(PG8_SA(0, 0), cA, voffA); PG8_STAGE(PG8_SA(0, 1), cA + hstep, voffA);
        if (wr == 1) PG8_BAR;
        PG8_WAIT_V(2); PG8_BAR;
        PG8_STAGE(PG8_SB(1, 0), cB + kstep, voffB); PG8_STAGE(PG8_SA(1, 0), cA + kstep, voffA); PG8_STAGE(PG8_SB(1, 1), cB + hstep + kstep, voffB);
        PG8_WAIT_V(6); PG8_BAR;
    } else {
        PG8_STAGE(PG8_SB(0, 0), cB, voffB); PG8_STAGE(PG8_SA(0, 0), cA, voffA); PG8_STAGE(PG8_SB(0, 1), cB + hstep, voffB); PG8_STAGE(PG8_SA(0, 1), cA + hstep, voffA);
        if (wr == 1) PG8_BAR;
        PG8_WAIT_V(4); PG8_BAR;
        PG8_STAGE(PG8_SB(1, 0), cB + kstep, voffB); PG8_STAGE(PG8_SA(1, 0), cA + kstep, voffA); PG8_STAGE(PG8_SB(1, 1), cB + hstep + kstep, voffB);
        PG8_WAIT_V(6); PG8_BAR;
    }
    for (;;) {
        const bool has_next = S.next(ui + 1, nxt);
        const char* nA = has_next ? (const char*)g.A + (size_t)nxt.pm * tstep : cA; const char* nB = has_next ? (const char*)g.Bt + (size_t)nxt.pn * tstep : cB;
        for (int t = 0; t < nt; t += 2) {
            const bool last = (t == nt - 2);
            const char* a1 = cA + (size_t)(t + 1) * kstep;
            const char* a2 = last ? nA : cA + (size_t)(t + 2) * kstep; const char* b2 = last ? nB : cB + (size_t)(t + 2) * kstep;
            const char* a3 = a2 + kstep; const char* b3 = b2 + kstep;
            if (last && has_next) S.a_ready(nxt);
            if constexpr (SP2) {
            PG8_LDB(B0, 0, 0); PG8_LDB(B1, 0, 1); PG8_SCHED; PG8_LDA(At, 0, 0); PG8_STAGE(PG8_SA(1, 1), a1 + hstep, voffA);
            PG8_WAIT_V(8); PG8_WAIT_L(0); PG8_BAR; PG8_MMA(0, 0, At, B0); PG8_MMA(0, 1, At, B1); PG8_BAR; PG8_SCHED;
            PG8_LDA(At, 0, 1); PG8_STAGE(PG8_SB(0, 0), b2, voffB); PG8_STAGE(PG8_SB(0, 1), b2 + hstep, voffB); PG8_STAGE(PG8_SA(0, 0), a2, voffA);
            PG8_WAIT_V(8); PG8_WAIT_L(0); PG8_BAR; PG8_MMA(1, 0, At, B0); PG8_MMA(1, 1, At, B1); PG8_BAR; PG8_SCHED;
            PG8_LDB(B0, 1, 0); PG8_LDB(B1, 1, 1); PG8_SCHED; PG8_LDA(At, 1, 0); PG8_STAGE(PG8_SA(0, 1), a2 + hstep, voffA);
            PG8_WAIT_V(8); PG8_WAIT_L(0); PG8_BAR; PG8_MMA(0, 0, At, B0); PG8_MMA(0, 1, At, B1); PG8_BAR; PG8_SCHED;
            PG8_LDA(At, 1, 1); PG8_STAGE(PG8_SB(1, 0), b3, voffB); PG8_STAGE(PG8_SB(1, 1), b3 + hstep, voffB); PG8_STAGE(PG8_SA(1, 0), a3, voffA);
            PG8_WAIT_V(8); PG8_WAIT_L(0); PG8_BAR; PG8_MMA(1, 0, At, B0); PG8_MMA(1, 1, At, B1); PG8_BAR; PG8_SCHED;
            } else {
            PG8_LDB(B0, 0, 0); PG8_SCHED; PG8_LDA(At, 0, 0); PG8_STAGE(PG8_SA(1, 1), a1 + hstep, voffA);
            PG8_WAIT_L(8); PG8_BAR; PG8_WAIT_L(0); PG8_MMA(0, 0, At, B0); PG8_BAR; PG8_SCHED;
            PG8_LDB(B1, 0, 1); PG8_STAGE(PG8_SB(0, 0), b2, voffB);
            PG8_BAR; PG8_WAIT_L(0); PG8_MMA(0, 1, At, B1); PG8_BAR;
            PG8_LDA(At, 0, 1); PG8_STAGE(PG8_SA(0, 0), a2, voffA);
            PG8_BAR; PG8_WAIT_L(0); PG8_MMA(1, 0, At, B0); PG8_BAR; PG8_SCHED;
            PG8_STAGE(PG8_SB(0, 1), b2 + hstep, voffB);
            PG8_WAIT_V(6); PG8_BAR; PG8_MMA(1, 1, At, B1); PG8_BAR;
            PG8_LDB(B0, 1, 0); PG8_SCHED; PG8_LDA(At, 1, 0); PG8_STAGE(PG8_SA(0, 1), a2 + hstep, voffA);
            PG8_WAIT_L(8); PG8_BAR; PG8_WAIT_L(0); PG8_MMA(0, 0, At, B0); PG8_BAR; PG8_SCHED;
            PG8_LDB(B1, 1, 1); PG8_STAGE(PG8_SB(1, 0), b3, voffB);
            PG8_BAR; PG8_WAIT_L(0); PG8_MMA(0, 1, At, B1); PG8_BAR;
            PG8_LDA(At, 1, 1); PG8_STAGE(PG8_SA(1, 0), a3, voffA);
            PG8_BAR; PG8_WAIT_L(0); PG8_MMA(1, 0, At, B0); PG8_BAR; PG8_SCHED;
            PG8_STAGE(PG8_SB(1, 1), b3 + hstep, voffB);
            PG8_WAIT_V(6); PG8_BAR; PG8_MMA(1, 1, At, B1); PG8_BAR;
            }
        }
        if constexpr (ALIGN_EPI) { if (wr == 0) PG8_BAR; }
        if constexpr (!Epi::AFTER_DRAIN) { E(acc, cur, wr, wc, fr, fq); S.done(cur); }
        if (!has_next) break;
#pragma unroll
        for (int a = 0; a < 2; ++a)
#pragma unroll
            for (int b = 0; b < 2; ++b)
#pragma unroll
                for (int m = 0; m < 4; ++m)
#pragma unroll
                    for (int n = 0; n < 2; ++n) acc[a][b][m][n] = (f32x4){0.f, 0.f, 0.f, 0.f};
        cur = nxt; cA = nA; cB = nB; ++ui;
        if constexpr (ALIGN_EPI) { if (wr == 1) PG8_BAR; }
    }
    PG8_WAIT_V(0);
    if constexpr (!ALIGN_EPI) { if (wr == 0) PG8_BAR; }
    PG8_BAR;
    if constexpr (Epi::AFTER_DRAIN) { E.fused(acc, cur, wr, wc, fr, fq, lds, wid, lane); S.done(cur); }
#undef PG8_SA
#undef PG8_SB
#undef PG8_STAGE
#undef PG8_LDA
#undef PG8_LDB
#undef PG8_MMA
#undef PG8_WAIT_V
#undef PG8_WAIT_L
#undef PG8_BAR
#undef PG8_SCHED
}
}
namespace pg8 {
struct EpiRes {
    static constexpr bool PERM = false, AFTER_DRAIN = false;
    const float* xp; const float* xs;
    float* out; const float* gate;
    __device__ __forceinline__ void operator()(const f32x4 (&acc)[2][2][4][2], const Unit& u, int wr, int wc, int fr, int fq) const {
        const int row0 = u.pm * BM + wr * 64 + fr, col0 = u.pn * BM + wc * 32 + 4 * fq;
        const int v = (u.pm * BM < 8192) ? 0 : 1 + ((u.pm * BM - 8192) >> 12);
        const float* g = gate + (size_t)v * 6144 + col0;
        f32x4 gv[2][2];
#pragma unroll
        for (int bj = 0; bj < 2; ++bj)
#pragma unroll
            for (int n = 0; n < 2; ++n) gv[bj][n] = *(const f32x4*)(g + bj * HALF + n * 16);
#pragma unroll
        for (int ai = 0; ai < 2; ++ai)
#pragma unroll
            for (int m = 0; m < 4; ++m) {
                const int row = row0 + ai * HALF + m * 16;
                const float* bp = (row < 8192 ? xp + (size_t)row * 1024 : xs + (size_t)(row - 8192) * 1024) + col0;
                float* op = out + (size_t)row * 1024 + col0;
#pragma unroll
                for (int bj = 0; bj < 2; ++bj)
#pragma unroll
                    for (int n = 0; n < 2; ++n) { const f32x4 b = *(const f32x4*)(bp + bj * HALF + n * 16); *(f32x4*)(op + bj * HALF + n * 16) = b + gv[bj][n] * acc[ai][bj][m][n]; }
            }
    }
};
}

constexpr int DM = 1024, TP = 8192, TSMP = 32768, TT = 40960, INW = 3072, FF = 2816, FF2 = 5632;
constexpr int NCHUNK = 320, HALF_T = 20480;
constexpr int OFF_LF = 41943040, OFF_LB = OFF_LF + 16384, OFF_RF = OFF_LB + 16384, OFF_RB = OFF_RF + 2097152;
constexpr size_t MiB = 1u << 20;
constexpr size_t WS_MOD = 0, WS_WL = 256 * 1024, WS_AGG = 1 * MiB, WS_CAR = 3 * MiB + 512 * 1024;
constexpr size_t WS_WIN = 5 * MiB, WS_WOUT = 11 * MiB, WS_WGU = 13 * MiB, WS_WD = 24 * MiB;
constexpr size_t WS_XN = 30 * MiB, WS_SB = 30 * MiB, WS_PROJ = 110 * MiB, WS_Y = 350 * MiB, WS_KVT = 430 * MiB;
constexpr size_t WS_GH = 110 * MiB, WS_U = 220 * MiB, WS_END = 510 * MiB;
constexpr int LDS_BYTES = 147456, LDSCTL_OFF = 143360;
constexpr size_t WS_BAR = 768 * 1024;
constexpr int NWAVES = 8;

#define GAS __attribute__((address_space(1)))
#define LAS __attribute__((address_space(3)))
typedef unsigned short bf16;
typedef unsigned v4u __attribute__((ext_vector_type(4)));
typedef unsigned v2u __attribute__((ext_vector_type(2)));
typedef float f32x4 __attribute__((ext_vector_type(4)));
typedef short bf16x8 __attribute__((ext_vector_type(8)));
#define LDS_WAIT() asm volatile("s_waitcnt lgkmcnt(0)" ::: "memory")
typedef float f32x2_t __attribute__((ext_vector_type(2)));
typedef __bf16 bf16x2_t __attribute__((ext_vector_type(2)));
__device__ __forceinline__ unsigned pk2(float lo, float hi) { const f32x2_t v = {lo, hi}; const bf16x2_t b = __builtin_convertvector(v, bf16x2_t); return __builtin_bit_cast(unsigned, b); }
__device__ __forceinline__ unsigned f2bf(float f) { return pk2(f, 0.f) & 0xffffu; }

__device__ __forceinline__ float bflo(unsigned w) { return __builtin_bit_cast(float, w << 16); }
__device__ __forceinline__ float bfhi(unsigned w) { return __builtin_bit_cast(float, w & 0xffff0000u); }
__device__ __forceinline__ float bf2f(unsigned short h) { return __builtin_bit_cast(float, ((unsigned)h) << 16); }
__device__ __forceinline__ float sigmoidf_(float x) { return 1.0f / (1.0f + __expf(-x)); }
__device__ __forceinline__ float siluf_(float x) { return x * __builtin_amdgcn_rcpf(1.0f + __builtin_amdgcn_exp2f(-1.4426950408889634f * x)); }
__device__ __forceinline__ float gelu_tanh(float x) { const float z = x * fmaf(0.044715f * x, x, 1.0f); return x * __builtin_amdgcn_rcpf(1.0f + __builtin_amdgcn_exp2f(-2.302208198f * z)); }

struct Args { const float* in[35]; float* out; unsigned char* ws; int ph_lo, ph_hi; };

#define XB_TMO      128
#define XB_XCNT(j)  (256  + 64 * (j))
#define XB_XSUB(j)  (1280 + 64 * (j))
#define XB_XGEN(j)  (2304 + 64 * (j))
#define XB_TOP      3328
#define XB_TOPGEN   3392
#define XCD_BAR_WORDS 3456
#define XB_SPIN_CAP (1u << 18)

__device__ __forceinline__ unsigned xb_ld(unsigned* p)              { return __hip_atomic_load(p, __ATOMIC_RELAXED, __HIP_MEMORY_SCOPE_AGENT); }
__device__ __forceinline__ unsigned xb_add(unsigned* p, unsigned v) { return __hip_atomic_fetch_add(p, v, __ATOMIC_RELAXED, __HIP_MEMORY_SCOPE_AGENT); }
__device__ __forceinline__ unsigned xb_xcc_id() { return (unsigned)__builtin_amdgcn_s_getreg((3 << 11) | 20) & 0xFu; }
#define XB_SPIN(cond, bar) do { unsigned _sp = 0; while (cond) { __builtin_amdgcn_s_sleep(1); \
    if ((++_sp & 255u) == 0u) { if (xb_ld(&(bar)[XB_TMO])) break; if (_sp > XB_SPIN_CAP) { atomicAdd(&(bar)[XB_TMO], 1u); break; } } } } while (0)

struct XcdBarrier {
    unsigned* bar; unsigned x;
    volatile LAS unsigned* st;
};

__device__ __forceinline__ XcdBarrier xcd_barrier_post(unsigned* bar, volatile LAS unsigned* st) {
    XcdBarrier b; b.bar = bar; b.x = xb_xcc_id(); b.st = st;
    if (threadIdx.x == 0) (void)xb_add(&bar[XB_XCNT(b.x)], 1u);
    return b;
}
__device__ __forceinline__ void xcd_barrier_complete(unsigned* bar, unsigned x, unsigned& nloc, unsigned& nx) {
    const unsigned G = gridDim.x * gridDim.y * gridDim.z;
    unsigned sum, cnt, mine, sp = 0u;
    for (;;) {
        sum = 0u; cnt = 0u; mine = 0u;
#pragma unroll
        for (unsigned j = 0; j < 16; ++j) { const unsigned c = xb_ld(&bar[XB_XCNT(j)]); sum += c; cnt += (c > 0u) ? 1u : 0u; mine = (j == x) ? c : mine; }
        if (sum == G) break;
        __builtin_amdgcn_s_sleep(1);
        if ((++sp & 255u) == 0u) { if (xb_ld(&bar[XB_TMO])) break; if (sp > XB_SPIN_CAP) { atomicAdd(&bar[XB_TMO], 1u); break; } }
    }
    nloc = mine > 0u ? mine : 1u; nx = cnt > 0u ? cnt : 1u;
}

__device__ __forceinline__ void xcd_barrier(const XcdBarrier& b) {
    asm volatile("s_waitcnt vmcnt(0)" ::: "memory");
    __syncthreads();
    if (threadIdx.x == 0) {
        unsigned* bar = b.bar;
        __builtin_amdgcn_s_waitcnt(0);
        unsigned nloc = b.st[0], nx = b.st[1];
        if (nloc == 0u) { xcd_barrier_complete(bar, b.x, nloc, nx); b.st[0] = nloc; b.st[1] = nx; }
        const unsigned old = xb_add(&bar[XB_XSUB(b.x)], 1u);
        const unsigned gen = old / nloc;
        if (old + 1u == (gen + 1u) * nloc) {
            __builtin_amdgcn_fence(__ATOMIC_RELEASE, "agent");
            asm volatile("s_waitcnt vmcnt(0)" ::: "memory");
            const unsigned og = xb_add(&bar[XB_TOP], 1u);
            const unsigned tg = og / nx;
            if (og + 1u == (tg + 1u) * nx) xb_add(&bar[XB_TOPGEN], 1u);
            else XB_SPIN(xb_ld(&bar[XB_TOPGEN]) == tg, bar);
            __builtin_amdgcn_fence(__ATOMIC_ACQUIRE, "agent");
            xb_add(&bar[XB_XGEN(b.x)], 1u);
            asm volatile("s_waitcnt vmcnt(0)" ::: "memory");
        } else {
            XB_SPIN(xb_ld(&bar[XB_XGEN(b.x)]) == gen, bar);
            __builtin_amdgcn_fence(__ATOMIC_ACQUIRE, "agent");
            asm volatile("s_waitcnt vmcnt(0)" ::: "memory");
        }
    }
    __syncthreads();
}
__device__ __forceinline__ float wave_sum(float v) {
#pragma unroll
    for (int o = 1; o < 64; o <<= 1) v += __shfl_xor(v, o);
    return v;
}
__device__ __forceinline__ void p0_transpose_item(const float* W, int K, int N, bf16* WT, int row_off, LAS float* scr, int item, int lane) {
    const int nblk = N / 32, kb = item / nblk, nb = item % nblk, k0 = 64 * kb, n0 = 32 * nb;
#pragma unroll 8
    for (int i = 0; i < 32; ++i) { const int kk = 2 * i + (lane >> 5); scr[kk * 33 + (lane & 31)] = W[(size_t)(k0 + kk) * N + n0 + (lane & 31)]; }
    LDS_WAIT(); asm volatile("" ::: "memory");
    const int c = lane & 7;
#pragma unroll
    for (int j = 0; j < 4; ++j) { const int n = (lane >> 3) + 8 * j; const LAS float* s = scr + (8 * c) * 33 + n;
        v4u o; o.x = pk2(s[0 * 33], s[1 * 33]); o.y = pk2(s[2 * 33], s[3 * 33]); o.z = pk2(s[4 * 33], s[5 * 33]); o.w = pk2(s[6 * 33], s[7 * 33]);
        *(v4u*)(WT + (size_t)(row_off + n0 + n) * K + k0 + 8 * c) = o; }
    LDS_WAIT(); asm volatile("" ::: "memory");
}
__device__ __forceinline__ int mod_index(int row) { return row < TP ? 0 : 1 + ((row - TP) >> 12); }

__device__ __forceinline__ void phase_prologue(const Args& a, LAS unsigned char* lds, int tid, int wave, int lane) {
    unsigned char* ws = a.ws;
    if (blockIdx.x < 96) {
        LAS float* sc = (LAS float*)lds;
        LAS float* red = (LAS float*)(lds + 9 * 1024 * 4);
        for (int i = tid; i < 9 * 1024; i += 512) { const int v = i >> 10, k = i & 1023; const float x = (v == 0) ? a.in[7][k] : a.in[6][(v - 1) * 1024 + k]; sc[i] = siluf_(x); }
        __syncthreads();
        const int col = blockIdx.x * 64 + lane;
        const float* wm = a.in[9] + col;
        float acc[9];
#pragma unroll
        for (int v = 0; v < 9; ++v) acc[v] = 0.f;
        const int kbeg = wave * 128;
#pragma unroll 8
        for (int kk = 0; kk < 128; ++kk) { const int k = kbeg + kk; const float wv = wm[(size_t)k * 6144];
#pragma unroll
            for (int v = 0; v < 9; ++v) acc[v] += sc[v * 1024 + k] * wv; }
#pragma unroll
        for (int v = 0; v < 9; ++v) red[(wave * 9 + v) * 64 + lane] = acc[v];
        __syncthreads();
        for (int i = tid; i < 9 * 64; i += 512) { const int v = i >> 6, l = i & 63; float s = 0.f;
#pragma unroll
            for (int w = 0; w < 8; ++w) s += red[(w * 9 + v) * 64 + l];
            const int cc = blockIdx.x * 64 + l; ((float*)(ws + WS_MOD))[v * 6144 + cc] = s + a.in[10][cc]; }
        __syncthreads();
    }
    LAS float* scr = (LAS float*)(lds + wave * 16384);
    const int gw = blockIdx.x * NWAVES + wave, NGW = gridDim.x * NWAVES;
    constexpr int I_IN = 16 * 96, I_OUT = 16 * 32, I_G = 16 * 88, I_D = 44 * 32, I_L = 64;
    constexpr int NITEMS = I_IN + I_OUT + 2 * I_G + I_D + I_L;
    for (int it = gw; it < NITEMS; it += NGW) {
        int r = it;
        if (r < I_IN) { p0_transpose_item(a.in[11], 1024, 3072, (bf16*)(ws + WS_WIN), 0, scr, r, lane); continue; } r -= I_IN;
        if (r < I_OUT) { p0_transpose_item(a.in[27], 1024, 1024, (bf16*)(ws + WS_WOUT), 0, scr, r, lane); continue; } r -= I_OUT;
        if (r < I_G) { p0_transpose_item(a.in[29], 1024, 2816, (bf16*)(ws + WS_WGU), 0, scr, r, lane); continue; } r -= I_G;
        if (r < I_G) { p0_transpose_item(a.in[30], 1024, 2816, (bf16*)(ws + WS_WGU), 2816, scr, r, lane); continue; } r -= I_G;
        if (r < I_D) { p0_transpose_item(a.in[33], 2816, 1024, (bf16*)(ws + WS_WD), 0, scr, r, lane); continue; } r -= I_D;
        { const int blk = r >> 1, sub = r & 1, mat = blk >> 3, nb = blk & 7;
          const float* src = (mat == 0 ? a.in[14] : mat == 1 ? a.in[16] : mat == 2 ? a.in[19] : a.in[21]) + nb * 4096;
          p0_transpose_item(src, 64, 64, (bf16*)(ws + WS_WL) + (size_t)(mat * 8 + nb) * 4096, 0, scr, sub, lane); }
    }
}

template <int MODE>
__device__ __forceinline__ void phase_rownorm(const float* xp, const float* xs, const float* w, const float* mod_scale, const float* mod_shift, bf16* obf, float* of32, int wave, int lane) {
    const int gw = blockIdx.x * NWAVES + wave, NGW = gridDim.x * NWAVES;
    f32x4 wv[4];
#pragma unroll
    for (int j = 0; j < 4; ++j) wv[j] = *(const f32x4*)(w + 4 * lane + 256 * j);
    for (int row0 = gw; row0 < TT; row0 += 2 * NGW) {
        const int row1 = row0 + NGW; const bool has1 = row1 < TT; const int r1 = has1 ? row1 : row0;
        const float* xr0 = (row0 < TP ? xp + (size_t)row0 * DM : xs + (size_t)(row0 - TP) * DM) + 4 * lane;
        const float* xr1 = (r1 < TP ? xp + (size_t)r1 * DM : xs + (size_t)(r1 - TP) * DM) + 4 * lane;
        f32x4 v0[4], v1[4]; float s0 = 0.f, s1 = 0.f;
#pragma unroll
        for (int j = 0; j < 4; ++j) { v0[j] = *(const f32x4*)(xr0 + 256 * j); v1[j] = *(const f32x4*)(xr1 + 256 * j); }
#pragma unroll
        for (int j = 0; j < 4; ++j) { s0 += (v0[j].x * v0[j].x + v0[j].y * v0[j].y) + (v0[j].z * v0[j].z + v0[j].w * v0[j].w); s1 += (v1[j].x * v1[j].x + v1[j].y * v1[j].y) + (v1[j].z * v1[j].z + v1[j].w * v1[j].w); }
        const float rs0 = 1.0f / sqrtf(wave_sum(s0) * (1.0f / DM) + 1e-6f), rs1 = 1.0f / sqrtf(wave_sum(s1) * (1.0f / DM) + 1e-6f);
#pragma unroll
        for (int k = 0; k < 2; ++k) {
            if (k == 1 && !has1) break;
            const int row = k ? row1 : row0; const float rstd = k ? rs1 : rs0;
            if (MODE == 0) {
                const int mv = mod_index(row);
                const float* sc = mod_scale + (size_t)mv * 6144 + 4 * lane; const float* sh = mod_shift + (size_t)mv * 6144 + 4 * lane;
                unsigned long long* o8 = (unsigned long long*)(obf + (size_t)row * DM) + lane;
#pragma unroll
                for (int j = 0; j < 4; ++j) { const f32x4 scv = *(const f32x4*)(sc + 256 * j), shv = *(const f32x4*)(sh + 256 * j);
                    const f32x4 y = (k ? v1[j] : v0[j]) * rstd * wv[j] * (scv + 1.0f) + shv;
                    o8[64 * j] = (unsigned long long)pk2(y.x, y.y) | ((unsigned long long)pk2(y.z, y.w) << 32); }
            } else {
                float* o = of32 + (size_t)row * DM + 4 * lane;
#pragma unroll
                for (int j = 0; j < 4; ++j) *(f32x4*)(o + 256 * j) = (k ? v1[j] : v0[j]) * rstd * wv[j];
            }
        }
    }
}
constexpr int RS = 272;
constexpr int REG = 128 * RS;
constexpr int XCS = 1040;
#define MFMA16(a, b, c) __builtin_amdgcn_mfma_f32_16x16x32_bf16((a), (b), (c), 0, 0, 0)

__device__ __forceinline__ void mm128(f32x4 (&acc)[8], const LAS unsigned char* Aimg, const LAS unsigned char* Bimg, int wave, int c, int q) {
#pragma unroll
    for (int s = 0; s < 4; ++s) {
        const bf16x8 af = *(const LAS bf16x8*)(Aimg + (16 * wave + c) * RS + (32 * s + 8 * q) * 2);
#pragma unroll
        for (int t = 0; t < 8; ++t) { const bf16x8 bfr = *(const LAS bf16x8*)(Bimg + (16 * t + c) * RS + (32 * s + 8 * q) * 2); acc[t] = MFMA16(bfr, af, acc[t]); }
    }
}
__device__ __forceinline__ void mm128x2(f32x4 (&acc1)[8], f32x4 (&acc2)[8], const LAS unsigned char* Aimg, const LAS unsigned char* B1, const LAS unsigned char* B2, int wave, int c, int q) {
#pragma unroll
    for (int s = 0; s < 4; ++s) {
        const bf16x8 af = *(const LAS bf16x8*)(Aimg + (16 * wave + c) * RS + (32 * s + 8 * q) * 2);
#pragma unroll
        for (int t = 0; t < 8; ++t) { const bf16x8 b1 = *(const LAS bf16x8*)(B1 + (16 * t + c) * RS + (32 * s + 8 * q) * 2); acc1[t] = MFMA16(b1, af, acc1[t]);
                                      const bf16x8 b2 = *(const LAS bf16x8*)(B2 + (16 * t + c) * RS + (32 * s + 8 * q) * 2); acc2[t] = MFMA16(b2, af, acc2[t]); }
    }
}
__device__ __forceinline__ void load_rm(LAS unsigned char* img, const bf16* g, int pitch, int tid) {
#pragma unroll
    for (int i = 0; i < 4; ++i) { const int p = tid + 512 * i, row = p >> 4, cp = p & 15; const v4u v = *(const v4u*)(g + (size_t)row * pitch + cp * 8); *(LAS v4u*)(img + row * RS + cp * 16) = v; }
}
#define HW(v, e) (((e) & 1) ? ((v)[(e) >> 1] >> 16) : ((v)[(e) >> 1] & 0xffffu))
__device__ __forceinline__ void load_tr(LAS unsigned char* img, const bf16* g, int pitch, int wave, int lane) {
#pragma unroll
    for (int it = 0; it < 2; ++it) { const int dg = wave + 8 * it;
        const v4u a = *(const v4u*)(g + (size_t)(2 * lane) * pitch + dg * 8), b = *(const v4u*)(g + (size_t)(2 * lane + 1) * pitch + dg * 8);
#pragma unroll
        for (int e = 0; e < 8; ++e) { const unsigned lo = HW(a, e), hi = HW(b, e); *(LAS unsigned*)(img + (dg * 8 + e) * RS + lane * 4) = lo | (hi << 16); } }
}
__device__ __forceinline__ float log_sigmoid_(float x) { return -log1pf(__expf(-x)); }

template <int PASS>
__device__ __forceinline__ void ret_item(const Args& a, LAS unsigned char* lds, int ci, int h, int tid, int wave, int lane) {
    unsigned char* ws = a.ws;
    const int c = lane & 15, q = lane >> 4;
    const bf16* PROJ = (const bf16*)(ws + WS_PROJ);
    const size_t rowbase = (size_t)ci * 128;
    const bf16* Qg = PROJ + rowbase * INW + 1024 + h * 128;
    const bf16* Kg = PROJ + rowbase * INW + 1536 + h * 128;
    const bf16* Vg = PROJ + rowbase * INW + 2048 + h * 128;
    const float lf2 = log_sigmoid_(a.in[24][h]) * 1.4426950408889634f, lb2 = log_sigmoid_(a.in[25][h]) * 1.4426950408889634f;
    const float scale = 0.08838834764831845f;
    LAS unsigned char* R1 = lds; LAS unsigned char* R2 = lds + REG; LAS unsigned char* R3 = lds + 2 * REG; LAS unsigned char* R4 = lds + 3 * REG;
    if (PASS == 1) {
        const float j0 = (float)(2 * lane), j1 = (float)(2 * lane + 1);
        const float wf0 = scale * __builtin_amdgcn_exp2f(lf2 * (127.f - j0)), wf1 = scale * __builtin_amdgcn_exp2f(lf2 * (127.f - j1)), wb0 = scale * __builtin_amdgcn_exp2f(lb2 * j0), wb1 = scale * __builtin_amdgcn_exp2f(lb2 * j1);
        load_tr(R1, Kg, INW, wave, lane);
#pragma unroll
        for (int it = 0; it < 2; ++it) { const int dg = wave + 8 * it;
            const v4u va = *(const v4u*)(Vg + (size_t)(2 * lane) * INW + dg * 8), vb = *(const v4u*)(Vg + (size_t)(2 * lane + 1) * INW + dg * 8);
#pragma unroll
            for (int e = 0; e < 8; ++e) { const float lo = bf2f((unsigned short)HW(va, e)), hi = bf2f((unsigned short)HW(vb, e));
                *(LAS unsigned*)(R2 + (dg * 8 + e) * RS + lane * 4) = pk2(lo * wf0, hi * wf1);
                *(LAS unsigned*)(R3 + (dg * 8 + e) * RS + lane * 4) = pk2(lo * wb0, hi * wb1); } }
        __syncthreads();
        f32x4 af[8], ab[8];
#pragma unroll
        for (int t = 0; t < 8; ++t) { af[t] = (f32x4){0.f, 0.f, 0.f, 0.f}; ab[t] = (f32x4){0.f, 0.f, 0.f, 0.f}; }
        mm128(af, R2, R1, wave, c, q);
        mm128(ab, R3, R1, wave, c, q);
        bf16* KVT = (bf16*)(ws + WS_KVT) + ((size_t)(ci * 4 + h) * 2) * 16384 + (16 * wave + c) * 128 + 4 * q;
#pragma unroll
        for (int t = 0; t < 8; ++t) { *(v2u*)(KVT + 16 * t) = (v2u){pk2(af[t][0], af[t][1]), pk2(af[t][2], af[t][3])};
                                      *(v2u*)(KVT + 16384 + 16 * t) = (v2u){pk2(ab[t][0], ab[t][1]), pk2(ab[t][2], ab[t][3])}; }
        __syncthreads();
    } else {
        const bf16* SB = (const bf16*)(ws + WS_SB) + ((size_t)(ci * 4 + h) * 2) * 16384;
        load_rm(R1, Qg, INW, tid);
        load_rm(R2, Kg, INW, tid);
        load_tr(R3, Vg, INW, wave, lane);
        load_rm(R4, SB, 128, tid);
        __syncthreads();
        f32x4 aS[8], aF[8];
#pragma unroll
        for (int t = 0; t < 8; ++t) { aS[t] = (f32x4){0.f, 0.f, 0.f, 0.f}; aF[t] = (f32x4){0.f, 0.f, 0.f, 0.f}; }
        mm128x2(aS, aF, R1, R2, R4, wave, c, q);
        __syncthreads();
        const int i = 16 * wave + c;
#pragma unroll
        for (int t = 0; t < 8; ++t) { float p[4];
#pragma unroll
            for (int r = 0; r < 4; ++r) { const int dl = i - (16 * t + 4 * q + r);
                const float f = dl > 0 ? __builtin_amdgcn_exp2f(lf2 * (float)dl) : (dl < 0 ? __builtin_amdgcn_exp2f(lb2 * (float)(-dl)) : 2.0f);
                p[r] = aS[t][r] * scale * f; }
            *(LAS v2u*)(R2 + i * RS + (16 * t + 4 * q) * 2) = (v2u){pk2(p[0], p[1]), pk2(p[2], p[3])}; }
        load_rm(R4, SB + 16384, 128, tid);
        __syncthreads();
        const float hf = __builtin_amdgcn_exp2f(lf2 * (float)(i + 1)), hb = __builtin_amdgcn_exp2f(lb2 * (float)(128 - i));
        f32x4 aB[8];
#pragma unroll
        for (int t = 0; t < 8; ++t) { aF[t] = aF[t] * hf; aB[t] = (f32x4){0.f, 0.f, 0.f, 0.f}; }
        mm128(aF, R2, R3, wave, c, q);
        mm128(aB, R1, R4, wave, c, q);
        f32x4 (&aO)[8] = aF;
        float s = 0.f;
#pragma unroll
        for (int t = 0; t < 8; ++t) { aO[t] = aO[t] + aB[t] * hb; s += (aO[t][0] + aO[t][1]) + (aO[t][2] + aO[t][3]); }
        s += __shfl_xor(s, 16); s += __shfl_xor(s, 32);
        const float mean = s * (1.0f / 128.0f); float v2 = 0.f;
#pragma unroll
        for (int t = 0; t < 8; ++t) { aO[t] = aO[t] - mean; v2 += (aO[t][0] * aO[t][0] + aO[t][1] * aO[t][1]) + (aO[t][2] * aO[t][2] + aO[t][3] * aO[t][3]); }
        v2 += __shfl_xor(v2, 16); v2 += __shfl_xor(v2, 32);
        const float rstd = 1.0f / sqrtf(v2 * (1.0f / 128.0f) + 1e-6f);
        const bf16* Gg = PROJ + (rowbase + i) * INW + 2560 + h * 128 + 4 * q;
        const float* gn = a.in[26] + h * 128 + 4 * q;
        bf16* Yp = (bf16*)(ws + WS_Y) + (rowbase + i) * DM + 512 + h * 128 + 4 * q;
#pragma unroll
        for (int t = 0; t < 8; ++t) { const v2u gv = *(const v2u*)(Gg + 16 * t); const f32x4 w = *(const f32x4*)(gn + 16 * t);
            const float y0 = aO[t][0] * rstd * w[0] * siluf_(bflo(gv[0])), y1 = aO[t][1] * rstd * w[1] * siluf_(bfhi(gv[0]));
            const float y2 = aO[t][2] * rstd * w[2] * siluf_(bflo(gv[1])), y3 = aO[t][3] * rstd * w[3] * siluf_(bfhi(gv[1]));
            *(v2u*)(Yp + 16 * t) = (v2u){pk2(y0, y1), pk2(y2, y3)};
            if (t & 1) asm volatile("" ::: "memory"); }
        __syncthreads();
    }
}
template <int PASS, int DIR>
__device__ __forceinline__ void lru_dir(const LAS unsigned char* xcl, const bf16x8 (&idf)[2], const bf16x8 (&wa)[2], const bf16x8 (&wx)[2], float ba, float bx, float sp8,
                                        float hc_in, float* hsp, float& Aout, float& Hout, float& edge, int c, int q, const bf16* Gp, bf16* Yp) {
    float Ac = 1.f, Hc = hc_in;
    float hn[4]; unsigned short gn[4];
    if (PASS == 3 && DIR == 1) {
#pragma unroll
        for (int r = 0; r < 4; ++r) { hn[r] = hsp[(7 * 4 + r) * 64]; gn[r] = Gp[(size_t)(16 * 7 + 4 * q + r) * INW]; }
    }
#pragma unroll 1
    for (int ti = 0; ti < 8; ++ti) {
        const int tt = DIR == 0 ? ti : 7 - ti;
        float hcur[4]; unsigned short gcur[4];
        if (PASS == 3 && DIR == 1) {
#pragma unroll
            for (int r = 0; r < 4; ++r) { hcur[r] = hn[r]; gcur[r] = gn[r]; }
            const int tn = tt > 0 ? tt - 1 : 0;
#pragma unroll
            for (int r = 0; r < 4; ++r) { hn[r] = hsp[(tn * 4 + r) * 64]; gn[r] = Gp[(size_t)(16 * tn + 4 * q + r) * INW]; }
        }
        f32x4 aI = (f32x4){0.f, 0.f, 0.f, 0.f}, aA = aI, aX = aI;
#pragma unroll
        for (int s = 0; s < 2; ++s) { const bf16x8 xf = *(const LAS bf16x8*)(xcl + (16 * tt) * XCS + 64 * s);
            aI = MFMA16(xf, idf[s], aI); aA = MFMA16(xf, wa[s], aA); aX = MFMA16(xf, wx[s], aX); }
        float av[4], uv[4];
#pragma unroll
        for (int r = 0; r < 4; ++r) {
            const float rg = __builtin_amdgcn_rcpf(1.0f + __builtin_amdgcn_exp2f(fmaf(aA[r], -1.4426950408889634f, ba)));
            const float ig = __builtin_amdgcn_rcpf(1.0f + __builtin_amdgcn_exp2f(fmaf(aX[r], -1.4426950408889634f, bx)));
            const float la = -sp8 * rg;
            const float aa = __builtin_amdgcn_exp2f(la * 1.4426950408889634f);
            const float t = -2.0f * la;
            const float ser = t * fmaf(-0.5f * t, fmaf(-0.33333334f * t, fmaf(-0.25f, t, 1.0f), 1.0f), 1.0f);
            const float om = t < 0.125f ? ser : fmaf(-aa, aa, 1.0f);
            av[r] = aa; uv[r] = __builtin_amdgcn_sqrtf(om) * (ig * aI[r]); }
        float pa[4], hl[4]; float P = 1.f, H = 0.f;
#pragma unroll
        for (int rr = 0; rr < 4; ++rr) { const int r = DIR == 0 ? rr : 3 - rr; H = av[r] * H + uv[r]; P *= av[r]; pa[r] = P; hl[r] = H; }
        float A = P, Hh = H, Ap, Hp, Ae, He, At, Ht;
        if (DIR == 0) {
            Ap = __shfl_up(A, 16); Hp = __shfl_up(Hh, 16); if (q >= 1) { Hh = A * Hp + Hh; A = Ap * A; }
            Ap = __shfl_up(A, 32); Hp = __shfl_up(Hh, 32); if (q >= 2) { Hh = A * Hp + Hh; A = Ap * A; }
            Ae = __shfl_up(A, 16); He = __shfl_up(Hh, 16); if (q == 0) { Ae = 1.f; He = 0.f; }
            At = __shfl(A, 48 + c); Ht = __shfl(Hh, 48 + c);
        } else {
            Ap = __shfl_down(A, 16); Hp = __shfl_down(Hh, 16); if (q <= 2) { Hh = A * Hp + Hh; A = Ap * A; }
            Ap = __shfl_down(A, 32); Hp = __shfl_down(Hh, 32); if (q <= 1) { Hh = A * Hp + Hh; A = Ap * A; }
            Ae = __shfl_down(A, 16); He = __shfl_down(Hh, 16); if (q == 3) { Ae = 1.f; He = 0.f; }
            At = __shfl(A, c); Ht = __shfl(Hh, c);
        }
        if (PASS == 3) {
            const float hin = Ae * Hc + He;
#pragma unroll
            for (int r = 0; r < 4; ++r) { const float hv = pa[r] * hin + hl[r];
                if (DIR == 0) hsp[(tt * 4 + r) * 64] = hv;
                else { const size_t tok = (size_t)(16 * tt + 4 * q + r); Yp[tok * DM] = (bf16)f2bf((hcur[r] + hv) * gelu_tanh(bf2f(gcur[r]))); }
                if (DIR == 0 && tt == 0 && r == 0) edge = hv;
                if (DIR == 1 && tt == 7 && r == 3) edge = hv; }
        }
        Hc = At * Hc + Ht; Ac = Ac * At;
    }
    Aout = Ac; Hout = Hc;
}

template <int PASS>
__device__ __forceinline__ void lru_item(const Args& a, LAS unsigned char* lds, int ci, int tid, int wave, int lane) {
    unsigned char* ws = a.ws;
    const int c = lane & 15, q = lane >> 4;
    const bf16* PROJ = (const bf16*)(ws + WS_PROJ);
    int seq, n, seqlen, seqtok0, nch;
    if (ci < 64) { seq = ci >> 1; n = ci & 1; seqlen = 256; seqtok0 = seq * 256; nch = 2; }
    else { seq = (ci - 64) >> 5; n = (ci - 64) & 31; seqlen = 4096; seqtok0 = TP + seq * 4096; nch = 32; }
    const bool isprompt = ci < 64;
    const int p0 = n * 128;
    {
        float w0[8], w1[8], w2[8], w3[8], bb[8];
#pragma unroll
        for (int e = 0; e < 8; ++e) { w0[e] = a.in[12][0 * 512 + 8 * lane + e]; w1[e] = a.in[12][1 * 512 + 8 * lane + e]; w2[e] = a.in[12][2 * 512 + 8 * lane + e]; w3[e] = a.in[12][3 * 512 + 8 * lane + e]; bb[e] = a.in[13][8 * lane + e]; }
        const int pb = p0 + 16 * wave;
        const bf16* base = PROJ + (size_t)seqtok0 * INW + 8 * lane;
#define LDROW(p) (((p) < 0 || (p) >= seqlen) ? (v4u){0u, 0u, 0u, 0u} : *(const v4u*)(base + (size_t)(p) * INW))
        v4u rows[19];
#pragma unroll
        for (int k = 0; k < 19; ++k) rows[k] = LDROW(pb - 2 + k);
#pragma unroll
        for (int i = 0; i < 16; ++i) {
            float o[8];
#pragma unroll
            for (int e = 0; e < 8; ++e) o[e] = fmaf(w3[e], bf2f((unsigned short)HW(rows[i + 3], e)), fmaf(w2[e], bf2f((unsigned short)HW(rows[i + 2], e)), fmaf(w1[e], bf2f((unsigned short)HW(rows[i + 1], e)), fmaf(w0[e], bf2f((unsigned short)HW(rows[i], e)), bb[e]))));
            *(LAS v4u*)(lds + (16 * wave + i) * XCS + 16 * lane) = (v4u){pk2(o[0], o[1]), pk2(o[2], o[3]), pk2(o[4], o[5]), pk2(o[6], o[7])};
        }
#undef LDROW
    }
    __syncthreads();
    const LAS unsigned char* xcl = lds + c * XCS + (64 * wave + 8 * q) * 2;
    const bf16* WL = (const bf16*)(ws + WS_WL);
    const size_t rowbase = (size_t)seqtok0 + p0;
    for (int rt = 0; rt < 4; ++rt) {
        const int dl = 16 * rt + c, d = 64 * wave + dl;
        bf16x8 idf[2];
#pragma unroll
        for (int s = 0; s < 2; ++s)
#pragma unroll
            for (int e = 0; e < 8; ++e) idf[s][e] = (32 * s + 8 * q + e == dl) ? (short)0x3F80 : (short)0;
        float* hs = a.out + (size_t)(blockIdx.x * NWAVES + wave) * 2048 + lane;
        float Af, Hf, Ab, Hb, ef = 0.f, eb = 0.f;
        float cf = 0.f, cb = 0.f;
        if (PASS == 3) { cf = ((const float*)(ws + WS_CAR))[(size_t)(ci * 2 + 0) * 512 + d]; cb = ((const float*)(ws + WS_CAR))[(size_t)(ci * 2 + 1) * 512 + d]; }
        const bf16* Gp = PROJ + rowbase * INW + 512 + d;
        bf16* Yp = (bf16*)(ws + WS_Y) + rowbase * DM + d;
        bf16x8 waf[2], wxf[2], wab[2], wxb[2];
#pragma unroll
        for (int s2 = 0; s2 < 2; ++s2) { const int o = dl * 64 + 32 * s2 + 8 * q;
            waf[s2] = *(const bf16x8*)(WL + (size_t)(0 * 8 + wave) * 4096 + o); wxf[s2] = *(const bf16x8*)(WL + (size_t)(1 * 8 + wave) * 4096 + o);
            wab[s2] = *(const bf16x8*)(WL + (size_t)(2 * 8 + wave) * 4096 + o); wxb[s2] = *(const bf16x8*)(WL + (size_t)(3 * 8 + wave) * 4096 + o); }
        const float baf = a.in[15][d], bxf = a.in[17][d], lmf = a.in[18][d], bab = a.in[20][d], bxb = a.in[22][d], lmb = a.in[23][d];
        lru_dir<PASS, 0>(xcl, idf, waf, wxf, -1.4426950408889634f * baf, -1.4426950408889634f * bxf, 8.0f * log1pf(__expf(-lmf)), cf, hs, Af, Hf, ef, c, q, Gp, Yp);
        lru_dir<PASS, 1>(xcl, idf, wab, wxb, -1.4426950408889634f * bab, -1.4426950408889634f * bxb, 8.0f * log1pf(__expf(-lmb)), cb, hs, Ab, Hb, eb, c, q, Gp, Yp);
        if (PASS == 1) {
            if (q == 0) { float* ag = (float*)(ws + WS_AGG) + (size_t)(ci * 2) * 1024 + d; ag[0] = Af; ag[512] = Hf; ag[1024] = Ab; ag[1536] = Hb; }
        } else {
            if (isprompt && n == 0 && q == 0) a.out[OFF_LF + seq * 512 + d] = ef;
            if (isprompt && n == nch - 1 && q == 3) a.out[OFF_LB + seq * 512 + d] = eb;
        }
    }
    __syncthreads();
}

__device__ __forceinline__ void phase_carries(const Args& a, int tid) {
    unsigned char* ws = a.ws;
    const int gtid = blockIdx.x * 512 + tid, GT = gridDim.x * 512;
    for (int task = gtid; task < 655360; task += GT) {
        const int dv = task & 127, dkg = (task >> 7) & 15, dir = (task >> 11) & 1, h = (task >> 12) & 3, sq = task >> 14;
        const bool isprompt = sq >= 8; const int seq = isprompt ? sq - 8 : sq, N = isprompt ? 2 : 32, cibase = isprompt ? seq * 2 : 64 + seq * 32;
        const float g = __expf(log_sigmoid_(dir ? a.in[25][h] : a.in[24][h]) * 128.0f);
        float S[8];
        if (isprompt) {
#pragma unroll
            for (int e = 0; e < 8; ++e) S[e] = 0.f;
        } else { const float* s0 = (dir ? a.in[5] : a.in[4]) + ((size_t)(seq * 4 + h) * 128 + dkg * 8) * 128 + dv;
#pragma unroll
            for (int e = 0; e < 8; ++e) S[e] = s0[e * 128]; }
        const size_t ibase = ((size_t)h * 2 + dir) * 16384 + dv * 128 + dkg * 8;
        const bf16* kvp = (const bf16*)(ws + WS_KVT) + ibase; bf16* sbp = (bf16*)(ws + WS_SB) + ibase;
        for (int s0 = 0; s0 < N; s0 += 8) {
            v4u kv[8];
#pragma unroll
            for (int j = 0; j < 8; ++j) { const int step = s0 + j; const int n = dir ? N - 1 - step : step; const int ci = cibase + (step < N ? n : (dir ? 0 : N - 1));
                kv[j] = *(const v4u*)(kvp + (size_t)ci * 131072); }
#pragma unroll
            for (int j = 0; j < 8; ++j) { const int step = s0 + j;
                if (step < N) { const int n = dir ? N - 1 - step : step, ci = cibase + n;
                    *(v4u*)(sbp + (size_t)ci * 131072) = (v4u){pk2(S[0], S[1]), pk2(S[2], S[3]), pk2(S[4], S[5]), pk2(S[6], S[7])};
#pragma unroll
                    for (int e2 = 0; e2 < 8; ++e2) S[e2] = g * S[e2] + bf2f((unsigned short)HW(kv[j], e2)); } }
        }
        if (isprompt) { float* o = a.out + (dir ? OFF_RB : OFF_RF) + ((size_t)(seq * 4 + h) * 128 + dkg * 8) * 128 + dv;
#pragma unroll
            for (int e = 0; e < 8; ++e) o[e * 128] = S[e]; }
    }
    for (int task = gtid; task < 40960; task += GT) {
        const int d = task & 511, dir = (task >> 9) & 1, sq = task >> 10;
        const bool isprompt = sq >= 8; const int seq = isprompt ? sq - 8 : sq, N = isprompt ? 2 : 32, cibase = isprompt ? seq * 2 : 64 + seq * 32;
        float hcar = isprompt ? 0.f : (dir ? a.in[3] : a.in[2])[seq * 512 + d];
        for (int step = 0; step < N; ++step) {
            const int n = dir ? N - 1 - step : step, ci = cibase + n;
            ((float*)(ws + WS_CAR))[(size_t)(ci * 2 + dir) * 512 + d] = hcar;
            const float* ag = (const float*)(ws + WS_AGG) + ((size_t)(ci * 2 + dir) * 2) * 512 + d;
            hcar = ag[0] * hcar + ag[512];
        }
    }
}

__device__ __forceinline__ v4u ldg16(const bf16* p, bool ok) { return ok ? *(const v4u*)p : (v4u){0u, 0u, 0u, 0u}; }
__device__ __forceinline__ void phase_act(const Args& a, int half, int wave, int lane) {
    unsigned char* ws = a.ws;
    const bf16* __restrict__ GH = (const bf16*)(ws + WS_GH);
    bf16* __restrict__ U = (bf16*)(ws + WS_U);
    const int gw = blockIdx.x * NWAVES + wave, NGW = gridDim.x * NWAVES;
    const int p = lane >> 5;
    for (int wt = gw; wt < 7040; wt += NGW) {
        const int slab = wt % 11; int r = wt / 11;
        int tok0, ts, lat, steps0, nwalk;
        bool isimg;
        if (half == 1 || r >= 256) {
            if (half == 0) r -= 256;
            const int pair = r & 31, seg = (r >> 5) & 3, img = (r >> 7) + (half == 0 ? 0 : 3);
            const int gc = 2 * pair + p; steps0 = 16 * seg; nwalk = 64; ts = 64; lat = 1; isimg = true;
            tok0 = TP + img * 4096 + steps0 * 64 + gc;
        } else {
            const int sp = r & 7, seq = r >> 3; steps0 = 32 * sp + 16 * p; nwalk = 256; ts = 1; lat = 0; isimg = false;
            tok0 = seq * 256 + steps0;
        }
        const int ch0 = (slab * 32 + (lane & 31)) * 8;
        const int gcol = isimg ? (tok0 & 63) : 1;
        const bool okl = isimg && gcol > 0, okr = isimg && gcol < 63;
        float wk[9][8], bb[8];
#pragma unroll
        for (int k = 0; k < 9; ++k) { const int aa = k / 3, b = k % 3;
            const int src = isimg ? k : (3 + aa);
            const f32x4 x0 = *(const f32x4*)(a.in[31] + (size_t)src * FF + ch0), x1 = *(const f32x4*)(a.in[31] + (size_t)src * FF + ch0 + 4);
            const float z = (isimg || b == 1) ? 1.f : 0.f;
            wk[k][0] = x0[0] * z; wk[k][1] = x0[1] * z; wk[k][2] = x0[2] * z; wk[k][3] = x0[3] * z; wk[k][4] = x1[0] * z; wk[k][5] = x1[1] * z; wk[k][6] = x1[2] * z; wk[k][7] = x1[3] * z; }
        { const f32x4 x0 = *(const f32x4*)(a.in[32] + ch0), x1 = *(const f32x4*)(a.in[32] + ch0 + 4); bb[0] = x0[0]; bb[1] = x0[1]; bb[2] = x0[2]; bb[3] = x0[3]; bb[4] = x1[0]; bb[5] = x1[1]; bb[6] = x1[2]; bb[7] = x1[3]; }
        const bf16* gp = GH + (size_t)(tok0 - half * HALF_T) * FF + ch0;
        bf16* up = U + (size_t)tok0 * FF + ch0;
        const size_t gs = (size_t)ts * FF;
        v4u w0[3], w1[3], w2[3], w3[3];
        { const bool okp = steps0 > 0;
          w0[0] = ldg16(gp - gs - FF, okp && okl); w0[1] = ldg16(gp - gs, okp); w0[2] = ldg16(gp - gs + FF, okp && okr);
          w1[0] = ldg16(gp - FF, okl); w1[1] = *(const v4u*)gp; w1[2] = ldg16(gp + FF, okr); }
#pragma unroll 1
        for (int st = 0; st < 16; st += 2) {
            const bool ok2 = steps0 + st + 1 < nwalk, ok3 = steps0 + st + 2 < nwalk;
            const bf16* g2 = gp + (size_t)(st + 1) * gs; const bf16* g3 = g2 + gs;
            w2[0] = ldg16(g2 - FF, ok2 && okl); w2[1] = ldg16(g2, ok2); w2[2] = ldg16(g2 + FF, ok2 && okr);
            w3[0] = ldg16(g3 - FF, ok3 && okl); w3[1] = ldg16(g3, ok3); w3[2] = ldg16(g3 + FF, ok3 && okr);
            bf16* u0 = up + (size_t)st * gs; bf16* u1 = u0 + gs;
            const v4u uv0 = *(const v4u*)u0, uv1 = *(const v4u*)u1;
            float acc0[8], acc1[8];
#pragma unroll
            for (int e = 0; e < 8; ++e) { acc0[e] = bb[e]; acc1[e] = bb[e]; }
#pragma unroll
            for (int b = 0; b < 3; ++b)
#pragma unroll
                for (int e = 0; e < 8; ++e) {
                    { const float g0 = bf2f((unsigned short)HW(w0[b], e)), g1 = bf2f((unsigned short)HW(w1[b], e)), g2 = bf2f((unsigned short)HW(w2[b], e)), g3 = bf2f((unsigned short)HW(w3[b], e));
                    acc0[e] = fmaf(wk[6 + b][e], g2, fmaf(wk[3 + b][e], g1, fmaf(wk[0 + b][e], g0, acc0[e])));
                    acc1[e] = fmaf(wk[6 + b][e], g3, fmaf(wk[3 + b][e], g2, fmaf(wk[0 + b][e], g1, acc1[e]))); } }
            float o0[8], o1[8];
#pragma unroll
            for (int e = 0; e < 8; ++e) { o0[e] = gelu_tanh(acc0[e]) * bf2f((unsigned short)HW(uv0, e)); o1[e] = gelu_tanh(acc1[e]) * bf2f((unsigned short)HW(uv1, e)); }
            *(v4u*)u0 = (v4u){pk2(o0[0], o0[1]), pk2(o0[2], o0[3]), pk2(o0[4], o0[5]), pk2(o0[6], o0[7])};
            *(v4u*)u1 = (v4u){pk2(o1[0], o1[1]), pk2(o1[2], o1[3]), pk2(o1[4], o1[5]), pk2(o1[6], o1[7])};
#pragma unroll
            for (int b = 0; b < 3; ++b) { w0[b] = w2[b]; w1[b] = w3[b]; }
        }
    }
}
template <int PASS>
__device__ __forceinline__ void phase_mixer(const Args& a, LAS unsigned char* lds, int tid, int wave, int lane) {
    unsigned* ctr = (unsigned*)(a.ws + WS_BAR) + (PASS == 1 ? 3584 : 3648);
    volatile LAS int* slot = (volatile LAS int*)(lds + LDSCTL_OFF + 256);
    for (;;) {
        if (tid == 0) *slot = (int)__hip_atomic_fetch_add(ctr, 1u, __ATOMIC_RELAXED, __HIP_MEMORY_SCOPE_AGENT);
        __syncthreads();
        const int it = *slot;
        if (it >= NCHUNK + 4 * NCHUNK) break;
        asm volatile("" : "+v"(tid), "+v"(lane));
        if (it < NCHUNK) lru_item<PASS>(a, lds, it, tid, wave, lane);
        else { const int r = it - NCHUNK; ret_item<PASS>(a, lds, r >> 2, r & 3, tid, wave, lane); }
    }
}

__global__ void __launch_bounds__(512, 2) fwd(Args a) {
    extern __shared__ __attribute__((aligned(16))) unsigned char lds_raw[];
    LAS unsigned char* lds = (LAS unsigned char*)lds_raw;
    unsigned char* ws = a.ws;
    int tid = threadIdx.x, lane = tid & 63; const int wave = __builtin_amdgcn_readfirstlane(tid >> 6);
#define FRESH() do { tid = threadIdx.x; asm volatile("" : "+v"(tid)); lane = tid & 63; } while (0)
    for (int u = tid; u < (LDS_BYTES - LDSCTL_OFF) / 4; u += 512) ((LAS unsigned*)(lds + LDSCTL_OFF))[u] = 0u;
    __syncthreads();
    const XcdBarrier bar = xcd_barrier_post((unsigned*)(ws + WS_BAR), (volatile LAS unsigned*)(lds + LDSCTL_OFF + 64));
    const float* MOD = (const float*)(ws + WS_MOD);
    const int G = gridDim.x;
    const int lo = a.ph_lo, hi = a.ph_hi;
#ifndef PHMASK
#define PHMASK 0xffff
#endif
#define IN(k) ((((PHMASK) >> (k)) & 1) && lo <= (k) && (k) < hi)
#ifndef REPMASK
#define REPMASK 0u
#endif
#define NREP(k) ((((REPMASK) >> (k)) & 1u) ? 2 : 1)
#define SEAM(k) do { if (IN(k) && IN((k) + 1)) xcd_barrier(bar); } while (0)
    FRESH();
    for (int rep = 0; rep < NREP(0); ++rep) if (IN(0)) phase_prologue(a, lds, tid, wave, lane);
    if (IN(0) && IN(1)) { cg::grid_group grid = cg::this_grid(); grid.sync(); }
    FRESH();
    for (int rep = 0; rep < NREP(1); ++rep) if (IN(1)) phase_rownorm<0>(a.in[0], a.in[1], a.in[8], MOD + 1024, MOD + 0, (bf16*)(ws + WS_XN), nullptr, wave, lane);
    SEAM(1);
    FRESH();
    for (int rep = 0; rep < NREP(2); ++rep) if (IN(2)) { pg8::Gemm g{(const bf16*)(ws + WS_XN), (const bf16*)(ws + WS_WIN), TT, INW, DM}; pg8::StaticOrder S; S.init(TT, INW, G, (int)blockIdx.x);
        pg8::EpiBf16<0> E{(bf16*)(ws + WS_PROJ), INW, nullptr, 0, 0, 1.f};
        pg8::gemm_phase<pg8::EpiBf16<0>, pg8::StaticOrder, true, true>(lds, g, S, E); }
    SEAM(2);
    FRESH();
    for (int rep = 0; rep < NREP(3); ++rep) if (IN(3)) phase_mixer<1>(a, lds, tid, wave, lane);
    SEAM(3);
    FRESH();
    for (int rep = 0; rep < NREP(4); ++rep) if (IN(4)) phase_carries(a, tid);
    SEAM(4);
    FRESH();
    for (int rep = 0; rep < NREP(5); ++rep) if (IN(5)) phase_mixer<3>(a, lds, tid, wave, lane);
    SEAM(5);
    FRESH();
    for (int rep = 0; rep < NREP(6); ++rep) if (IN(6)) { pg8::Gemm g{(const bf16*)(ws + WS_Y), (const bf16*)(ws + WS_WOUT), TT, DM, DM}; pg8::StaticOrder S; S.init(TT, DM, G, (int)blockIdx.x);
        pg8::EpiRes E{a.in[0], a.in[1], a.out, MOD + 2048};
        pg8::gemm_phase<pg8::EpiRes, pg8::StaticOrder, true, true>(lds, g, S, E); }
    SEAM(6);
    FRESH();
    for (int rep = 0; rep < NREP(7); ++rep) if (IN(7)) phase_rownorm<0>(a.out, a.out + (size_t)TP * DM, a.in[28], MOD + 4096, MOD + 3072, (bf16*)(ws + WS_XN), nullptr, wave, lane);
    SEAM(7);
#pragma unroll
    for (int half = 0; half < 2; ++half) {
        FRESH();
        if (IN(8 + 2 * half)) { pg8::Gemm g{(const bf16*)(ws + WS_XN) + (size_t)half * HALF_T * DM, (const bf16*)(ws + WS_WGU), HALF_T, FF2, DM}; pg8::StaticOrder S; S.init(HALF_T, FF2, G, (int)blockIdx.x);
            pg8::EpiBf16<0> E{(bf16*)(ws + WS_GH), FF, nullptr, FF, (size_t)((WS_U - WS_GH) / 2) + (size_t)half * HALF_T * FF, 1.f};
            pg8::gemm_phase<pg8::EpiBf16<0>, pg8::StaticOrder, true, true>(lds, g, S, E); }
        SEAM(8 + 2 * half);
        FRESH();
        if (IN(9 + 2 * half)) phase_act(a, half, wave, lane);
        SEAM(9 + 2 * half);
    }
    FRESH();
    for (int rep = 0; rep < NREP(12); ++rep) if (IN(12)) { pg8::Gemm g{(const bf16*)(ws + WS_U), (const bf16*)(ws + WS_WD), TT, DM, FF}; pg8::StaticOrder S; S.init(TT, DM, G, (int)blockIdx.x);
        pg8::EpiRes E{a.out, a.out + (size_t)TP * DM, a.out, MOD + 5120};
        pg8::gemm_phase<pg8::EpiRes, pg8::StaticOrder, true, true>(lds, g, S, E); }
    SEAM(12);
    FRESH();
    if (IN(13)) phase_rownorm<1>(a.out, a.out + (size_t)TP * DM, a.in[34], nullptr, nullptr, nullptr, a.out, wave, lane);
#undef IN
#undef SEAM
}

extern "C" void kernel_launch(void* const* d_in, const int* in_sizes, int n_in, void* d_out, int out_size,
                              void* d_ws, size_t ws_size, hipStream_t stream) {
    static int grid = 0;
    if (grid == 0) {
        int dev = 0, cus = 0, per_cu = 0;
        hipGetDevice(&dev);
        hipDeviceGetAttribute(&cus, hipDeviceAttributeMultiprocessorCount, dev);
        hipFuncSetAttribute((const void*)fwd, hipFuncAttributeMaxDynamicSharedMemorySize, LDS_BYTES);
        hipOccupancyMaxActiveBlocksPerMultiprocessor(&per_cu, (const void*)fwd, 512, LDS_BYTES);
        if (per_cu < 1) per_cu = 1;
        grid = cus * per_cu;
        if (n_in != 35 || ws_size < WS_END) fprintf(stderr, "kernel_launch: unexpected n_in %d / ws_size %zu\n", n_in, ws_size);
    }
    if (hipMemsetAsync((char*)d_ws + WS_BAR, 0, 16384, stream) != hipSuccess) fprintf(stderr, "kernel_launch: memset failed\n");
    Args a{};
    for (int i = 0; i < 35; ++i) a.in[i] = (const float*)d_in[i];
    a.out = (float*)d_out; a.ws = (unsigned char*)d_ws; a.ph_lo = 0; a.ph_hi = 14;
    void* args[] = {&a};
    hipError_t e = hipLaunchCooperativeKernel((const void*)fwd, dim3(grid), dim3(512), args, LDS_BYTES, stream);
    if (e != hipSuccess) fprintf(stderr, "cooperative launch failed: %s (grid %d)\n", hipGetErrorString(e), grid);
}
```

```cpp
#include <hip/hip_runtime.h>
#include <hip/hip_cooperative_groups.h>
#include <cstdio>
#include <cstdint>
namespace cg = cooperative_groups;
namespace pg8 {
#define PG8_LAS __attribute__((address_space(3)))
typedef unsigned short bf16_t;
typedef short bf16x8 __attribute__((ext_vector_type(8)));
typedef float f32x4 __attribute__((ext_vector_type(4)));
typedef unsigned u32x4 __attribute__((ext_vector_type(4)));
constexpr int BM = 256, BK = 64, HALF = 128, HTB = HALF * BK * 2  , STAGE_BYTES = 8 * HTB, NXCD = 8, WGM = 8;

__host__ __device__ __forceinline__ int lds_byte(int r, int c) { const int st = (r >> 4) * 2 + (c >> 5), rr = r & 15, cc = c & 31, ob = rr * 64 + cc * 2; return st * 1024 + (ob ^ (((ob >> 9) & 1) << 5)); }
__host__ __device__ __forceinline__ void stage_rc(int b, int& R, int& C) { const int st = b / 1024, sb = b % 1024, swz = sb ^ (((sb >> 9) & 1) << 5); R = (st >> 1) * 16 + swz / 64; C = (st & 1) * 32 + (swz % 64) / 2; }
__host__ __device__ __forceinline__ int perm32(int rho) { const int n = rho >> 4, i = rho & 15; return 8 * (i >> 2) + 4 * n + (i & 3); }

struct Unit { int pm, pn; };
struct Gemm { const bf16_t* A; const bf16_t* Bt; int M, N, K; };

struct StaticOrder {
    int nM, nN, nwg, G, c;
    __host__ __device__ void init(int M, int N, int G_, int c_) { nM = M / BM; nN = N / BM; nwg = nM * nN; G = G_; c = c_; }
    __host__ __device__ bool next(int i, Unit& u) const {
        const long L = (long)i * G + c; if (L >= nwg) return false;
        int wgid = (int)L; { const int q = nwg / NXCD, r = nwg % NXCD, xcd = wgid % NXCD, off = wgid / NXCD; wgid = (xcd < r ? xcd * (q + 1) : r * (q + 1) + (xcd - r) * q) + off; }
        const int nig = WGM * nN, gid = wgid / nig, fm = gid * WGM, gsz = (nM - fm) < WGM ? (nM - fm) : WGM;
        u.pm = fm + ((wgid % nig) % gsz); u.pn = (wgid % nig) / gsz; return true;
    }
    __device__ __forceinline__ void a_ready(const Unit&) const {}
    __device__ __forceinline__ void done(const Unit&) const {}
};

__device__ __forceinline__ unsigned cvt_pk_bf16(float lo, float hi) { unsigned r; asm volatile("v_cvt_pk_bf16_f32 %0, %1, %2" : "=v"(r) : "v"(lo), "v"(hi)); return r; }
typedef float f32x2 __attribute__((ext_vector_type(2)));
__device__ __forceinline__ f32x2 gelu_pk(f32x2 v) {
    const f32x2 av = __builtin_elementwise_abs(v), d = av * 0.2316418882f + 1.0f;
    f32x2 t; t.x = __builtin_amdgcn_rcpf(d.x); t.y = __builtin_amdgcn_rcpf(d.y);
    f32x2 q = t * 0.5307027145f + (-0.7265760135f); q = q * t + 0.7107068705f; q = q * t + (-0.142248368f); q = q * t + 0.127414796f; q = q * t;
    const f32x2 s = (v * v) * (-0.72134752044f);
    f32x2 e; e.x = __builtin_amdgcn_exp2f(s.x); e.y = __builtin_amdgcn_exp2f(s.y);
    const f32x2 m = v * (q * e), r = v - m;
    f32x2 o; o.x = v.x < 0.f ? m.x : r.x; o.y = v.y < 0.f ? m.y : r.y; return o;
}

template <int ACT  > struct EpiBf16 {
    static constexpr bool PERM = true, AFTER_DRAIN = false; static_assert(ACT == 0 || ACT == 1, "EpiBf16: ACT is 0 (none) or 1 (gelu_pk)");
    bf16_t* O; int ldc; const float* bias; int split_cols; size_t split_stride; float scale0;
    __device__ __forceinline__ void operator()(const f32x4 (&acc)[2][2][4][2], const Unit& u, int wr, int wc, int fr, int fq) const {
        const int row0 = u.pm * BM + wr * 64 + fr; int colt = u.pn * BM; bf16_t* base = O;
        float sc = 1.f; if (split_cols) { const int t = colt / split_cols; base += (size_t)t * split_stride; colt -= t * split_cols; if (t == 0) sc = scale0; }
        const int col0 = colt + wc * 32 + 8 * fq, bcol0 = u.pn * BM + wc * 32 + 8 * fq;
        f32x4 bv[2][2];
#pragma unroll
        for (int bj = 0; bj < 2; ++bj)
#pragma unroll
            for (int n = 0; n < 2; ++n) bv[bj][n] = bias ? *(const f32x4*)(bias + bcol0 + bj * HALF + 4 * n) : (f32x4){0.f, 0.f, 0.f, 0.f};
#pragma unroll
        for (int ai = 0; ai < 2; ++ai)
#pragma unroll
            for (int m = 0; m < 4; ++m) { bf16_t* rowp = base + (size_t)(row0 + ai * HALF + m * 16) * ldc + col0;
#pragma unroll
                for (int bj = 0; bj < 2; ++bj) { f32x4 v0 = acc[ai][bj][m][0] + bv[bj][0], v1 = acc[ai][bj][m][1] + bv[bj][1];
                    if (ACT == 1) { f32x2 a = gelu_pk((f32x2){v0[0], v0[1]}), b = gelu_pk((f32x2){v0[2], v0[3]}), c = gelu_pk((f32x2){v1[0], v1[1]}), d = gelu_pk((f32x2){v1[2], v1[3]});
                        v0 = (f32x4){a.x, a.y, b.x, b.y}; v1 = (f32x4){c.x, c.y, d.x, d.y}; }
                    v0 = v0 * sc; v1 = v1 * sc; u32x4 w; w.x = cvt_pk_bf16(v0[0], v0[1]); w.y = cvt_pk_bf16(v0[2], v0[3]); w.z = cvt_pk_bf16(v1[0], v1[1]); w.w = cvt_pk_bf16(v1[2], v1[3]);
                    *(u32x4*)(rowp + bj * HALF) = w; } }
    }
};
template <class Epi, class Sched, bool ALIGN_EPI = false, bool SP2 = false>
__device__ __forceinline__ void gemm_phase(PG8_LAS unsigned char* lds, const Gemm g, const Sched& S, const Epi& E) {
    int tid_ = threadIdx.x; asm volatile("" : "+v"(tid_));
    const int tid = tid_, wid = __builtin_amdgcn_readfirstlane(tid >> 6), lane = tid & 63, wr = wid >> 2, wc = wid & 3, fr = lane & 15, fq = lane >> 4;
    const int K = g.K, nt = K / BK;
    unsigned voffA[2], voffB[2];
#pragma unroll
    for (int i = 0; i < 2; ++i) { int R, C; stage_rc(tid * 16 + i * 8192, R, C); const int Rb = Epi::PERM ? ((R & ~31) + perm32(R & 31)) : R;
        voffA[i] = (unsigned)(R * K + C) * 2u; voffB[i] = (unsigned)(Rb * K + C) * 2u; }
    const size_t kstep = (size_t)(BK * 2);
    const size_t hstep = (size_t)HALF * K * 2;
    const size_t tstep = 2 * hstep;
    const unsigned ldsw = (unsigned)wid * 1024u;
    const int aoff = lds_byte(wr * 64 + fr, fq * 8), boff = lds_byte(wc * 32 + fr, fq * 8);
#define PG8_SA(b, h) (((b) * 2 + (h)) * HTB)
#define PG8_SB(b, h) ((4 + (b) * 2 + (h)) * HTB)
#define PG8_STAGE(bufoff, gbase, voff) do { _Pragma("unroll") for (int _i = 0; _i < 2; ++_i) \
        __builtin_amdgcn_global_load_lds((const unsigned*)((const char*)(gbase) + (voff)[_i]), (PG8_LAS unsigned*)(lds + (bufoff) + ldsw + _i * 8192), 16, 0, 0); } while (0)
#define PG8_LDA(dst, b, h) do { _Pragma("unroll") for (int m = 0; m < 4; ++m) _Pragma("unroll") for (int k = 0; k < 2; ++k) dst[m][k] = *(const PG8_LAS bf16x8*)(lds + PG8_SA(b, h) + aoff + m * 2048 + k * 1024); } while (0)
#define PG8_LDB(dst, b, h) do { _Pragma("unroll") for (int n = 0; n < 2; ++n) _Pragma("unroll") for (int k = 0; k < 2; ++k) dst[n][k] = *(const PG8_LAS bf16x8*)(lds + PG8_SB(b, h) + boff + n * 2048 + k * 1024); } while (0)
#define PG8_MMA(ai, bj, At, Bt) do { __builtin_amdgcn_s_setprio(1); _Pragma("unroll") for (int m = 0; m < 4; ++m) _Pragma("unroll") for (int n = 0; n < 2; ++n) _Pragma("unroll") for (int k = 0; k < 2; ++k) \
        acc[ai][bj][m][n] = __builtin_amdgcn_mfma_f32_16x16x32_bf16(Bt[n][k], At[m][k], acc[ai][bj][m][n], 0, 0, 0); __builtin_amdgcn_s_setprio(0); } while (0)
#define PG8_WAIT_V(n) asm volatile("s_waitcnt vmcnt(" #n ")" ::: "memory")
#define PG8_WAIT_L(n) asm volatile("s_waitcnt lgkmcnt(" #n ")" ::: "memory")
#define PG8_BAR __builtin_amdgcn_s_barrier()
#define PG8_SCHED __builtin_amdgcn_sched_barrier(0)
    Unit cur, nxt; int ui = 0;
    if (!S.next(0, cur)) return;
    f32x4 acc[2][2][4][2];
#pragma unroll
    for (int a = 0; a < 2; ++a)
#pragma unroll
        for (int b = 0; b < 2; ++b)
#pragma unroll
            for (int m = 0; m < 4; ++m)
#pragma unroll
                for (int n = 0; n < 2; ++n) acc[a][b][m][n] = (f32x4){0.f, 0.f, 0.f, 0.f};
    bf16x8 At[4][2], B0[2][2], B1[2][2];
    const char* cA = (const char*)g.A + (size_t)cur.pm * tstep; const char* cB = (const char*)g.Bt + (size_t)cur.pn * tstep;
    S.a_ready(cur);
    if constexpr (SP2) {
        PG8_STAGE(PG8_SB(0, 0), cB, voffB); PG8_STAGE(PG8_SB(0, 1), cB + hstep, voffB); PG8_STAGE(PG8_SA(0, 0), cA, voffA); PG8_STAGE(PG8_SA(0, 1), cA + hstep, voffA);
        if (wr == 1) PG8_BAR;
        PG8_WAIT_V(2); PG8_BAR;
        PG8_STAGE(PG8_SB(1, 0), cB + kstep, voffB); PG8_STAGE(PG8_SA(1, 0), cA + kstep, voffA); PG8_STAGE(PG8_SB(1, 1), cB + hstep + kstep, voffB);
        PG8_WAIT_V(6); PG8_BAR;
    } else {
        PG8_STAGE(PG8_SB(0, 0), cB, voffB); PG8_STAGE(PG8_SA(0, 0), cA, voffA); PG8_STAGE(PG8_SB(0, 1), cB + hstep, voffB); PG8_STAGE(PG8_SA(0, 1), cA + hstep, voffA);
        if (wr == 1) PG8_BAR;
        PG8_WAIT_V(4); PG8_BAR;
        PG8_STAGE(PG8_SB(1, 0), cB + kstep, voffB); PG8_STAGE(PG8_SA(1, 0), cA + kstep, voffA); PG8_STAGE(PG8_SB(1, 1), cB + hstep + kstep, voffB);
        PG8_WAIT_V(6); PG8_BAR;
    }
    for (;;) {
        const bool has_next = S.next(ui + 1, nxt);
        const char* nA = has_next ? (const char*)g.A + (size_t)nxt.pm * tstep : cA; const char* nB = has_next ? (const char*)g.Bt + (size_t)nxt.pn * tstep : cB;
        for (int t = 0; t < nt; t += 2) {
            const bool last = (t == nt - 2);
            const char* a1 = cA + (size_t)(t + 1) * kstep;
            const char* a2 = last ? nA : cA + (size_t)(t + 2) * kstep; const char* b2 = last ? nB : cB + (size_t)(t + 2) * kstep;
            const char* a3 = a2 + kstep; const char* b3 = b2 + kstep;
            if (last && has_next) S.a_ready(nxt);
            if constexpr (SP2) {
            PG8_LDB(B0, 0, 0); PG8_LDB(B1, 0, 1); PG8_SCHED; PG8_LDA(At, 0, 0); PG8_STAGE(PG8_SA(1, 1), a1 + hstep, voffA);
            PG8_WAIT_V(8); PG8_WAIT_L(0); PG8_BAR; PG8_MMA(0, 0, At, B0); PG8_MMA(0, 1, At, B1); PG8_BAR; PG8_SCHED;
            PG8_LDA(At, 0, 1); PG8_STAGE(PG8_SB(0, 0), b2, voffB); PG8_STAGE(PG8_SB(0, 1), b2 + hstep, voffB); PG8_STAGE(PG8_SA(0, 0), a2, voffA);
            PG8_WAIT_V(8); PG8_WAIT_L(0); PG8_BAR; PG8_MMA(1, 0, At, B0); PG8_MMA(1, 1, At, B1); PG8_BAR; PG8_SCHED;
            PG8_LDB(B0, 1, 0); PG8_LDB(B1, 1, 1); PG8_SCHED; PG8_LDA(At, 1, 0); PG8_STAGE(PG8_SA(0, 1), a2 + hstep, voffA);
            PG8_WAIT_V(8); PG8_WAIT_L(0); PG8_BAR; PG8_MMA(0, 0, At, B0); PG8_MMA(0, 1, At, B1); PG8_BAR; PG8_SCHED;
            PG8_LDA(At, 1, 1); PG8_STAGE(PG8_SB(1, 0), b3, voffB); PG8_STAGE(PG8_SB(1, 1), b3 + hstep, voffB); PG8_STAGE(PG8_SA(1, 0), a3, voffA);
            PG8_WAIT_V(8); PG8_WAIT_L(0); PG8_BAR; PG8_MMA(1, 0, At, B0); PG8_MMA(1, 1, At, B1); PG8_BAR; PG8_SCHED;
            } else {
            PG8_LDB(B0, 0, 0); PG8_SCHED; PG8_LDA(At, 0, 0); PG8_STAGE(PG8_SA(1, 1), a1 + hstep, voffA);
            PG8_WAIT_L(8); PG8_BAR; PG8_WAIT_L(0); PG8_MMA(0, 0, At, B0); PG8_BAR; PG8_SCHED;
            PG8_LDB(B1, 0, 1); PG8_STAGE(PG8_SB(0, 0), b2, voffB);
            PG8_BAR; PG8_WAIT_L(0); PG8_MMA(0, 1, At, B1); PG8_BAR;
            PG8_LDA(At, 0, 1); PG8_STAGE(PG8_SA(0, 0), a2, voffA);
            PG8_BAR; PG8_WAIT_L(0); PG8_MMA(1, 0, At, B0); PG8_BAR; PG8_SCHED;
            PG8_STAGE(PG8_SB(0, 1), b2 + hstep, voffB);
            PG8_WAIT_V(6); PG8_BAR; PG8_MMA(1, 1, At, B1); PG8_BAR;
            PG8_LDB(B0, 1, 0); PG8_SCHED; PG8_LDA(At, 1, 0); PG8_STAGE(PG8_SA(0, 1), a2 + hstep, voffA);
            PG8_WAIT_L(8); PG8_BAR; PG8_WAIT_L(0); PG8_MMA(0, 0, At, B0); PG8_BAR; PG8_SCHED;
            PG8_LDB(B1, 1, 1); PG8_STAGE(PG8_SB(1, 0), b3, voffB);
            PG8_BAR; PG8_WAIT_L(0); PG8_MMA(0, 1, At, B1); PG8_BAR;
            PG8_LDA(At, 1, 1); PG8_STAGE(PG8_SA(1, 0), a3, voffA);
            PG8_BAR; PG8_WAIT_L(0); PG8_MMA(1, 0, At, B0); PG8_BAR; PG8_SCHED;
            PG8_STAGE(PG8_SB(1, 1), b3 + hstep, voffB);
            PG8_WAIT_V(6); PG8_BAR; PG8_MMA(1, 1, At, B1); PG8_BAR;
            }
        }
        if constexpr (ALIGN_EPI) { if (wr == 0) PG8_BAR; }
        if constexpr (!Epi::AFTER_DRAIN) { E(acc, cur, wr, wc, fr, fq); S.done(cur); }
        if (!has_next) break;
#pragma unroll
        for (int a = 0; a < 2; ++a)
#pragma unroll
            for (int b = 0; b < 2; ++b)
#pragma unroll
                for (int m = 0; m < 4; ++m)
#pragma unroll
                    for (int n = 0; n < 2; ++n) acc[a][b][m][n] = (f32x4){0.f, 0.f, 0.f, 0.f};
        cur = nxt; cA = nA; cB = nB; ++ui;
        if constexpr (ALIGN_EPI) { if (wr == 1) PG8_BAR; }
    }
    PG8_WAIT_V(0);
    if constexpr (!ALIGN_EPI) { if (wr == 0) PG8_BAR; }
    PG8_BAR;
    if constexpr (Epi::AFTER_DRAIN) { E.fused(acc, cur, wr, wc, fr, fq, lds, wid, lane); S.done(cur); }
#undef PG8_SA
#undef PG8_SB
#undef PG8_STAGE
#undef PG8_LDA
#undef PG8_LDB
#undef PG8_MMA
#undef PG8_WAIT_V
#undef PG8_WAIT_L
#undef PG8_BAR
#undef PG8_SCHED
}
}
namespace pg8 {
struct EpiRes {
    static constexpr bool PERM = false, AFTER_DRAIN = false;
    const float* xp; const float* xs;
    float* out; const float* gate;
    __device__ __forceinline__ void operator()(const f32x4 (&acc)[2][2][4][2], const Unit& u, int wr, int wc, int fr, int fq) const {
        const int row0 = u.pm * BM + wr * 64 + fr, col0 = u.pn * BM + wc * 32 + 4 * fq;
        const int v = (u.pm * BM < 8192) ? 0 : 1 + ((u.pm * BM - 8192) >> 12);
        const float* g = gate + (size_t)v * 6144 + col0;
        f32x4 gv[2][2];
#pragma unroll
        for (int bj = 0; bj < 2; ++bj)
#pragma unroll
            for (int n = 0; n < 2; ++n) gv[bj][n] = *(const f32x4*)(g + bj * HALF + n * 16);
#pragma unroll
        for (int ai = 0; ai < 2; ++ai)
#pragma unroll
            for (int m = 0; m < 4; ++m) {
                const int row = row0 + ai * HALF + m * 16;
                const float* bp = (row < 8192 ? xp + (size_t)row * 1024 : xs + (size_t)(row - 8192) * 1024) + col0;
                float* op = out + (size_t)row * 1024 + col0;
#pragma unroll
                for (int bj = 0; bj < 2; ++bj)
#pragma unroll
                    for (int n = 0; n < 2; ++n) { const f32x4 b = *(const f32x4*)(bp + bj * HALF + n * 16); *(f32x4*)(op + bj * HALF + n * 16) = b + gv[bj][n] * acc[ai][bj][m][n]; }
            }
    }
};
}

constexpr int DM = 1024, TP = 8192, TSMP = 32768, TT = 40960, INW = 3072, FF = 2816, FF2 = 5632;
constexpr int NCHUNK = 320, HALF_T = 20480;
constexpr int OFF_LF = 41943040, OFF_LB = OFF_LF + 16384, OFF_RF = OFF_LB + 16384, OFF_RB = OFF_RF + 2097152;
constexpr size_t MiB = 1u << 20;
constexpr size_t WS_MOD = 0, WS_WL = 256 * 1024, WS_AGG = 1 * MiB, WS_CAR = 3 * MiB + 512 * 1024;
constexpr size_t WS_WIN = 5 * MiB, WS_WOUT = 11 * MiB, WS_WGU = 13 * MiB, WS_WD = 24 * MiB;
constexpr size_t WS_XN = 30 * MiB, WS_SB = 30 * MiB, WS_PROJ = 110 * MiB, WS_Y = 350 * MiB, WS_KVT = 430 * MiB;
constexpr size_t WS_GH = 110 * MiB, WS_U = 220 * MiB, WS_END = 510 * MiB;
constexpr int LDS_BYTES = 147456, LDSCTL_OFF = 143360;
constexpr size_t WS_BAR = 768 * 1024;
constexpr int NWAVES = 8;

#define GAS __attribute__((address_space(1)))
#define LAS __attribute__((address_space(3)))
typedef unsigned short bf16;
typedef unsigned v4u __attribute__((ext_vector_type(4)));
typedef unsigned v2u __attribute__((ext_vector_type(2)));
typedef float f32x4 __attribute__((ext_vector_type(4)));
typedef short bf16x8 __attribute__((ext_vector_type(8)));
#define LDS_WAIT() asm volatile("s_waitcnt lgkmcnt(0)" ::: "memory")
typedef float f32x2_t __attribute__((ext_vector_type(2)));
typedef __bf16 bf16x2_t __attribute__((ext_vector_type(2)));
__device__ __forceinline__ unsigned pk2(float lo, float hi) { const f32x2_t v = {lo, hi}; const bf16x2_t b = __builtin_convertvector(v, bf16x2_t); return __builtin_bit_cast(unsigned, b); }
__device__ __forceinline__ unsigned f2bf(float f) { return pk2(f, 0.f) & 0xffffu; }

__device__ __forceinline__ float bflo(unsigned w) { return __builtin_bit_cast(float, w << 16); }
__device__ __forceinline__ float bfhi(unsigned w) { return __builtin_bit_cast(float, w & 0xffff0000u); }
__device__ __forceinline__ float bf2f(unsigned short h) { return __builtin_bit_cast(float, ((unsigned)h) << 16); }
__device__ __forceinline__ float sigmoidf_(float x) { return 1.0f / (1.0f + __expf(-x)); }
__device__ __forceinline__ float siluf_(float x) { return x * __builtin_amdgcn_rcpf(1.0f + __builtin_amdgcn_exp2f(-1.4426950408889634f * x)); }
__device__ __forceinline__ float gelu_tanh(float x) { const float z = x * fmaf(0.044715f * x, x, 1.0f); return x * __builtin_amdgcn_rcpf(1.0f + __builtin_amdgcn_exp2f(-2.302208198f * z)); }

struct Args { const float* in[35]; float* out; unsigned char* ws; int ph_lo, ph_hi; };

#define XB_TMO      128
#define XB_XCNT(j)  (256  + 64 * (j))
#define XB_XSUB(j)  (1280 + 64 * (j))
#define XB_XGEN(j)  (2304 + 64 * (j))
#define XB_TOP      3328
#define XB_TOPGEN   3392
#define XCD_BAR_WORDS 3456
#define XB_SPIN_CAP (1u << 18)

__device__ __forceinline__ unsigned xb_ld(unsigned* p)              { return __hip_atomic_load(p, __ATOMIC_RELAXED, __HIP_MEMORY_SCOPE_AGENT); }
__device__ __forceinline__ unsigned xb_add(unsigned* p, unsigned v) { return __hip_atomic_fetch_add(p, v, __ATOMIC_RELAXED, __HIP_MEMORY_SCOPE_AGENT); }
__device__ __forceinline__ unsigned xb_xcc_id() { return (unsigned)__builtin_amdgcn_s_getreg((3 << 11) | 20) & 0xFu; }
#define XB_SPIN(cond, bar) do { unsigned _sp = 0; while (cond) { __builtin_amdgcn_s_sleep(1); \
    if ((++_sp & 255u) == 0u) { if (xb_ld(&(bar)[XB_TMO])) break; if (_sp > XB_SPIN_CAP) { atomicAdd(&(bar)[XB_TMO], 1u); break; } } } } while (0)

struct XcdBarrier {
    unsigned* bar; unsigned x;
    volatile LAS unsigned* st;
};

__device__ __forceinline__ XcdBarrier xcd_barrier_post(unsigned* bar, volatile LAS unsigned* st) {
    XcdBarrier b; b.bar = bar; b.x = xb_xcc_id(); b.st = st;
    if (threadIdx.x == 0) (void)xb_add(&bar[XB_XCNT(b.x)], 1u);
    return b;
}
__device__ __forceinline__ void xcd_barrier_complete(unsigned* bar, unsigned x, unsigned& nloc, unsigned& nx) {
    const unsigned G = gridDim.x * gridDim.y * gridDim.z;
    unsigned sum, cnt, mine, sp = 0u;
    for (;;) {
        sum = 0u; cnt = 0u; mine = 0u;
#pragma unroll
        for (unsigned j = 0; j < 16; ++j) { const unsigned c = xb_ld(&bar[XB_XCNT(j)]); sum += c; cnt += (c > 0u) ? 1u : 0u; mine = (j == x) ? c : mine; }
        if (sum == G) break;
        __builtin_amdgcn_s_sleep(1);
        if ((++sp & 255u) == 0u) { if (xb_ld(&bar[XB_TMO])) break; if (sp > XB_SPIN_CAP) { atomicAdd(&bar[XB_TMO], 1u); break; } }
    }
    nloc = mine > 0u ? mine : 1u; nx = cnt > 0u ? cnt : 1u;
}

__device__ __forceinline__ void xcd_barrier(const XcdBarrier& b) {
    asm volatile("s_waitcnt vmcnt(0)" ::: "memory");
    __syncthreads();
    if (threadIdx.x == 0) {
        unsigned* bar = b.bar;
        __builtin_amdgcn_s_waitcnt(0);
        unsigned nloc = b.st[0], nx = b.st[1];
        if (nloc == 0u) { xcd_barrier_complete(bar, b.x, nloc, nx); b.st[0] = nloc; b.st[1] = nx; }
        const unsigned old = xb_add(&bar[XB_XSUB(b.x)], 1u);
        const unsigned gen = old / nloc;
        if (old + 1u == (gen + 1u) * nloc) {
            __builtin_amdgcn_fence(__ATOMIC_RELEASE, "agent");
            asm volatile("s_waitcnt vmcnt(0)" ::: "memory");
            const unsigned og = xb_add(&bar[XB_TOP], 1u);
            const unsigned tg = og / nx;
            if (og + 1u == (tg + 1u) * nx) xb_add(&bar[XB_TOPGEN], 1u);
            else XB_SPIN(xb_ld(&bar[XB_TOPGEN]) == tg, bar);
            __builtin_amdgcn_fence(__ATOMIC_ACQUIRE, "agent");
            xb_add(&bar[XB_XGEN(b.x)], 1u);
            asm volatile("s_waitcnt vmcnt(0)" ::: "memory");
        } else {
            XB_SPIN(xb_ld(&bar[XB_XGEN(b.x)]) == gen, bar);
            __builtin_amdgcn_fence(__ATOMIC_ACQUIRE, "agent");
            asm volatile("s_waitcnt vmcnt(0)" ::: "memory");
        }
    }
    __syncthreads();
}
__device__ __forceinline__ float wave_sum(float v) {
#pragma unroll
    for (int o = 1; o < 64; o <<= 1) v += __shfl_xor(v, o);
    return v;
}
__device__ __forceinline__ void p0_transpose_item(const float* W, int K, int N, bf16* WT, int row_off, LAS float* scr, int item, int lane) {
    const int nblk = N / 32, kb = item / nblk, nb = item % nblk, k0 = 64 * kb, n0 = 32 * nb;
#pragma unroll 8
    for (int i = 0; i < 32; ++i) { const int kk = 2 * i + (lane >> 5); scr[kk * 33 + (lane & 31)] = W[(size_t)(k0 + kk) * N + n0 + (lane & 31)]; }
    LDS_WAIT(); asm volatile("" ::: "memory");
    const int c = lane & 7;
#pragma unroll
    for (int j = 0; j < 4; ++j) { const int n = (lane >> 3) + 8 * j; const LAS float* s = scr + (8 * c) * 33 + n;
        v4u o; o.x = pk2(s[0 * 33], s[1 * 33]); o.y = pk2(s[2 * 33], s[3 * 33]); o.z = pk2(s[4 * 33], s[5 * 33]); o.w = pk2(s[6 * 33], s[7 * 33]);
        *(v4u*)(WT + (size_t)(row_off + n0 + n) * K + k0 + 8 * c) = o; }
    LDS_WAIT(); asm volatile("" ::: "memory");
}
__device__ __forceinline__ int mod_index(int row) { return row < TP ? 0 : 1 + ((row - TP) >> 12); }

__device__ __forceinline__ void phase_prologue(const Args& a, LAS unsigned char* lds, int tid, int wave, int lane) {
    unsigned char* ws = a.ws;
    if (blockIdx.x < 96) {
        LAS float* sc = (LAS float*)lds;
        LAS float* red = (LAS float*)(lds + 9 * 1024 * 4);
        for (int i = tid; i < 9 * 1024; i += 512) { const int v = i >> 10, k = i & 1023; const float x = (v == 0) ? a.in[7][k] : a.in[6][(v - 1) * 1024 + k]; sc[i] = siluf_(x); }
        __syncthreads();
        const int col = blockIdx.x * 64 + lane;
        const float* wm = a.in[9] + col;
        float acc[9];
#pragma unroll
        for (int v = 0; v < 9; ++v) acc[v] = 0.f;
        const int kbeg = wave * 128;
#pragma unroll 8
        for (int kk = 0; kk < 128; ++kk) { const int k = kbeg + kk; const float wv = wm[(size_t)k * 6144];
#pragma unroll
            for (int v = 0; v < 9; ++v) acc[v] += sc[v * 1024 + k] * wv; }
#pragma unroll
        for (int v = 0; v < 9; ++v) red[(wave * 9 + v) * 64 + lane] = acc[v];
        __syncthreads();
        for (int i = tid; i < 9 * 64; i += 512) { const int v = i >> 6, l = i & 63; float s = 0.f;
#pragma unroll
            for (int w = 0; w < 8; ++w) s += red[(w * 9 + v) * 64 + l];
            const int cc = blockIdx.x * 64 + l; ((float*)(ws + WS_MOD))[v * 6144 + cc] = s + a.in[10][cc]; }
        __syncthreads();
    }
    LAS float* scr = (LAS float*)(lds + wave * 16384);
    const int gw = blockIdx.x * NWAVES + wave, NGW = gridDim.x * NWAVES;
    constexpr int I_IN = 16 * 96, I_OUT = 16 * 32, I_G = 16 * 88, I_D = 44 * 32, I_L = 64;
    constexpr int NITEMS = I_IN + I_OUT + 2 * I_G + I_D + I_L;
    for (int it = gw; it < NITEMS; it += NGW) {
        int r = it;
        if (r < I_IN) { p0_transpose_item(a.in[11], 1024, 3072, (bf16*)(ws + WS_WIN), 0, scr, r, lane); continue; } r -= I_IN;
        if (r < I_OUT) { p0_transpose_item(a.in[27], 1024, 1024, (bf16*)(ws + WS_WOUT), 0, scr, r, lane); continue; } r -= I_OUT;
        if (r < I_G) { p0_transpose_item(a.in[29], 1024, 2816, (bf16*)(ws + WS_WGU), 0, scr, r, lane); continue; } r -= I_G;
        if (r < I_G) { p0_transpose_item(a.in[30], 1024, 2816, (bf16*)(ws + WS_WGU), 2816, scr, r, lane); continue; } r -= I_G;
        if (r < I_D) { p0_transpose_item(a.in[33], 2816, 1024, (bf16*)(ws + WS_WD), 0, scr, r, lane); continue; } r -= I_D;
        { const int blk = r >> 1, sub = r & 1, mat = blk >> 3, nb = blk & 7;
          const float* src = (mat == 0 ? a.in[14] : mat == 1 ? a.in[16] : mat == 2 ? a.in[19] : a.in[21]) + nb * 4096;
          p0_transpose_item(src, 64, 64, (bf16*)(ws + WS_WL) + (size_t)(mat * 8 + nb) * 4096, 0, scr, sub, lane); }
    }
}

template <int MODE>
__device__ __forceinline__ void phase_rownorm(const float* xp, const float* xs, const float* w, const float* mod_scale, const float* mod_shift, bf16* obf, float* of32, int wave, int lane) {
    const int gw = blockIdx.x * NWAVES + wave, NGW = gridDim.x * NWAVES;
    f32x4 wv[4];
#pragma unroll
    for (int j = 0; j < 4; ++j) wv[j] = *(const f32x4*)(w + 4 * lane + 256 * j);
    for (int row0 = gw; row0 < TT; row0 += 2 * NGW) {
        const int row1 = row0 + NGW; const bool has1 = row1 < TT; const int r1 = has1 ? row1 : row0;
        const float* xr0 = (row0 < TP ? xp + (size_t)row0 * DM : xs + (size_t)(row0 - TP) * DM) + 4 * lane;
        const float* xr1 = (r1 < TP ? xp + (size_t)r1 * DM : xs + (size_t)(r1 - TP) * DM) + 4 * lane;
        f32x4 v0[4], v1[4]; float s0 = 0.f, s1 = 0.f;
#pragma unroll
        for (int j = 0; j < 4; ++j) { v0[j] = *(const f32x4*)(xr0 + 256 * j); v1[j] = *(const f32x4*)(xr1 + 256 * j); }
#pragma unroll
        for (int j = 0; j < 4; ++j) { s0 += (v0[j].x * v0[j].x + v0[j].y * v0[j].y) + (v0[j].z * v0[j].z + v0[j].w * v0[j].w); s1 += (v1[j].x * v1[j].x + v1[j].y * v1[j].y) + (v1[j].z * v1[j].z + v1[j].w * v1[j].w); }
        const float rs0 = 1.0f / sqrtf(wave_sum(s0) * (1.0f / DM) + 1e-6f), rs1 = 1.0f / sqrtf(wave_sum(s1) * (1.0f / DM) + 1e-6f);
#pragma unroll
        for (int k = 0; k < 2; ++k) {
            if (k == 1 && !has1) break;
            const int row = k ? row1 : row0; const float rstd = k ? rs1 : rs0;
            if (MODE == 0) {
                const int mv = mod_index(row);
                const float* sc = mod_scale + (size_t)mv * 6144 + 4 * lane; const float* sh = mod_shift + (size_t)mv * 6144 + 4 * lane;
                unsigned long long* o8 = (unsigned long long*)(obf + (size_t)row * DM) + lane;
#pragma unroll
                for (int j = 0; j < 4; ++j) { const f32x4 scv = *(const f32x4*)(sc + 256 * j), shv = *(const f32x4*)(sh + 256 * j);
                    const f32x4 y = (k ? v1[j] : v0[j]) * rstd * wv[j] * (scv + 1.0f) + shv;
                    o8[64 * j] = (unsigned long long)pk2(y.x, y.y) | ((unsigned long long)pk2(y.z, y.w) << 32); }
            } else {
                float* o = of32 + (size_t)row * DM + 4 * lane;
#pragma unroll
                for (int j = 0; j < 4; ++j) *(f32x4*)(o + 256 * j) = (k ? v1[j] : v0[j]) * rstd * wv[j];
            }
        }
    }
}
constexpr int RS = 272;
constexpr int REG = 128 * RS;
constexpr int XCS = 1040;
#define MFMA16(a, b, c) __builtin_amdgcn_mfma_f32_16x16x32_bf16((a), (b), (c), 0, 0, 0)

__device__ __forceinline__ void mm128(f32x4 (&acc)[8], const LAS unsigned char* Aimg, const LAS unsigned char* Bimg, int wave, int c, int q) {
#pragma unroll
    for (int s = 0; s < 4; ++s) {
        const bf16x8 af = *(const LAS bf16x8*)(Aimg + (16 * wave + c) * RS + (32 * s + 8 * q) * 2);
#pragma unroll
        for (int t = 0; t < 8; ++t) { const bf16x8 bfr = *(const LAS bf16x8*)(Bimg + (16 * t + c) * RS + (32 * s + 8 * q) * 2); acc[t] = MFMA16(bfr, af, acc[t]); }
    }
}
__device__ __forceinline__ void mm128x2(f32x4 (&acc1)[8], f32x4 (&acc2)[8], const LAS unsigned char* Aimg, const LAS unsigned char* B1, const LAS unsigned char* B2, int wave, int c, int q) {
#pragma unroll
    for (int s = 0; s < 4; ++s) {
        const bf16x8 af = *(const LAS bf16x8*)(Aimg + (16 * wave + c) * RS + (32 * s + 8 * q) * 2);
#pragma unroll
        for (int t = 0; t < 8; ++t) { const bf16x8 b1 = *(const LAS bf16x8*)(B1 + (16 * t + c) * RS + (32 * s + 8 * q) * 2); acc1[t] = MFMA16(b1, af, acc1[t]);
                                      const bf16x8 b2 = *(const LAS bf16x8*)(B2 + (16 * t + c) * RS + (32 * s + 8 * q) * 2); acc2[t] = MFMA16(b2, af, acc2[t]); }
    }
}
__device__ __forceinline__ void load_rm(LAS unsigned char* img, const bf16* g, int pitch, int tid) {
#pragma unroll
    for (int i = 0; i < 4; ++i) { const int p = tid + 512 * i, row = p >> 4, cp = p & 15; const v4u v = *(const v4u*)(g + (size_t)row * pitch + cp * 8); *(LAS v4u*)(img + row * RS + cp * 16) = v; }
}
#define HW(v, e) (((e) & 1) ? ((v)[(e) >> 1] >> 16) : ((v)[(e) >> 1] & 0xffffu))
__device__ __forceinline__ void load_tr(LAS unsigned char* img, const bf16* g, int pitch, int wave, int lane) {
#pragma unroll
    for (int it = 0; it < 2; ++it) { const int dg = wave + 8 * it;
        const v4u a = *(const v4u*)(g + (size_t)(2 * lane) * pitch + dg * 8), b = *(const v4u*)(g + (size_t)(2 * lane + 1) * pitch + dg * 8);
#pragma unroll
        for (int e = 0; e < 8; ++e) { const unsigned lo = HW(a, e), hi = HW(b, e); *(LAS unsigned*)(img + (dg * 8 + e) * RS + lane * 4) = lo | (hi << 16); } }
}
__device__ __forceinline__ float log_sigmoid_(float x) { return -log1pf(__expf(-x)); }

template <int PASS>
__device__ __forceinline__ void ret_item(const Args& a, LAS unsigned char* lds, int ci, int h, int tid, int wave, int lane) {
    unsigned char* ws = a.ws;
    const int c = lane & 15, q = lane >> 4;
    const bf16* PROJ = (const bf16*)(ws + WS_PROJ);
    const size_t rowbase = (size_t)ci * 128;
    const bf16* Qg = PROJ + rowbase * INW + 1024 + h * 128;
    const bf16* Kg = PROJ + rowbase * INW + 1536 + h * 128;
    const bf16* Vg = PROJ + rowbase * INW + 2048 + h * 128;
    const float lf2 = log_sigmoid_(a.in[24][h]) * 1.4426950408889634f, lb2 = log_sigmoid_(a.in[25][h]) * 1.4426950408889634f;
    const float scale = 0.08838834764831845f;
    LAS unsigned char* R1 = lds; LAS unsigned char* R2 = lds + REG; LAS unsigned char* R3 = lds + 2 * REG; LAS unsigned char* R4 = lds + 3 * REG;
    if (PASS == 1) {
        const float j0 = (float)(2 * lane), j1 = (float)(2 * lane + 1);
        const float wf0 = scale * __builtin_amdgcn_exp2f(lf2 * (127.f - j0)), wf1 = scale * __builtin_amdgcn_exp2f(lf2 * (127.f - j1)), wb0 = scale * __builtin_amdgcn_exp2f(lb2 * j0), wb1 = scale * __builtin_amdgcn_exp2f(lb2 * j1);
        load_tr(R1, Kg, INW, wave, lane);
#pragma unroll
        for (int it = 0; it < 2; ++it) { const int dg = wave + 8 * it;
            const v4u va = *(const v4u*)(Vg + (size_t)(2 * lane) * INW + dg * 8), vb = *(const v4u*)(Vg + (size_t)(2 * lane + 1) * INW + dg * 8);
#pragma unroll
            for (int e = 0; e < 8; ++e) { const float lo = bf2f((unsigned short)HW(va, e)), hi = bf2f((unsigned short)HW(vb, e));
                *(LAS unsigned*)(R2 + (dg * 8 + e) * RS + lane * 4) = pk2(lo * wf0, hi * wf1);
                *(LAS unsigned*)(R3 + (dg * 8 + e) * RS + lane * 4) = pk2(lo * wb0, hi * wb1); } }
        __syncthreads();
        f32x4 af[8], ab[8];
#pragma unroll
        for (int t = 0; t < 8; ++t) { af[t] = (f32x4){0.f, 0.f, 0.f, 0.f}; ab[t] = (f32x4){0.f, 0.f, 0.f, 0.f}; }
        mm128(af, R2, R1, wave, c, q);
        mm128(ab, R3, R1, wave, c, q);
        bf16* KVT = (bf16*)(ws + WS_KVT) + ((size_t)(ci * 4 + h) * 2) * 16384 + (16 * wave + c) * 128 + 4 * q;
#pragma unroll
        for (int t = 0; t < 8; ++t) { *(v2u*)(KVT + 16 * t) = (v2u){pk2(af[t][0], af[t][1]), pk2(af[t][2], af[t][3])};
                                      *(v2u*)(KVT + 16384 + 16 * t) = (v2u){pk2(ab[t][0], ab[t][1]), pk2(ab[t][2], ab[t][3])}; }
        __syncthreads();
    } else {
        const bf16* SB = (const bf16*)(ws + WS_SB) + ((size_t)(ci * 4 + h) * 2) * 16384;
        load_rm(R1, Qg, INW, tid);
        load_rm(R2, Kg, INW, tid);
        load_tr(R3, Vg, INW, wave, lane);
        load_rm(R4, SB, 128, tid);
        __syncthreads();
        f32x4 aS[8], aF[8];
#pragma unroll
        for (int t = 0; t < 8; ++t) { aS[t] = (f32x4){0.f, 0.f, 0.f, 0.f}; aF[t] = (f32x4){0.f, 0.f, 0.f, 0.f}; }
        mm128x2(aS, aF, R1, R2, R4, wave, c, q);
        __syncthreads();
        const int i = 16 * wave + c;
#pragma unroll
        for (int t = 0; t < 8; ++t) { float p[4];
#pragma unroll
            for (int r = 0; r < 4; ++r) { const int dl = i - (16 * t + 4 * q + r);
                const float ex = __builtin_amdgcn_exp2f(dl > 0 ? lf2 * (float)dl : lb2 * (float)(-dl));
                const float f = dl == 0 ? 2.0f : ex;
                p[r] = aS[t][r] * scale * f; }
            *(LAS v2u*)(R2 + i * RS + (16 * t + 4 * q) * 2) = (v2u){pk2(p[0], p[1]), pk2(p[2], p[3])}; }
        load_rm(R4, SB + 16384, 128, tid);
        __syncthreads();
        const float hf = __builtin_amdgcn_exp2f(lf2 * (float)(i + 1)), hb = __builtin_amdgcn_exp2f(lb2 * (float)(128 - i));
        f32x4 aB[8];
#pragma unroll
        for (int t = 0; t < 8; ++t) { aF[t] = aF[t] * hf; aB[t] = (f32x4){0.f, 0.f, 0.f, 0.f}; }
        mm128(aF, R2, R3, wave, c, q);
        mm128(aB, R1, R4, wave, c, q);
        f32x4 (&aO)[8] = aF;
        float s = 0.f;
#pragma unroll
        for (int t = 0; t < 8; ++t) { aO[t] = aO[t] + aB[t] * hb; s += (aO[t][0] + aO[t][1]) + (aO[t][2] + aO[t][3]); }
        s += __shfl_xor(s, 16); s += __shfl_xor(s, 32);
        const float mean = s * (1.0f / 128.0f); float v2 = 0.f;
#pragma unroll
        for (int t = 0; t < 8; ++t) { aO[t] = aO[t] - mean; v2 += (aO[t][0] * aO[t][0] + aO[t][1] * aO[t][1]) + (aO[t][2] * aO[t][2] + aO[t][3] * aO[t][3]); }
        v2 += __shfl_xor(v2, 16); v2 += __shfl_xor(v2, 32);
        const float rstd = 1.0f / sqrtf(v2 * (1.0f / 128.0f) + 1e-6f);
        const bf16* Gg = PROJ + (rowbase + i) * INW + 2560 + h * 128 + 4 * q;
        const float* gn = a.in[26] + h * 128 + 4 * q;
        bf16* Yp = (bf16*)(ws + WS_Y) + (rowbase + i) * DM + 512 + h * 128 + 4 * q;
#pragma unroll
        for (int t = 0; t < 8; ++t) { const v2u gv = *(const v2u*)(Gg + 16 * t); const f32x4 w = *(const f32x4*)(gn + 16 * t);
            const float y0 = aO[t][0] * rstd * w[0] * siluf_(bflo(gv[0])), y1 = aO[t][1] * rstd * w[1] * siluf_(bfhi(gv[0]));
            const float y2 = aO[t][2] * rstd * w[2] * siluf_(bflo(gv[1])), y3 = aO[t][3] * rstd * w[3] * siluf_(bfhi(gv[1]));
            *(v2u*)(Yp + 16 * t) = (v2u){pk2(y0, y1), pk2(y2, y3)};
            if (t & 1) asm volatile("" ::: "memory"); }
        __syncthreads();
    }
}
template <int PASS, int DIR>
__device__ __forceinline__ void lru_dir(const LAS unsigned char* xcl, const bf16x8 (&idf)[2], const bf16x8 (&wa)[2], const bf16x8 (&wx)[2], float ba, float bx, float sp8,
                                        float hc_in, float* hsp, float& Aout, float& Hout, float& edge, int c, int q, const bf16* Gp, bf16* Yp) {
    float Ac = 1.f, Hc = hc_in;
    float hn[4]; unsigned short gn[4];
    if (PASS == 3 && DIR == 1) {
#pragma unroll
        for (int r = 0; r < 4; ++r) { hn[r] = hsp[(7 * 4 + r) * 64]; gn[r] = Gp[(size_t)(16 * 7 + 4 * q + r) * INW]; }
    }
#pragma unroll 1
    for (int ti = 0; ti < 8; ++ti) {
        const int tt = DIR == 0 ? ti : 7 - ti;
        float hcur[4]; unsigned short gcur[4];
        if (PASS == 3 && DIR == 1) {
#pragma unroll
            for (int r = 0; r < 4; ++r) { hcur[r] = hn[r]; gcur[r] = gn[r]; }
            const int tn = tt > 0 ? tt - 1 : 0;
#pragma unroll
            for (int r = 0; r < 4; ++r) { hn[r] = hsp[(tn * 4 + r) * 64]; gn[r] = Gp[(size_t)(16 * tn + 4 * q + r) * INW]; }
        }
        f32x4 aI = (f32x4){0.f, 0.f, 0.f, 0.f}, aA = aI, aX = aI;
#pragma unroll
        for (int s = 0; s < 2; ++s) { const bf16x8 xf = *(const LAS bf16x8*)(xcl + (16 * tt) * XCS + 64 * s);
            aI = MFMA16(xf, idf[s], aI); aA = MFMA16(xf, wa[s], aA); aX = MFMA16(xf, wx[s], aX); }
        float av[4], uv[4];
#pragma unroll
        for (int r = 0; r < 4; ++r) {
            const float rg = __builtin_amdgcn_rcpf(1.0f + __builtin_amdgcn_exp2f(fmaf(aA[r], -1.4426950408889634f, ba)));
            const float ig = __builtin_amdgcn_rcpf(1.0f + __builtin_amdgcn_exp2f(fmaf(aX[r], -1.4426950408889634f, bx)));
            const float la = -sp8 * rg;
            const float aa = __builtin_amdgcn_exp2f(la * 1.4426950408889634f);
            const float t = -2.0f * la;
            const float ser = t * fmaf(-0.5f * t, fmaf(-0.33333334f * t, fmaf(-0.25f, t, 1.0f), 1.0f), 1.0f);
            const float om = t < 0.125f ? ser : fmaf(-aa, aa, 1.0f);
            av[r] = aa; uv[r] = __builtin_amdgcn_sqrtf(om) * (ig * aI[r]); }
        float pa[4], hl[4]; float P = 1.f, H = 0.f;
#pragma unroll
        for (int rr = 0; rr < 4; ++rr) { const int r = DIR == 0 ? rr : 3 - rr; H = av[r] * H + uv[r]; P *= av[r]; pa[r] = P; hl[r] = H; }
        float A = P, Hh = H, Ap, Hp, Ae, He, At, Ht;
        if (DIR == 0) {
            Ap = __shfl_up(A, 16); Hp = __shfl_up(Hh, 16); if (q >= 1) { Hh = A * Hp + Hh; A = Ap * A; }
            Ap = __shfl_up(A, 32); Hp = __shfl_up(Hh, 32); if (q >= 2) { Hh = A * Hp + Hh; A = Ap * A; }
            Ae = __shfl_up(A, 16); He = __shfl_up(Hh, 16); if (q == 0) { Ae = 1.f; He = 0.f; }
            At = __shfl(A, 48 + c); Ht = __shfl(Hh, 48 + c);
        } else {
            Ap = __shfl_down(A, 16); Hp = __shfl_down(Hh, 16); if (q <= 2) { Hh = A * Hp + Hh; A = Ap * A; }
            Ap = __shfl_down(A, 32); Hp = __shfl_down(Hh, 32); if (q <= 1) { Hh = A * Hp + Hh; A = Ap * A; }
            Ae = __shfl_down(A, 16); He = __shfl_down(Hh, 16); if (q == 3) { Ae = 1.f; He = 0.f; }
            At = __shfl(A, c); Ht = __shfl(Hh, c);
        }
        if (PASS == 3) {
            const float hin = Ae * Hc + He;
#pragma unroll
            for (int r = 0; r < 4; ++r) { const float hv = pa[r] * hin + hl[r];
                if (DIR == 0) hsp[(tt * 4 + r) * 64] = hv;
                else { const size_t tok = (size_t)(16 * tt + 4 * q + r); Yp[tok * DM] = (bf16)f2bf((hcur[r] + hv) * gelu_tanh(bf2f(gcur[r]))); }
                if (DIR == 0 && tt == 0 && r == 0) edge = hv;
                if (DIR == 1 && tt == 7 && r == 3) edge = hv; }
        }
        Hc = At * Hc + Ht; Ac = Ac * At;
    }
    Aout = Ac; Hout = Hc;
}

template <int PASS>
__device__ __forceinline__ void lru_item(const Args& a, LAS unsigned char* lds, int ci, int tid, int wave, int lane) {
    unsigned char* ws = a.ws;
    const int c = lane & 15, q = lane >> 4;
    const bf16* PROJ = (const bf16*)(ws + WS_PROJ);
    int seq, n, seqlen, seqtok0, nch;
    if (ci < 64) { seq = ci >> 1; n = ci & 1; seqlen = 256; seqtok0 = seq * 256; nch = 2; }
    else { seq = (ci - 64) >> 5; n = (ci - 64) & 31; seqlen = 4096; seqtok0 = TP + seq * 4096; nch = 32; }
    const bool isprompt = ci < 64;
    const int p0 = n * 128;
    {
        float w0[8], w1[8], w2[8], w3[8], bb[8];
#pragma unroll
        for (int e = 0; e < 8; ++e) { w0[e] = a.in[12][0 * 512 + 8 * lane + e]; w1[e] = a.in[12][1 * 512 + 8 * lane + e]; w2[e] = a.in[12][2 * 512 + 8 * lane + e]; w3[e] = a.in[12][3 * 512 + 8 * lane + e]; bb[e] = a.in[13][8 * lane + e]; }
        const int pb = p0 + 16 * wave;
        const bf16* base = PROJ + (size_t)seqtok0 * INW + 8 * lane;
#define LDROW(p) (((p) < 0 || (p) >= seqlen) ? (v4u){0u, 0u, 0u, 0u} : *(const v4u*)(base + (size_t)(p) * INW))
        v4u rows[19];
#pragma unroll
        for (int k = 0; k < 19; ++k) rows[k] = LDROW(pb - 2 + k);
#pragma unroll
        for (int i = 0; i < 16; ++i) {
            float o[8];
#pragma unroll
            for (int e = 0; e < 8; ++e) o[e] = fmaf(w3[e], bf2f((unsigned short)HW(rows[i + 3], e)), fmaf(w2[e], bf2f((unsigned short)HW(rows[i + 2], e)), fmaf(w1[e], bf2f((unsigned short)HW(rows[i + 1], e)), fmaf(w0[e], bf2f((unsigned short)HW(rows[i], e)), bb[e]))));
            *(LAS v4u*)(lds + (16 * wave + i) * XCS + 16 * lane) = (v4u){pk2(o[0], o[1]), pk2(o[2], o[3]), pk2(o[4], o[5]), pk2(o[6], o[7])};
        }
#undef LDROW
    }
    __syncthreads();
    const LAS unsigned char* xcl = lds + c * XCS + (64 * wave + 8 * q) * 2;
    const bf16* WL = (const bf16*)(ws + WS_WL);
    const size_t rowbase = (size_t)seqtok0 + p0;
    for (int rt = 0; rt < 4; ++rt) {
        const int dl = 16 * rt + c, d = 64 * wave + dl;
        bf16x8 idf[2];
#pragma unroll
        for (int s = 0; s < 2; ++s)
#pragma unroll
            for (int e = 0; e < 8; ++e) idf[s][e] = (32 * s + 8 * q + e == dl) ? (short)0x3F80 : (short)0;
        float* hs = a.out + (size_t)(blockIdx.x * NWAVES + wave) * 2048 + lane;
        float Af, Hf, Ab, Hb, ef = 0.f, eb = 0.f;
        float cf = 0.f, cb = 0.f;
        if (PASS == 3) { cf = ((const float*)(ws + WS_CAR))[(size_t)(ci * 2 + 0) * 512 + d]; cb = ((const float*)(ws + WS_CAR))[(size_t)(ci * 2 + 1) * 512 + d]; }
        const bf16* Gp = PROJ + rowbase * INW + 512 + d;
        bf16* Yp = (bf16*)(ws + WS_Y) + rowbase * DM + d;
        bf16x8 waf[2], wxf[2], wab[2], wxb[2];
#pragma unroll
        for (int s2 = 0; s2 < 2; ++s2) { const int o = dl * 64 + 32 * s2 + 8 * q;
            waf[s2] = *(const bf16x8*)(WL + (size_t)(0 * 8 + wave) * 4096 + o); wxf[s2] = *(const bf16x8*)(WL + (size_t)(1 * 8 + wave) * 4096 + o);
            wab[s2] = *(const bf16x8*)(WL + (size_t)(2 * 8 + wave) * 4096 + o); wxb[s2] = *(const bf16x8*)(WL + (size_t)(3 * 8 + wave) * 4096 + o); }
        const float baf = a.in[15][d], bxf = a.in[17][d], lmf = a.in[18][d], bab = a.in[20][d], bxb = a.in[22][d], lmb = a.in[23][d];
        lru_dir<PASS, 0>(xcl, idf, waf, wxf, -1.4426950408889634f * baf, -1.4426950408889634f * bxf, 8.0f * log1pf(__expf(-lmf)), cf, hs, Af, Hf, ef, c, q, Gp, Yp);
        lru_dir<PASS, 1>(xcl, idf, wab, wxb, -1.4426950408889634f * bab, -1.4426950408889634f * bxb, 8.0f * log1pf(__expf(-lmb)), cb, hs, Ab, Hb, eb, c, q, Gp, Yp);
        if (PASS == 1) {
            if (q == 0) { float* ag = (float*)(ws + WS_AGG) + (size_t)(ci * 2) * 1024 + d; ag[0] = Af; ag[512] = Hf; ag[1024] = Ab; ag[1536] = Hb; }
        } else {
            if (isprompt && n == 0 && q == 0) a.out[OFF_LF + seq * 512 + d] = ef;
            if (isprompt && n == nch - 1 && q == 3) a.out[OFF_LB + seq * 512 + d] = eb;
        }
    }
    __syncthreads();
}

__device__ __forceinline__ void phase_carries(const Args& a, int tid) {
    unsigned char* ws = a.ws;
    const int gtid = blockIdx.x * 512 + tid, GT = gridDim.x * 512;
    for (int task = gtid; task < 655360; task += GT) {
        const int dv = task & 127, dkg = (task >> 7) & 15, dir = (task >> 11) & 1, h = (task >> 12) & 3, sq = task >> 14;
        const bool isprompt = sq >= 8; const int seq = isprompt ? sq - 8 : sq, N = isprompt ? 2 : 32, cibase = isprompt ? seq * 2 : 64 + seq * 32;
        const float g = __expf(log_sigmoid_(dir ? a.in[25][h] : a.in[24][h]) * 128.0f);
        float S[8];
        if (isprompt) {
#pragma unroll
            for (int e = 0; e < 8; ++e) S[e] = 0.f;
        } else { const float* s0 = (dir ? a.in[5] : a.in[4]) + ((size_t)(seq * 4 + h) * 128 + dkg * 8) * 128 + dv;
#pragma unroll
            for (int e = 0; e < 8; ++e) S[e] = s0[e * 128]; }
        const size_t ibase = ((size_t)h * 2 + dir) * 16384 + dv * 128 + dkg * 8;
        const bf16* kvp = (const bf16*)(ws + WS_KVT) + ibase; bf16* sbp = (bf16*)(ws + WS_SB) + ibase;
        for (int s0 = 0; s0 < N; s0 += 8) {
            v4u kv[8];
#pragma unroll
            for (int j = 0; j < 8; ++j) { const int step = s0 + j; const int n = dir ? N - 1 - step : step; const int ci = cibase + (step < N ? n : (dir ? 0 : N - 1));
                kv[j] = *(const v4u*)(kvp + (size_t)ci * 131072); }
#pragma unroll
            for (int j = 0; j < 8; ++j) { const int step = s0 + j;
                if (step < N) { const int n = dir ? N - 1 - step : step, ci = cibase + n;
                    *(v4u*)(sbp + (size_t)ci * 131072) = (v4u){pk2(S[0], S[1]), pk2(S[2], S[3]), pk2(S[4], S[5]), pk2(S[6], S[7])};
#pragma unroll
                    for (int e2 = 0; e2 < 8; ++e2) S[e2] = g * S[e2] + bf2f((unsigned short)HW(kv[j], e2)); } }
        }
        if (isprompt) { float* o = a.out + (dir ? OFF_RB : OFF_RF) + ((size_t)(seq * 4 + h) * 128 + dkg * 8) * 128 + dv;
#pragma unroll
            for (int e = 0; e < 8; ++e) o[e * 128] = S[e]; }
    }
    for (int task = gtid; task < 40960; task += GT) {
        const int d = task & 511, dir = (task >> 9) & 1, sq = task >> 10;
        const bool isprompt = sq >= 8; const int seq = isprompt ? sq - 8 : sq, N = isprompt ? 2 : 32, cibase = isprompt ? seq * 2 : 64 + seq * 32;
        float hcar = isprompt ? 0.f : (dir ? a.in[3] : a.in[2])[seq * 512 + d];
        for (int step = 0; step < N; ++step) {
            const int n = dir ? N - 1 - step : step, ci = cibase + n;
            ((float*)(ws + WS_CAR))[(size_t)(ci * 2 + dir) * 512 + d] = hcar;
            const float* ag = (const float*)(ws + WS_AGG) + ((size_t)(ci * 2 + dir) * 2) * 512 + d;
            hcar = ag[0] * hcar + ag[512];
        }
    }
}

__device__ __forceinline__ v4u ldg16(const bf16* p, bool ok) { return ok ? *(const v4u*)p : (v4u){0u, 0u, 0u, 0u}; }
__device__ __forceinline__ void phase_act(const Args& a, int half, int wave, int lane) {
    unsigned char* ws = a.ws;
    const bf16* __restrict__ GH = (const bf16*)(ws + WS_GH);
    bf16* __restrict__ U = (bf16*)(ws + WS_U);
    const int gw = blockIdx.x * NWAVES + wave, NGW = gridDim.x * NWAVES;
    const int p = lane >> 5;
    for (int wt = gw; wt < 7040; wt += NGW) {
        const int slab = wt % 11; int r = wt / 11;
        int tok0, ts, lat, steps0, nwalk;
        bool isimg;
        if (half == 1 || r >= 256) {
            if (half == 0) r -= 256;
            const int pair = r & 31, seg = (r >> 5) & 3, img = (r >> 7) + (half == 0 ? 0 : 3);
            const int gc = 2 * pair + p; steps0 = 16 * seg; nwalk = 64; ts = 64; lat = 1; isimg = true;
            tok0 = TP + img * 4096 + steps0 * 64 + gc;
        } else {
            const int sp = r & 7, seq = r >> 3; steps0 = 32 * sp + 16 * p; nwalk = 256; ts = 1; lat = 0; isimg = false;
            tok0 = seq * 256 + steps0;
        }
        const int ch0 = (slab * 32 + (lane & 31)) * 8;
        const int gcol = isimg ? (tok0 & 63) : 1;
        const bool okl = isimg && gcol > 0, okr = isimg && gcol < 63;
        float wk[9][8], bb[8];
#pragma unroll
        for (int k = 0; k < 9; ++k) { const int aa = k / 3, b = k % 3;
            const int src = isimg ? k : (3 + aa);
            const f32x4 x0 = *(const f32x4*)(a.in[31] + (size_t)src * FF + ch0), x1 = *(const f32x4*)(a.in[31] + (size_t)src * FF + ch0 + 4);
            const float z = (isimg || b == 1) ? 1.f : 0.f;
            wk[k][0] = x0[0] * z; wk[k][1] = x0[1] * z; wk[k][2] = x0[2] * z; wk[k][3] = x0[3] * z; wk[k][4] = x1[0] * z; wk[k][5] = x1[1] * z; wk[k][6] = x1[2] * z; wk[k][7] = x1[3] * z; }
        { const f32x4 x0 = *(const f32x4*)(a.in[32] + ch0), x1 = *(const f32x4*)(a.in[32] + ch0 + 4); bb[0] = x0[0]; bb[1] = x0[1]; bb[2] = x0[2]; bb[3] = x0[3]; bb[4] = x1[0]; bb[5] = x1[1]; bb[6] = x1[2]; bb[7] = x1[3]; }
        const bf16* gp = GH + (size_t)(tok0 - half * HALF_T) * FF + ch0;
        bf16* up = U + (size_t)tok0 * FF + ch0;
        const size_t gs = (size_t)ts * FF;
        v4u w0[3], w1[3], w2[3], w3[3];
        { const bool okp = steps0 > 0;
          w0[0] = ldg16(gp - gs - FF, okp && okl); w0[1] = ldg16(gp - gs, okp); w0[2] = ldg16(gp - gs + FF, okp && okr);
          w1[0] = ldg16(gp - FF, okl); w1[1] = *(const v4u*)gp; w1[2] = ldg16(gp + FF, okr); }
#pragma unroll 1
        for (int st = 0; st < 16; st += 2) {
            const bool ok2 = steps0 + st + 1 < nwalk, ok3 = steps0 + st + 2 < nwalk;
            const bf16* g2 = gp + (size_t)(st + 1) * gs; const bf16* g3 = g2 + gs;
            w2[0] = ldg16(g2 - FF, ok2 && okl); w2[1] = ldg16(g2, ok2); w2[2] = ldg16(g2 + FF, ok2 && okr);
            w3[0] = ldg16(g3 - FF, ok3 && okl); w3[1] = ldg16(g3, ok3); w3[2] = ldg16(g3 + FF, ok3 && okr);
            bf16* u0 = up + (size_t)st * gs; bf16* u1 = u0 + gs;
            const v4u uv0 = *(const v4u*)u0, uv1 = *(const v4u*)u1;
            float acc0[8], acc1[8];
#pragma unroll
            for (int e = 0; e < 8; ++e) { acc0[e] = bb[e]; acc1[e] = bb[e]; }
#pragma unroll
            for (int b = 0; b < 3; ++b)
#pragma unroll
                for (int e = 0; e < 8; ++e) {
                    { const float g0 = bf2f((unsigned short)HW(w0[b], e)), g1 = bf2f((unsigned short)HW(w1[b], e)), g2 = bf2f((unsigned short)HW(w2[b], e)), g3 = bf2f((unsigned short)HW(w3[b], e));
                    acc0[e] = fmaf(wk[6 + b][e], g2, fmaf(wk[3 + b][e], g1, fmaf(wk[0 + b][e], g0, acc0[e])));
                    acc1[e] = fmaf(wk[6 + b][e], g3, fmaf(wk[3 + b][e], g2, fmaf(wk[0 + b][e], g1, acc1[e]))); } }
            float o0[8], o1[8];
#pragma unroll
            for (int e = 0; e < 8; ++e) { o0[e] = gelu_tanh(acc0[e]) * bf2f((unsigned short)HW(uv0, e)); o1[e] = gelu_tanh(acc1[e]) * bf2f((unsigned short)HW(uv1, e)); }
            *(v4u*)u0 = (v4u){pk2(o0[0], o0[1]), pk2(o0[2], o0[3]), pk2(o0[4], o0[5]), pk2(o0[6], o0[7])};
            *(v4u*)u1 = (v4u){pk2(o1[0], o1[1]), pk2(o1[2], o1[3]), pk2(o1[4], o1[5]), pk2(o1[6], o1[7])};
#pragma unroll
            for (int b = 0; b < 3; ++b) { w0[b] = w2[b]; w1[b] = w3[b]; }
        }
    }
}
template <int PASS>
__device__ __forceinline__ void phase_mixer(const Args& a, LAS unsigned char* lds, int tid, int wave, int lane) {
    unsigned* ctr = (unsigned*)(a.ws + WS_BAR) + (PASS == 1 ? 3584 : 3648);
    volatile LAS int* slot = (volatile LAS int*)(lds + LDSCTL_OFF + 256);
    for (;;) {
        if (tid == 0) *slot = (int)__hip_atomic_fetch_add(ctr, 1u, __ATOMIC_RELAXED, __HIP_MEMORY_SCOPE_AGENT);
        __syncthreads();
        const int it = *slot;
        if (it >= NCHUNK + 4 * NCHUNK) break;
        asm volatile("" : "+v"(tid), "+v"(lane));
        if (it < NCHUNK) lru_item<PASS>(a, lds, it, tid, wave, lane);
        else { const int r = it - NCHUNK; ret_item<PASS>(a, lds, r >> 2, r & 3, tid, wave, lane); }
    }
}

__global__ void __launch_bounds__(512, 2) fwd(Args a) {
    extern __shared__ __attribute__((aligned(16))) unsigned char lds_raw[];
    LAS unsigned char* lds = (LAS unsigned char*)lds_raw;
    unsigned char* ws = a.ws;
    int tid = threadIdx.x, lane = tid & 63; const int wave = __builtin_amdgcn_readfirstlane(tid >> 6);
#define FRESH() do { tid = threadIdx.x; asm volatile("" : "+v"(tid)); lane = tid & 63; } while (0)
    for (int u = tid; u < (LDS_BYTES - LDSCTL_OFF) / 4; u += 512) ((LAS unsigned*)(lds + LDSCTL_OFF))[u] = 0u;
    __syncthreads();
    const XcdBarrier bar = xcd_barrier_post((unsigned*)(ws + WS_BAR), (volatile LAS unsigned*)(lds + LDSCTL_OFF + 64));
    const float* MOD = (const float*)(ws + WS_MOD);
    const int G = gridDim.x;
    const int lo = a.ph_lo, hi = a.ph_hi;
#ifndef PHMASK
#define PHMASK 0xffff
#endif
#define IN(k) ((((PHMASK) >> (k)) & 1) && lo <= (k) && (k) < hi)
#ifndef REPMASK
#define REPMASK 0u
#endif
#define NREP(k) ((((REPMASK) >> (k)) & 1u) ? 2 : 1)
#define SEAM(k) do { if (IN(k) && IN((k) + 1)) xcd_barrier(bar); } while (0)
    FRESH();
    for (int rep = 0; rep < NREP(0); ++rep) if (IN(0)) phase_prologue(a, lds, tid, wave, lane);
    if (IN(0) && IN(1)) { cg::grid_group grid = cg::this_grid(); grid.sync(); }
    FRESH();
    for (int rep = 0; rep < NREP(1); ++rep) if (IN(1)) phase_rownorm<0>(a.in[0], a.in[1], a.in[8], MOD + 1024, MOD + 0, (bf16*)(ws + WS_XN), nullptr, wave, lane);
    SEAM(1);
    FRESH();
    for (int rep = 0; rep < NREP(2); ++rep) if (IN(2)) { pg8::Gemm g{(const bf16*)(ws + WS_XN), (const bf16*)(ws + WS_WIN), TT, INW, DM}; pg8::StaticOrder S; S.init(TT, INW, G, (int)blockIdx.x);
        pg8::EpiBf16<0> E{(bf16*)(ws + WS_PROJ), INW, nullptr, 0, 0, 1.f};
        pg8::gemm_phase<pg8::EpiBf16<0>, pg8::StaticOrder, true, true>(lds, g, S, E); }
    SEAM(2);
    FRESH();
    for (int rep = 0; rep < NREP(3); ++rep) if (IN(3)) phase_mixer<1>(a, lds, tid, wave, lane);
    SEAM(3);
    FRESH();
    for (int rep = 0; rep < NREP(4); ++rep) if (IN(4)) phase_carries(a, tid);
    SEAM(4);
    FRESH();
    for (int rep = 0; rep < NREP(5); ++rep) if (IN(5)) phase_mixer<3>(a, lds, tid, wave, lane);
    SEAM(5);
    FRESH();
    for (int rep = 0; rep < NREP(6); ++rep) if (IN(6)) { pg8::Gemm g{(const bf16*)(ws + WS_Y), (const bf16*)(ws + WS_WOUT), TT, DM, DM}; pg8::StaticOrder S; S.init(TT, DM, G, (int)blockIdx.x);
        pg8::EpiRes E{a.in[0], a.in[1], a.out, MOD + 2048};
        pg8::gemm_phase<pg8::EpiRes, pg8::StaticOrder, true, true>(lds, g, S, E); }
    SEAM(6);
    FRESH();
    for (int rep = 0; rep < NREP(7); ++rep) if (IN(7)) phase_rownorm<0>(a.out, a.out + (size_t)TP * DM, a.in[28], MOD + 4096, MOD + 3072, (bf16*)(ws + WS_XN), nullptr, wave, lane);
    SEAM(7);
#pragma unroll
    for (int half = 0; half < 2; ++half) {
        FRESH();
        if (IN(8 + 2 * half)) { pg8::Gemm g{(const bf16*)(ws + WS_XN) + (size_t)half * HALF_T * DM, (const bf16*)(ws + WS_WGU), HALF_T, FF2, DM}; pg8::StaticOrder S; S.init(HALF_T, FF2, G, (int)blockIdx.x);
            pg8::EpiBf16<0> E{(bf16*)(ws + WS_GH), FF, nullptr, FF, (size_t)((WS_U - WS_GH) / 2) + (size_t)half * HALF_T * FF, 1.f};
            pg8::gemm_phase<pg8::EpiBf16<0>, pg8::StaticOrder, true, true>(lds, g, S, E); }
        SEAM(8 + 2 * half);
        FRESH();
        if (IN(9 + 2 * half)) phase_act(a, half, wave, lane);
        SEAM(9 + 2 * half);
    }
    FRESH();
    for (int rep = 0; rep < NREP(12); ++rep) if (IN(12)) { pg8::Gemm g{(const bf16*)(ws + WS_U), (const bf16*)(ws + WS_WD), TT, DM, FF}; pg8::StaticOrder S; S.init(TT, DM, G, (int)blockIdx.x);
        pg8::EpiRes E{a.out, a.out + (size_t)TP * DM, a.out, MOD + 5120};
        pg8::gemm_phase<pg8::EpiRes, pg8::StaticOrder, true, true>(lds, g, S, E); }
    SEAM(12);
    FRESH();
    if (IN(13)) phase_rownorm<1>(a.out, a.out + (size_t)TP * DM, a.in[34], nullptr, nullptr, nullptr, a.out, wave, lane);
#undef IN
#undef SEAM
}

extern "C" void kernel_launch(void* const* d_in, const int* in_sizes, int n_in, void* d_out, int out_size,
                              void* d_ws, size_t ws_size, hipStream_t stream) {
    static int grid = 0;
    if (grid == 0) {
        int dev = 0, cus = 0, per_cu = 0;
        hipGetDevice(&dev);
        hipDeviceGetAttribute(&cus, hipDeviceAttributeMultiprocessorCount, dev);
        hipFuncSetAttribute((const void*)fwd, hipFuncAttributeMaxDynamicSharedMemorySize, LDS_BYTES);
        hipOccupancyMaxActiveBlocksPerMultiprocessor(&per_cu, (const void*)fwd, 512, LDS_BYTES);
        if (per_cu < 1) per_cu = 1;
        grid = cus * per_cu;
        if (n_in != 35 || ws_size < WS_END) fprintf(stderr, "kernel_launch: unexpected n_in %d / ws_size %zu\n", n_in, ws_size);
    }
    if (hipMemsetAsync((char*)d_ws + WS_BAR, 0, 16384, stream) != hipSuccess) fprintf(stderr, "kernel_launch: memset failed\n");
    Args a{};
    for (int i = 0; i < 35; ++i) a.in[i] = (const float*)d_in[i];
    a.out = (float*)d_out; a.ws = (unsigned char*)d_ws; a.ph_lo = 0; a.ph_hi = 14;
    void* args[] = {&a};
    hipError_t e = hipLaunchCooperativeKernel((const void*)fwd, dim3(grid), dim3(512), args, LDS_BYTES, stream);
    if (e != hipSuccess) fprintf(stderr, "cooperative launch failed: %s (grid %d)\n", hipGetErrorString(e), grid);
}
```

```cpp
#include <hip/hip_runtime.h>
#include <hip/hip_cooperative_groups.h>
#include <cstdio>
#include <cstdint>
namespace cg = cooperative_groups;
namespace pg8 {
#define PG8_LAS __attribute__((address_space(3)))
typedef unsigned short bf16_t;
typedef short bf16x8 __attribute__((ext_vector_type(8)));
typedef float f32x4 __attribute__((ext_vector_type(4)));
typedef unsigned u32x4 __attribute__((ext_vector_type(4)));
constexpr int BM = 256, BK = 64, HALF = 128, HTB = HALF * BK * 2  , STAGE_BYTES = 8 * HTB, NXCD = 8, WGM = 8;

__host__ __device__ __forceinline__ int lds_byte(int r, int c) { const int st = (r >> 4) * 2 + (c >> 5), rr = r & 15, cc = c & 31, ob = rr * 64 + cc * 2; return st * 1024 + (ob ^ (((ob >> 9) & 1) << 5)); }
__host__ __device__ __forceinline__ void stage_rc(int b, int& R, int& C) { const int st = b / 1024, sb = b % 1024, swz = sb ^ (((sb >> 9) & 1) << 5); R = (st >> 1) * 16 + swz / 64; C = (st & 1) * 32 + (swz % 64) / 2; }
__host__ __device__ __forceinline__ int perm32(int rho) { const int n = rho >> 4, i = rho & 15; return 8 * (i >> 2) + 4 * n + (i & 3); }

struct Unit { int pm, pn; };
struct Gemm { const bf16_t* A; const bf16_t* Bt; int M, N, K; };

struct StaticOrder {
    int nM, nN, nwg, G, c;
    __host__ __device__ void init(int M, int N, int G_, int c_) { nM = M / BM; nN = N / BM; nwg = nM * nN; G = G_; c = c_; }
    __host__ __device__ bool next(int i, Unit& u) const {
        const long L = (long)i * G + c; if (L >= nwg) return false;
        int wgid = (int)L; { const int q = nwg / NXCD, r = nwg % NXCD, xcd = wgid % NXCD, off = wgid / NXCD; wgid = (xcd < r ? xcd * (q + 1) : r * (q + 1) + (xcd - r) * q) + off; }
        const int nig = WGM * nN, gid = wgid / nig, fm = gid * WGM, gsz = (nM - fm) < WGM ? (nM - fm) : WGM;
        u.pm = fm + ((wgid % nig) % gsz); u.pn = (wgid % nig) / gsz; return true;
    }
    __device__ __forceinline__ void a_ready(const Unit&) const {}
    __device__ __forceinline__ void done(const Unit&) const {}
};

__device__ __forceinline__ unsigned cvt_pk_bf16(float lo, float hi) { unsigned r; asm volatile("v_cvt_pk_bf16_f32 %0, %1, %2" : "=v"(r) : "v"(lo), "v"(hi)); return r; }
typedef float f32x2 __attribute__((ext_vector_type(2)));
__device__ __forceinline__ f32x2 gelu_pk(f32x2 v) {
    const f32x2 av = __builtin_elementwise_abs(v), d = av * 0.2316418882f + 1.0f;
    f32x2 t; t.x = __builtin_amdgcn_rcpf(d.x); t.y = __builtin_amdgcn_rcpf(d.y);
    f32x2 q = t * 0.5307027145f + (-0.7265760135f); q = q * t + 0.7107068705f; q = q * t + (-0.142248368f); q = q * t + 0.127414796f; q = q * t;
    const f32x2 s = (v * v) * (-0.72134752044f);
    f32x2 e; e.x = __builtin_amdgcn_exp2f(s.x); e.y = __builtin_amdgcn_exp2f(s.y);
    const f32x2 m = v * (q * e), r = v - m;
    f32x2 o; o.x = v.x < 0.f ? m.x : r.x; o.y = v.y < 0.f ? m.y : r.y; return o;
}

template <int ACT  > struct EpiBf16 {
    static constexpr bool PERM = true, AFTER_DRAIN = false; static_assert(ACT == 0 || ACT == 1, "EpiBf16: ACT is 0 (none) or 1 (gelu_pk)");
    bf16_t* O; int ldc; const float* bias; int split_cols; size_t split_stride; float scale0;
    __device__ __forceinline__ void operator()(const f32x4 (&acc)[2][2][4][2], const Unit& u, int wr, int wc, int fr, int fq) const {
        const int row0 = u.pm * BM + wr * 64 + fr; int colt = u.pn * BM; bf16_t* base = O;
        float sc = 1.f; if (split_cols) { const int t = colt / split_cols; base += (size_t)t * split_stride; colt -= t * split_cols; if (t == 0) sc = scale0; }
        const int col0 = colt + wc * 32 + 8 * fq, bcol0 = u.pn * BM + wc * 32 + 8 * fq;
        f32x4 bv[2][2];
#pragma unroll
        for (int bj = 0; bj < 2; ++bj)
#pragma unroll
            for (int n = 0; n < 2; ++n) bv[bj][n] = bias ? *(const f32x4*)(bias + bcol0 + bj * HALF + 4 * n) : (f32x4){0.f, 0.f, 0.f, 0.f};
#pragma unroll
        for (int ai = 0; ai < 2; ++ai)
#pragma unroll
            for (int m = 0; m < 4; ++m) { bf16_t* rowp = base + (size_t)(row0 + ai * HALF + m * 16) * ldc + col0;
#pragma unroll
                for (int bj = 0; bj < 2; ++bj) { f32x4 v0 = acc[ai][bj][m][0] + bv[bj][0], v1 = acc[ai][bj][m][1] + bv[bj][1];
                    if (ACT == 1) { f32x2 a = gelu_pk((f32x2){v0[0], v0[1]}), b = gelu_pk((f32x2){v0[2], v0[3]}), c = gelu_pk((f32x2){v1[0], v1[1]}), d = gelu_pk((f32x2){v1[2], v1[3]});
                        v0 = (f32x4){a.x, a.y, b.x, b.y}; v1 = (f32x4){c.x, c.y, d.x, d.y}; }
                    v0 = v0 * sc; v1 = v1 * sc; u32x4 w; w.x = cvt_pk_bf16(v0[0], v0[1]); w.y = cvt_pk_bf16(v0[2], v0[3]); w.z = cvt_pk_bf16(v1[0], v1[1]); w.w = cvt_pk_bf16(v1[2], v1[3]);
                    *(u32x4*)(rowp + bj * HALF) = w; } }
    }
};
template <class Epi, class Sched, bool ALIGN_EPI = false, bool SP2 = false>
__device__ __forceinline__ void gemm_phase(PG8_LAS unsigned char* lds, const Gemm g, const Sched& S, const Epi& E) {
    int tid_ = threadIdx.x; asm volatile("" : "+v"(tid_));
    const int tid = tid_, wid = __builtin_amdgcn_readfirstlane(tid >> 6), lane = tid & 63, wr = wid >> 2, wc = wid & 3, fr = lane & 15, fq = lane >> 4;
    const int K = g.K, nt = K / BK;
    unsigned voffA[2], voffB[2];
#pragma unroll
    for (int i = 0; i < 2; ++i) { int R, C; stage_rc(tid * 16 + i * 8192, R, C); const int Rb = Epi::PERM ? ((R & ~31) + perm32(R & 31)) : R;
        voffA[i] = (unsigned)(R * K + C) * 2u; voffB[i] = (unsigned)(Rb * K + C) * 2u; }
    const size_t kstep = (size_t)(BK * 2);
    const size_t hstep = (size_t)HALF * K * 2;
    const size_t tstep = 2 * hstep;
    const unsigned ldsw = (unsigned)wid * 1024u;
    const int aoff = lds_byte(wr * 64 + fr, fq * 8), boff = lds_byte(wc * 32 + fr, fq * 8);
#define PG8_SA(b, h) (((b) * 2 + (h)) * HTB)
#define PG8_SB(b, h) ((4 + (b) * 2 + (h)) * HTB)
#define PG8_STAGE(bufoff, gbase, voff) do { _Pragma("unroll") for (int _i = 0; _i < 2; ++_i) \
        __builtin_amdgcn_global_load_lds((const unsigned*)((const char*)(gbase) + (voff)[_i]), (PG8_LAS unsigned*)(lds + (bufoff) + ldsw + _i * 8192), 16, 0, 0); } while (0)
#define PG8_LDA(dst, b, h) do { _Pragma("unroll") for (int m = 0; m < 4; ++m) _Pragma("unroll") for (int k = 0; k < 2; ++k) dst[m][k] = *(const PG8_LAS bf16x8*)(lds + PG8_SA(b, h) + aoff + m * 2048 + k * 1024); } while (0)
#define PG8_LDB(dst, b, h) do { _Pragma("unroll") for (int n = 0; n < 2; ++n) _Pragma("unroll") for (int k = 0; k < 2; ++k) dst[n][k] = *(const PG8_LAS bf16x8*)(lds + PG8_SB(b, h) + boff + n * 2048 + k * 1024); } while (0)
#define PG8_MMA(ai, bj, At, Bt) do { __builtin_amdgcn_s_setprio(1); _Pragma("unroll") for (int m = 0; m < 4; ++m) _Pragma("unroll") for (int n = 0; n < 2; ++n) _Pragma("unroll") for (int k = 0; k < 2; ++k) \
        acc[ai][bj][m][n] = __builtin_amdgcn_mfma_f32_16x16x32_bf16(Bt[n][k], At[m][k], acc[ai][bj][m][n], 0, 0, 0); __builtin_amdgcn_s_setprio(0); } while (0)
#define PG8_WAIT_V(n) asm volatile("s_waitcnt vmcnt(" #n ")" ::: "memory")
#define PG8_WAIT_L(n) asm volatile("s_waitcnt lgkmcnt(" #n ")" ::: "memory")
#define PG8_BAR __builtin_amdgcn_s_barrier()
#define PG8_SCHED __builtin_amdgcn_sched_barrier(0)
    Unit cur, nxt; int ui = 0;
    if (!S.next(0, cur)) return;
    f32x4 acc[2][2][4][2];
#pragma unroll
    for (int a = 0; a < 2; ++a)
#pragma unroll
        for (int b = 0; b < 2; ++b)
#pragma unroll
            for (int m = 0; m < 4; ++m)
#pragma unroll
                for (int n = 0; n < 2; ++n) acc[a][b][m][n] = (f32x4){0.f, 0.f, 0.f, 0.f};
    bf16x8 At[4][2], B0[2][2], B1[2][2];
    const char* cA = (const char*)g.A + (size_t)cur.pm * tstep; const char* cB = (const char*)g.Bt + (size_t)cur.pn * tstep;
    S.a_ready(cur);
    if constexpr (SP2) {
        PG8_STAGE(PG8_SB(0, 0), cB, voffB); PG8_STAGE(PG8_SB(0, 1), cB + hstep, voffB); PG8_STAGE(PG8_SA(0, 0), cA, voffA); PG8_STAGE(PG8_SA(0, 1), cA + hstep, voffA);
        if (wr == 1) PG8_BAR;
        PG8_WAIT_V(2); PG8_BAR;
        PG8_STAGE(PG8_SB(1, 0), cB + kstep, voffB); PG8_STAGE(PG8_SA(1, 0), cA + kstep, voffA); PG8_STAGE(PG8_SB(1, 1), cB + hstep + kstep, voffB);
        PG8_WAIT_V(6); PG8_BAR;
    } else {
        PG8_STAGE(PG8_SB(0, 0), cB, voffB); PG8_STAGE(PG8_SA(0, 0), cA, voffA); PG8_STAGE(PG8_SB(0, 1), cB + hstep, voffB); PG8_STAGE(PG8_SA(0, 1), cA + hstep, voffA);
        if (wr == 1) PG8_BAR;
        PG8_WAIT_V(4); PG8_BAR;
        PG8_STAGE(PG8_SB(1, 0), cB + kstep, voffB); PG8_STAGE(PG8_SA(1, 0), cA + kstep, voffA); PG8_STAGE(PG8_SB(1, 1), cB + hstep + kstep, voffB);
        PG8_WAIT_V(6); PG8_BAR;
    }
    for (;;) {
        const bool has_next = S.next(ui + 1, nxt);
        const char* nA = has_next ? (const char*)g.A + (size_t)nxt.pm * tstep : cA; const char* nB = has_next ? (const char*)g.Bt + (size_t)nxt.pn * tstep : cB;
        for (int t = 0; t < nt; t += 2) {
            const bool last = (t == nt - 2);
            const char* a1 = cA + (size_t)(t + 1) * kstep;
            const char* a2 = last ? nA : cA + (size_t)(t + 2) * kstep; const char* b2 = last ? nB : cB + (size_t)(t + 2) * kstep;
            const char* a3 = a2 + kstep; const char* b3 = b2 + kstep;
            if (last && has_next) S.a_ready(nxt);
            if constexpr (SP2) {
            PG8_LDB(B0, 0, 0); PG8_LDB(B1, 0, 1); PG8_SCHED; PG8_LDA(At, 0, 0); PG8_STAGE(PG8_SA(1, 1), a1 + hstep, voffA);
            PG8_WAIT_V(8); PG8_WAIT_L(0); PG8_BAR; PG8_MMA(0, 0, At, B0); PG8_MMA(0, 1, At, B1); PG8_BAR; PG8_SCHED;
            PG8_LDA(At, 0, 1); PG8_STAGE(PG8_SB(0, 0), b2, voffB); PG8_STAGE(PG8_SB(0, 1), b2 + hstep, voffB); PG8_STAGE(PG8_SA(0, 0), a2, voffA);
            PG8_WAIT_V(8); PG8_WAIT_L(0); PG8_BAR; PG8_MMA(1, 0, At, B0); PG8_MMA(1, 1, At, B1); PG8_BAR; PG8_SCHED;
            PG8_LDB(B0, 1, 0); PG8_LDB(B1, 1, 1); PG8_SCHED; PG8_LDA(At, 1, 0); PG8_STAGE(PG8_SA(0, 1), a2 + hstep, voffA);
            PG8_WAIT_V(8); PG8_WAIT_L(0); PG8_BAR; PG8_MMA(0, 0, At, B0); PG8_MMA(0, 1, At, B1); PG8_BAR; PG8_SCHED;
            PG8_LDA(At, 1, 1); PG8_STAGE(PG8_SB(1, 0), b3, voffB); PG8_STAGE(PG8_SB(1, 1), b3 + hstep, voffB); PG8_STAGE(PG8_SA(1, 0), a3, voffA);
            PG8_WAIT_V(8); PG8_WAIT_L(0); PG8_BAR; PG8_MMA(1, 0, At, B0); PG8_MMA(1, 1, At, B1); PG8_BAR; PG8_SCHED;
            } else {
            PG8_LDB(B0, 0, 0); PG8_SCHED; PG8_LDA(At, 0, 0); PG8_STAGE(PG8_SA(1, 1), a1 + hstep, voffA);
            PG8_WAIT_L(8); PG8_BAR; PG8_WAIT_L(0); PG8_MMA(0, 0, At, B0); PG8_BAR; PG8_SCHED;
            PG8_LDB(B1, 0, 1); PG8_STAGE(PG8_SB(0, 0), b2, voffB);
            PG8_BAR; PG8_WAIT_L(0); PG8_MMA(0, 1, At, B1); PG8_BAR;
            PG8_LDA(At, 0, 1); PG8_STAGE(PG8_SA(0, 0), a2, voffA);
            PG8_BAR; PG8_WAIT_L(0); PG8_MMA(1, 0, At, B0); PG8_BAR; PG8_SCHED;
            PG8_STAGE(PG8_SB(0, 1), b2 + hstep, voffB);
            PG8_WAIT_V(6); PG8_BAR; PG8_MMA(1, 1, At, B1); PG8_BAR;
            PG8_LDB(B0, 1, 0); PG8_SCHED; PG8_LDA(At, 1, 0); PG8_STAGE(PG8_SA(0, 1), a2 + hstep, voffA);
            PG8_WAIT_L(8); PG8_BAR; PG8_WAIT_L(0); PG8_MMA(0, 0, At, B0); PG8_BAR; PG8_SCHED;
            PG8_LDB(B1, 1, 1); PG8_STAGE(PG8_SB(1, 0), b3, voffB);
            PG8_BAR; PG8_WAIT_L(0); PG8_MMA(0, 1, At, B1); PG8_BAR;
            PG8_LDA(At, 1, 1); PG8_STAGE(PG8_SA(1, 0), a3, voffA);
            PG8_BAR; PG8_WAIT_L(0); PG8_MMA(1, 0, At, B0); PG8_BAR; PG8_SCHED;
            PG8_STAGE(PG8_SB(1, 1), b3 + hstep, voffB);
            PG8_WAIT_V(6); PG8_BAR; PG8_MMA(1, 1, At, B1); PG8_BAR;
            }
        }
        if constexpr (ALIGN_EPI) { if (wr == 0) PG8_BAR; }
        if constexpr (!Epi::AFTER_DRAIN) { E(acc, cur, wr, wc, fr, fq); S.done(cur); }
        if (!has_next) break;
#pragma unroll
        for (int a = 0; a < 2; ++a)
#pragma unroll
            for (int b = 0; b < 2; ++b)
#pragma unroll
                for (int m = 0; m < 4; ++m)
#pragma unroll
                    for (int n = 0; n < 2; ++n) acc[a][b][m][n] = (f32x4){0.f, 0.f, 0.f, 0.f};
        cur = nxt; cA = nA; cB = nB; ++ui;
        if constexpr (ALIGN_EPI) { if (wr == 1) PG8_BAR; }
    }
    PG8_WAIT_V(0);
    if constexpr (!ALIGN_EPI) { if (wr == 0) PG8_BAR; }
    PG8_BAR;
    if constexpr (Epi::AFTER_DRAIN) { E.fused(acc, cur, wr, wc, fr, fq, lds, wid, lane); S.done(cur); }
#undef PG8_SA
#undef PG8_SB
#undef PG8_STAGE
#undef PG8_LDA
#undef PG8_LDB
#undef PG8_MMA
#undef PG8_WAIT_V
#undef PG8_WAIT_L
#undef PG8_BAR
#undef PG8_SCHED
}
}
namespace pg8 {
struct EpiRes {
    static constexpr bool PERM = false, AFTER_DRAIN = false;
    const float* xp; const float* xs;
    float* out; const float* gate;
    __device__ __forceinline__ void operator()(const f32x4 (&acc)[2][2][4][2], const Unit& u, int wr, int wc, int fr, int fq) const {
        const int row0 = u.pm * BM + wr * 64 + fr, col0 = u.pn * BM + wc * 32 + 4 * fq;
        const int v = (u.pm * BM < 8192) ? 0 : 1 + ((u.pm * BM - 8192) >> 12);
        const float* g = gate + (size_t)v * 6144 + col0;
        f32x4 gv[2][2];
#pragma unroll
        for (int bj = 0; bj < 2; ++bj)
#pragma unroll
            for (int n = 0; n < 2; ++n) gv[bj][n] = *(const f32x4*)(g + bj * HALF + n * 16);
#pragma unroll
        for (int ai = 0; ai < 2; ++ai)
#pragma unroll
            for (int m = 0; m < 4; ++m) {
                const int row = row0 + ai * HALF + m * 16;
                const float* bp = (row < 8192 ? xp + (size_t)row * 1024 : xs + (size_t)(row - 8192) * 1024) + col0;
                float* op = out + (size_t)row * 1024 + col0;
#pragma unroll
                for (int bj = 0; bj < 2; ++bj)
#pragma unroll
                    for (int n = 0; n < 2; ++n) { const f32x4 b = *(const f32x4*)(bp + bj * HALF + n * 16); *(f32x4*)(op + bj * HALF + n * 16) = b + gv[bj][n] * acc[ai][bj][m][n]; }
            }
    }
};
}

constexpr int DM = 1024, TP = 8192, TSMP = 32768, TT = 40960, INW = 3072, FF = 2816, FF2 = 5632;
constexpr int NCHUNK = 320, HALF_T = 20480;
constexpr int OFF_LF = 41943040, OFF_LB = OFF_LF + 16384, OFF_RF = OFF_LB + 16384, OFF_RB = OFF_RF + 2097152;
constexpr size_t MiB = 1u << 20;
constexpr size_t WS_MOD = 0, WS_WL = 256 * 1024, WS_AGG = 1 * MiB, WS_CAR = 3 * MiB + 512 * 1024;
constexpr size_t WS_WIN = 5 * MiB, WS_WOUT = 11 * MiB, WS_WGU = 13 * MiB, WS_WD = 24 * MiB;
constexpr size_t WS_XN = 30 * MiB, WS_SB = 30 * MiB, WS_PROJ = 110 * MiB, WS_Y = 350 * MiB, WS_KVT = 430 * MiB;
constexpr size_t WS_GH = 110 * MiB, WS_U = 220 * MiB, WS_END = 510 * MiB;
constexpr int LDS_BYTES = 147456, LDSCTL_OFF = 143360;
constexpr size_t WS_BAR = 768 * 1024;
constexpr int NWAVES = 8;

#define GAS __attribute__((address_space(1)))
#define LAS __attribute__((address_space(3)))
typedef unsigned short bf16;
typedef unsigned v4u __attribute__((ext_vector_type(4)));
typedef unsigned v2u __attribute__((ext_vector_type(2)));
typedef float f32x4 __attribute__((ext_vector_type(4)));
typedef short bf16x8 __attribute__((ext_vector_type(8)));
#define LDS_WAIT() asm volatile("s_waitcnt lgkmcnt(0)" ::: "memory")
typedef float f32x2_t __attribute__((ext_vector_type(2)));
typedef __bf16 bf16x2_t __attribute__((ext_vector_type(2)));
__device__ __forceinline__ unsigned pk2(float lo, float hi) { const f32x2_t v = {lo, hi}; const bf16x2_t b = __builtin_convertvector(v, bf16x2_t); return __builtin_bit_cast(unsigned, b); }
__device__ __forceinline__ unsigned f2bf(float f) { return pk2(f, 0.f) & 0xffffu; }

__device__ __forceinline__ float bflo(unsigned w) { return __builtin_bit_cast(float, w << 16); }
__device__ __forceinline__ float bfhi(unsigned w) { return __builtin_bit_cast(float, w & 0xffff0000u); }
__device__ __forceinline__ float bf2f(unsigned short h) { return __builtin_bit_cast(float, ((unsigned)h) << 16); }
__device__ __forceinline__ float sigmoidf_(float x) { return 1.0f / (1.0f + __expf(-x)); }
__device__ __forceinline__ float siluf_(float x) { return x * __builtin_amdgcn_rcpf(1.0f + __builtin_amdgcn_exp2f(-1.4426950408889634f * x)); }
__device__ __forceinline__ float gelu_tanh(float x) { const float z = x * fmaf(0.044715f * x, x, 1.0f); return x * __builtin_amdgcn_rcpf(1.0f + __builtin_amdgcn_exp2f(-2.302208198f * z)); }

struct Args { const float* in[35]; float* out; unsigned char* ws; int ph_lo, ph_hi; };

#define XB_TMO      128
#define XB_XCNT(j)  (256  + 64 * (j))
#define XB_XSUB(j)  (1280 + 64 * (j))
#define XB_XGEN(j)  (2304 + 64 * (j))
#define XB_TOP      3328
#define XB_TOPGEN   3392
#define XCD_BAR_WORDS 3456
#define XB_SPIN_CAP (1u << 18)

__device__ __forceinline__ unsigned xb_ld(unsigned* p)              { return __hip_atomic_load(p, __ATOMIC_RELAXED, __HIP_MEMORY_SCOPE_AGENT); }
__device__ __forceinline__ unsigned xb_add(unsigned* p, unsigned v) { return __hip_atomic_fetch_add(p, v, __ATOMIC_RELAXED, __HIP_MEMORY_SCOPE_AGENT); }
__device__ __forceinline__ unsigned xb_xcc_id() { return (unsigned)__builtin_amdgcn_s_getreg((3 << 11) | 20) & 0xFu; }
#define XB_SPIN(cond, bar) do { unsigned _sp = 0; while (cond) { __builtin_amdgcn_s_sleep(1); \
    if ((++_sp & 255u) == 0u) { if (xb_ld(&(bar)[XB_TMO])) break; if (_sp > XB_SPIN_CAP) { atomicAdd(&(bar)[XB_TMO], 1u); break; } } } } while (0)

struct XcdBarrier {
    unsigned* bar; unsigned x;
    volatile LAS unsigned* st;
};

__device__ __forceinline__ XcdBarrier xcd_barrier_post(unsigned* bar, volatile LAS unsigned* st) {
    XcdBarrier b; b.bar = bar; b.x = xb_xcc_id(); b.st = st;
    if (threadIdx.x == 0) (void)xb_add(&bar[XB_XCNT(b.x)], 1u);
    return b;
}
__device__ __forceinline__ void xcd_barrier_complete(unsigned* bar, unsigned x, unsigned& nloc, unsigned& nx) {
    const unsigned G = gridDim.x * gridDim.y * gridDim.z;
    unsigned sum, cnt, mine, sp = 0u;
    for (;;) {
        sum = 0u; cnt = 0u; mine = 0u;
#pragma unroll
        for (unsigned j = 0; j < 16; ++j) { const unsigned c = xb_ld(&bar[XB_XCNT(j)]); sum += c; cnt += (c > 0u) ? 1u : 0u; mine = (j == x) ? c : mine; }
        if (sum == G) break;
        __builtin_amdgcn_s_sleep(1);
        if ((++sp & 255u) == 0u) { if (xb_ld(&bar[XB_TMO])) break; if (sp > XB_SPIN_CAP) { atomicAdd(&bar[XB_TMO], 1u); break; } }
    }
    nloc = mine > 0u ? mine : 1u; nx = cnt > 0u ? cnt : 1u;
}

__device__ __forceinline__ void xcd_barrier(const XcdBarrier& b) {
    asm volatile("s_waitcnt vmcnt(0)" ::: "memory");
    __syncthreads();
    if (threadIdx.x == 0) {
        unsigned* bar = b.bar;
        __builtin_amdgcn_s_waitcnt(0);
        unsigned nloc = b.st[0], nx = b.st[1];
        if (nloc == 0u) { xcd_barrier_complete(bar, b.x, nloc, nx); b.st[0] = nloc; b.st[1] = nx; }
        const unsigned old = xb_add(&bar[XB_XSUB(b.x)], 1u);
        const unsigned gen = old / nloc;
        if (old + 1u == (gen + 1u) * nloc) {
            __builtin_amdgcn_fence(__ATOMIC_RELEASE, "agent");
            asm volatile("s_waitcnt vmcnt(0)" ::: "memory");
            const unsigned og = xb_add(&bar[XB_TOP], 1u);
            const unsigned tg = og / nx;
            if (og + 1u == (tg + 1u) * nx) xb_add(&bar[XB_TOPGEN], 1u);
            else XB_SPIN(xb_ld(&bar[XB_TOPGEN]) == tg, bar);
            __builtin_amdgcn_fence(__ATOMIC_ACQUIRE, "agent");
            xb_add(&bar[XB_XGEN(b.x)], 1u);
            asm volatile("s_waitcnt vmcnt(0)" ::: "memory");
        } else {
            XB_SPIN(xb_ld(&bar[XB_XGEN(b.x)]) == gen, bar);
            __builtin_amdgcn_fence(__ATOMIC_ACQUIRE, "agent");
            asm volatile("s_waitcnt vmcnt(0)" ::: "memory");
        }
    }
    __syncthreads();
}
__device__ __forceinline__ float wave_sum(float v) {
#pragma unroll
    for (int o = 1; o < 64; o <<= 1) v += __shfl_xor(v, o);
    return v;
}
__device__ __forceinline__ void p0_transpose_item(const float* W, int K, int N, bf16* WT, int row_off, LAS float* scr, int item, int lane) {
    const int nblk = N / 32, kb = item / nblk, nb = item % nblk, k0 = 64 * kb, n0 = 32 * nb;
#pragma unroll 8
    for (int i = 0; i < 32; ++i) { const int kk = 2 * i + (lane >> 5); scr[kk * 33 + (lane & 31)] = W[(size_t)(k0 + kk) * N + n0 + (lane & 31)]; }
    LDS_WAIT(); asm volatile("" ::: "memory");
    const int c = lane & 7;
#pragma unroll
    for (int j = 0; j < 4; ++j) { const int n = (lane >> 3) + 8 * j; const LAS float* s = scr + (8 * c) * 33 + n;
        v4u o; o.x = pk2(s[0 * 33], s[1 * 33]); o.y = pk2(s[2 * 33], s[3 * 33]); o.z = pk2(s[4 * 33], s[5 * 33]); o.w = pk2(s[6 * 33], s[7 * 33]);
        *(v4u*)(WT + (size_t)(row_off + n0 + n) * K + k0 + 8 * c) = o; }
    LDS_WAIT(); asm volatile("" ::: "memory");
}
__device__ __forceinline__ int mod_index(int row) { return row < TP ? 0 : 1 + ((row - TP) >> 12); }

__device__ __forceinline__ void phase_prologue(const Args& a, LAS unsigned char* lds, int tid, int wave, int lane) {
    unsigned char* ws = a.ws;
    if (blockIdx.x < 96) {
        LAS float* sc = (LAS float*)lds;
        LAS float* red = (LAS float*)(lds + 9 * 1024 * 4);
        for (int i = tid; i < 9 * 1024; i += 512) { const int v = i >> 10, k = i & 1023; const float x = (v == 0) ? a.in[7][k] : a.in[6][(v - 1) * 1024 + k]; sc[i] = siluf_(x); }
        __syncthreads();
        const int col = blockIdx.x * 64 + lane;
        const float* wm = a.in[9] + col;
        float acc[9];
#pragma unroll
        for (int v = 0; v < 9; ++v) acc[v] = 0.f;
        const int kbeg = wave * 128;
#pragma unroll 8
        for (int kk = 0; kk < 128; ++kk) { const int k = kbeg + kk; const float wv = wm[(size_t)k * 6144];
#pragma unroll
            for (int v = 0; v < 9; ++v) acc[v] += sc[v * 1024 + k] * wv; }
#pragma unroll
        for (int v = 0; v < 9; ++v) red[(wave * 9 + v) * 64 + lane] = acc[v];
        __syncthreads();
        for (int i = tid; i < 9 * 64; i += 512) { const int v = i >> 6, l = i & 63; float s = 0.f;
#pragma unroll
            for (int w = 0; w < 8; ++w) s += red[(w * 9 + v) * 64 + l];
            const int cc = blockIdx.x * 64 + l; ((float*)(ws + WS_MOD))[v * 6144 + cc] = s + a.in[10][cc]; }
        __syncthreads();
    }
    LAS float* scr = (LAS float*)(lds + wave * 16384);
    const int gw = blockIdx.x * NWAVES + wave, NGW = gridDim.x * NWAVES;
    constexpr int I_IN = 16 * 96, I_OUT = 16 * 32, I_G = 16 * 88, I_D = 44 * 32, I_L = 64;
    constexpr int NITEMS = I_IN + I_OUT + 2 * I_G + I_D + I_L;
    for (int it = gw; it < NITEMS; it += NGW) {
        int r = it;
        if (r < I_IN) { p0_transpose_item(a.in[11], 1024, 3072, (bf16*)(ws + WS_WIN), 0, scr, r, lane); continue; } r -= I_IN;
        if (r < I_OUT) { p0_transpose_item(a.in[27], 1024, 1024, (bf16*)(ws + WS_WOUT), 0, scr, r, lane); continue; } r -= I_OUT;
        if (r < I_G) { p0_transpose_item(a.in[29], 1024, 2816, (bf16*)(ws + WS_WGU), 0, scr, r, lane); continue; } r -= I_G;
        if (r < I_G) { p0_transpose_item(a.in[30], 1024, 2816, (bf16*)(ws + WS_WGU), 2816, scr, r, lane); continue; } r -= I_G;
        if (r < I_D) { p0_transpose_item(a.in[33], 2816, 1024, (bf16*)(ws + WS_WD), 0, scr, r, lane); continue; } r -= I_D;
        { const int blk = r >> 1, sub = r & 1, mat = blk >> 3, nb = blk & 7;
          const float* src = (mat == 0 ? a.in[14] : mat == 1 ? a.in[16] : mat == 2 ? a.in[19] : a.in[21]) + nb * 4096;
          p0_transpose_item(src, 64, 64, (bf16*)(ws + WS_WL) + (size_t)(mat * 8 + nb) * 4096, 0, scr, sub, lane); }
    }
}

template <int MODE>
__device__ __forceinline__ void phase_rownorm(const float* xp, const float* xs, const float* w, const float* mod_scale, const float* mod_shift, bf16* obf, float* of32, int wave, int lane) {
    const int gw = blockIdx.x * NWAVES + wave, NGW = gridDim.x * NWAVES;
    f32x4 wv[4];
#pragma unroll
    for (int j = 0; j < 4; ++j) wv[j] = *(const f32x4*)(w + 4 * lane + 256 * j);
    for (int row0 = gw; row0 < TT; row0 += 2 * NGW) {
        const int row1 = row0 + NGW; const bool has1 = row1 < TT; const int r1 = has1 ? row1 : row0;
        const float* xr0 = (row0 < TP ? xp + (size_t)row0 * DM : xs + (size_t)(row0 - TP) * DM) + 4 * lane;
        const float* xr1 = (r1 < TP ? xp + (size_t)r1 * DM : xs + (size_t)(r1 - TP) * DM) + 4 * lane;
        f32x4 v0[4], v1[4]; float s0 = 0.f, s1 = 0.f;
#pragma unroll
        for (int j = 0; j < 4; ++j) { v0[j] = *(const f32x4*)(xr0 + 256 * j); v1[j] = *(const f32x4*)(xr1 + 256 * j); }
#pragma unroll
        for (int j = 0; j < 4; ++j) { s0 += (v0[j].x * v0[j].x + v0[j].y * v0[j].y) + (v0[j].z * v0[j].z + v0[j].w * v0[j].w); s1 += (v1[j].x * v1[j].x + v1[j].y * v1[j].y) + (v1[j].z * v1[j].z + v1[j].w * v1[j].w); }
        const float rs0 = 1.0f / sqrtf(wave_sum(s0) * (1.0f / DM) + 1e-6f), rs1 = 1.0f / sqrtf(wave_sum(s1) * (1.0f / DM) + 1e-6f);
#pragma unroll
        for (int k = 0; k < 2; ++k) {
            if (k == 1 && !has1) break;
            const int row = k ? row1 : row0; const float rstd = k ? rs1 : rs0;
            if (MODE == 0) {
                const int mv = mod_index(row);
                const float* sc = mod_scale + (size_t)mv * 6144 + 4 * lane; const float* sh = mod_shift + (size_t)mv * 6144 + 4 * lane;
                unsigned long long* o8 = (unsigned long long*)(obf + (size_t)row * DM) + lane;
#pragma unroll
                for (int j = 0; j < 4; ++j) { const f32x4 scv = *(const f32x4*)(sc + 256 * j), shv = *(const f32x4*)(sh + 256 * j);
                    const f32x4 y = (k ? v1[j] : v0[j]) * rstd * wv[j] * (scv + 1.0f) + shv;
                    o8[64 * j] = (unsigned long long)pk2(y.x, y.y) | ((unsigned long long)pk2(y.z, y.w) << 32); }
            } else {
                float* o = of32 + (size_t)row * DM + 4 * lane;
#pragma unroll
                for (int j = 0; j < 4; ++j) *(f32x4*)(o + 256 * j) = (k ? v1[j] : v0[j]) * rstd * wv[j];
            }
        }
    }
}

template <int MODE>
__device__ __forceinline__ void phase_resnorm(const float* xp, const float* xs, const bf16* tb, const float* gate, float* x1out, const float* w, const float* mod_scale, const float* mod_shift,
                                              bf16* obf, float* of32, int wave, int lane) {
    const int gw = blockIdx.x * NWAVES + wave, NGW = gridDim.x * NWAVES;
    f32x4 wv[4];
#pragma unroll
    for (int j = 0; j < 4; ++j) wv[j] = *(const f32x4*)(w + 4 * lane + 256 * j);
    for (int row0 = gw; row0 < TT; row0 += 2 * NGW) {
        const int row1 = row0 + NGW; const bool has1 = row1 < TT; const int r1 = has1 ? row1 : row0;
        const float* xr0 = (row0 < TP ? xp + (size_t)row0 * DM : xs + (size_t)(row0 - TP) * DM) + 4 * lane;
        const float* xr1 = (r1 < TP ? xp + (size_t)r1 * DM : xs + (size_t)(r1 - TP) * DM) + 4 * lane;
        const bf16* t0 = tb + (size_t)row0 * DM + 4 * lane; const bf16* t1 = tb + (size_t)r1 * DM + 4 * lane;
        f32x4 v0[4], v1[4]; v2u u0[4], u1[4];
#pragma unroll
        for (int j = 0; j < 4; ++j) { v0[j] = *(const f32x4*)(xr0 + 256 * j); v1[j] = *(const f32x4*)(xr1 + 256 * j); u0[j] = *(const v2u*)(t0 + 256 * j); u1[j] = *(const v2u*)(t1 + 256 * j); }
        const float* g0 = gate + (size_t)mod_index(row0) * 6144 + 4 * lane; const float* g1 = gate + (size_t)mod_index(r1) * 6144 + 4 * lane;
        float s0 = 0.f, s1 = 0.f;
#pragma unroll
        for (int j = 0; j < 4; ++j) { const f32x4 ga = *(const f32x4*)(g0 + 256 * j), gb = *(const f32x4*)(g1 + 256 * j);
            v0[j] = v0[j] + ga * (f32x4){bflo(u0[j][0]), bfhi(u0[j][0]), bflo(u0[j][1]), bfhi(u0[j][1])};
            v1[j] = v1[j] + gb * (f32x4){bflo(u1[j][0]), bfhi(u1[j][0]), bflo(u1[j][1]), bfhi(u1[j][1])};
            s0 += (v0[j].x * v0[j].x + v0[j].y * v0[j].y) + (v0[j].z * v0[j].z + v0[j].w * v0[j].w); s1 += (v1[j].x * v1[j].x + v1[j].y * v1[j].y) + (v1[j].z * v1[j].z + v1[j].w * v1[j].w); }
        const float rs0 = 1.0f / sqrtf(wave_sum(s0) * (1.0f / DM) + 1e-6f), rs1 = 1.0f / sqrtf(wave_sum(s1) * (1.0f / DM) + 1e-6f);
#pragma unroll
        for (int k = 0; k < 2; ++k) {
            if (k == 1 && !has1) break;
            const int row = k ? row1 : row0; const float rstd = k ? rs1 : rs0;
            if (x1out) { float* o = x1out + (size_t)row * DM + 4 * lane;
#pragma unroll
                for (int j = 0; j < 4; ++j) *(f32x4*)(o + 256 * j) = (k ? v1[j] : v0[j]); }
            if (MODE == 0) {
                const int mv = mod_index(row);
                const float* sc = mod_scale + (size_t)mv * 6144 + 4 * lane; const float* sh = mod_shift + (size_t)mv * 6144 + 4 * lane;
                unsigned long long* o8 = (unsigned long long*)(obf + (size_t)row * DM) + lane;
#pragma unroll
                for (int j = 0; j < 4; ++j) { const f32x4 scv = *(const f32x4*)(sc + 256 * j), shv = *(const f32x4*)(sh + 256 * j);
                    const f32x4 y = (k ? v1[j] : v0[j]) * rstd * wv[j] * (scv + 1.0f) + shv;
                    o8[64 * j] = (unsigned long long)pk2(y.x, y.y) | ((unsigned long long)pk2(y.z, y.w) << 32); }
            } else {
                float* o = of32 + (size_t)row * DM + 4 * lane;
#pragma unroll
                for (int j = 0; j < 4; ++j) *(f32x4*)(o + 256 * j) = (k ? v1[j] : v0[j]) * rstd * wv[j];
            }
        }
    }
}
constexpr int RS = 272;
constexpr int REG = 128 * RS;
constexpr int XCS = 1040;
#define MFMA16(a, b, c) __builtin_amdgcn_mfma_f32_16x16x32_bf16((a), (b), (c), 0, 0, 0)

__device__ __forceinline__ void mm128(f32x4 (&acc)[8], const LAS unsigned char* Aimg, const LAS unsigned char* Bimg, int wave, int c, int q) {
#pragma unroll
    for (int s = 0; s < 4; ++s) {
        const bf16x8 af = *(const LAS bf16x8*)(Aimg + (16 * wave + c) * RS + (32 * s + 8 * q) * 2);
#pragma unroll
        for (int t = 0; t < 8; ++t) { const bf16x8 bfr = *(const LAS bf16x8*)(Bimg + (16 * t + c) * RS + (32 * s + 8 * q) * 2); acc[t] = MFMA16(bfr, af, acc[t]); }
    }
}
__device__ __forceinline__ void mm128x2(f32x4 (&acc1)[8], f32x4 (&acc2)[8], const LAS unsigned char* Aimg, const LAS unsigned char* B1, const LAS unsigned char* B2, int wave, int c, int q) {
#pragma unroll
    for (int s = 0; s < 4; ++s) {
        const bf16x8 af = *(const LAS bf16x8*)(Aimg + (16 * wave + c) * RS + (32 * s + 8 * q) * 2);
#pragma unroll
        for (int t = 0; t < 8; ++t) { const bf16x8 b1 = *(const LAS bf16x8*)(B1 + (16 * t + c) * RS + (32 * s + 8 * q) * 2); acc1[t] = MFMA16(b1, af, acc1[t]);
                                      const bf16x8 b2 = *(const LAS bf16x8*)(B2 + (16 * t + c) * RS + (32 * s + 8 * q) * 2); acc2[t] = MFMA16(b2, af, acc2[t]); }
    }
}
__device__ __forceinline__ void load_rm(LAS unsigned char* img, const bf16* g, int pitch, int tid) {
#pragma unroll
    for (int i = 0; i < 4; ++i) { const int p = tid + 512 * i, row = p >> 4, cp = p & 15; const v4u v = *(const v4u*)(g + (size_t)row * pitch + cp * 8); *(LAS v4u*)(img + row * RS + cp * 16) = v; }
}
#define HW(v, e) (((e) & 1) ? ((v)[(e) >> 1] >> 16) : ((v)[(e) >> 1] & 0xffffu))
__device__ __forceinline__ void load_tr(LAS unsigned char* img, const bf16* g, int pitch, int wave, int lane) {
#pragma unroll
    for (int it = 0; it < 2; ++it) { const int dg = wave + 8 * it;
        const v4u a = *(const v4u*)(g + (size_t)(2 * lane) * pitch + dg * 8), b = *(const v4u*)(g + (size_t)(2 * lane + 1) * pitch + dg * 8);
#pragma unroll
        for (int e = 0; e < 8; ++e) { const unsigned lo = HW(a, e), hi = HW(b, e); *(LAS unsigned*)(img + (dg * 8 + e) * RS + lane * 4) = lo | (hi << 16); } }
}
__device__ __forceinline__ float log_sigmoid_(float x) { return -log1pf(__expf(-x)); }

template <int PASS>
__device__ __forceinline__ void ret_item(const Args& a, LAS unsigned char* lds, int ci, int h, int tid, int wave, int lane) {
    unsigned char* ws = a.ws;
    const int c = lane & 15, q = lane >> 4;
    const bf16* PROJ = (const bf16*)(ws + WS_PROJ);
    const size_t rowbase = (size_t)ci * 128;
    const bf16* Qg = PROJ + rowbase * INW + 1024 + h * 128;
    const bf16* Kg = PROJ + rowbase * INW + 1536 + h * 128;
    const bf16* Vg = PROJ + rowbase * INW + 2048 + h * 128;
    const float lf2 = log_sigmoid_(a.in[24][h]) * 1.4426950408889634f, lb2 = log_sigmoid_(a.in[25][h]) * 1.4426950408889634f;
    const float scale = 0.08838834764831845f;
    LAS unsigned char* R1 = lds; LAS unsigned char* R2 = lds + REG; LAS unsigned char* R3 = lds + 2 * REG; LAS unsigned char* R4 = lds + 3 * REG;
    if (PASS == 1) {
        const float j0 = (float)(2 * lane), j1 = (float)(2 * lane + 1);
        const float wf0 = scale * __builtin_amdgcn_exp2f(lf2 * (127.f - j0)), wf1 = scale * __builtin_amdgcn_exp2f(lf2 * (127.f - j1)), wb0 = scale * __builtin_amdgcn_exp2f(lb2 * j0), wb1 = scale * __builtin_amdgcn_exp2f(lb2 * j1);
        load_tr(R1, Kg, INW, wave, lane);
#pragma unroll
        for (int it = 0; it < 2; ++it) { const int dg = wave + 8 * it;
            const v4u va = *(const v4u*)(Vg + (size_t)(2 * lane) * INW + dg * 8), vb = *(const v4u*)(Vg + (size_t)(2 * lane + 1) * INW + dg * 8);
#pragma unroll
            for (int e = 0; e < 8; ++e) { const float lo = bf2f((unsigned short)HW(va, e)), hi = bf2f((unsigned short)HW(vb, e));
                *(LAS unsigned*)(R2 + (dg * 8 + e) * RS + lane * 4) = pk2(lo * wf0, hi * wf1);
                *(LAS unsigned*)(R3 + (dg * 8 + e) * RS + lane * 4) = pk2(lo * wb0, hi * wb1); } }
        __syncthreads();
        f32x4 af[8], ab[8];
#pragma unroll
        for (int t = 0; t < 8; ++t) { af[t] = (f32x4){0.f, 0.f, 0.f, 0.f}; ab[t] = (f32x4){0.f, 0.f, 0.f, 0.f}; }
        mm128(af, R2, R1, wave, c, q);
        mm128(ab, R3, R1, wave, c, q);
        bf16* KVT = (bf16*)(ws + WS_KVT) + ((size_t)(ci * 4 + h) * 2) * 16384 + (16 * wave + c) * 128 + 4 * q;
#pragma unroll
        for (int t = 0; t < 8; ++t) { *(v2u*)(KVT + 16 * t) = (v2u){pk2(af[t][0], af[t][1]), pk2(af[t][2], af[t][3])};
                                      *(v2u*)(KVT + 16384 + 16 * t) = (v2u){pk2(ab[t][0], ab[t][1]), pk2(ab[t][2], ab[t][3])}; }
        __syncthreads();
    } else {
        const bf16* SB = (const bf16*)(ws + WS_SB) + ((size_t)(ci * 4 + h) * 2) * 16384;
        load_rm(R1, Qg, INW, tid);
        load_rm(R2, Kg, INW, tid);
        load_tr(R3, Vg, INW, wave, lane);
        load_rm(R4, SB, 128, tid);
        __syncthreads();
        f32x4 aS[8], aF[8];
#pragma unroll
        for (int t = 0; t < 8; ++t) { aS[t] = (f32x4){0.f, 0.f, 0.f, 0.f}; aF[t] = (f32x4){0.f, 0.f, 0.f, 0.f}; }
        mm128x2(aS, aF, R1, R2, R4, wave, c, q);
        __syncthreads();
        const int i = 16 * wave + c;
#pragma unroll
        for (int t = 0; t < 8; ++t) { float p[4];
#pragma unroll
            for (int r = 0; r < 4; ++r) { const int dl = i - (16 * t + 4 * q + r);
                const float ex = __builtin_amdgcn_exp2f(dl > 0 ? lf2 * (float)dl : lb2 * (float)(-dl));
                const float f = dl == 0 ? 2.0f : ex;
                p[r] = aS[t][r] * scale * f; }
            *(LAS v2u*)(R2 + i * RS + (16 * t + 4 * q) * 2) = (v2u){pk2(p[0], p[1]), pk2(p[2], p[3])}; }
        load_rm(R4, SB + 16384, 128, tid);
        __syncthreads();
        const float hf = __builtin_amdgcn_exp2f(lf2 * (float)(i + 1)), hb = __builtin_amdgcn_exp2f(lb2 * (float)(128 - i));
        f32x4 aB[8];
#pragma unroll
        for (int t = 0; t < 8; ++t) { aF[t] = aF[t] * hf; aB[t] = (f32x4){0.f, 0.f, 0.f, 0.f}; }
        mm128(aF, R2, R3, wave, c, q);
        mm128(aB, R1, R4, wave, c, q);
        f32x4 (&aO)[8] = aF;
        float s = 0.f;
#pragma unroll
        for (int t = 0; t < 8; ++t) { aO[t] = aO[t] + aB[t] * hb; s += (aO[t][0] + aO[t][1]) + (aO[t][2] + aO[t][3]); }
        s += __shfl_xor(s, 16); s += __shfl_xor(s, 32);
        const float mean = s * (1.0f / 128.0f); float v2 = 0.f;
#pragma unroll
        for (int t = 0; t < 8; ++t) { aO[t] = aO[t] - mean; v2 += (aO[t][0] * aO[t][0] + aO[t][1] * aO[t][1]) + (aO[t][2] * aO[t][2] + aO[t][3] * aO[t][3]); }
        v2 += __shfl_xor(v2, 16); v2 += __shfl_xor(v2, 32);
        const float rstd = 1.0f / sqrtf(v2 * (1.0f / 128.0f) + 1e-6f);
        const bf16* Gg = PROJ + (rowbase + i) * INW + 2560 + h * 128 + 4 * q;
        const float* gn = a.in[26] + h * 128 + 4 * q;
        bf16* Yp = (bf16*)(ws + WS_Y) + (rowbase + i) * DM + 512 + h * 128 + 4 * q;
#pragma unroll
        for (int t = 0; t < 8; ++t) { const v2u gv = *(const v2u*)(Gg + 16 * t); const f32x4 w = *(const f32x4*)(gn + 16 * t);
            const float y0 = aO[t][0] * rstd * w[0] * siluf_(bflo(gv[0])), y1 = aO[t][1] * rstd * w[1] * siluf_(bfhi(gv[0]));
            const float y2 = aO[t][2] * rstd * w[2] * siluf_(bflo(gv[1])), y3 = aO[t][3] * rstd * w[3] * siluf_(bfhi(gv[1]));
            *(v2u*)(Yp + 16 * t) = (v2u){pk2(y0, y1), pk2(y2, y3)};
            if (t & 1) asm volatile("" ::: "memory"); }
        __syncthreads();
    }
}
template <int PASS, int DIR>
__device__ __forceinline__ void lru_dir(const LAS unsigned char* xcl, const bf16x8 (&idf)[2], const bf16x8 (&wa)[2], const bf16x8 (&wx)[2], float ba, float bx, float sp8,
                                        float hc_in, float* hsp, float& Aout, float& Hout, float& edge, int c, int q, const bf16* Gp, bf16* Yp) {
    float Ac = 1.f, Hc = hc_in;
    float hn[4]; unsigned short gn[4];
    if (PASS == 3 && DIR == 1) {
#pragma unroll
        for (int r = 0; r < 4; ++r) { hn[r] = hsp[(7 * 4 + r) * 64]; gn[r] = Gp[(size_t)(16 * 7 + 4 * q + r) * INW]; }
    }
#pragma unroll 1
    for (int ti = 0; ti < 8; ++ti) {
        const int tt = DIR == 0 ? ti : 7 - ti;
        float hcur[4]; unsigned short gcur[4];
        if (PASS == 3 && DIR == 1) {
#pragma unroll
            for (int r = 0; r < 4; ++r) { hcur[r] = hn[r]; gcur[r] = gn[r]; }
            const int tn = tt > 0 ? tt - 1 : 0;
#pragma unroll
            for (int r = 0; r < 4; ++r) { hn[r] = hsp[(tn * 4 + r) * 64]; gn[r] = Gp[(size_t)(16 * tn + 4 * q + r) * INW]; }
        }
        f32x4 aI = (f32x4){0.f, 0.f, 0.f, 0.f}, aA = aI, aX = aI;
#pragma unroll
        for (int s = 0; s < 2; ++s) { const bf16x8 xf = *(const LAS bf16x8*)(xcl + (16 * tt) * XCS + 64 * s);
            aI = MFMA16(xf, idf[s], aI); aA = MFMA16(xf, wa[s], aA); aX = MFMA16(xf, wx[s], aX); }
        float av[4], uv[4];
#pragma unroll
        for (int r = 0; r < 4; ++r) {
            const float rg = __builtin_amdgcn_rcpf(1.0f + __builtin_amdgcn_exp2f(fmaf(aA[r], -1.4426950408889634f, ba)));
            const float ig = __builtin_amdgcn_rcpf(1.0f + __builtin_amdgcn_exp2f(fmaf(aX[r], -1.4426950408889634f, bx)));
            const float la = -sp8 * rg;
            const float aa = __builtin_amdgcn_exp2f(la * 1.4426950408889634f);
            const float t = -2.0f * la;
            const float ser = t * fmaf(-0.5f * t, fmaf(-0.33333334f * t, fmaf(-0.25f, t, 1.0f), 1.0f), 1.0f);
            const float om = t < 0.125f ? ser : fmaf(-aa, aa, 1.0f);
            av[r] = aa; uv[r] = __builtin_amdgcn_sqrtf(om) * (ig * aI[r]); }
        float pa[4], hl[4]; float P = 1.f, H = 0.f;
#pragma unroll
        for (int rr = 0; rr < 4; ++rr) { const int r = DIR == 0 ? rr : 3 - rr; H = av[r] * H + uv[r]; P *= av[r]; pa[r] = P; hl[r] = H; }
        float A = P, Hh = H, Ap, Hp, Ae, He, At, Ht;
        if (DIR == 0) {
            Ap = __shfl_up(A, 16); Hp = __shfl_up(Hh, 16); if (q >= 1) { Hh = A * Hp + Hh; A = Ap * A; }
            Ap = __shfl_up(A, 32); Hp = __shfl_up(Hh, 32); if (q >= 2) { Hh = A * Hp + Hh; A = Ap * A; }
            Ae = __shfl_up(A, 16); He = __shfl_up(Hh, 16); if (q == 0) { Ae = 1.f; He = 0.f; }
            At = __shfl(A, 48 + c); Ht = __shfl(Hh, 48 + c);
        } else {
            Ap = __shfl_down(A, 16); Hp = __shfl_down(Hh, 16); if (q <= 2) { Hh = A * Hp + Hh; A = Ap * A; }
            Ap = __shfl_down(A, 32); Hp = __shfl_down(Hh, 32); if (q <= 1) { Hh = A * Hp + Hh; A = Ap * A; }
            Ae = __shfl_down(A, 16); He = __shfl_down(Hh, 16); if (q == 3) { Ae = 1.f; He = 0.f; }
            At = __shfl(A, c); Ht = __shfl(Hh, c);
        }
        if (PASS == 3) {
            const float hin = Ae * Hc + He;
#pragma unroll
            for (int r = 0; r < 4; ++r) { const float hv = pa[r] * hin + hl[r];
                if (DIR == 0) hsp[(tt * 4 + r) * 64] = hv;
                else { const size_t tok = (size_t)(16 * tt + 4 * q + r); Yp[tok * DM] = (bf16)f2bf((hcur[r] + hv) * gelu_tanh(bf2f(gcur[r]))); }
                if (DIR == 0 && tt == 0 && r == 0) edge = hv;
                if (DIR == 1 && tt == 7 && r == 3) edge = hv; }
        }
        Hc = At * Hc + Ht; Ac = Ac * At;
    }
    Aout = Ac; Hout = Hc;
}

template <int PASS>
__device__ __forceinline__ void lru_item(const Args& a, LAS unsigned char* lds, int ci, int tid, int wave, int lane) {
    unsigned char* ws = a.ws;
    const int c = lane & 15, q = lane >> 4;
    const bf16* PROJ = (const bf16*)(ws + WS_PROJ);
    int seq, n, seqlen, seqtok0, nch;
    if (ci < 64) { seq = ci >> 1; n = ci & 1; seqlen = 256; seqtok0 = seq * 256; nch = 2; }
    else { seq = (ci - 64) >> 5; n = (ci - 64) & 31; seqlen = 4096; seqtok0 = TP + seq * 4096; nch = 32; }
    const bool isprompt = ci < 64;
    const int p0 = n * 128;
    {
        float w0[8], w1[8], w2[8], w3[8], bb[8];
#pragma unroll
        for (int e = 0; e < 8; ++e) { w0[e] = a.in[12][0 * 512 + 8 * lane + e]; w1[e] = a.in[12][1 * 512 + 8 * lane + e]; w2[e] = a.in[12][2 * 512 + 8 * lane + e]; w3[e] = a.in[12][3 * 512 + 8 * lane + e]; bb[e] = a.in[13][8 * lane + e]; }
        const int pb = p0 + 16 * wave;
        const bf16* base = PROJ + (size_t)seqtok0 * INW + 8 * lane;
#define LDROW(p) (((p) < 0 || (p) >= seqlen) ? (v4u){0u, 0u, 0u, 0u} : *(const v4u*)(base + (size_t)(p) * INW))
        v4u rows[19];
#pragma unroll
        for (int k = 0; k < 19; ++k) rows[k] = LDROW(pb - 2 + k);
#pragma unroll
        for (int i = 0; i < 16; ++i) {
            float o[8];
#pragma unroll
            for (int e = 0; e < 8; ++e) o[e] = fmaf(w3[e], bf2f((unsigned short)HW(rows[i + 3], e)), fmaf(w2[e], bf2f((unsigned short)HW(rows[i + 2], e)), fmaf(w1[e], bf2f((unsigned short)HW(rows[i + 1], e)), fmaf(w0[e], bf2f((unsigned short)HW(rows[i], e)), bb[e]))));
            *(LAS v4u*)(lds + (16 * wave + i) * XCS + 16 * lane) = (v4u){pk2(o[0], o[1]), pk2(o[2], o[3]), pk2(o[4], o[5]), pk2(o[6], o[7])};
        }
#undef LDROW
    }
    __syncthreads();
    const LAS unsigned char* xcl = lds + c * XCS + (64 * wave + 8 * q) * 2;
    const bf16* WL = (const bf16*)(ws + WS_WL);
    const size_t rowbase = (size_t)seqtok0 + p0;
    for (int rt = 0; rt < 4; ++rt) {
        const int dl = 16 * rt + c, d = 64 * wave + dl;
        bf16x8 idf[2];
#pragma unroll
        for (int s = 0; s < 2; ++s)
#pragma unroll
            for (int e = 0; e < 8; ++e) idf[s][e] = (32 * s + 8 * q + e == dl) ? (short)0x3F80 : (short)0;
        float* hs = a.out + (size_t)(blockIdx.x * NWAVES + wave) * 2048 + lane;
        float Af, Hf, Ab, Hb, ef = 0.f, eb = 0.f;
        float cf = 0.f, cb = 0.f;
        if (PASS == 3) { cf = ((const float*)(ws + WS_CAR))[(size_t)(ci * 2 + 0) * 512 + d]; cb = ((const float*)(ws + WS_CAR))[(size_t)(ci * 2 + 1) * 512 + d]; }
        const bf16* Gp = PROJ + rowbase * INW + 512 + d;
        bf16* Yp = (bf16*)(ws + WS_Y) + rowbase * DM + d;
        bf16x8 waf[2], wxf[2], wab[2], wxb[2];
#pragma unroll
        for (int s2 = 0; s2 < 2; ++s2) { const int o = dl * 64 + 32 * s2 + 8 * q;
            waf[s2] = *(const bf16x8*)(WL + (size_t)(0 * 8 + wave) * 4096 + o); wxf[s2] = *(const bf16x8*)(WL + (size_t)(1 * 8 + wave) * 4096 + o);
            wab[s2] = *(const bf16x8*)(WL + (size_t)(2 * 8 + wave) * 4096 + o); wxb[s2] = *(const bf16x8*)(WL + (size_t)(3 * 8 + wave) * 4096 + o); }
        const float baf = a.in[15][d], bxf = a.in[17][d], lmf = a.in[18][d], bab = a.in[20][d], bxb = a.in[22][d], lmb = a.in[23][d];
        lru_dir<PASS, 0>(xcl, idf, waf, wxf, -1.4426950408889634f * baf, -1.4426950408889634f * bxf, 8.0f * log1pf(__expf(-lmf)), cf, hs, Af, Hf, ef, c, q, Gp, Yp);
        lru_dir<PASS, 1>(xcl, idf, wab, wxb, -1.4426950408889634f * bab, -1.4426950408889634f * bxb, 8.0f * log1pf(__expf(-lmb)), cb, hs, Ab, Hb, eb, c, q, Gp, Yp);
        if (PASS == 1) {
            if (q == 0) { float* ag = (float*)(ws + WS_AGG) + (size_t)(ci * 2) * 1024 + d; ag[0] = Af; ag[512] = Hf; ag[1024] = Ab; ag[1536] = Hb; }
        } else {
            if (isprompt && n == 0 && q == 0) a.out[OFF_LF + seq * 512 + d] = ef;
            if (isprompt && n == nch - 1 && q == 3) a.out[OFF_LB + seq * 512 + d] = eb;
        }
    }
    __syncthreads();
}

__device__ __forceinline__ void phase_carries(const Args& a, int tid) {
    unsigned char* ws = a.ws;
    const int gtid = blockIdx.x * 512 + tid, GT = gridDim.x * 512;
    for (int task = gtid; task < 655360; task += GT) {
        const int dv = task & 127, dkg = (task >> 7) & 15, dir = (task >> 11) & 1, h = (task >> 12) & 3, sq = task >> 14;
        const bool isprompt = sq >= 8; const int seq = isprompt ? sq - 8 : sq, N = isprompt ? 2 : 32, cibase = isprompt ? seq * 2 : 64 + seq * 32;
        const float g = __expf(log_sigmoid_(dir ? a.in[25][h] : a.in[24][h]) * 128.0f);
        float S[8];
        if (isprompt) {
#pragma unroll
            for (int e = 0; e < 8; ++e) S[e] = 0.f;
        } else { const float* s0 = (dir ? a.in[5] : a.in[4]) + ((size_t)(seq * 4 + h) * 128 + dkg * 8) * 128 + dv;
#pragma unroll
            for (int e = 0; e < 8; ++e) S[e] = s0[e * 128]; }
        const size_t ibase = ((size_t)h * 2 + dir) * 16384 + dv * 128 + dkg * 8;
        const bf16* kvp = (const bf16*)(ws + WS_KVT) + ibase; bf16* sbp = (bf16*)(ws + WS_SB) + ibase;
        for (int s0 = 0; s0 < N; s0 += 8) {
            v4u kv[8];
#pragma unroll
            for (int j = 0; j < 8; ++j) { const int step = s0 + j; const int n = dir ? N - 1 - step : step; const int ci = cibase + (step < N ? n : (dir ? 0 : N - 1));
                kv[j] = *(const v4u*)(kvp + (size_t)ci * 131072); }
#pragma unroll
            for (int j = 0; j < 8; ++j) { const int step = s0 + j;
                if (step < N) { const int n = dir ? N - 1 - step : step, ci = cibase + n;
                    *(v4u*)(sbp + (size_t)ci * 131072) = (v4u){pk2(S[0], S[1]), pk2(S[2], S[3]), pk2(S[4], S[5]), pk2(S[6], S[7])};
#pragma unroll
                    for (int e2 = 0; e2 < 8; ++e2) S[e2] = g * S[e2] + bf2f((unsigned short)HW(kv[j], e2)); } }
        }
        if (isprompt) { float* o = a.out + (dir ? OFF_RB : OFF_RF) + ((size_t)(seq * 4 + h) * 128 + dkg * 8) * 128 + dv;
#pragma unroll
            for (int e = 0; e < 8; ++e) o[e * 128] = S[e]; }
    }
    for (int task = gtid; task < 40960; task += GT) {
        const int d = task & 511, dir = (task >> 9) & 1, sq = task >> 10;
        const bool isprompt = sq >= 8; const int seq = isprompt ? sq - 8 : sq, N = isprompt ? 2 : 32, cibase = isprompt ? seq * 2 : 64 + seq * 32;
        float hcar = isprompt ? 0.f : (dir ? a.in[3] : a.in[2])[seq * 512 + d];
        for (int step = 0; step < N; ++step) {
            const int n = dir ? N - 1 - step : step, ci = cibase + n;
            ((float*)(ws + WS_CAR))[(size_t)(ci * 2 + dir) * 512 + d] = hcar;
            const float* ag = (const float*)(ws + WS_AGG) + ((size_t)(ci * 2 + dir) * 2) * 512 + d;
            hcar = ag[0] * hcar + ag[512];
        }
    }
}

__device__ __forceinline__ v4u ldg16(const bf16* p, bool ok) { return ok ? *(const v4u*)p : (v4u){0u, 0u, 0u, 0u}; }
__device__ __forceinline__ void phase_act(const Args& a, int half, int wave, int lane) {
    unsigned char* ws = a.ws;
    const bf16* __restrict__ GH = (const bf16*)(ws + WS_GH);
    bf16* __restrict__ U = (bf16*)(ws + WS_U);
    const int gw = blockIdx.x * NWAVES + wave, NGW = gridDim.x * NWAVES;
    const int p = lane >> 5;
    for (int wt = gw; wt < 7040; wt += NGW) {
        const int slab = wt % 11; int r = wt / 11;
        int tok0, ts, lat, steps0, nwalk;
        bool isimg;
        if (half == 1 || r >= 256) {
            if (half == 0) r -= 256;
            const int pair = r & 31, seg = (r >> 5) & 3, img = (r >> 7) + (half == 0 ? 0 : 3);
            const int gc = 2 * pair + p; steps0 = 16 * seg; nwalk = 64; ts = 64; lat = 1; isimg = true;
            tok0 = TP + img * 4096 + steps0 * 64 + gc;
        } else {
            const int sp = r & 7, seq = r >> 3; steps0 = 32 * sp + 16 * p; nwalk = 256; ts = 1; lat = 0; isimg = false;
            tok0 = seq * 256 + steps0;
        }
        const int ch0 = (slab * 32 + (lane & 31)) * 8;
        const int gcol = isimg ? (tok0 & 63) : 1;
        const bool okl = isimg && gcol > 0, okr = isimg && gcol < 63;
        float wk[9][8], bb[8];
#pragma unroll
        for (int k = 0; k < 9; ++k) { const int aa = k / 3, b = k % 3;
            const int src = isimg ? k : (3 + aa);
            const f32x4 x0 = *(const f32x4*)(a.in[31] + (size_t)src * FF + ch0), x1 = *(const f32x4*)(a.in[31] + (size_t)src * FF + ch0 + 4);
            const float z = (isimg || b == 1) ? 1.f : 0.f;
            wk[k][0] = x0[0] * z; wk[k][1] = x0[1] * z; wk[k][2] = x0[2] * z; wk[k][3] = x0[3] * z; wk[k][4] = x1[0] * z; wk[k][5] = x1[1] * z; wk[k][6] = x1[2] * z; wk[k][7] = x1[3] * z; }
        { const f32x4 x0 = *(const f32x4*)(a.in[32] + ch0), x1 = *(const f32x4*)(a.in[32] + ch0 + 4); bb[0] = x0[0]; bb[1] = x0[1]; bb[2] = x0[2]; bb[3] = x0[3]; bb[4] = x1[0]; bb[5] = x1[1]; bb[6] = x1[2]; bb[7] = x1[3]; }
        const bf16* gp = GH + (size_t)(tok0 - half * HALF_T) * FF + ch0;
        bf16* up = U + (size_t)tok0 * FF + ch0;
        const size_t gs = (size_t)ts * FF;
        v4u w0[3], w1[3], w2[3], w3[3];
        { const bool okp = steps0 > 0;
          w0[0] = ldg16(gp - gs - FF, okp && okl); w0[1] = ldg16(gp - gs, okp); w0[2] = ldg16(gp - gs + FF, okp && okr);
          w1[0] = ldg16(gp - FF, okl); w1[1] = *(const v4u*)gp; w1[2] = ldg16(gp + FF, okr); }
#pragma unroll 1
        for (int st = 0; st < 16; st += 2) {
            const bool ok2 = steps0 + st + 1 < nwalk, ok3 = steps0 + st + 2 < nwalk;
            const bf16* g2 = gp + (size_t)(st + 1) * gs; const bf16* g3 = g2 + gs;
            w2[0] = ldg16(g2 - FF, ok2 && okl); w2[1] = ldg16(g2, ok2); w2[2] = ldg16(g2 + FF, ok2 && okr);
            w3[0] = ldg16(g3 - FF, ok3 && okl); w3[1] = ldg16(g3, ok3); w3[2] = ldg16(g3 + FF, ok3 && okr);
            bf16* u0 = up + (size_t)st * gs; bf16* u1 = u0 + gs;
            const v4u uv0 = *(const v4u*)u0, uv1 = *(const v4u*)u1;
            float acc0[8], acc1[8];
#pragma unroll
            for (int e = 0; e < 8; ++e) { acc0[e] = bb[e]; acc1[e] = bb[e]; }
#pragma unroll
            for (int b = 0; b < 3; ++b)
#pragma unroll
                for (int e = 0; e < 8; ++e) {
                    { const float g0 = bf2f((unsigned short)HW(w0[b], e)), g1 = bf2f((unsigned short)HW(w1[b], e)), g2 = bf2f((unsigned short)HW(w2[b], e)), g3 = bf2f((unsigned short)HW(w3[b], e));
                    acc0[e] = fmaf(wk[6 + b][e], g2, fmaf(wk[3 + b][e], g1, fmaf(wk[0 + b][e], g0, acc0[e])));
                    acc1[e] = fmaf(wk[6 + b][e], g3, fmaf(wk[3 + b][e], g2, fmaf(wk[0 + b][e], g1, acc1[e]))); } }
            float o0[8], o1[8];
#pragma unroll
            for (int e = 0; e < 8; ++e) { o0[e] = gelu_tanh(acc0[e]) * bf2f((unsigned short)HW(uv0, e)); o1[e] = gelu_tanh(acc1[e]) * bf2f((unsigned short)HW(uv1, e)); }
            *(v4u*)u0 = (v4u){pk2(o0[0], o0[1]), pk2(o0[2], o0[3]), pk2(o0[4], o0[5]), pk2(o0[6], o0[7])};
            *(v4u*)u1 = (v4u){pk2(o1[0], o1[1]), pk2(o1[2], o1[3]), pk2(o1[4], o1[5]), pk2(o1[6], o1[7])};
#pragma unroll
            for (int b = 0; b < 3; ++b) { w0[b] = w2[b]; w1[b] = w3[b]; }
        }
    }
}
template <int PASS>
__device__ __forceinline__ void phase_mixer(const Args& a, LAS unsigned char* lds, int tid, int wave, int lane) {
    unsigned* ctr = (unsigned*)(a.ws + WS_BAR) + (PASS == 1 ? 3584 : 3648);
    volatile LAS int* slot = (volatile LAS int*)(lds + LDSCTL_OFF + 256);
    for (;;) {
        if (tid == 0) *slot = (int)__hip_atomic_fetch_add(ctr, 1u, __ATOMIC_RELAXED, __HIP_MEMORY_SCOPE_AGENT);
        __syncthreads();
        const int it = *slot;
        if (it >= NCHUNK + 4 * NCHUNK) break;
        asm volatile("" : "+v"(tid), "+v"(lane));
        if (it < NCHUNK) lru_item<PASS>(a, lds, it, tid, wave, lane);
        else { const int r = it - NCHUNK; ret_item<PASS>(a, lds, r >> 2, r & 3, tid, wave, lane); }
    }
}

__global__ void __launch_bounds__(512, 2) fwd(Args a) {
    extern __shared__ __attribute__((aligned(16))) unsigned char lds_raw[];
    LAS unsigned char* lds = (LAS unsigned char*)lds_raw;
    unsigned char* ws = a.ws;
    int tid = threadIdx.x, lane = tid & 63; const int wave = __builtin_amdgcn_readfirstlane(tid >> 6);
#define FRESH() do { tid = threadIdx.x; asm volatile("" : "+v"(tid)); lane = tid & 63; } while (0)
    for (int u = tid; u < (LDS_BYTES - LDSCTL_OFF) / 4; u += 512) ((LAS unsigned*)(lds + LDSCTL_OFF))[u] = 0u;
    __syncthreads();
    const XcdBarrier bar = xcd_barrier_post((unsigned*)(ws + WS_BAR), (volatile LAS unsigned*)(lds + LDSCTL_OFF + 64));
    const float* MOD = (const float*)(ws + WS_MOD);
    const int G = gridDim.x;
    const int lo = a.ph_lo, hi = a.ph_hi;
#ifndef PHMASK
#define PHMASK 0xffff
#endif
#define IN(k) ((((PHMASK) >> (k)) & 1) && lo <= (k) && (k) < hi)
#ifndef REPMASK
#define REPMASK 0u
#endif
#define NREP(k) ((((REPMASK) >> (k)) & 1u) ? 2 : 1)
#define SEAM(k) do { if (IN(k) && IN((k) + 1)) xcd_barrier(bar); } while (0)
    FRESH();
    for (int rep = 0; rep < NREP(0); ++rep) if (IN(0)) phase_prologue(a, lds, tid, wave, lane);
    if (IN(0) && IN(1)) { cg::grid_group grid = cg::this_grid(); grid.sync(); }
    FRESH();
    for (int rep = 0; rep < NREP(1); ++rep) if (IN(1)) phase_rownorm<0>(a.in[0], a.in[1], a.in[8], MOD + 1024, MOD + 0, (bf16*)(ws + WS_XN), nullptr, wave, lane);
    SEAM(1);
    FRESH();
    for (int rep = 0; rep < NREP(2); ++rep) if (IN(2)) { pg8::Gemm g{(const bf16*)(ws + WS_XN), (const bf16*)(ws + WS_WIN), TT, INW, DM}; pg8::StaticOrder S; S.init(TT, INW, G, (int)blockIdx.x);
        pg8::EpiBf16<0> E{(bf16*)(ws + WS_PROJ), INW, nullptr, 0, 0, 1.f};
        pg8::gemm_phase<pg8::EpiBf16<0>, pg8::StaticOrder, true, true>(lds, g, S, E); }
    SEAM(2);
    FRESH();
    for (int rep = 0; rep < NREP(3); ++rep) if (IN(3)) phase_mixer<1>(a, lds, tid, wave, lane);
    SEAM(3);
    FRESH();
    for (int rep = 0; rep < NREP(4); ++rep) if (IN(4)) phase_carries(a, tid);
    SEAM(4);
    FRESH();
    for (int rep = 0; rep < NREP(5); ++rep) if (IN(5)) phase_mixer<3>(a, lds, tid, wave, lane);
    SEAM(5);
    FRESH();
    for (int rep = 0; rep < NREP(6); ++rep) if (IN(6)) { pg8::Gemm g{(const bf16*)(ws + WS_Y), (const bf16*)(ws + WS_WOUT), TT, DM, DM}; pg8::StaticOrder S; S.init(TT, DM, G, (int)blockIdx.x);
        pg8::EpiBf16<0> E{(bf16*)(ws + WS_KVT), DM, nullptr, 0, 0, 1.f};
        pg8::gemm_phase<pg8::EpiBf16<0>, pg8::StaticOrder, true, true>(lds, g, S, E); }
    SEAM(6);
    FRESH();
    for (int rep = 0; rep < NREP(7); ++rep) if (IN(7)) phase_resnorm<0>(a.in[0], a.in[1], (const bf16*)(ws + WS_KVT), MOD + 2048, a.out, a.in[28], MOD + 4096, MOD + 3072, (bf16*)(ws + WS_XN), nullptr, wave, lane);
    SEAM(7);
#pragma unroll
    for (int half = 0; half < 2; ++half) {
        FRESH();
        if (IN(8 + 2 * half)) { pg8::Gemm g{(const bf16*)(ws + WS_XN) + (size_t)half * HALF_T * DM, (const bf16*)(ws + WS_WGU), HALF_T, FF2, DM}; pg8::StaticOrder S; S.init(HALF_T, FF2, G, (int)blockIdx.x);
            pg8::EpiBf16<0> E{(bf16*)(ws + WS_GH), FF, nullptr, FF, (size_t)((WS_U - WS_GH) / 2) + (size_t)half * HALF_T * FF, 1.f};
            pg8::gemm_phase<pg8::EpiBf16<0>, pg8::StaticOrder, true, true>(lds, g, S, E); }
        SEAM(8 + 2 * half);
        FRESH();
        if (IN(9 + 2 * half)) phase_act(a, half, wave, lane);
        SEAM(9 + 2 * half);
    }
    FRESH();
    for (int rep = 0; rep < NREP(12); ++rep) if (IN(12)) { pg8::Gemm g{(const bf16*)(ws + WS_U), (const bf16*)(ws + WS_WD), TT, DM, FF}; pg8::StaticOrder S; S.init(TT, DM, G, (int)blockIdx.x);
        pg8::EpiBf16<0> E{(bf16*)(ws + WS_XN), DM, nullptr, 0, 0, 1.f};
        pg8::gemm_phase<pg8::EpiBf16<0>, pg8::StaticOrder, true, true>(lds, g, S, E); }
    SEAM(12);
    FRESH();
    if (IN(13)) phase_resnorm<1>(a.out, a.out + (size_t)TP * DM, (const bf16*)(ws + WS_XN), MOD + 5120, nullptr, a.in[34], nullptr, nullptr, nullptr, a.out, wave, lane);
#undef IN
#undef SEAM
}

extern "C" void kernel_launch(void* const* d_in, const int* in_sizes, int n_in, void* d_out, int out_size,
                              void* d_ws, size_t ws_size, hipStream_t stream) {
    static int grid = 0;
    if (grid == 0) {
        int dev = 0, cus = 0, per_cu = 0;
        hipGetDevice(&dev);
        hipDeviceGetAttribute(&cus, hipDeviceAttributeMultiprocessorCount, dev);
        hipFuncSetAttribute((const void*)fwd, hipFuncAttributeMaxDynamicSharedMemorySize, LDS_BYTES);
        hipOccupancyMaxActiveBlocksPerMultiprocessor(&per_cu, (const void*)fwd, 512, LDS_BYTES);
        if (per_cu < 1) per_cu = 1;
        grid = cus * per_cu;
        if (n_in != 35 || ws_size < WS_END) fprintf(stderr, "kernel_launch: unexpected n_in %d / ws_size %zu\n", n_in, ws_size);
    }
    if (hipMemsetAsync((char*)d_ws + WS_BAR, 0, 16384, stream) != hipSuccess) fprintf(stderr, "kernel_launch: memset failed\n");
    Args a{};
    for (int i = 0; i < 35; ++i) a.in[i] = (const float*)d_in[i];
    a.out = (float*)d_out; a.ws = (unsigned char*)d_ws; a.ph_lo = 0; a.ph_hi = 14;
    void* args[] = {&a};
    hipError_t e = hipLaunchCooperativeKernel((const void*)fwd, dim3(grid), dim3(512), args, LDS_BYTES, stream);
    if (e != hipSuccess) fprintf(stderr, "cooperative launch failed: %s (grid %d)\n", hipGetErrorString(e), grid);
}
```

```cpp
#include <hip/hip_runtime.h>
#include <hip/hip_cooperative_groups.h>
#include <cstdio>
#include <cstdint>
namespace cg = cooperative_groups;
namespace pg8 {
#define PG8_LAS __attribute__((address_space(3)))
typedef unsigned short bf16_t;
typedef short bf16x8 __attribute__((ext_vector_type(8)));
typedef float f32x4 __attribute__((ext_vector_type(4)));
typedef unsigned u32x4 __attribute__((ext_vector_type(4)));
constexpr int BM = 256, BK = 64, HALF = 128, HTB = HALF * BK * 2  , STAGE_BYTES = 8 * HTB, NXCD = 8, WGM = 8;

__host__ __device__ __forceinline__ int lds_byte(int r, int c) { const int st = (r >> 4) * 2 + (c >> 5), rr = r & 15, cc = c & 31, ob = rr * 64 + cc * 2; return st * 1024 + (ob ^ (((ob >> 9) & 1) << 5)); }
__host__ __device__ __forceinline__ void stage_rc(int b, int& R, int& C) { const int st = b / 1024, sb = b % 1024, swz = sb ^ (((sb >> 9) & 1) << 5); R = (st >> 1) * 16 + swz / 64; C = (st & 1) * 32 + (swz % 64) / 2; }
__host__ __device__ __forceinline__ int perm32(int rho) { const int n = rho >> 4, i = rho & 15; return 8 * (i >> 2) + 4 * n + (i & 3); }

struct Unit { int pm, pn; };
struct Gemm { const bf16_t* A; const bf16_t* Bt; int M, N, K; };

struct StaticOrder {
    int nM, nN, nwg, G, c;
    __host__ __device__ void init(int M, int N, int G_, int c_) { nM = M / BM; nN = N / BM; nwg = nM * nN; G = G_; c = c_; }
    __host__ __device__ bool next(int i, Unit& u) const {
        const long L = (long)i * G + c; if (L >= nwg) return false;
        int wgid = (int)L; { const int q = nwg / NXCD, r = nwg % NXCD, xcd = wgid % NXCD, off = wgid / NXCD; wgid = (xcd < r ? xcd * (q + 1) : r * (q + 1) + (xcd - r) * q) + off; }
        const int nig = WGM * nN, gid = wgid / nig, fm = gid * WGM, gsz = (nM - fm) < WGM ? (nM - fm) : WGM;
        u.pm = fm + ((wgid % nig) % gsz); u.pn = (wgid % nig) / gsz; return true;
    }
    __device__ __forceinline__ void a_ready(const Unit&) const {}
    __device__ __forceinline__ void done(const Unit&) const {}
};

__device__ __forceinline__ unsigned cvt_pk_bf16(float lo, float hi) { unsigned r; asm volatile("v_cvt_pk_bf16_f32 %0, %1, %2" : "=v"(r) : "v"(lo), "v"(hi)); return r; }
typedef float f32x2 __attribute__((ext_vector_type(2)));
__device__ __forceinline__ f32x2 gelu_pk(f32x2 v) {
    const f32x2 av = __builtin_elementwise_abs(v), d = av * 0.2316418882f + 1.0f;
    f32x2 t; t.x = __builtin_amdgcn_rcpf(d.x); t.y = __builtin_amdgcn_rcpf(d.y);
    f32x2 q = t * 0.5307027145f + (-0.7265760135f); q = q * t + 0.7107068705f; q = q * t + (-0.142248368f); q = q * t + 0.127414796f; q = q * t;
    const f32x2 s = (v * v) * (-0.72134752044f);
    f32x2 e; e.x = __builtin_amdgcn_exp2f(s.x); e.y = __builtin_amdgcn_exp2f(s.y);
    const f32x2 m = v * (q * e), r = v - m;
    f32x2 o; o.x = v.x < 0.f ? m.x : r.x; o.y = v.y < 0.f ? m.y : r.y; return o;
}

template <int ACT  > struct EpiBf16 {
    static constexpr bool PERM = true, AFTER_DRAIN = false; static_assert(ACT == 0 || ACT == 1, "EpiBf16: ACT is 0 (none) or 1 (gelu_pk)");
    bf16_t* O; int ldc; const float* bias; int split_cols; size_t split_stride; float scale0;
    __device__ __forceinline__ void operator()(const f32x4 (&acc)[2][2][4][2], const Unit& u, int wr, int wc, int fr, int fq) const {
        const int row0 = u.pm * BM + wr * 64 + fr; int colt = u.pn * BM; bf16_t* base = O;
        float sc = 1.f; if (split_cols) { const int t = colt / split_cols; base += (size_t)t * split_stride; colt -= t * split_cols; if (t == 0) sc = scale0; }
        const int col0 = colt + wc * 32 + 8 * fq, bcol0 = u.pn * BM + wc * 32 + 8 * fq;
        f32x4 bv[2][2];
#pragma unroll
        for (int bj = 0; bj < 2; ++bj)
#pragma unroll
            for (int n = 0; n < 2; ++n) bv[bj][n] = bias ? *(const f32x4*)(bias + bcol0 + bj * HALF + 4 * n) : (f32x4){0.f, 0.f, 0.f, 0.f};
#pragma unroll
        for (int ai = 0; ai < 2; ++ai)
#pragma unroll
            for (int m = 0; m < 4; ++m) { bf16_t* rowp = base + (size_t)(row0 + ai * HALF + m * 16) * ldc + col0;
#pragma unroll
                for (int bj = 0; bj < 2; ++bj) { f32x4 v0 = acc[ai][bj][m][0] + bv[bj][0], v1 = acc[ai][bj][m][1] + bv[bj][1];
                    if (ACT == 1) { f32x2 a = gelu_pk((f32x2){v0[0], v0[1]}), b = gelu_pk((f32x2){v0[2], v0[3]}), c = gelu_pk((f32x2){v1[0], v1[1]}), d = gelu_pk((f32x2){v1[2], v1[3]});
                        v0 = (f32x4){a.x, a.y, b.x, b.y}; v1 = (f32x4){c.x, c.y, d.x, d.y}; }
                    v0 = v0 * sc; v1 = v1 * sc; u32x4 w; w.x = cvt_pk_bf16(v0[0], v0[1]); w.y = cvt_pk_bf16(v0[2], v0[3]); w.z = cvt_pk_bf16(v1[0], v1[1]); w.w = cvt_pk_bf16(v1[2], v1[3]);
                    *(u32x4*)(rowp + bj * HALF) = w; } }
    }
};
template <class Epi, class Sched, bool ALIGN_EPI = false, bool SP2 = false>
__device__ __forceinline__ void gemm_phase(PG8_LAS unsigned char* lds, const Gemm g, const Sched& S, const Epi& E) {
    int tid_ = threadIdx.x; asm volatile("" : "+v"(tid_));
    const int tid = tid_, wid = __builtin_amdgcn_readfirstlane(tid >> 6), lane = tid & 63, wr = wid >> 2, wc = wid & 3, fr = lane & 15, fq = lane >> 4;
    const int K = g.K, nt = K / BK;
    unsigned voffA[2], voffB[2];
#pragma unroll
    for (int i = 0; i < 2; ++i) { int R, C; stage_rc(tid * 16 + i * 8192, R, C); const int Rb = Epi::PERM ? ((R & ~31) + perm32(R & 31)) : R;
        voffA[i] = (unsigned)(R * K + C) * 2u; voffB[i] = (unsigned)(Rb * K + C) * 2u; }
    const size_t kstep = (size_t)(BK * 2);
    const size_t hstep = (size_t)HALF * K * 2;
    const size_t tstep = 2 * hstep;
    const unsigned ldsw = (unsigned)wid * 1024u;
    const int aoff = lds_byte(wr * 64 + fr, fq * 8), boff = lds_byte(wc * 32 + fr, fq * 8);
#define PG8_SA(b, h) (((b) * 2 + (h)) * HTB)
#define PG8_SB(b, h) ((4 + (b) * 2 + (h)) * HTB)
#define PG8_STAGE(bufoff, gbase, voff) do { _Pragma("unroll") for (int _i = 0; _i < 2; ++_i) \
        __builtin_amdgcn_global_load_lds((const unsigned*)((const char*)(gbase) + (voff)[_i]), (PG8_LAS unsigned*)(lds + (bufoff) + ldsw + _i * 8192), 16, 0, 0); } while (0)
#define PG8_LDA(dst, b, h) do { _Pragma("unroll") for (int m = 0; m < 4; ++m) _Pragma("unroll") for (int k = 0; k < 2; ++k) dst[m][k] = *(const PG8_LAS bf16x8*)(lds + PG8_SA(b, h) + aoff + m * 2048 + k * 1024); } while (0)
#define PG8_LDB(dst, b, h) do { _Pragma("unroll") for (int n = 0; n < 2; ++n) _Pragma("unroll") for (int k = 0; k < 2; ++k) dst[n][k] = *(const PG8_LAS bf16x8*)(lds + PG8_SB(b, h) + boff + n * 2048 + k * 1024); } while (0)
#define PG8_MMA(ai, bj, At, Bt) do { __builtin_amdgcn_s_setprio(1); _Pragma("unroll") for (int m = 0; m < 4; ++m) _Pragma("unroll") for (int n = 0; n < 2; ++n) _Pragma("unroll") for (int k = 0; k < 2; ++k) \
        acc[ai][bj][m][n] = __builtin_amdgcn_mfma_f32_16x16x32_bf16(Bt[n][k], At[m][k], acc[ai][bj][m][n], 0, 0, 0); __builtin_amdgcn_s_setprio(0); } while (0)
#define PG8_WAIT_V(n) asm volatile("s_waitcnt vmcnt(" #n ")" ::: "memory")
#define PG8_WAIT_L(n) asm volatile("s_waitcnt lgkmcnt(" #n ")" ::: "memory")
#define PG8_BAR __builtin_amdgcn_s_barrier()
#define PG8_SCHED __builtin_amdgcn_sched_barrier(0)
    Unit cur, nxt; int ui = 0;
    if (!S.next(0, cur)) return;
    f32x4 acc[2][2][4][2];
#pragma unroll
    for (int a = 0; a < 2; ++a)
#pragma unroll
        for (int b = 0; b < 2; ++b)
#pragma unroll
            for (int m = 0; m < 4; ++m)
#pragma unroll
                for (int n = 0; n < 2; ++n) acc[a][b][m][n] = (f32x4){0.f, 0.f, 0.f, 0.f};
    bf16x8 At[4][2], B0[2][2], B1[2][2];
    const char* cA = (const char*)g.A + (size_t)cur.pm * tstep; const char* cB = (const char*)g.Bt + (size_t)cur.pn * tstep;
    S.a_ready(cur);
    if constexpr (SP2) {
        PG8_STAGE(PG8_SB(0, 0), cB, voffB); PG8_STAGE(PG8_SB(0, 1), cB + hstep, voffB); PG8_STAGE(PG8_SA(0, 0), cA, voffA); PG8_STAGE(PG8_SA(0, 1), cA + hstep, voffA);
        if (wr == 1) PG8_BAR;
        PG8_WAIT_V(2); PG8_BAR;
        PG8_STAGE(PG8_SB(1, 0), cB + kstep, voffB); PG8_STAGE(PG8_SA(1, 0), cA + kstep, voffA); PG8_STAGE(PG8_SB(1, 1), cB + hstep + kstep, voffB);
        PG8_WAIT_V(6); PG8_BAR;
    } else {
        PG8_STAGE(PG8_SB(0, 0), cB, voffB); PG8_STAGE(PG8_SA(0, 0), cA, voffA); PG8_STAGE(PG8_SB(0, 1), cB + hstep, voffB); PG8_STAGE(PG8_SA(0, 1), cA + hstep, voffA);
        if (wr == 1) PG8_BAR;
        PG8_WAIT_V(4); PG8_BAR;
        PG8_STAGE(PG8_SB(1, 0), cB + kstep, voffB); PG8_STAGE(PG8_SA(1, 0), cA + kstep, voffA); PG8_STAGE(PG8_SB(1, 1), cB + hstep + kstep, voffB);
        PG8_WAIT_V(6); PG8_BAR;
    }
    for (;;) {
        const bool has_next = S.next(ui + 1, nxt);
        const char* nA = has_next ? (const char*)g.A + (size_t)nxt.pm * tstep : cA; const char* nB = has_next ? (const char*)g.Bt + (size_t)nxt.pn * tstep : cB;
        for (int t = 0; t < nt; t += 2) {
            const bool last = (t == nt - 2);
            const char* a1 = cA + (size_t)(t + 1) * kstep;
            const char* a2 = last ? nA : cA + (size_t)(t + 2) * kstep; const char* b2 = last ? nB : cB + (size_t)(t + 2) * kstep;
            const char* a3 = a2 + kstep; const char* b3 = b2 + kstep;
            if (last && has_next) S.a_ready(nxt);
            if constexpr (SP2) {
            PG8_LDB(B0, 0, 0); PG8_LDB(B1, 0, 1); PG8_SCHED; PG8_LDA(At, 0, 0); PG8_STAGE(PG8_SA(1, 1), a1 + hstep, voffA);
            PG8_WAIT_V(8); PG8_WAIT_L(0); PG8_BAR; PG8_MMA(0, 0, At, B0); PG8_MMA(0, 1, At, B1); PG8_BAR; PG8_SCHED;
            PG8_LDA(At, 0, 1); PG8_STAGE(PG8_SB(0, 0), b2, voffB); PG8_STAGE(PG8_SB(0, 1), b2 + hstep, voffB); PG8_STAGE(PG8_SA(0, 0), a2, voffA);
            PG8_WAIT_V(8); PG8_WAIT_L(0); PG8_BAR; PG8_MMA(1, 0, At, B0); PG8_MMA(1, 1, At, B1); PG8_BAR; PG8_SCHED;
            PG8_LDB(B0, 1, 0); PG8_LDB(B1, 1, 1); PG8_SCHED; PG8_LDA(At, 1, 0); PG8_STAGE(PG8_SA(0, 1), a2 + hstep, voffA);
            PG8_WAIT_V(8); PG8_WAIT_L(0); PG8_BAR; PG8_MMA(0, 0, At, B0); PG8_MMA(0, 1, At, B1); PG8_BAR; PG8_SCHED;
            PG8_LDA(At, 1, 1); PG8_STAGE(PG8_SB(1, 0), b3, voffB); PG8_STAGE(PG8_SB(1, 1), b3 + hstep, voffB); PG8_STAGE(PG8_SA(1, 0), a3, voffA);
            PG8_WAIT_V(8); PG8_WAIT_L(0); PG8_BAR; PG8_MMA(1, 0, At, B0); PG8_MMA(1, 1, At, B1); PG8_BAR; PG8_SCHED;
            } else {
            PG8_LDB(B0, 0, 0); PG8_SCHED; PG8_LDA(At, 0, 0); PG8_STAGE(PG8_SA(1, 1), a1 + hstep, voffA);
            PG8_WAIT_L(8); PG8_BAR; PG8_WAIT_L(0); PG8_MMA(0, 0, At, B0); PG8_BAR; PG8_SCHED;
            PG8_LDB(B1, 0, 1); PG8_STAGE(PG8_SB(0, 0), b2, voffB);
            PG8_BAR; PG8_WAIT_L(0); PG8_MMA(0, 1, At, B1); PG8_BAR;
            PG8_LDA(At, 0, 1); PG8_STAGE(PG8_SA(0, 0), a2, voffA);
            PG8_BAR; PG8_WAIT_L(0); PG8_MMA(1, 0, At, B0); PG8_BAR; PG8_SCHED;
            PG8_STAGE(PG8_SB(0, 1), b2 + hstep, voffB);
            PG8_WAIT_V(6); PG8_BAR; PG8_MMA(1, 1, At, B1); PG8_BAR;
            PG8_LDB(B0, 1, 0); PG8_SCHED; PG8_LDA(At, 1, 0); PG8_STAGE(PG8_SA(0, 1), a2 + hstep, voffA);
            PG8_WAIT_L(8); PG8_BAR; PG8_WAIT_L(0); PG8_MMA(0, 0, At, B0); PG8_BAR; PG8_SCHED;
            PG8_LDB(B1, 1, 1); PG8_STAGE(PG8_SB(1, 0), b3, voffB);
            PG8_BAR; PG8_WAIT_L(0); PG8_MMA(0, 1, At, B1); PG8_BAR;
            PG8_LDA(At, 1, 1); PG8_STAGE(PG8_SA(1, 0), a3, voffA);
            PG8_BAR; PG8_WAIT_L(0); PG8_MMA(1, 0, At, B0); PG8_BAR; PG8_SCHED;
            PG8_STAGE(PG8_SB(1, 1), b3 + hstep, voffB);
            PG8_WAIT_V(6); PG8_BAR; PG8_MMA(1, 1, At, B1); PG8_BAR;
            }
        }
        if constexpr (ALIGN_EPI) { if (wr == 0) PG8_BAR; }
        if constexpr (!Epi::AFTER_DRAIN) { E(acc, cur, wr, wc, fr, fq); S.done(cur); }
        if (!has_next) break;
#pragma unroll
        for (int a = 0; a < 2; ++a)
#pragma unroll
            for (int b = 0; b < 2; ++b)
#pragma unroll
                for (int m = 0; m < 4; ++m)
#pragma unroll
                    for (int n = 0; n < 2; ++n) acc[a][b][m][n] = (f32x4){0.f, 0.f, 0.f, 0.f};
        cur = nxt; cA = nA; cB = nB; ++ui;
        if constexpr (ALIGN_EPI) { if (wr == 1) PG8_BAR; }
    }
    PG8_WAIT_V(0);
    if constexpr (!ALIGN_EPI) { if (wr == 0) PG8_BAR; }
    PG8_BAR;
    if constexpr (Epi::AFTER_DRAIN) { E.fused(acc, cur, wr, wc, fr, fq, lds, wid, lane); S.done(cur); }
#undef PG8_SA
#undef PG8_SB
#undef PG8_STAGE
#undef PG8_LDA
#undef PG8_LDB
#undef PG8_MMA
#undef PG8_WAIT_V
#undef PG8_WAIT_L
#undef PG8_BAR
#undef PG8_SCHED
}
}
namespace pg8 {
struct EpiRes {
    static constexpr bool PERM = false, AFTER_DRAIN = false;
    const float* xp; const float* xs;
    float* out; const float* gate;
    __device__ __forceinline__ void operator()(const f32x4 (&acc)[2][2][4][2], const Unit& u, int wr, int wc, int fr, int fq) const {
        const int row0 = u.pm * BM + wr * 64 + fr, col0 = u.pn * BM + wc * 32 + 4 * fq;
        const int v = (u.pm * BM < 8192) ? 0 : 1 + ((u.pm * BM - 8192) >> 12);
        const float* g = gate + (size_t)v * 6144 + col0;
        f32x4 gv[2][2];
#pragma unroll
        for (int bj = 0; bj < 2; ++bj)
#pragma unroll
            for (int n = 0; n < 2; ++n) gv[bj][n] = *(const f32x4*)(g + bj * HALF + n * 16);
#pragma unroll
        for (int ai = 0; ai < 2; ++ai)
#pragma unroll
            for (int m = 0; m < 4; ++m) {
                const int row = row0 + ai * HALF + m * 16;
                const float* bp = (row < 8192 ? xp + (size_t)row * 1024 : xs + (size_t)(row - 8192) * 1024) + col0;
                float* op = out + (size_t)row * 1024 + col0;
#pragma unroll
                for (int bj = 0; bj < 2; ++bj)
#pragma unroll
                    for (int n = 0; n < 2; ++n) { const f32x4 b = *(const f32x4*)(bp + bj * HALF + n * 16); *(f32x4*)(op + bj * HALF + n * 16) = b + gv[bj][n] * acc[ai][bj][m][n]; }
            }
    }
};
}

constexpr int DM = 1024, TP = 8192, TSMP = 32768, TT = 40960, INW = 3072, FF = 2816, FF2 = 5632;
constexpr int NCHUNK = 320, HALF_T = 20480;
constexpr int OFF_LF = 41943040, OFF_LB = OFF_LF + 16384, OFF_RF = OFF_LB + 16384, OFF_RB = OFF_RF + 2097152;
constexpr size_t MiB = 1u << 20;
constexpr size_t WS_MOD = 0, WS_WL = 256 * 1024, WS_AGG = 1 * MiB, WS_CAR = 3 * MiB + 512 * 1024;
constexpr size_t WS_WIN = 5 * MiB, WS_WOUT = 11 * MiB, WS_WGU = 13 * MiB, WS_WD = 24 * MiB;
constexpr size_t WS_XN = 30 * MiB, WS_SB = 30 * MiB, WS_PROJ = 110 * MiB, WS_Y = 350 * MiB, WS_KVT = 430 * MiB;
constexpr size_t WS_GH = 110 * MiB, WS_U = 220 * MiB, WS_END = 510 * MiB;
constexpr int LDS_BYTES = 147456, LDSCTL_OFF = 143360;
constexpr size_t WS_BAR = 768 * 1024;
constexpr int NWAVES = 8;

#define GAS __attribute__((address_space(1)))
#define LAS __attribute__((address_space(3)))
typedef unsigned short bf16;
typedef unsigned v4u __attribute__((ext_vector_type(4)));
typedef unsigned v2u __attribute__((ext_vector_type(2)));
typedef float f32x4 __attribute__((ext_vector_type(4)));
typedef short bf16x8 __attribute__((ext_vector_type(8)));
#define LDS_WAIT() asm volatile("s_waitcnt lgkmcnt(0)" ::: "memory")
typedef float f32x2_t __attribute__((ext_vector_type(2)));
typedef __bf16 bf16x2_t __attribute__((ext_vector_type(2)));
__device__ __forceinline__ unsigned pk2(float lo, float hi) { const f32x2_t v = {lo, hi}; const bf16x2_t b = __builtin_convertvector(v, bf16x2_t); return __builtin_bit_cast(unsigned, b); }
__device__ __forceinline__ unsigned f2bf(float f) { return pk2(f, 0.f) & 0xffffu; }

__device__ __forceinline__ float bflo(unsigned w) { return __builtin_bit_cast(float, w << 16); }
__device__ __forceinline__ float bfhi(unsigned w) { return __builtin_bit_cast(float, w & 0xffff0000u); }
__device__ __forceinline__ float bf2f(unsigned short h) { return __builtin_bit_cast(float, ((unsigned)h) << 16); }
__device__ __forceinline__ float sigmoidf_(float x) { return 1.0f / (1.0f + __expf(-x)); }
__device__ __forceinline__ float siluf_(float x) { return x * __builtin_amdgcn_rcpf(1.0f + __builtin_amdgcn_exp2f(-1.4426950408889634f * x)); }
__device__ __forceinline__ float gelu_tanh(float x) { const float z = x * fmaf(0.044715f * x, x, 1.0f); return x * __builtin_amdgcn_rcpf(1.0f + __builtin_amdgcn_exp2f(-2.302208198f * z)); }

struct Args { const float* in[35]; float* out; unsigned char* ws; int ph_lo, ph_hi; };

#define XB_TMO      128
#define XB_XCNT(j)  (256  + 64 * (j))
#define XB_XSUB(j)  (1280 + 64 * (j))
#define XB_XGEN(j)  (2304 + 64 * (j))
#define XB_TOP      3328
#define XB_TOPGEN   3392
#define XCD_BAR_WORDS 3456
#define XB_SPIN_CAP (1u << 18)

__device__ __forceinline__ unsigned xb_ld(unsigned* p)              { return __hip_atomic_load(p, __ATOMIC_RELAXED, __HIP_MEMORY_SCOPE_AGENT); }
__device__ __forceinline__ unsigned xb_add(unsigned* p, unsigned v) { return __hip_atomic_fetch_add(p, v, __ATOMIC_RELAXED, __HIP_MEMORY_SCOPE_AGENT); }
__device__ __forceinline__ unsigned xb_xcc_id() { return (unsigned)__builtin_amdgcn_s_getreg((3 << 11) | 20) & 0xFu; }
#define XB_SPIN(cond, bar) do { unsigned _sp = 0; while (cond) { __builtin_amdgcn_s_sleep(1); \
    if ((++_sp & 255u) == 0u) { if (xb_ld(&(bar)[XB_TMO])) break; if (_sp > XB_SPIN_CAP) { atomicAdd(&(bar)[XB_TMO], 1u); break; } } } } while (0)

struct XcdBarrier {
    unsigned* bar; unsigned x;
    volatile LAS unsigned* st;
};

__device__ __forceinline__ XcdBarrier xcd_barrier_post(unsigned* bar, volatile LAS unsigned* st) {
    XcdBarrier b; b.bar = bar; b.x = xb_xcc_id(); b.st = st;
    if (threadIdx.x == 0) (void)xb_add(&bar[XB_XCNT(b.x)], 1u);
    return b;
}
__device__ __forceinline__ void xcd_barrier_complete(unsigned* bar, unsigned x, unsigned& nloc, unsigned& nx) {
    const unsigned G = gridDim.x * gridDim.y * gridDim.z;
    unsigned sum, cnt, mine, sp = 0u;
    for (;;) {
        sum = 0u; cnt = 0u; mine = 0u;
#pragma unroll
        for (unsigned j = 0; j < 16; ++j) { const unsigned c = xb_ld(&bar[XB_XCNT(j)]); sum += c; cnt += (c > 0u) ? 1u : 0u; mine = (j == x) ? c : mine; }
        if (sum == G) break;
        __builtin_amdgcn_s_sleep(1);
        if ((++sp & 255u) == 0u) { if (xb_ld(&bar[XB_TMO])) break; if (sp > XB_SPIN_CAP) { atomicAdd(&bar[XB_TMO], 1u); break; } }
    }
    nloc = mine > 0u ? mine : 1u; nx = cnt > 0u ? cnt : 1u;
}

__device__ __forceinline__ void xcd_barrier(const XcdBarrier& b) {
    asm volatile("s_waitcnt vmcnt(0)" ::: "memory");
    __syncthreads();
    if (threadIdx.x == 0) {
        unsigned* bar = b.bar;
        __builtin_amdgcn_s_waitcnt(0);
        unsigned nloc = b.st[0], nx = b.st[1];
        if (nloc == 0u) { xcd_barrier_complete(bar, b.x, nloc, nx); b.st[0] = nloc; b.st[1] = nx; }
        const unsigned old = xb_add(&bar[XB_XSUB(b.x)], 1u);
        const unsigned gen = old / nloc;
        if (old + 1u == (gen + 1u) * nloc) {
            __builtin_amdgcn_fence(__ATOMIC_RELEASE, "agent");
            asm volatile("s_waitcnt vmcnt(0)" ::: "memory");
            const unsigned og = xb_add(&bar[XB_TOP], 1u);
            const unsigned tg = og / nx;
            if (og + 1u == (tg + 1u) * nx) xb_add(&bar[XB_TOPGEN], 1u);
            else XB_SPIN(xb_ld(&bar[XB_TOPGEN]) == tg, bar);
            __builtin_amdgcn_fence(__ATOMIC_ACQUIRE, "agent");
            xb_add(&bar[XB_XGEN(b.x)], 1u);
            asm volatile("s_waitcnt vmcnt(0)" ::: "memory");
        } else {
            XB_SPIN(xb_ld(&bar[XB_XGEN(b.x)]) == gen, bar);
            __builtin_amdgcn_fence(__ATOMIC_ACQUIRE, "agent");
            asm volatile("s_waitcnt vmcnt(0)" ::: "memory");
        }
    }
    __syncthreads();
}
__device__ __forceinline__ float wave_sum(float v) {
#pragma unroll
    for (int o = 1; o < 64; o <<= 1) v += __shfl_xor(v, o);
    return v;
}
__device__ __forceinline__ void p0_transpose_item(const float* W, int K, int N, bf16* WT, int row_off, LAS float* scr, int item, int lane) {
    const int nblk = N / 32, kb = item / nblk, nb = item % nblk, k0 = 64 * kb, n0 = 32 * nb;
#pragma unroll 8
    for (int i = 0; i < 32; ++i) { const int kk = 2 * i + (lane >> 5); scr[kk * 33 + (lane & 31)] = W[(size_t)(k0 + kk) * N + n0 + (lane & 31)]; }
    LDS_WAIT(); asm volatile("" ::: "memory");
    const int c = lane & 7;
#pragma unroll
    for (int j = 0; j < 4; ++j) { const int n = (lane >> 3) + 8 * j; const LAS float* s = scr + (8 * c) * 33 + n;
        v4u o; o.x = pk2(s[0 * 33], s[1 * 33]); o.y = pk2(s[2 * 33], s[3 * 33]); o.z = pk2(s[4 * 33], s[5 * 33]); o.w = pk2(s[6 * 33], s[7 * 33]);
        *(v4u*)(WT + (size_t)(row_off + n0 + n) * K + k0 + 8 * c) = o; }
    LDS_WAIT(); asm volatile("" ::: "memory");
}
__device__ __forceinline__ int mod_index(int row) { return row < TP ? 0 : 1 + ((row - TP) >> 12); }

__device__ __forceinline__ void phase_prologue(const Args& a, LAS unsigned char* lds, int tid, int wave, int lane) {
    unsigned char* ws = a.ws;
    if (blockIdx.x < 96) {
        LAS float* sc = (LAS float*)lds;
        LAS float* red = (LAS float*)(lds + 9 * 1024 * 4);
        for (int i = tid; i < 9 * 1024; i += 512) { const int v = i >> 10, k = i & 1023; const float x = (v == 0) ? a.in[7][k] : a.in[6][(v - 1) * 1024 + k]; sc[i] = siluf_(x); }
        __syncthreads();
        const int col = blockIdx.x * 64 + lane;
        const float* wm = a.in[9] + col;
        float acc[9];
#pragma unroll
        for (int v = 0; v < 9; ++v) acc[v] = 0.f;
        const int kbeg = wave * 128;
#pragma unroll 8
        for (int kk = 0; kk < 128; ++kk) { const int k = kbeg + kk; const float wv = wm[(size_t)k * 6144];
#pragma unroll
            for (int v = 0; v < 9; ++v) acc[v] += sc[v * 1024 + k] * wv; }
#pragma unroll
        for (int v = 0; v < 9; ++v) red[(wave * 9 + v) * 64 + lane] = acc[v];
        __syncthreads();
        for (int i = tid; i < 9 * 64; i += 512) { const int v = i >> 6, l = i & 63; float s = 0.f;
#pragma unroll
            for (int w = 0; w < 8; ++w) s += red[(w * 9 + v) * 64 + l];
            const int cc = blockIdx.x * 64 + l; ((float*)(ws + WS_MOD))[v * 6144 + cc] = s + a.in[10][cc]; }
        __syncthreads();
    }
    LAS float* scr = (LAS float*)(lds + wave * 16384);
    const int gw = blockIdx.x * NWAVES + wave, NGW = gridDim.x * NWAVES;
    constexpr int I_IN = 16 * 96, I_OUT = 16 * 32, I_G = 16 * 88, I_D = 44 * 32, I_L = 64;
    constexpr int NITEMS = I_IN + I_OUT + 2 * I_G + I_D + I_L;
    for (int it = gw; it < NITEMS; it += NGW) {
        int r = it;
        if (r < I_IN) { p0_transpose_item(a.in[11], 1024, 3072, (bf16*)(ws + WS_WIN), 0, scr, r, lane); continue; } r -= I_IN;
        if (r < I_OUT) { p0_transpose_item(a.in[27], 1024, 1024, (bf16*)(ws + WS_WOUT), 0, scr, r, lane); continue; } r -= I_OUT;
        if (r < I_G) { p0_transpose_item(a.in[29], 1024, 2816, (bf16*)(ws + WS_WGU), 0, scr, r, lane); continue; } r -= I_G;
        if (r < I_G) { p0_transpose_item(a.in[30], 1024, 2816, (bf16*)(ws + WS_WGU), 2816, scr, r, lane); continue; } r -= I_G;
        if (r < I_D) { p0_transpose_item(a.in[33], 2816, 1024, (bf16*)(ws + WS_WD), 0, scr, r, lane); continue; } r -= I_D;
        { const int blk = r >> 1, sub = r & 1, mat = blk >> 3, nb = blk & 7;
          const float* src = (mat == 0 ? a.in[14] : mat == 1 ? a.in[16] : mat == 2 ? a.in[19] : a.in[21]) + nb * 4096;
          p0_transpose_item(src, 64, 64, (bf16*)(ws + WS_WL) + (size_t)(mat * 8 + nb) * 4096, 0, scr, sub, lane); }
    }
}

template <int MODE>
__device__ __forceinline__ void phase_rownorm(const float* xp, const float* xs, const float* w, const float* mod_scale, const float* mod_shift, bf16* obf, float* of32, int wave, int lane) {
    const int gw = blockIdx.x * NWAVES + wave, NGW = gridDim.x * NWAVES;
    f32x4 wv[4];
#pragma unroll
    for (int j = 0; j < 4; ++j) wv[j] = *(const f32x4*)(w + 4 * lane + 256 * j);
    for (int row0 = gw; row0 < TT; row0 += 2 * NGW) {
        const int row1 = row0 + NGW; const bool has1 = row1 < TT; const int r1 = has1 ? row1 : row0;
        const float* xr0 = (row0 < TP ? xp + (size_t)row0 * DM : xs + (size_t)(row0 - TP) * DM) + 4 * lane;
        const float* xr1 = (r1 < TP ? xp + (size_t)r1 * DM : xs + (size_t)(r1 - TP) * DM) + 4 * lane;
        f32x4 v0[4], v1[4]; float s0 = 0.f, s1 = 0.f;
#pragma unroll
        for (int j = 0; j < 4; ++j) { v0[j] = *(const f32x4*)(xr0 + 256 * j); v1[j] = *(const f32x4*)(xr1 + 256 * j); }
#pragma unroll
        for (int j = 0; j < 4; ++j) { s0 += (v0[j].x * v0[j].x + v0[j].y * v0[j].y) + (v0[j].z * v0[j].z + v0[j].w * v0[j].w); s1 += (v1[j].x * v1[j].x + v1[j].y * v1[j].y) + (v1[j].z * v1[j].z + v1[j].w * v1[j].w); }
        const float rs0 = 1.0f / sqrtf(wave_sum(s0) * (1.0f / DM) + 1e-6f), rs1 = 1.0f / sqrtf(wave_sum(s1) * (1.0f / DM) + 1e-6f);
#pragma unroll
        for (int k = 0; k < 2; ++k) {
            if (k == 1 && !has1) break;
            const int row = k ? row1 : row0; const float rstd = k ? rs1 : rs0;
            if (MODE == 0) {
                const int mv = mod_index(row);
                const float* sc = mod_scale + (size_t)mv * 6144 + 4 * lane; const float* sh = mod_shift + (size_t)mv * 6144 + 4 * lane;
                unsigned long long* o8 = (unsigned long long*)(obf + (size_t)row * DM) + lane;
#pragma unroll
                for (int j = 0; j < 4; ++j) { const f32x4 scv = *(const f32x4*)(sc + 256 * j), shv = *(const f32x4*)(sh + 256 * j);
                    const f32x4 y = (k ? v1[j] : v0[j]) * rstd * wv[j] * (scv + 1.0f) + shv;
                    o8[64 * j] = (unsigned long long)pk2(y.x, y.y) | ((unsigned long long)pk2(y.z, y.w) << 32); }
            } else {
                float* o = of32 + (size_t)row * DM + 4 * lane;
#pragma unroll
                for (int j = 0; j < 4; ++j) *(f32x4*)(o + 256 * j) = (k ? v1[j] : v0[j]) * rstd * wv[j];
            }
        }
    }
}

template <int MODE>
__device__ __forceinline__ void phase_resnorm(const float* xp, const float* xs, const bf16* tb, const float* gate, float* x1out, const float* w, const float* mod_scale, const float* mod_shift,
                                              bf16* obf, float* of32, int wave, int lane) {
    const int gw = blockIdx.x * NWAVES + wave, NGW = gridDim.x * NWAVES;
    f32x4 wv[4];
#pragma unroll
    for (int j = 0; j < 4; ++j) wv[j] = *(const f32x4*)(w + 4 * lane + 256 * j);
    for (int row0 = gw; row0 < TT; row0 += 2 * NGW) {
        const int row1 = row0 + NGW; const bool has1 = row1 < TT; const int r1 = has1 ? row1 : row0;
        const float* xr0 = (row0 < TP ? xp + (size_t)row0 * DM : xs + (size_t)(row0 - TP) * DM) + 4 * lane;
        const float* xr1 = (r1 < TP ? xp + (size_t)r1 * DM : xs + (size_t)(r1 - TP) * DM) + 4 * lane;
        const bf16* t0 = tb + (size_t)row0 * DM + 4 * lane; const bf16* t1 = tb + (size_t)r1 * DM + 4 * lane;
        f32x4 v0[4], v1[4]; v2u u0[4], u1[4];
#pragma unroll
        for (int j = 0; j < 4; ++j) { v0[j] = *(const f32x4*)(xr0 + 256 * j); v1[j] = *(const f32x4*)(xr1 + 256 * j); u0[j] = *(const v2u*)(t0 + 256 * j); u1[j] = *(const v2u*)(t1 + 256 * j); }
        const float* g0 = gate + (size_t)mod_index(row0) * 6144 + 4 * lane; const float* g1 = gate + (size_t)mod_index(r1) * 6144 + 4 * lane;
        float s0 = 0.f, s1 = 0.f;
#pragma unroll
        for (int j = 0; j < 4; ++j) { const f32x4 ga = *(const f32x4*)(g0 + 256 * j), gb = *(const f32x4*)(g1 + 256 * j);
            v0[j] = v0[j] + ga * (f32x4){bflo(u0[j][0]), bfhi(u0[j][0]), bflo(u0[j][1]), bfhi(u0[j][1])};
            v1[j] = v1[j] + gb * (f32x4){bflo(u1[j][0]), bfhi(u1[j][0]), bflo(u1[j][1]), bfhi(u1[j][1])};
            s0 += (v0[j].x * v0[j].x + v0[j].y * v0[j].y) + (v0[j].z * v0[j].z + v0[j].w * v0[j].w); s1 += (v1[j].x * v1[j].x + v1[j].y * v1[j].y) + (v1[j].z * v1[j].z + v1[j].w * v1[j].w); }
        const float rs0 = 1.0f / sqrtf(wave_sum(s0) * (1.0f / DM) + 1e-6f), rs1 = 1.0f / sqrtf(wave_sum(s1) * (1.0f / DM) + 1e-6f);
#pragma unroll
        for (int k = 0; k < 2; ++k) {
            if (k == 1 && !has1) break;
            const int row = k ? row1 : row0; const float rstd = k ? rs1 : rs0;
            if (x1out) { float* o = x1out + (size_t)row * DM + 4 * lane;
#pragma unroll
                for (int j = 0; j < 4; ++j) *(f32x4*)(o + 256 * j) = (k ? v1[j] : v0[j]); }
            if (MODE == 0) {
                const int mv = mod_index(row);
                const float* sc = mod_scale + (size_t)mv * 6144 + 4 * lane; const float* sh = mod_shift + (size_t)mv * 6144 + 4 * lane;
                unsigned long long* o8 = (unsigned long long*)(obf + (size_t)row * DM) + lane;
#pragma unroll
                for (int j = 0; j < 4; ++j) { const f32x4 scv = *(const f32x4*)(sc + 256 * j), shv = *(const f32x4*)(sh + 256 * j);
                    const f32x4 y = (k ? v1[j] : v0[j]) * rstd * wv[j] * (scv + 1.0f) + shv;
                    o8[64 * j] = (unsigned long long)pk2(y.x, y.y) | ((unsigned long long)pk2(y.z, y.w) << 32); }
            } else {
                float* o = of32 + (size_t)row * DM + 4 * lane;
#pragma unroll
                for (int j = 0; j < 4; ++j) *(f32x4*)(o + 256 * j) = (k ? v1[j] : v0[j]) * rstd * wv[j];
            }
        }
    }
}
constexpr int RS = 272;
constexpr int REG = 128 * RS;
constexpr int XCS = 1040;
#define MFMA16(a, b, c) __builtin_amdgcn_mfma_f32_16x16x32_bf16((a), (b), (c), 0, 0, 0)

__device__ __forceinline__ void mm128(f32x4 (&acc)[8], const LAS unsigned char* Aimg, const LAS unsigned char* Bimg, int wave, int c, int q) {
#pragma unroll
    for (int s = 0; s < 4; ++s) {
        const bf16x8 af = *(const LAS bf16x8*)(Aimg + (16 * wave + c) * RS + (32 * s + 8 * q) * 2);
#pragma unroll
        for (int t = 0; t < 8; ++t) { const bf16x8 bfr = *(const LAS bf16x8*)(Bimg + (16 * t + c) * RS + (32 * s + 8 * q) * 2); acc[t] = MFMA16(bfr, af, acc[t]); }
    }
}
__device__ __forceinline__ void mm128x2(f32x4 (&acc1)[8], f32x4 (&acc2)[8], const LAS unsigned char* Aimg, const LAS unsigned char* B1, const LAS unsigned char* B2, int wave, int c, int q) {
#pragma unroll
    for (int s = 0; s < 4; ++s) {
        const bf16x8 af = *(const LAS bf16x8*)(Aimg + (16 * wave + c) * RS + (32 * s + 8 * q) * 2);
#pragma unroll
        for (int t = 0; t < 8; ++t) { const bf16x8 b1 = *(const LAS bf16x8*)(B1 + (16 * t + c) * RS + (32 * s + 8 * q) * 2); acc1[t] = MFMA16(b1, af, acc1[t]);
                                      const bf16x8 b2 = *(const LAS bf16x8*)(B2 + (16 * t + c) * RS + (32 * s + 8 * q) * 2); acc2[t] = MFMA16(b2, af, acc2[t]); }
    }
}
__device__ __forceinline__ void load_rm(LAS unsigned char* img, const bf16* g, int pitch, int tid) {
#pragma unroll
    for (int i = 0; i < 4; ++i) { const int p = tid + 512 * i, row = p >> 4, cp = p & 15; const v4u v = *(const v4u*)(g + (size_t)row * pitch + cp * 8); *(LAS v4u*)(img + row * RS + cp * 16) = v; }
}
__device__ __forceinline__ void load_tiled(LAS unsigned char* img, const bf16* g, int tid) {
#pragma unroll
    for (int i = 0; i < 4; ++i) { const int p = tid + 512 * i, cp = p >> 7, row = p & 127; const v4u v = *(const v4u*)(g + (size_t)p * 8); *(LAS v4u*)(img + row * RS + cp * 16) = v; }
}
#define HW(v, e) (((e) & 1) ? ((v)[(e) >> 1] >> 16) : ((v)[(e) >> 1] & 0xffffu))
__device__ __forceinline__ void load_tr(LAS unsigned char* img, const bf16* g, int pitch, int wave, int lane) {
#pragma unroll
    for (int it = 0; it < 2; ++it) { const int dg = wave + 8 * it;
        const v4u a = *(const v4u*)(g + (size_t)(2 * lane) * pitch + dg * 8), b = *(const v4u*)(g + (size_t)(2 * lane + 1) * pitch + dg * 8);
#pragma unroll
        for (int e = 0; e < 8; ++e) { const unsigned lo = HW(a, e), hi = HW(b, e); *(LAS unsigned*)(img + (dg * 8 + e) * RS + lane * 4) = lo | (hi << 16); } }
}
__device__ __forceinline__ float log_sigmoid_(float x) { return -log1pf(__expf(-x)); }

template <int PASS>
__device__ __forceinline__ void ret_item(const Args& a, LAS unsigned char* lds, int ci, int h, int tid, int wave, int lane) {
    unsigned char* ws = a.ws;
    const int c = lane & 15, q = lane >> 4;
    const bf16* PROJ = (const bf16*)(ws + WS_PROJ);
    const size_t rowbase = (size_t)ci * 128;
    const bf16* Qg = PROJ + rowbase * INW + 1024 + h * 128;
    const bf16* Kg = PROJ + rowbase * INW + 1536 + h * 128;
    const bf16* Vg = PROJ + rowbase * INW + 2048 + h * 128;
    const float lf2 = log_sigmoid_(a.in[24][h]) * 1.4426950408889634f, lb2 = log_sigmoid_(a.in[25][h]) * 1.4426950408889634f;
    const float scale = 0.08838834764831845f;
    LAS unsigned char* R1 = lds; LAS unsigned char* R2 = lds + REG; LAS unsigned char* R3 = lds + 2 * REG; LAS unsigned char* R4 = lds + 3 * REG;
    if (PASS == 1) {
        const float j0 = (float)(2 * lane), j1 = (float)(2 * lane + 1);
        const float wf0 = scale * __builtin_amdgcn_exp2f(lf2 * (127.f - j0)), wf1 = scale * __builtin_amdgcn_exp2f(lf2 * (127.f - j1)), wb0 = scale * __builtin_amdgcn_exp2f(lb2 * j0), wb1 = scale * __builtin_amdgcn_exp2f(lb2 * j1);
        load_tr(R1, Kg, INW, wave, lane);
#pragma unroll
        for (int it = 0; it < 2; ++it) { const int dg = wave + 8 * it;
            const v4u va = *(const v4u*)(Vg + (size_t)(2 * lane) * INW + dg * 8), vb = *(const v4u*)(Vg + (size_t)(2 * lane + 1) * INW + dg * 8);
#pragma unroll
            for (int e = 0; e < 8; ++e) { const float lo = bf2f((unsigned short)HW(va, e)), hi = bf2f((unsigned short)HW(vb, e));
                *(LAS unsigned*)(R2 + (dg * 8 + e) * RS + lane * 4) = pk2(lo * wf0, hi * wf1);
                *(LAS unsigned*)(R3 + (dg * 8 + e) * RS + lane * 4) = pk2(lo * wb0, hi * wb1); } }
        __syncthreads();
        f32x4 af[8], ab[8];
#pragma unroll
        for (int t = 0; t < 8; ++t) { af[t] = (f32x4){0.f, 0.f, 0.f, 0.f}; ab[t] = (f32x4){0.f, 0.f, 0.f, 0.f}; }
        mm128(af, R2, R1, wave, c, q);
        mm128(ab, R3, R1, wave, c, q);
        bf16* KVT = (bf16*)(ws + WS_KVT) + ((size_t)(ci * 4 + h) * 2) * 16384 + ((q >> 1) * 128 + 16 * wave + c) * 8 + 4 * (q & 1);
#pragma unroll
        for (int t = 0; t < 8; ++t) { *(v2u*)(KVT + 2 * t * 1024) = (v2u){pk2(af[t][0], af[t][1]), pk2(af[t][2], af[t][3])};
                                      *(v2u*)(KVT + 16384 + 2 * t * 1024) = (v2u){pk2(ab[t][0], ab[t][1]), pk2(ab[t][2], ab[t][3])}; }
        __syncthreads();
    } else {
        const bf16* SB = (const bf16*)(ws + WS_SB) + ((size_t)(ci * 4 + h) * 2) * 16384;
        load_rm(R1, Qg, INW, tid);
        load_rm(R2, Kg, INW, tid);
        load_tr(R3, Vg, INW, wave, lane);
        load_tiled(R4, SB, tid);
        __syncthreads();
        f32x4 aS[8], aF[8];
#pragma unroll
        for (int t = 0; t < 8; ++t) { aS[t] = (f32x4){0.f, 0.f, 0.f, 0.f}; aF[t] = (f32x4){0.f, 0.f, 0.f, 0.f}; }
        mm128x2(aS, aF, R1, R2, R4, wave, c, q);
        __syncthreads();
        const int i = 16 * wave + c;
#pragma unroll
        for (int t = 0; t < 8; ++t) { float p[4];
#pragma unroll
            for (int r = 0; r < 4; ++r) { const int dl = i - (16 * t + 4 * q + r);
                const float ex = __builtin_amdgcn_exp2f(dl > 0 ? lf2 * (float)dl : lb2 * (float)(-dl));
                const float f = dl == 0 ? 2.0f : ex;
                p[r] = aS[t][r] * scale * f; }
            *(LAS v2u*)(R2 + i * RS + (16 * t + 4 * q) * 2) = (v2u){pk2(p[0], p[1]), pk2(p[2], p[3])}; }
        load_tiled(R4, SB + 16384, tid);
        __syncthreads();
        const float hf = __builtin_amdgcn_exp2f(lf2 * (float)(i + 1)), hb = __builtin_amdgcn_exp2f(lb2 * (float)(128 - i));
        f32x4 aB[8];
#pragma unroll
        for (int t = 0; t < 8; ++t) { aF[t] = aF[t] * hf; aB[t] = (f32x4){0.f, 0.f, 0.f, 0.f}; }
        mm128(aF, R2, R3, wave, c, q);
        mm128(aB, R1, R4, wave, c, q);
        f32x4 (&aO)[8] = aF;
        float s = 0.f;
#pragma unroll
        for (int t = 0; t < 8; ++t) { aO[t] = aO[t] + aB[t] * hb; s += (aO[t][0] + aO[t][1]) + (aO[t][2] + aO[t][3]); }
        s += __shfl_xor(s, 16); s += __shfl_xor(s, 32);
        const float mean = s * (1.0f / 128.0f); float v2 = 0.f;
#pragma unroll
        for (int t = 0; t < 8; ++t) { aO[t] = aO[t] - mean; v2 += (aO[t][0] * aO[t][0] + aO[t][1] * aO[t][1]) + (aO[t][2] * aO[t][2] + aO[t][3] * aO[t][3]); }
        v2 += __shfl_xor(v2, 16); v2 += __shfl_xor(v2, 32);
        const float rstd = 1.0f / sqrtf(v2 * (1.0f / 128.0f) + 1e-6f);
        const bf16* Gg = PROJ + (rowbase + i) * INW + 2560 + h * 128 + 4 * q;
        const float* gn = a.in[26] + h * 128 + 4 * q;
        bf16* Yp = (bf16*)(ws + WS_Y) + (rowbase + i) * DM + 512 + h * 128 + 4 * q;
#pragma unroll
        for (int t = 0; t < 8; ++t) { const v2u gv = *(const v2u*)(Gg + 16 * t); const f32x4 w = *(const f32x4*)(gn + 16 * t);
            const float y0 = aO[t][0] * rstd * w[0] * siluf_(bflo(gv[0])), y1 = aO[t][1] * rstd * w[1] * siluf_(bfhi(gv[0]));
            const float y2 = aO[t][2] * rstd * w[2] * siluf_(bflo(gv[1])), y3 = aO[t][3] * rstd * w[3] * siluf_(bfhi(gv[1]));
            *(v2u*)(Yp + 16 * t) = (v2u){pk2(y0, y1), pk2(y2, y3)};
            if (t & 1) asm volatile("" ::: "memory"); }
        __syncthreads();
    }
}
template <int PASS, int DIR>
__device__ __forceinline__ void lru_dir(const LAS unsigned char* xcl, const bf16x8 (&idf)[2], const bf16x8 (&wa)[2], const bf16x8 (&wx)[2], float ba, float bx, float sp8,
                                        float hc_in, float* hsp, float& Aout, float& Hout, float& edge, int c, int q, const bf16* Gp, bf16* Yp) {
    float Ac = 1.f, Hc = hc_in;
    float hn[4]; unsigned short gn[4];
    if (PASS == 3 && DIR == 1) {
#pragma unroll
        for (int r = 0; r < 4; ++r) { hn[r] = hsp[(7 * 4 + r) * 64]; gn[r] = Gp[(size_t)(16 * 7 + 4 * q + r) * INW]; }
    }
#pragma unroll 1
    for (int ti = 0; ti < 8; ++ti) {
        const int tt = DIR == 0 ? ti : 7 - ti;
        float hcur[4]; unsigned short gcur[4];
        if (PASS == 3 && DIR == 1) {
#pragma unroll
            for (int r = 0; r < 4; ++r) { hcur[r] = hn[r]; gcur[r] = gn[r]; }
            const int tn = tt > 0 ? tt - 1 : 0;
#pragma unroll
            for (int r = 0; r < 4; ++r) { hn[r] = hsp[(tn * 4 + r) * 64]; gn[r] = Gp[(size_t)(16 * tn + 4 * q + r) * INW]; }
        }
        f32x4 aI = (f32x4){0.f, 0.f, 0.f, 0.f}, aA = aI, aX = aI;
#pragma unroll
        for (int s = 0; s < 2; ++s) { const bf16x8 xf = *(const LAS bf16x8*)(xcl + (16 * tt) * XCS + 64 * s);
            aI = MFMA16(xf, idf[s], aI); aA = MFMA16(xf, wa[s], aA); aX = MFMA16(xf, wx[s], aX); }
        float av[4], uv[4];
#pragma unroll
        for (int r = 0; r < 4; ++r) {
            const float rg = __builtin_amdgcn_rcpf(1.0f + __builtin_amdgcn_exp2f(fmaf(aA[r], -1.4426950408889634f, ba)));
            const float ig = __builtin_amdgcn_rcpf(1.0f + __builtin_amdgcn_exp2f(fmaf(aX[r], -1.4426950408889634f, bx)));
            const float la = -sp8 * rg;
            const float aa = __builtin_amdgcn_exp2f(la * 1.4426950408889634f);
            const float t = -2.0f * la;
            const float ser = t * fmaf(-0.5f * t, fmaf(-0.33333334f * t, fmaf(-0.25f, t, 1.0f), 1.0f), 1.0f);
            const float om = t < 0.125f ? ser : fmaf(-aa, aa, 1.0f);
            av[r] = aa; uv[r] = __builtin_amdgcn_sqrtf(om) * (ig * aI[r]); }
        float pa[4], hl[4]; float P = 1.f, H = 0.f;
#pragma unroll
        for (int rr = 0; rr < 4; ++rr) { const int r = DIR == 0 ? rr : 3 - rr; H = av[r] * H + uv[r]; P *= av[r]; pa[r] = P; hl[r] = H; }
        float A = P, Hh = H, Ap, Hp, Ae, He, At, Ht;
        if (DIR == 0) {
            Ap = __shfl_up(A, 16); Hp = __shfl_up(Hh, 16); if (q >= 1) { Hh = A * Hp + Hh; A = Ap * A; }
            Ap = __shfl_up(A, 32); Hp = __shfl_up(Hh, 32); if (q >= 2) { Hh = A * Hp + Hh; A = Ap * A; }
            Ae = __shfl_up(A, 16); He = __shfl_up(Hh, 16); if (q == 0) { Ae = 1.f; He = 0.f; }
            At = __shfl(A, 48 + c); Ht = __shfl(Hh, 48 + c);
        } else {
            Ap = __shfl_down(A, 16); Hp = __shfl_down(Hh, 16); if (q <= 2) { Hh = A * Hp + Hh; A = Ap * A; }
            Ap = __shfl_down(A, 32); Hp = __shfl_down(Hh, 32); if (q <= 1) { Hh = A * Hp + Hh; A = Ap * A; }
            Ae = __shfl_down(A, 16); He = __shfl_down(Hh, 16); if (q == 3) { Ae = 1.f; He = 0.f; }
            At = __shfl(A, c); Ht = __shfl(Hh, c);
        }
        if (PASS == 3) {
            const float hin = Ae * Hc + He;
#pragma unroll
            for (int r = 0; r < 4; ++r) { const float hv = pa[r] * hin + hl[r];
                if (DIR == 0) hsp[(tt * 4 + r) * 64] = hv;
                else { const size_t tok = (size_t)(16 * tt + 4 * q + r); Yp[tok * DM] = (bf16)f2bf((hcur[r] + hv) * gelu_tanh(bf2f(gcur[r]))); }
                if (DIR == 0 && tt == 0 && r == 0) edge = hv;
                if (DIR == 1 && tt == 7 && r == 3) edge = hv; }
        }
        Hc = At * Hc + Ht; Ac = Ac * At;
    }
    Aout = Ac; Hout = Hc;
}

template <int PASS>
__device__ __forceinline__ void lru_item(const Args& a, LAS unsigned char* lds, int ci, int tid, int wave, int lane) {
    unsigned char* ws = a.ws;
    const int c = lane & 15, q = lane >> 4;
    const bf16* PROJ = (const bf16*)(ws + WS_PROJ);
    int seq, n, seqlen, seqtok0, nch;
    if (ci < 64) { seq = ci >> 1; n = ci & 1; seqlen = 256; seqtok0 = seq * 256; nch = 2; }
    else { seq = (ci - 64) >> 5; n = (ci - 64) & 31; seqlen = 4096; seqtok0 = TP + seq * 4096; nch = 32; }
    const bool isprompt = ci < 64;
    const int p0 = n * 128;
    {
        float w0[8], w1[8], w2[8], w3[8], bb[8];
#pragma unroll
        for (int e = 0; e < 8; ++e) { w0[e] = a.in[12][0 * 512 + 8 * lane + e]; w1[e] = a.in[12][1 * 512 + 8 * lane + e]; w2[e] = a.in[12][2 * 512 + 8 * lane + e]; w3[e] = a.in[12][3 * 512 + 8 * lane + e]; bb[e] = a.in[13][8 * lane + e]; }
        const int pb = p0 + 16 * wave;
        const bf16* base = PROJ + (size_t)seqtok0 * INW + 8 * lane;
#define LDROW(p) (((p) < 0 || (p) >= seqlen) ? (v4u){0u, 0u, 0u, 0u} : *(const v4u*)(base + (size_t)(p) * INW))
        v4u rows[19];
#pragma unroll
        for (int k = 0; k < 19; ++k) rows[k] = LDROW(pb - 2 + k);
#pragma unroll
        for (int i = 0; i < 16; ++i) {
            float o[8];
#pragma unroll
            for (int e = 0; e < 8; ++e) o[e] = fmaf(w3[e], bf2f((unsigned short)HW(rows[i + 3], e)), fmaf(w2[e], bf2f((unsigned short)HW(rows[i + 2], e)), fmaf(w1[e], bf2f((unsigned short)HW(rows[i + 1], e)), fmaf(w0[e], bf2f((unsigned short)HW(rows[i], e)), bb[e]))));
            *(LAS v4u*)(lds + (16 * wave + i) * XCS + 16 * lane) = (v4u){pk2(o[0], o[1]), pk2(o[2], o[3]), pk2(o[4], o[5]), pk2(o[6], o[7])};
        }
#undef LDROW
    }
    __syncthreads();
    const LAS unsigned char* xcl = lds + c * XCS + (64 * wave + 8 * q) * 2;
    const bf16* WL = (const bf16*)(ws + WS_WL);
    const size_t rowbase = (size_t)seqtok0 + p0;
    for (int rt = 0; rt < 4; ++rt) {
        const int dl = 16 * rt + c, d = 64 * wave + dl;
        bf16x8 idf[2];
#pragma unroll
        for (int s = 0; s < 2; ++s)
#pragma unroll
            for (int e = 0; e < 8; ++e) idf[s][e] = (32 * s + 8 * q + e == dl) ? (short)0x3F80 : (short)0;
        float* hs = a.out + (size_t)(blockIdx.x * NWAVES + wave) * 2048 + lane;
        float Af, Hf, Ab, Hb, ef = 0.f, eb = 0.f;
        float cf = 0.f, cb = 0.f;
        if (PASS == 3) { cf = ((const float*)(ws + WS_CAR))[(size_t)(ci * 2 + 0) * 512 + d]; cb = ((const float*)(ws + WS_CAR))[(size_t)(ci * 2 + 1) * 512 + d]; }
        const bf16* Gp = PROJ + rowbase * INW + 512 + d;
        bf16* Yp = (bf16*)(ws + WS_Y) + rowbase * DM + d;
        bf16x8 waf[2], wxf[2], wab[2], wxb[2];
#pragma unroll
        for (int s2 = 0; s2 < 2; ++s2) { const int o = dl * 64 + 32 * s2 + 8 * q;
            waf[s2] = *(const bf16x8*)(WL + (size_t)(0 * 8 + wave) * 4096 + o); wxf[s2] = *(const bf16x8*)(WL + (size_t)(1 * 8 + wave) * 4096 + o);
            wab[s2] = *(const bf16x8*)(WL + (size_t)(2 * 8 + wave) * 4096 + o); wxb[s2] = *(const bf16x8*)(WL + (size_t)(3 * 8 + wave) * 4096 + o); }
        const float baf = a.in[15][d], bxf = a.in[17][d], lmf = a.in[18][d], bab = a.in[20][d], bxb = a.in[22][d], lmb = a.in[23][d];
        lru_dir<PASS, 0>(xcl, idf, waf, wxf, -1.4426950408889634f * baf, -1.4426950408889634f * bxf, 8.0f * log1pf(__expf(-lmf)), cf, hs, Af, Hf, ef, c, q, Gp, Yp);
        lru_dir<PASS, 1>(xcl, idf, wab, wxb, -1.4426950408889634f * bab, -1.4426950408889634f * bxb, 8.0f * log1pf(__expf(-lmb)), cb, hs, Ab, Hb, eb, c, q, Gp, Yp);
        if (PASS == 1) {
            if (q == 0) { float* ag = (float*)(ws + WS_AGG) + (size_t)(ci * 2) * 1024 + d; ag[0] = Af; ag[512] = Hf; ag[1024] = Ab; ag[1536] = Hb; }
        } else {
            if (isprompt && n == 0 && q == 0) a.out[OFF_LF + seq * 512 + d] = ef;
            if (isprompt && n == nch - 1 && q == 3) a.out[OFF_LB + seq * 512 + d] = eb;
        }
    }
    __syncthreads();
}

__device__ __forceinline__ void phase_carries(const Args& a, int tid) {
    unsigned char* ws = a.ws;
    const int gtid = blockIdx.x * 512 + tid, GT = gridDim.x * 512;
    for (int task = gtid; task < 655360; task += GT) {
        const int dv = task & 127, dkg = (task >> 7) & 15, dir = (task >> 11) & 1, h = (task >> 12) & 3, sq = task >> 14;
        const bool isprompt = sq >= 8; const int seq = isprompt ? sq - 8 : sq, N = isprompt ? 2 : 32, cibase = isprompt ? seq * 2 : 64 + seq * 32;
        const float g = __expf(log_sigmoid_(dir ? a.in[25][h] : a.in[24][h]) * 128.0f);
        float S[8];
        if (isprompt) {
#pragma unroll
            for (int e = 0; e < 8; ++e) S[e] = 0.f;
        } else { const float* s0 = (dir ? a.in[5] : a.in[4]) + ((size_t)(seq * 4 + h) * 128 + dkg * 8) * 128 + dv;
#pragma unroll
            for (int e = 0; e < 8; ++e) S[e] = s0[e * 128]; }
        const size_t ibase = ((size_t)h * 2 + dir) * 16384 + ((size_t)dkg * 128 + dv) * 8;
        const bf16* kvp = (const bf16*)(ws + WS_KVT) + ibase; bf16* sbp = (bf16*)(ws + WS_SB) + ibase;
        for (int s0 = 0; s0 < N; s0 += 8) {
            v4u kv[8];
#pragma unroll
            for (int j = 0; j < 8; ++j) { const int step = s0 + j; const int n = dir ? N - 1 - step : step; const int ci = cibase + (step < N ? n : (dir ? 0 : N - 1));
                kv[j] = *(const v4u*)(kvp + (size_t)ci * 131072); }
#pragma unroll
            for (int j = 0; j < 8; ++j) { const int step = s0 + j;
                if (step < N) { const int n = dir ? N - 1 - step : step, ci = cibase + n;
                    *(v4u*)(sbp + (size_t)ci * 131072) = (v4u){pk2(S[0], S[1]), pk2(S[2], S[3]), pk2(S[4], S[5]), pk2(S[6], S[7])};
#pragma unroll
                    for (int e2 = 0; e2 < 8; ++e2) S[e2] = g * S[e2] + bf2f((unsigned short)HW(kv[j], e2)); } }
        }
        if (isprompt) { float* o = a.out + (dir ? OFF_RB : OFF_RF) + ((size_t)(seq * 4 + h) * 128 + dkg * 8) * 128 + dv;
#pragma unroll
            for (int e = 0; e < 8; ++e) o[e * 128] = S[e]; }
    }
    for (int task = gtid; task < 40960; task += GT) {
        const int d = task & 511, dir = (task >> 9) & 1, sq = task >> 10;
        const bool isprompt = sq >= 8; const int seq = isprompt ? sq - 8 : sq, N = isprompt ? 2 : 32, cibase = isprompt ? seq * 2 : 64 + seq * 32;
        float hcar = isprompt ? 0.f : (dir ? a.in[3] : a.in[2])[seq * 512 + d];
        for (int step = 0; step < N; ++step) {
            const int n = dir ? N - 1 - step : step, ci = cibase + n;
            ((float*)(ws + WS_CAR))[(size_t)(ci * 2 + dir) * 512 + d] = hcar;
            const float* ag = (const float*)(ws + WS_AGG) + ((size_t)(ci * 2 + dir) * 2) * 512 + d;
            hcar = ag[0] * hcar + ag[512];
        }
    }
}

__device__ __forceinline__ v4u ldg16(const bf16* p, bool ok) { return ok ? *(const v4u*)p : (v4u){0u, 0u, 0u, 0u}; }
__device__ __forceinline__ void phase_act(const Args& a, int half, int wave, int lane) {
    unsigned char* ws = a.ws;
    const bf16* __restrict__ GH = (const bf16*)(ws + WS_GH);
    bf16* __restrict__ U = (bf16*)(ws + WS_U);
    const int gw = blockIdx.x * NWAVES + wave, NGW = gridDim.x * NWAVES;
    const int p = lane >> 5;
    for (int wt = gw; wt < 7040; wt += NGW) {
        const int slab = wt % 11; int r = wt / 11;
        int tok0, ts, lat, steps0, nwalk;
        bool isimg;
        if (half == 1 || r >= 256) {
            if (half == 0) r -= 256;
            const int pair = r & 31, seg = (r >> 5) & 3, img = (r >> 7) + (half == 0 ? 0 : 3);
            const int gc = 2 * pair + p; steps0 = 16 * seg; nwalk = 64; ts = 64; lat = 1; isimg = true;
            tok0 = TP + img * 4096 + steps0 * 64 + gc;
        } else {
            const int sp = r & 7, seq = r >> 3; steps0 = 32 * sp + 16 * p; nwalk = 256; ts = 1; lat = 0; isimg = false;
            tok0 = seq * 256 + steps0;
        }
        const int ch0 = (slab * 32 + (lane & 31)) * 8;
        const int gcol = isimg ? (tok0 & 63) : 1;
        const bool okl = isimg && gcol > 0, okr = isimg && gcol < 63;
        float wk[9][8], bb[8];
#pragma unroll
        for (int k = 0; k < 9; ++k) { const int aa = k / 3, b = k % 3;
            const int src = isimg ? k : (3 + aa);
            const f32x4 x0 = *(const f32x4*)(a.in[31] + (size_t)src * FF + ch0), x1 = *(const f32x4*)(a.in[31] + (size_t)src * FF + ch0 + 4);
            const float z = (isimg || b == 1) ? 1.f : 0.f;
            wk[k][0] = x0[0] * z; wk[k][1] = x0[1] * z; wk[k][2] = x0[2] * z; wk[k][3] = x0[3] * z; wk[k][4] = x1[0] * z; wk[k][5] = x1[1] * z; wk[k][6] = x1[2] * z; wk[k][7] = x1[3] * z; }
        { const f32x4 x0 = *(const f32x4*)(a.in[32] + ch0), x1 = *(const f32x4*)(a.in[32] + ch0 + 4); bb[0] = x0[0]; bb[1] = x0[1]; bb[2] = x0[2]; bb[3] = x0[3]; bb[4] = x1[0]; bb[5] = x1[1]; bb[6] = x1[2]; bb[7] = x1[3]; }
        const bf16* gp = GH + (size_t)(tok0 - half * HALF_T) * FF + ch0;
        bf16* up = U + (size_t)tok0 * FF + ch0;
        const size_t gs = (size_t)ts * FF;
        v4u w0[3], w1[3], w2[3], w3[3];
        { const bool okp = steps0 > 0;
          w0[0] = ldg16(gp - gs - FF, okp && okl); w0[1] = ldg16(gp - gs, okp); w0[2] = ldg16(gp - gs + FF, okp && okr);
          w1[0] = ldg16(gp - FF, okl); w1[1] = *(const v4u*)gp; w1[2] = ldg16(gp + FF, okr); }
#pragma unroll 1
        for (int st = 0; st < 16; st += 2) {
            const bool ok2 = steps0 + st + 1 < nwalk, ok3 = steps0 + st + 2 < nwalk;
            const bf16* g2 = gp + (size_t)(st + 1) * gs; const bf16* g3 = g2 + gs;
            w2[0] = ldg16(g2 - FF, ok2 && okl); w2[1] = ldg16(g2, ok2); w2[2] = ldg16(g2 + FF, ok2 && okr);
            w3[0] = ldg16(g3 - FF, ok3 && okl); w3[1] = ldg16(g3, ok3); w3[2] = ldg16(g3 + FF, ok3 && okr);
            bf16* u0 = up + (size_t)st * gs; bf16* u1 = u0 + gs;
            const v4u uv0 = *(const v4u*)u0, uv1 = *(const v4u*)u1;
            float acc0[8], acc1[8];
#pragma unroll
            for (int e = 0; e < 8; ++e) { acc0[e] = bb[e]; acc1[e] = bb[e]; }
#pragma unroll
            for (int b = 0; b < 3; ++b)
#pragma unroll
                for (int e = 0; e < 8; ++e) {
                    { const float g0 = bf2f((unsigned short)HW(w0[b], e)), g1 = bf2f((unsigned short)HW(w1[b], e)), g2 = bf2f((unsigned short)HW(w2[b], e)), g3 = bf2f((unsigned short)HW(w3[b], e));
                    acc0[e] = fmaf(wk[6 + b][e], g2, fmaf(wk[3 + b][e], g1, fmaf(wk[0 + b][e], g0, acc0[e])));
                    acc1[e] = fmaf(wk[6 + b][e], g3, fmaf(wk[3 + b][e], g2, fmaf(wk[0 + b][e], g1, acc1[e]))); } }
            float o0[8], o1[8];
#pragma unroll
            for (int e = 0; e < 8; ++e) { o0[e] = gelu_tanh(acc0[e]) * bf2f((unsigned short)HW(uv0, e)); o1[e] = gelu_tanh(acc1[e]) * bf2f((unsigned short)HW(uv1, e)); }
            *(v4u*)u0 = (v4u){pk2(o0[0], o0[1]), pk2(o0[2], o0[3]), pk2(o0[4], o0[5]), pk2(o0[6], o0[7])};
            *(v4u*)u1 = (v4u){pk2(o1[0], o1[1]), pk2(o1[2], o1[3]), pk2(o1[4], o1[5]), pk2(o1[6], o1[7])};
#pragma unroll
            for (int b = 0; b < 3; ++b) { w0[b] = w2[b]; w1[b] = w3[b]; }
        }
    }
}
template <int PASS>
__device__ __forceinline__ void phase_mixer(const Args& a, LAS unsigned char* lds, int tid, int wave, int lane) {
    unsigned* ctr = (unsigned*)(a.ws + WS_BAR) + (PASS == 1 ? 3584 : 3648);
    volatile LAS int* slot = (volatile LAS int*)(lds + LDSCTL_OFF + 256);
    for (;;) {
        if (tid == 0) *slot = (int)__hip_atomic_fetch_add(ctr, 1u, __ATOMIC_RELAXED, __HIP_MEMORY_SCOPE_AGENT);
        __syncthreads();
        const int it = *slot;
        if (it >= NCHUNK + 4 * NCHUNK) break;
        asm volatile("" : "+v"(tid), "+v"(lane));
        if (it < NCHUNK) lru_item<PASS>(a, lds, it, tid, wave, lane);
        else { const int r = it - NCHUNK; ret_item<PASS>(a, lds, r >> 2, r & 3, tid, wave, lane); }
    }
}

__global__ void __launch_bounds__(512, 2) fwd(Args a) {
    extern __shared__ __attribute__((aligned(16))) unsigned char lds_raw[];
    LAS unsigned char* lds = (LAS unsigned char*)lds_raw;
    unsigned char* ws = a.ws;
    int tid = threadIdx.x, lane = tid & 63; const int wave = __builtin_amdgcn_readfirstlane(tid >> 6);
#define FRESH() do { tid = threadIdx.x; asm volatile("" : "+v"(tid)); lane = tid & 63; } while (0)
    for (int u = tid; u < (LDS_BYTES - LDSCTL_OFF) / 4; u += 512) ((LAS unsigned*)(lds + LDSCTL_OFF))[u] = 0u;
    __syncthreads();
    const XcdBarrier bar = xcd_barrier_post((unsigned*)(ws + WS_BAR), (volatile LAS unsigned*)(lds + LDSCTL_OFF + 64));
    const float* MOD = (const float*)(ws + WS_MOD);
    const int G = gridDim.x;
    const int lo = a.ph_lo, hi = a.ph_hi;
#ifndef PHMASK
#define PHMASK 0xffff
#endif
#define IN(k) ((((PHMASK) >> (k)) & 1) && lo <= (k) && (k) < hi)
#ifndef REPMASK
#define REPMASK 0u
#endif
#define NREP(k) ((((REPMASK) >> (k)) & 1u) ? 2 : 1)
#define SEAM(k) do { if (IN(k) && IN((k) + 1)) xcd_barrier(bar); } while (0)
    FRESH();
    for (int rep = 0; rep < NREP(0); ++rep) if (IN(0)) phase_prologue(a, lds, tid, wave, lane);
    if (IN(0) && IN(1)) { cg::grid_group grid = cg::this_grid(); grid.sync(); }
    FRESH();
    for (int rep = 0; rep < NREP(1); ++rep) if (IN(1)) phase_rownorm<0>(a.in[0], a.in[1], a.in[8], MOD + 1024, MOD + 0, (bf16*)(ws + WS_XN), nullptr, wave, lane);
    SEAM(1);
    FRESH();
    for (int rep = 0; rep < NREP(2); ++rep) if (IN(2)) { pg8::Gemm g{(const bf16*)(ws + WS_XN), (const bf16*)(ws + WS_WIN), TT, INW, DM}; pg8::StaticOrder S; S.init(TT, INW, G, (int)blockIdx.x);
        pg8::EpiBf16<0> E{(bf16*)(ws + WS_PROJ), INW, nullptr, 0, 0, 1.f};
        pg8::gemm_phase<pg8::EpiBf16<0>, pg8::StaticOrder, true, true>(lds, g, S, E); }
    SEAM(2);
    FRESH();
    for (int rep = 0; rep < NREP(3); ++rep) if (IN(3)) phase_mixer<1>(a, lds, tid, wave, lane);
    SEAM(3);
    FRESH();
    for (int rep = 0; rep < NREP(4); ++rep) if (IN(4)) phase_carries(a, tid);
    SEAM(4);
    FRESH();
    for (int rep = 0; rep < NREP(5); ++rep) if (IN(5)) phase_mixer<3>(a, lds, tid, wave, lane);
    SEAM(5);
    FRESH();
    for (int rep = 0; rep < NREP(6); ++rep) if (IN(6)) { pg8::Gemm g{(const bf16*)(ws + WS_Y), (const bf16*)(ws + WS_WOUT), TT, DM, DM}; pg8::StaticOrder S; S.init(TT, DM, G, (int)blockIdx.x);
        pg8::EpiBf16<0> E{(bf16*)(ws + WS_KVT), DM, nullptr, 0, 0, 1.f};
        pg8::gemm_phase<pg8::EpiBf16<0>, pg8::StaticOrder, true, true>(lds, g, S, E); }
    SEAM(6);
    FRESH();
    for (int rep = 0; rep < NREP(7); ++rep) if (IN(7)) phase_resnorm<0>(a.in[0], a.in[1], (const bf16*)(ws + WS_KVT), MOD + 2048, a.out, a.in[28], MOD + 4096, MOD + 3072, (bf16*)(ws + WS_XN), nullptr, wave, lane);
    SEAM(7);
#pragma unroll
    for (int half = 0; half < 2; ++half) {
        FRESH();
        if (IN(8 + 2 * half)) { pg8::Gemm g{(const bf16*)(ws + WS_XN) + (size_t)half * HALF_T * DM, (const bf16*)(ws + WS_WGU), HALF_T, FF2, DM}; pg8::StaticOrder S; S.init(HALF_T, FF2, G, (int)blockIdx.x);
            pg8::EpiBf16<0> E{(bf16*)(ws + WS_GH), FF, nullptr, FF, (size_t)((WS_U - WS_GH) / 2) + (size_t)half * HALF_T * FF, 1.f};
            pg8::gemm_phase<pg8::EpiBf16<0>, pg8::StaticOrder, true, true>(lds, g, S, E); }
        SEAM(8 + 2 * half);
        FRESH();
        if (IN(9 + 2 * half)) phase_act(a, half, wave, lane);
        SEAM(9 + 2 * half);
    }
    FRESH();
    for (int rep = 0; rep < NREP(12); ++rep) if (IN(12)) { pg8::Gemm g{(const bf16*)(ws + WS_U), (const bf16*)(ws + WS_WD), TT, DM, FF}; pg8::StaticOrder S; S.init(TT, DM, G, (int)blockIdx.x);
        pg8::EpiBf16<0> E{(bf16*)(ws + WS_XN), DM, nullptr, 0, 0, 1.f};
        pg8::gemm_phase<pg8::EpiBf16<0>, pg8::StaticOrder, true, true>(lds, g, S, E); }
    SEAM(12);
    FRESH();
    if (IN(13)) phase_resnorm<1>(a.out, a.out + (size_t)TP * DM, (const bf16*)(ws + WS_XN), MOD + 5120, nullptr, a.in[34], nullptr, nullptr, nullptr, a.out, wave, lane);
#undef IN
#undef SEAM
}

extern "C" void kernel_launch(void* const* d_in, const int* in_sizes, int n_in, void* d_out, int out_size,
                              void* d_ws, size_t ws_size, hipStream_t stream) {
    static int grid = 0;
    if (grid == 0) {
        int dev = 0, cus = 0, per_cu = 0;
        hipGetDevice(&dev);
        hipDeviceGetAttribute(&cus, hipDeviceAttributeMultiprocessorCount, dev);
        hipFuncSetAttribute((const void*)fwd, hipFuncAttributeMaxDynamicSharedMemorySize, LDS_BYTES);
        hipOccupancyMaxActiveBlocksPerMultiprocessor(&per_cu, (const void*)fwd, 512, LDS_BYTES);
        if (per_cu < 1) per_cu = 1;
        grid = cus * per_cu;
        if (n_in != 35 || ws_size < WS_END) fprintf(stderr, "kernel_launch: unexpected n_in %d / ws_size %zu\n", n_in, ws_size);
    }
    if (hipMemsetAsync((char*)d_ws + WS_BAR, 0, 16384, stream) != hipSuccess) fprintf(stderr, "kernel_launch: memset failed\n");
    Args a{};
    for (int i = 0; i < 35; ++i) a.in[i] = (const float*)d_in[i];
    a.out = (float*)d_out; a.ws = (unsigned char*)d_ws; a.ph_lo = 0; a.ph_hi = 14;
    void* args[] = {&a};
    hipError_t e = hipLaunchCooperativeKernel((const void*)fwd, dim3(grid), dim3(512), args, LDS_BYTES, stream);
    if (e != hipSuccess) fprintf(stderr, "cooperative launch failed: %s (grid %d)\n", hipGetErrorString(e), grid);
}
```

```cpp
#include <hip/hip_runtime.h>
#include <hip/hip_cooperative_groups.h>
#include <cstdio>
#include <cstdint>
namespace cg = cooperative_groups;
namespace pg8 {
#define PG8_LAS __attribute__((address_space(3)))
typedef unsigned short bf16_t;
typedef short bf16x8 __attribute__((ext_vector_type(8)));
typedef float f32x4 __attribute__((ext_vector_type(4)));
typedef unsigned u32x4 __attribute__((ext_vector_type(4)));
constexpr int BM = 256, BK = 64, HALF = 128, HTB = HALF * BK * 2  , STAGE_BYTES = 8 * HTB, NXCD = 8, WGM = 8;

__host__ __device__ __forceinline__ int lds_byte(int r, int c) { const int st = (r >> 4) * 2 + (c >> 5), rr = r & 15, cc = c & 31, ob = rr * 64 + cc * 2; return st * 1024 + (ob ^ (((ob >> 9) & 1) << 5)); }
__host__ __device__ __forceinline__ void stage_rc(int b, int& R, int& C) { const int st = b / 1024, sb = b % 1024, swz = sb ^ (((sb >> 9) & 1) << 5); R = (st >> 1) * 16 + swz / 64; C = (st & 1) * 32 + (swz % 64) / 2; }
__host__ __device__ __forceinline__ int perm32(int rho) { const int n = rho >> 4, i = rho & 15; return 8 * (i >> 2) + 4 * n + (i & 3); }

struct Unit { int pm, pn; };
struct Gemm { const bf16_t* A; const bf16_t* Bt; int M, N, K; };

struct StaticOrder {
    int nM, nN, nwg, G, c;
    __host__ __device__ void init(int M, int N, int G_, int c_) { nM = M / BM; nN = N / BM; nwg = nM * nN; G = G_; c = c_; }
    __host__ __device__ bool next(int i, Unit& u) const {
        const long L = (long)i * G + c; if (L >= nwg) return false;
        int wgid = (int)L; { const int q = nwg / NXCD, r = nwg % NXCD, xcd = wgid % NXCD, off = wgid / NXCD; wgid = (xcd < r ? xcd * (q + 1) : r * (q + 1) + (xcd - r) * q) + off; }
        const int nig = WGM * nN, gid = wgid / nig, fm = gid * WGM, gsz = (nM - fm) < WGM ? (nM - fm) : WGM;
        u.pm = fm + ((wgid % nig) % gsz); u.pn = (wgid % nig) / gsz; return true;
    }
    __device__ __forceinline__ void a_ready(const Unit&) const {}
    __device__ __forceinline__ void done(const Unit&) const {}
};

__device__ __forceinline__ unsigned cvt_pk_bf16(float lo, float hi) { unsigned r; asm volatile("v_cvt_pk_bf16_f32 %0, %1, %2" : "=v"(r) : "v"(lo), "v"(hi)); return r; }
typedef float f32x2 __attribute__((ext_vector_type(2)));
__device__ __forceinline__ f32x2 gelu_pk(f32x2 v) {
    const f32x2 av = __builtin_elementwise_abs(v), d = av * 0.2316418882f + 1.0f;
    f32x2 t; t.x = __builtin_amdgcn_rcpf(d.x); t.y = __builtin_amdgcn_rcpf(d.y);
    f32x2 q = t * 0.5307027145f + (-0.7265760135f); q = q * t + 0.7107068705f; q = q * t + (-0.142248368f); q = q * t + 0.127414796f; q = q * t;
    const f32x2 s = (v * v) * (-0.72134752044f);
    f32x2 e; e.x = __builtin_amdgcn_exp2f(s.x); e.y = __builtin_amdgcn_exp2f(s.y);
    const f32x2 m = v * (q * e), r = v - m;
    f32x2 o; o.x = v.x < 0.f ? m.x : r.x; o.y = v.y < 0.f ? m.y : r.y; return o;
}

template <int ACT  > struct EpiBf16 {
    static constexpr bool PERM = true, AFTER_DRAIN = false; static_assert(ACT == 0 || ACT == 1, "EpiBf16: ACT is 0 (none) or 1 (gelu_pk)");
    bf16_t* O; int ldc; const float* bias; int split_cols; size_t split_stride; float scale0;
    __device__ __forceinline__ void operator()(const f32x4 (&acc)[2][2][4][2], const Unit& u, int wr, int wc, int fr, int fq) const {
        const int row0 = u.pm * BM + wr * 64 + fr; int colt = u.pn * BM; bf16_t* base = O;
        float sc = 1.f; if (split_cols) { const int t = colt / split_cols; base += (size_t)t * split_stride; colt -= t * split_cols; if (t == 0) sc = scale0; }
        const int col0 = colt + wc * 32 + 8 * fq, bcol0 = u.pn * BM + wc * 32 + 8 * fq;
        f32x4 bv[2][2];
#pragma unroll
        for (int bj = 0; bj < 2; ++bj)
#pragma unroll
            for (int n = 0; n < 2; ++n) bv[bj][n] = bias ? *(const f32x4*)(bias + bcol0 + bj * HALF + 4 * n) : (f32x4){0.f, 0.f, 0.f, 0.f};
#pragma unroll
        for (int ai = 0; ai < 2; ++ai)
#pragma unroll
            for (int m = 0; m < 4; ++m) { bf16_t* rowp = base + (size_t)(row0 + ai * HALF + m * 16) * ldc + col0;
#pragma unroll
                for (int bj = 0; bj < 2; ++bj) { f32x4 v0 = acc[ai][bj][m][0] + bv[bj][0], v1 = acc[ai][bj][m][1] + bv[bj][1];
                    if (ACT == 1) { f32x2 a = gelu_pk((f32x2){v0[0], v0[1]}), b = gelu_pk((f32x2){v0[2], v0[3]}), c = gelu_pk((f32x2){v1[0], v1[1]}), d = gelu_pk((f32x2){v1[2], v1[3]});
                        v0 = (f32x4){a.x, a.y, b.x, b.y}; v1 = (f32x4){c.x, c.y, d.x, d.y}; }
                    v0 = v0 * sc; v1 = v1 * sc; u32x4 w; w.x = cvt_pk_bf16(v0[0], v0[1]); w.y = cvt_pk_bf16(v0[2], v0[3]); w.z = cvt_pk_bf16(v1[0], v1[1]); w.w = cvt_pk_bf16(v1[2], v1[3]);
                    *(u32x4*)(rowp + bj * HALF) = w; } }
    }
};
template <class Epi, class Sched, bool ALIGN_EPI = false, bool SP2 = false>
__device__ __forceinline__ void gemm_phase(PG8_LAS unsigned char* lds, const Gemm g, const Sched& S, const Epi& E) {
    int tid_ = threadIdx.x; asm volatile("" : "+v"(tid_));
    const int tid = tid_, wid = __builtin_amdgcn_readfirstlane(tid >> 6), lane = tid & 63, wr = wid >> 2, wc = wid & 3, fr = lane & 15, fq = lane >> 4;
    const int K = g.K, nt = K / BK;
    unsigned voffA[2], voffB[2];
#pragma unroll
    for (int i = 0; i < 2; ++i) { int R, C; stage_rc(tid * 16 + i * 8192, R, C); const int Rb = Epi::PERM ? ((R & ~31) + perm32(R & 31)) : R;
        voffA[i] = (unsigned)(R * K + C) * 2u; voffB[i] = (unsigned)(Rb * K + C) * 2u; }
    const size_t kstep = (size_t)(BK * 2);
    const size_t hstep = (size_t)HALF * K * 2;
    const size_t tstep = 2 * hstep;
    const unsigned ldsw = (unsigned)wid * 1024u;
    const int aoff = lds_byte(wr * 64 + fr, fq * 8), boff = lds_byte(wc * 32 + fr, fq * 8);
#define PG8_SA(b, h) (((b) * 2 + (h)) * HTB)
#define PG8_SB(b, h) ((4 + (b) * 2 + (h)) * HTB)
#define PG8_STAGE(bufoff, gbase, voff) do { _Pragma("unroll") for (int _i = 0; _i < 2; ++_i) \
        __builtin_amdgcn_global_load_lds((const unsigned*)((const char*)(gbase) + (voff)[_i]), (PG8_LAS unsigned*)(lds + (bufoff) + ldsw + _i * 8192), 16, 0, 0); } while (0)
#define PG8_LDA(dst, b, h) do { _Pragma("unroll") for (int m = 0; m < 4; ++m) _Pragma("unroll") for (int k = 0; k < 2; ++k) dst[m][k] = *(const PG8_LAS bf16x8*)(lds + PG8_SA(b, h) + aoff + m * 2048 + k * 1024); } while (0)
#define PG8_LDB(dst, b, h) do { _Pragma("unroll") for (int n = 0; n < 2; ++n) _Pragma("unroll") for (int k = 0; k < 2; ++k) dst[n][k] = *(const PG8_LAS bf16x8*)(lds + PG8_SB(b, h) + boff + n * 2048 + k * 1024); } while (0)
#define PG8_MMA(ai, bj, At, Bt) do { __builtin_amdgcn_s_setprio(1); _Pragma("unroll") for (int m = 0; m < 4; ++m) _Pragma("unroll") for (int n = 0; n < 2; ++n) _Pragma("unroll") for (int k = 0; k < 2; ++k) \
        acc[ai][bj][m][n] = __builtin_amdgcn_mfma_f32_16x16x32_bf16(Bt[n][k], At[m][k], acc[ai][bj][m][n], 0, 0, 0); __builtin_amdgcn_s_setprio(0); } while (0)
#define PG8_WAIT_V(n) asm volatile("s_waitcnt vmcnt(" #n ")" ::: "memory")
#define PG8_WAIT_L(n) asm volatile("s_waitcnt lgkmcnt(" #n ")" ::: "memory")
#define PG8_BAR __builtin_amdgcn_s_barrier()
#define PG8_SCHED __builtin_amdgcn_sched_barrier(0)
    Unit cur, nxt; int ui = 0;
    if (!S.next(0, cur)) return;
    f32x4 acc[2][2][4][2];
#pragma unroll
    for (int a = 0; a < 2; ++a)
#pragma unroll
        for (int b = 0; b < 2; ++b)
#pragma unroll
            for (int m = 0; m < 4; ++m)
#pragma unroll
                for (int n = 0; n < 2; ++n) acc[a][b][m][n] = (f32x4){0.f, 0.f, 0.f, 0.f};
    bf16x8 At[4][2], B0[2][2], B1[2][2];
    const char* cA = (const char*)g.A + (size_t)cur.pm * tstep; const char* cB = (const char*)g.Bt + (size_t)cur.pn * tstep;
    S.a_ready(cur);
    if constexpr (SP2) {
        PG8_STAGE(PG8_SB(0, 0), cB, voffB); PG8_STAGE(PG8_SB(0, 1), cB + hstep, voffB); PG8_STAGE(PG8_SA(0, 0), cA, voffA); PG8_STAGE(PG8_SA(0, 1), cA + hstep, voffA);
        if (wr == 1) PG8_BAR;
        PG8_WAIT_V(2); PG8_BAR;
        PG8_STAGE(PG8_SB(1, 0), cB + kstep, voffB); PG8_STAGE(PG8_SA(1, 0), cA + kstep, voffA); PG8_STAGE(PG8_SB(1, 1), cB + hstep + kstep, voffB);
        PG8_WAIT_V(6); PG8_BAR;
    } else {
        PG8_STAGE(PG8_SB(0, 0), cB, voffB); PG8_STAGE(PG8_SA(0, 0), cA, voffA); PG8_STAGE(PG8_SB(0, 1), cB + hstep, voffB); PG8_STAGE(PG8_SA(0, 1), cA + hstep, voffA);
        if (wr == 1) PG8_BAR;
        PG8_WAIT_V(4); PG8_BAR;
        PG8_STAGE(PG8_SB(1, 0), cB + kstep, voffB); PG8_STAGE(PG8_SA(1, 0), cA + kstep, voffA); PG8_STAGE(PG8_SB(1, 1), cB + hstep + kstep, voffB);
        PG8_WAIT_V(6); PG8_BAR;
    }
    for (;;) {
        const bool has_next = S.next(ui + 1, nxt);
        const char* nA = has_next ? (const char*)g.A + (size_t)nxt.pm * tstep : cA; const char* nB = has_next ? (const char*)g.Bt + (size_t)nxt.pn * tstep : cB;
        for (int t = 0; t < nt; t += 2) {
            const bool last = (t == nt - 2);
            const char* a1 = cA + (size_t)(t + 1) * kstep;
            const char* a2 = last ? nA : cA + (size_t)(t + 2) * kstep; const char* b2 = last ? nB : cB + (size_t)(t + 2) * kstep;
            const char* a3 = a2 + kstep; const char* b3 = b2 + kstep;
            if (last && has_next) S.a_ready(nxt);
            if constexpr (SP2) {
            PG8_LDB(B0, 0, 0); PG8_LDB(B1, 0, 1); PG8_SCHED; PG8_LDA(At, 0, 0); PG8_STAGE(PG8_SA(1, 1), a1 + hstep, voffA);
            PG8_WAIT_V(8); PG8_WAIT_L(0); PG8_BAR; PG8_MMA(0, 0, At, B0); PG8_MMA(0, 1, At, B1); PG8_BAR; PG8_SCHED;
            PG8_LDA(At, 0, 1); PG8_STAGE(PG8_SB(0, 0), b2, voffB); PG8_STAGE(PG8_SB(0, 1), b2 + hstep, voffB); PG8_STAGE(PG8_SA(0, 0), a2, voffA);
            PG8_WAIT_V(8); PG8_WAIT_L(0); PG8_BAR; PG8_MMA(1, 0, At, B0); PG8_MMA(1, 1, At, B1); PG8_BAR; PG8_SCHED;
            PG8_LDB(B0, 1, 0); PG8_LDB(B1, 1, 1); PG8_SCHED; PG8_LDA(At, 1, 0); PG8_STAGE(PG8_SA(0, 1), a2 + hstep, voffA);
            PG8_WAIT_V(8); PG8_WAIT_L(0); PG8_BAR; PG8_MMA(0, 0, At, B0); PG8_MMA(0, 1, At, B1); PG8_BAR; PG8_SCHED;
            PG8_LDA(At, 1, 1); PG8_STAGE(PG8_SB(1, 0), b3, voffB); PG8_STAGE(PG8_SB(1, 1), b3 + hstep, voffB); PG8_STAGE(PG8_SA(1, 0), a3, voffA);
            PG8_WAIT_V(8); PG8_WAIT_L(0); PG8_BAR; PG8_MMA(1, 0, At, B0); PG8_MMA(1, 1, At, B1); PG8_BAR; PG8_SCHED;
            } else {
            PG8_LDB(B0, 0, 0); PG8_SCHED; PG8_LDA(At, 0, 0); PG8_STAGE(PG8_SA(1, 1), a1 + hstep, voffA);
            PG8_WAIT_L(8); PG8_BAR; PG8_WAIT_L(0); PG8_MMA(0, 0, At, B0); PG8_BAR; PG8_SCHED;
            PG8_LDB(B1, 0, 1); PG8_STAGE(PG8_SB(0, 0), b2, voffB);
            PG8_BAR; PG8_WAIT_L(0); PG8_MMA(0, 1, At, B1); PG8_BAR;
            PG8_LDA(At, 0, 1); PG8_STAGE(PG8_SA(0, 0), a2, voffA);
            PG8_BAR; PG8_WAIT_L(0); PG8_MMA(1, 0, At, B0); PG8_BAR; PG8_SCHED;
            PG8_STAGE(PG8_SB(0, 1), b2 + hstep, voffB);
            PG8_WAIT_V(6); PG8_BAR; PG8_MMA(1, 1, At, B1); PG8_BAR;
            PG8_LDB(B0, 1, 0); PG8_SCHED; PG8_LDA(At, 1, 0); PG8_STAGE(PG8_SA(0, 1), a2 + hstep, voffA);
            PG8_WAIT_L(8); PG8_BAR; PG8_WAIT_L(0); PG8_MMA(0, 0, At, B0); PG8_BAR; PG8_SCHED;
            PG8_LDB(B1, 1, 1); PG8_STAGE(PG8_SB(1, 0), b3, voffB);
            PG8_BAR; PG8_WAIT_L(0); PG8_MMA(0, 1, At, B1); PG8_BAR;
            PG8_LDA(At, 1, 1); PG8_STAGE(PG8_SA(1, 0), a3, voffA);
            PG8_BAR; PG8_WAIT_L(0); PG8_MMA(1, 0, At, B0); PG8_BAR; PG8_SCHED;
            PG8_STAGE(PG8_SB(1, 1), b3 + hstep, voffB);
            PG8_WAIT_V(6); PG8_BAR; PG8_MMA(1, 1, At, B1); PG8_BAR;
            }
        }
        if constexpr (ALIGN_EPI) { if (wr == 0) PG8_BAR; }
        if constexpr (!Epi::AFTER_DRAIN) { E(acc, cur, wr, wc, fr, fq); S.done(cur); }
        if (!has_next) break;
#pragma unroll
        for (int a = 0; a < 2; ++a)
#pragma unroll
            for (int b = 0; b < 2; ++b)
#pragma unroll
                for (int m = 0; m < 4; ++m)
#pragma unroll
                    for (int n = 0; n < 2; ++n) acc[a][b][m][n] = (f32x4){0.f, 0.f, 0.f, 0.f};
        cur = nxt; cA = nA; cB = nB; ++ui;
        if constexpr (ALIGN_EPI) { if (wr == 1) PG8_BAR; }
    }
    PG8_WAIT_V(0);
    if constexpr (!ALIGN_EPI) { if (wr == 0) PG8_BAR; }
    PG8_BAR;
    if constexpr (Epi::AFTER_DRAIN) { E.fused(acc, cur, wr, wc, fr, fq, lds, wid, lane); S.done(cur); }
#undef PG8_SA
#undef PG8_SB
#undef PG8_STAGE
#undef PG8_LDA
#undef PG8_LDB
#undef PG8_MMA
#undef PG8_WAIT_V
#undef PG8_WAIT_L
#undef PG8_BAR
#undef PG8_SCHED
}
}
namespace pg8 {
struct EpiRes {
    static constexpr bool PERM = false, AFTER_DRAIN = false;
    const float* xp; const float* xs;
    float* out; const float* gate;
    __device__ __forceinline__ void operator()(const f32x4 (&acc)[2][2][4][2], const Unit& u, int wr, int wc, int fr, int fq) const {
        const int row0 = u.pm * BM + wr * 64 + fr, col0 = u.pn * BM + wc * 32 + 4 * fq;
        const int v = (u.pm * BM < 8192) ? 0 : 1 + ((u.pm * BM - 8192) >> 12);
        const float* g = gate + (size_t)v * 6144 + col0;
        f32x4 gv[2][2];
#pragma unroll
        for (int bj = 0; bj < 2; ++bj)
#pragma unroll
            for (int n = 0; n < 2; ++n) gv[bj][n] = *(const f32x4*)(g + bj * HALF + n * 16);
#pragma unroll
        for (int ai = 0; ai < 2; ++ai)
#pragma unroll
            for (int m = 0; m < 4; ++m) {
                const int row = row0 + ai * HALF + m * 16;
                const float* bp = (row < 8192 ? xp + (size_t)row * 1024 : xs + (size_t)(row - 8192) * 1024) + col0;
                float* op = out + (size_t)row * 1024 + col0;
#pragma unroll
                for (int bj = 0; bj < 2; ++bj)
#pragma unroll
                    for (int n = 0; n < 2; ++n) { const f32x4 b = *(const f32x4*)(bp + bj * HALF + n * 16); *(f32x4*)(op + bj * HALF + n * 16) = b + gv[bj][n] * acc[ai][bj][m][n]; }
            }
    }
};
}

constexpr int DM = 1024, TP = 8192, TSMP = 32768, TT = 40960, INW = 3072, FF = 2816, FF2 = 5632;
constexpr int NCHUNK = 320, HALF_T = 20480;
constexpr int OFF_LF = 41943040, OFF_LB = OFF_LF + 16384, OFF_RF = OFF_LB + 16384, OFF_RB = OFF_RF + 2097152;
constexpr size_t MiB = 1u << 20;
constexpr size_t WS_MOD = 0, WS_WL = 256 * 1024, WS_AGG = 1 * MiB, WS_CAR = 3 * MiB + 512 * 1024;
constexpr size_t WS_WIN = 5 * MiB, WS_WOUT = 11 * MiB, WS_WGU = 13 * MiB, WS_WD = 24 * MiB;
constexpr size_t WS_XN = 30 * MiB, WS_SB = 30 * MiB, WS_PROJ = 110 * MiB, WS_Y = 350 * MiB, WS_KVT = 430 * MiB;
constexpr size_t WS_GH = 110 * MiB, WS_U = 220 * MiB, WS_END = 510 * MiB;
constexpr int LDS_BYTES = 147456, LDSCTL_OFF = 143360;
constexpr size_t WS_BAR = 768 * 1024;
constexpr int NWAVES = 8;

#define GAS __attribute__((address_space(1)))
#define LAS __attribute__((address_space(3)))
typedef unsigned short bf16;
typedef unsigned v4u __attribute__((ext_vector_type(4)));
typedef unsigned v2u __attribute__((ext_vector_type(2)));
typedef float f32x4 __attribute__((ext_vector_type(4)));
typedef short bf16x8 __attribute__((ext_vector_type(8)));
#define LDS_WAIT() asm volatile("s_waitcnt lgkmcnt(0)" ::: "memory")
typedef float f32x2_t __attribute__((ext_vector_type(2)));
typedef __bf16 bf16x2_t __attribute__((ext_vector_type(2)));
__device__ __forceinline__ unsigned pk2(float lo, float hi) { const f32x2_t v = {lo, hi}; const bf16x2_t b = __builtin_convertvector(v, bf16x2_t); return __builtin_bit_cast(unsigned, b); }
__device__ __forceinline__ unsigned f2bf(float f) { return pk2(f, 0.f) & 0xffffu; }

__device__ __forceinline__ float bflo(unsigned w) { return __builtin_bit_cast(float, w << 16); }
__device__ __forceinline__ float bfhi(unsigned w) { return __builtin_bit_cast(float, w & 0xffff0000u); }
__device__ __forceinline__ float bf2f(unsigned short h) { return __builtin_bit_cast(float, ((unsigned)h) << 16); }
__device__ __forceinline__ float sigmoidf_(float x) { return 1.0f / (1.0f + __expf(-x)); }
__device__ __forceinline__ float siluf_(float x) { return x * __builtin_amdgcn_rcpf(1.0f + __builtin_amdgcn_exp2f(-1.4426950408889634f * x)); }
__device__ __forceinline__ float gelu_tanh(float x) { const float z = x * fmaf(0.044715f * x, x, 1.0f); return x * __builtin_amdgcn_rcpf(1.0f + __builtin_amdgcn_exp2f(-2.302208198f * z)); }

struct Args { const float* in[35]; float* out; unsigned char* ws; int ph_lo, ph_hi; };

#define XB_TMO      128
#define XB_XCNT(j)  (256  + 64 * (j))
#define XB_XSUB(j)  (1280 + 64 * (j))
#define XB_XGEN(j)  (2304 + 64 * (j))
#define XB_TOP      3328
#define XB_TOPGEN   3392
#define XCD_BAR_WORDS 3456
#define XB_SPIN_CAP (1u << 18)

__device__ __forceinline__ unsigned xb_ld(unsigned* p)              { return __hip_atomic_load(p, __ATOMIC_RELAXED, __HIP_MEMORY_SCOPE_AGENT); }
__device__ __forceinline__ unsigned xb_add(unsigned* p, unsigned v) { return __hip_atomic_fetch_add(p, v, __ATOMIC_RELAXED, __HIP_MEMORY_SCOPE_AGENT); }
__device__ __forceinline__ unsigned xb_xcc_id() { return (unsigned)__builtin_amdgcn_s_getreg((3 << 11) | 20) & 0xFu; }
#define XB_SPIN(cond, bar) do { unsigned _sp = 0; while (cond) { __builtin_amdgcn_s_sleep(1); \
    if ((++_sp & 255u) == 0u) { if (xb_ld(&(bar)[XB_TMO])) break; if (_sp > XB_SPIN_CAP) { atomicAdd(&(bar)[XB_TMO], 1u); break; } } } } while (0)

struct XcdBarrier {
    unsigned* bar; unsigned x;
    volatile LAS unsigned* st;
};

__device__ __forceinline__ XcdBarrier xcd_barrier_post(unsigned* bar, volatile LAS unsigned* st) {
    XcdBarrier b; b.bar = bar; b.x = xb_xcc_id(); b.st = st;
    if (threadIdx.x == 0) (void)xb_add(&bar[XB_XCNT(b.x)], 1u);
    return b;
}
__device__ __forceinline__ void xcd_barrier_complete(unsigned* bar, unsigned x, unsigned& nloc, unsigned& nx) {
    const unsigned G = gridDim.x * gridDim.y * gridDim.z;
    unsigned sum, cnt, mine, sp = 0u;
    for (;;) {
        sum = 0u; cnt = 0u; mine = 0u;
#pragma unroll
        for (unsigned j = 0; j < 16; ++j) { const unsigned c = xb_ld(&bar[XB_XCNT(j)]); sum += c; cnt += (c > 0u) ? 1u : 0u; mine = (j == x) ? c : mine; }
        if (sum == G) break;
        __builtin_amdgcn_s_sleep(1);
        if ((++sp & 255u) == 0u) { if (xb_ld(&bar[XB_TMO])) break; if (sp > XB_SPIN_CAP) { atomicAdd(&bar[XB_TMO], 1u); break; } }
    }
    nloc = mine > 0u ? mine : 1u; nx = cnt > 0u ? cnt : 1u;
}

__device__ __forceinline__ void xcd_barrier(const XcdBarrier& b) {
    asm volatile("s_waitcnt vmcnt(0)" ::: "memory");
    __syncthreads();
    if (threadIdx.x == 0) {
        unsigned* bar = b.bar;
        __builtin_amdgcn_s_waitcnt(0);
        unsigned nloc = b.st[0], nx = b.st[1];
        if (nloc == 0u) { xcd_barrier_complete(bar, b.x, nloc, nx); b.st[0] = nloc; b.st[1] = nx; }
        const unsigned old = xb_add(&bar[XB_XSUB(b.x)], 1u);
        const unsigned gen = old / nloc;
        if (old + 1u == (gen + 1u) * nloc) {
            __builtin_amdgcn_fence(__ATOMIC_RELEASE, "agent");
            asm volatile("s_waitcnt vmcnt(0)" ::: "memory");
            const unsigned og = xb_add(&bar[XB_TOP], 1u);
            const unsigned tg = og / nx;
            if (og + 1u == (tg + 1u) * nx) xb_add(&bar[XB_TOPGEN], 1u);
            else XB_SPIN(xb_ld(&bar[XB_TOPGEN]) == tg, bar);
            __builtin_amdgcn_fence(__ATOMIC_ACQUIRE, "agent");
            xb_add(&bar[XB_XGEN(b.x)], 1u);
            asm volatile("s_waitcnt vmcnt(0)" ::: "memory");
        } else {
            XB_SPIN(xb_ld(&bar[XB_XGEN(b.x)]) == gen, bar);
            __builtin_amdgcn_fence(__ATOMIC_ACQUIRE, "agent");
            asm volatile("s_waitcnt vmcnt(0)" ::: "memory");
        }
    }
    __syncthreads();
}
__device__ __forceinline__ float wave_sum(float v) {
#pragma unroll
    for (int o = 1; o < 64; o <<= 1) v += __shfl_xor(v, o);
    return v;
}
__device__ __forceinline__ void p0_transpose_item(const float* W, int K, int N, bf16* WT, int row_off, LAS float* scr, int item, int lane) {
    const int nblk = N / 32, kb = item / nblk, nb = item % nblk, k0 = 64 * kb, n0 = 32 * nb;
#pragma unroll 8
    for (int i = 0; i < 32; ++i) { const int kk = 2 * i + (lane >> 5); scr[kk * 33 + (lane & 31)] = W[(size_t)(k0 + kk) * N + n0 + (lane & 31)]; }
    LDS_WAIT(); asm volatile("" ::: "memory");
    const int c = lane & 7;
#pragma unroll
    for (int j = 0; j < 4; ++j) { const int n = (lane >> 3) + 8 * j; const LAS float* s = scr + (8 * c) * 33 + n;
        v4u o; o.x = pk2(s[0 * 33], s[1 * 33]); o.y = pk2(s[2 * 33], s[3 * 33]); o.z = pk2(s[4 * 33], s[5 * 33]); o.w = pk2(s[6 * 33], s[7 * 33]);
        *(v4u*)(WT + (size_t)(row_off + n0 + n) * K + k0 + 8 * c) = o; }
    LDS_WAIT(); asm volatile("" ::: "memory");
}
__device__ __forceinline__ int mod_index(int row) { return row < TP ? 0 : 1 + ((row - TP) >> 12); }

__device__ __forceinline__ void phase_prologue(const Args& a, LAS unsigned char* lds, int tid, int wave, int lane) {
    unsigned char* ws = a.ws;
    if (blockIdx.x < 96) {
        LAS float* sc = (LAS float*)lds;
        LAS float* red = (LAS float*)(lds + 9 * 1024 * 4);
        for (int i = tid; i < 9 * 1024; i += 512) { const int v = i >> 10, k = i & 1023; const float x = (v == 0) ? a.in[7][k] : a.in[6][(v - 1) * 1024 + k]; sc[i] = siluf_(x); }
        __syncthreads();
        const int col = blockIdx.x * 64 + lane;
        const float* wm = a.in[9] + col;
        float acc[9];
#pragma unroll
        for (int v = 0; v < 9; ++v) acc[v] = 0.f;
        const int kbeg = wave * 128;
#pragma unroll 8
        for (int kk = 0; kk < 128; ++kk) { const int k = kbeg + kk; const float wv = wm[(size_t)k * 6144];
#pragma unroll
            for (int v = 0; v < 9; ++v) acc[v] += sc[v * 1024 + k] * wv; }
#pragma unroll
        for (int v = 0; v < 9; ++v) red[(wave * 9 + v) * 64 + lane] = acc[v];
        __syncthreads();
        for (int i = tid; i < 9 * 64; i += 512) { const int v = i >> 6, l = i & 63; float s = 0.f;
#pragma unroll
            for (int w = 0; w < 8; ++w) s += red[(w * 9 + v) * 64 + l];
            const int cc = blockIdx.x * 64 + l; ((float*)(ws + WS_MOD))[v * 6144 + cc] = s + a.in[10][cc]; }
        __syncthreads();
    }
    LAS float* scr = (LAS float*)(lds + wave * 16384);
    const int gw = blockIdx.x * NWAVES + wave, NGW = gridDim.x * NWAVES;
    constexpr int I_IN = 16 * 96, I_OUT = 16 * 32, I_G = 16 * 88, I_D = 44 * 32, I_L = 64;
    constexpr int NITEMS = I_IN + I_OUT + 2 * I_G + I_D + I_L;
    for (int it = gw; it < NITEMS; it += NGW) {
        int r = it;
        if (r < I_IN) { p0_transpose_item(a.in[11], 1024, 3072, (bf16*)(ws + WS_WIN), 0, scr, r, lane); continue; } r -= I_IN;
        if (r < I_OUT) { p0_transpose_item(a.in[27], 1024, 1024, (bf16*)(ws + WS_WOUT), 0, scr, r, lane); continue; } r -= I_OUT;
        if (r < I_G) { p0_transpose_item(a.in[29], 1024, 2816, (bf16*)(ws + WS_WGU), 0, scr, r, lane); continue; } r -= I_G;
        if (r < I_G) { p0_transpose_item(a.in[30], 1024, 2816, (bf16*)(ws + WS_WGU), 2816, scr, r, lane); continue; } r -= I_G;
        if (r < I_D) { p0_transpose_item(a.in[33], 2816, 1024, (bf16*)(ws + WS_WD), 0, scr, r, lane); continue; } r -= I_D;
        { const int blk = r >> 1, sub = r & 1, mat = blk >> 3, nb = blk & 7;
          const float* src = (mat == 0 ? a.in[14] : mat == 1 ? a.in[16] : mat == 2 ? a.in[19] : a.in[21]) + nb * 4096;
          p0_transpose_item(src, 64, 64, (bf16*)(ws + WS_WL) + (size_t)(mat * 8 + nb) * 4096, 0, scr, sub, lane); }
    }
}

template <int MODE>
__device__ __forceinline__ void phase_rownorm(const float* xp, const float* xs, const float* w, const float* mod_scale, const float* mod_shift, bf16* obf, float* of32, int wave, int lane) {
    const int gw = blockIdx.x * NWAVES + wave, NGW = gridDim.x * NWAVES;
    f32x4 wv[4];
#pragma unroll
    for (int j = 0; j < 4; ++j) wv[j] = *(const f32x4*)(w + 4 * lane + 256 * j);
    for (int row0 = gw; row0 < TT; row0 += 2 * NGW) {
        const int row1 = row0 + NGW; const bool has1 = row1 < TT; const int r1 = has1 ? row1 : row0;
        const float* xr0 = (row0 < TP ? xp + (size_t)row0 * DM : xs + (size_t)(row0 - TP) * DM) + 4 * lane;
        const float* xr1 = (r1 < TP ? xp + (size_t)r1 * DM : xs + (size_t)(r1 - TP) * DM) + 4 * lane;
        f32x4 v0[4], v1[4]; float s0 = 0.f, s1 = 0.f;
#pragma unroll
        for (int j = 0; j < 4; ++j) { v0[j] = *(const f32x4*)(xr0 + 256 * j); v1[j] = *(const f32x4*)(xr1 + 256 * j); }
#pragma unroll
        for (int j = 0; j < 4; ++j) { s0 += (v0[j].x * v0[j].x + v0[j].y * v0[j].y) + (v0[j].z * v0[j].z + v0[j].w * v0[j].w); s1 += (v1[j].x * v1[j].x + v1[j].y * v1[j].y) + (v1[j].z * v1[j].z + v1[j].w * v1[j].w); }
        const float rs0 = 1.0f / sqrtf(wave_sum(s0) * (1.0f / DM) + 1e-6f), rs1 = 1.0f / sqrtf(wave_sum(s1) * (1.0f / DM) + 1e-6f);
#pragma unroll
        for (int k = 0; k < 2; ++k) {
            if (k == 1 && !has1) break;
            const int row = k ? row1 : row0; const float rstd = k ? rs1 : rs0;
            if (MODE == 0) {
                const int mv = mod_index(row);
                const float* sc = mod_scale + (size_t)mv * 6144 + 4 * lane; const float* sh = mod_shift + (size_t)mv * 6144 + 4 * lane;
                unsigned long long* o8 = (unsigned long long*)(obf + (size_t)row * DM) + lane;
#pragma unroll
                for (int j = 0; j < 4; ++j) { const f32x4 scv = *(const f32x4*)(sc + 256 * j), shv = *(const f32x4*)(sh + 256 * j);
                    const f32x4 y = (k ? v1[j] : v0[j]) * rstd * wv[j] * (scv + 1.0f) + shv;
                    o8[64 * j] = (unsigned long long)pk2(y.x, y.y) | ((unsigned long long)pk2(y.z, y.w) << 32); }
            } else {
                float* o = of32 + (size_t)row * DM + 4 * lane;
#pragma unroll
                for (int j = 0; j < 4; ++j) *(f32x4*)(o + 256 * j) = (k ? v1[j] : v0[j]) * rstd * wv[j];
            }
        }
    }
}

template <int MODE>
__device__ __forceinline__ void phase_resnorm(const float* xp, const float* xs, const bf16* tb, const float* gate, float* x1out, const float* w, const float* mod_scale, const float* mod_shift,
                                              bf16* obf, float* of32, int wave, int lane) {
    const int gw = blockIdx.x * NWAVES + wave, NGW = gridDim.x * NWAVES;
    f32x4 wv[4];
#pragma unroll
    for (int j = 0; j < 4; ++j) wv[j] = *(const f32x4*)(w + 4 * lane + 256 * j);
    for (int row0 = gw; row0 < TT; row0 += 2 * NGW) {
        const int row1 = row0 + NGW; const bool has1 = row1 < TT; const int r1 = has1 ? row1 : row0;
        const float* xr0 = (row0 < TP ? xp + (size_t)row0 * DM : xs + (size_t)(row0 - TP) * DM) + 4 * lane;
        const float* xr1 = (r1 < TP ? xp + (size_t)r1 * DM : xs + (size_t)(r1 - TP) * DM) + 4 * lane;
        const bf16* t0 = tb + (size_t)row0 * DM + 4 * lane; const bf16* t1 = tb + (size_t)r1 * DM + 4 * lane;
        f32x4 v0[4], v1[4]; v2u u0[4], u1[4];
#pragma unroll
        for (int j = 0; j < 4; ++j) { v0[j] = *(const f32x4*)(xr0 + 256 * j); v1[j] = *(const f32x4*)(xr1 + 256 * j); u0[j] = *(const v2u*)(t0 + 256 * j); u1[j] = *(const v2u*)(t1 + 256 * j); }
        const float* g0 = gate + (size_t)mod_index(row0) * 6144 + 4 * lane; const float* g1 = gate + (size_t)mod_index(r1) * 6144 + 4 * lane;
        float s0 = 0.f, s1 = 0.f;
#pragma unroll
        for (int j = 0; j < 4; ++j) { const f32x4 ga = *(const f32x4*)(g0 + 256 * j), gb = *(const f32x4*)(g1 + 256 * j);
            v0[j] = v0[j] + ga * (f32x4){bflo(u0[j][0]), bfhi(u0[j][0]), bflo(u0[j][1]), bfhi(u0[j][1])};
            v1[j] = v1[j] + gb * (f32x4){bflo(u1[j][0]), bfhi(u1[j][0]), bflo(u1[j][1]), bfhi(u1[j][1])};
            s0 += (v0[j].x * v0[j].x + v0[j].y * v0[j].y) + (v0[j].z * v0[j].z + v0[j].w * v0[j].w); s1 += (v1[j].x * v1[j].x + v1[j].y * v1[j].y) + (v1[j].z * v1[j].z + v1[j].w * v1[j].w); }
        const float rs0 = 1.0f / sqrtf(wave_sum(s0) * (1.0f / DM) + 1e-6f), rs1 = 1.0f / sqrtf(wave_sum(s1) * (1.0f / DM) + 1e-6f);
#pragma unroll
        for (int k = 0; k < 2; ++k) {
            if (k == 1 && !has1) break;
            const int row = k ? row1 : row0; const float rstd = k ? rs1 : rs0;
            if (x1out) { float* o = x1out + (size_t)row * DM + 4 * lane;
#pragma unroll
                for (int j = 0; j < 4; ++j) *(f32x4*)(o + 256 * j) = (k ? v1[j] : v0[j]); }
            if (MODE == 0) {
                const int mv = mod_index(row);
                const float* sc = mod_scale + (size_t)mv * 6144 + 4 * lane; const float* sh = mod_shift + (size_t)mv * 6144 + 4 * lane;
                unsigned long long* o8 = (unsigned long long*)(obf + (size_t)row * DM) + lane;
#pragma unroll
                for (int j = 0; j < 4; ++j) { const f32x4 scv = *(const f32x4*)(sc + 256 * j), shv = *(const f32x4*)(sh + 256 * j);
                    const f32x4 y = (k ? v1[j] : v0[j]) * rstd * wv[j] * (scv + 1.0f) + shv;
                    o8[64 * j] = (unsigned long long)pk2(y.x, y.y) | ((unsigned long long)pk2(y.z, y.w) << 32); }
            } else {
                float* o = of32 + (size_t)row * DM + 4 * lane;
#pragma unroll
                for (int j = 0; j < 4; ++j) *(f32x4*)(o + 256 * j) = (k ? v1[j] : v0[j]) * rstd * wv[j];
            }
        }
    }
}
constexpr int RS = 272;
constexpr int REG = 128 * RS;
constexpr int XCS = 1040;
#define MFMA16(a, b, c) __builtin_amdgcn_mfma_f32_16x16x32_bf16((a), (b), (c), 0, 0, 0)

__device__ __forceinline__ void mm128(f32x4 (&acc)[8], const LAS unsigned char* Aimg, const LAS unsigned char* Bimg, int wave, int c, int q) {
#pragma unroll
    for (int s = 0; s < 4; ++s) {
        const bf16x8 af = *(const LAS bf16x8*)(Aimg + (16 * wave + c) * RS + (32 * s + 8 * q) * 2);
#pragma unroll
        for (int t = 0; t < 8; ++t) { const bf16x8 bfr = *(const LAS bf16x8*)(Bimg + (16 * t + c) * RS + (32 * s + 8 * q) * 2); acc[t] = MFMA16(bfr, af, acc[t]); }
    }
}
__device__ __forceinline__ void mm128x2(f32x4 (&acc1)[8], f32x4 (&acc2)[8], const LAS unsigned char* Aimg, const LAS unsigned char* B1, const LAS unsigned char* B2, int wave, int c, int q) {
#pragma unroll
    for (int s = 0; s < 4; ++s) {
        const bf16x8 af = *(const LAS bf16x8*)(Aimg + (16 * wave + c) * RS + (32 * s + 8 * q) * 2);
#pragma unroll
        for (int t = 0; t < 8; ++t) { const bf16x8 b1 = *(const LAS bf16x8*)(B1 + (16 * t + c) * RS + (32 * s + 8 * q) * 2); acc1[t] = MFMA16(b1, af, acc1[t]);
                                      const bf16x8 b2 = *(const LAS bf16x8*)(B2 + (16 * t + c) * RS + (32 * s + 8 * q) * 2); acc2[t] = MFMA16(b2, af, acc2[t]); }
    }
}
__device__ __forceinline__ void load_rm(LAS unsigned char* img, const bf16* g, int pitch, int tid) {
#pragma unroll
    for (int i = 0; i < 4; ++i) { const int p = tid + 512 * i, row = p >> 4, cp = p & 15; const v4u v = *(const v4u*)(g + (size_t)row * pitch + cp * 8); *(LAS v4u*)(img + row * RS + cp * 16) = v; }
}
__device__ __forceinline__ void load_tiled(LAS unsigned char* img, const bf16* g, int tid) {
#pragma unroll
    for (int i = 0; i < 4; ++i) { const int p = tid + 512 * i, cp = p >> 7, row = p & 127; const v4u v = *(const v4u*)(g + (size_t)p * 8); *(LAS v4u*)(img + row * RS + cp * 16) = v; }
}
#define HW(v, e) (((e) & 1) ? ((v)[(e) >> 1] >> 16) : ((v)[(e) >> 1] & 0xffffu))
__device__ __forceinline__ void load_tr(LAS unsigned char* img, const bf16* g, int pitch, int wave, int lane) {
#pragma unroll
    for (int it = 0; it < 2; ++it) { const int dg = wave + 8 * it;
        const v4u a = *(const v4u*)(g + (size_t)(2 * lane) * pitch + dg * 8), b = *(const v4u*)(g + (size_t)(2 * lane + 1) * pitch + dg * 8);
#pragma unroll
        for (int e = 0; e < 8; ++e) { const unsigned lo = HW(a, e), hi = HW(b, e); *(LAS unsigned*)(img + (dg * 8 + e) * RS + lane * 4) = lo | (hi << 16); } }
}
__device__ __forceinline__ float log_sigmoid_(float x) { return -log1pf(__expf(-x)); }

template <int PASS>
__device__ __forceinline__ void ret_item(const Args& a, LAS unsigned char* lds, int ci, int h, int tid, int wave, int lane) {
    unsigned char* ws = a.ws;
    const int c = lane & 15, q = lane >> 4;
    const bf16* PROJ = (const bf16*)(ws + WS_PROJ);
    const size_t rowbase = (size_t)ci * 128;
    const bf16* Qg = PROJ + rowbase * INW + 1024 + h * 128;
    const bf16* Kg = PROJ + rowbase * INW + 1536 + h * 128;
    const bf16* Vg = PROJ + rowbase * INW + 2048 + h * 128;
    const float lf2 = log_sigmoid_(a.in[24][h]) * 1.4426950408889634f, lb2 = log_sigmoid_(a.in[25][h]) * 1.4426950408889634f;
    const float scale = 0.08838834764831845f;
    LAS unsigned char* R1 = lds; LAS unsigned char* R2 = lds + REG; LAS unsigned char* R3 = lds + 2 * REG; LAS unsigned char* R4 = lds + 3 * REG;
    if (PASS == 1) {
        const float j0 = (float)(2 * lane), j1 = (float)(2 * lane + 1);
        const float wf0 = scale * __builtin_amdgcn_exp2f(lf2 * (127.f - j0)), wf1 = scale * __builtin_amdgcn_exp2f(lf2 * (127.f - j1)), wb0 = scale * __builtin_amdgcn_exp2f(lb2 * j0), wb1 = scale * __builtin_amdgcn_exp2f(lb2 * j1);
        load_tr(R1, Kg, INW, wave, lane);
#pragma unroll
        for (int it = 0; it < 2; ++it) { const int dg = wave + 8 * it;
            const v4u va = *(const v4u*)(Vg + (size_t)(2 * lane) * INW + dg * 8), vb = *(const v4u*)(Vg + (size_t)(2 * lane + 1) * INW + dg * 8);
#pragma unroll
            for (int e = 0; e < 8; ++e) { const float lo = bf2f((unsigned short)HW(va, e)), hi = bf2f((unsigned short)HW(vb, e));
                *(LAS unsigned*)(R2 + (dg * 8 + e) * RS + lane * 4) = pk2(lo * wf0, hi * wf1);
                *(LAS unsigned*)(R3 + (dg * 8 + e) * RS + lane * 4) = pk2(lo * wb0, hi * wb1); } }
        __syncthreads();
        f32x4 af[8], ab[8];
#pragma unroll
        for (int t = 0; t < 8; ++t) { af[t] = (f32x4){0.f, 0.f, 0.f, 0.f}; ab[t] = (f32x4){0.f, 0.f, 0.f, 0.f}; }
        mm128(af, R2, R1, wave, c, q);
        mm128(ab, R3, R1, wave, c, q);
        bf16* KVT = (bf16*)(ws + WS_KVT) + ((size_t)(ci * 4 + h) * 2) * 16384 + ((q >> 1) * 128 + 16 * wave + c) * 8 + 4 * (q & 1);
#pragma unroll
        for (int t = 0; t < 8; ++t) { *(v2u*)(KVT + 2 * t * 1024) = (v2u){pk2(af[t][0], af[t][1]), pk2(af[t][2], af[t][3])};
                                      *(v2u*)(KVT + 16384 + 2 * t * 1024) = (v2u){pk2(ab[t][0], ab[t][1]), pk2(ab[t][2], ab[t][3])}; }
        __syncthreads();
    } else {
        const bf16* SB = (const bf16*)(ws + WS_SB) + ((size_t)(ci * 4 + h) * 2) * 16384;
        load_rm(R1, Qg, INW, tid);
        load_rm(R2, Kg, INW, tid);
        load_tr(R3, Vg, INW, wave, lane);
        load_tiled(R4, SB, tid);
        __syncthreads();
        f32x4 aS[8], aF[8];
#pragma unroll
        for (int t = 0; t < 8; ++t) { aS[t] = (f32x4){0.f, 0.f, 0.f, 0.f}; aF[t] = (f32x4){0.f, 0.f, 0.f, 0.f}; }
        mm128x2(aS, aF, R1, R2, R4, wave, c, q);
        __syncthreads();
        const int i = 16 * wave + c;
#pragma unroll
        for (int t = 0; t < 8; ++t) { float p[4];
#pragma unroll
            for (int r = 0; r < 4; ++r) { const int dl = i - (16 * t + 4 * q + r);
                const float ex = __builtin_amdgcn_exp2f(dl > 0 ? lf2 * (float)dl : lb2 * (float)(-dl));
                const float f = dl == 0 ? 2.0f : ex;
                p[r] = aS[t][r] * scale * f; }
            *(LAS v2u*)(R2 + i * RS + (16 * t + 4 * q) * 2) = (v2u){pk2(p[0], p[1]), pk2(p[2], p[3])}; }
        load_tiled(R4, SB + 16384, tid);
        __syncthreads();
        const float hf = __builtin_amdgcn_exp2f(lf2 * (float)(i + 1)), hb = __builtin_amdgcn_exp2f(lb2 * (float)(128 - i));
        f32x4 aB[8];
#pragma unroll
        for (int t = 0; t < 8; ++t) { aF[t] = aF[t] * hf; aB[t] = (f32x4){0.f, 0.f, 0.f, 0.f}; }
        mm128(aF, R2, R3, wave, c, q);
        mm128(aB, R1, R4, wave, c, q);
        f32x4 (&aO)[8] = aF;
        float s = 0.f;
#pragma unroll
        for (int t = 0; t < 8; ++t) { aO[t] = aO[t] + aB[t] * hb; s += (aO[t][0] + aO[t][1]) + (aO[t][2] + aO[t][3]); }
        s += __shfl_xor(s, 16); s += __shfl_xor(s, 32);
        const float mean = s * (1.0f / 128.0f); float v2 = 0.f;
#pragma unroll
        for (int t = 0; t < 8; ++t) { aO[t] = aO[t] - mean; v2 += (aO[t][0] * aO[t][0] + aO[t][1] * aO[t][1]) + (aO[t][2] * aO[t][2] + aO[t][3] * aO[t][3]); }
        v2 += __shfl_xor(v2, 16); v2 += __shfl_xor(v2, 32);
        const float rstd = 1.0f / sqrtf(v2 * (1.0f / 128.0f) + 1e-6f);
        const bf16* Gg = PROJ + (rowbase + i) * INW + 2560 + h * 128 + 4 * q;
        const float* gn = a.in[26] + h * 128 + 4 * q;
        bf16* Yp = (bf16*)(ws + WS_Y) + (rowbase + i) * DM + 512 + h * 128 + 4 * q;
#pragma unroll
        for (int t = 0; t < 8; ++t) { const v2u gv = *(const v2u*)(Gg + 16 * t); const f32x4 w = *(const f32x4*)(gn + 16 * t);
            const float y0 = aO[t][0] * rstd * w[0] * siluf_(bflo(gv[0])), y1 = aO[t][1] * rstd * w[1] * siluf_(bfhi(gv[0]));
            const float y2 = aO[t][2] * rstd * w[2] * siluf_(bflo(gv[1])), y3 = aO[t][3] * rstd * w[3] * siluf_(bfhi(gv[1]));
            *(v2u*)(Yp + 16 * t) = (v2u){pk2(y0, y1), pk2(y2, y3)};
            if (t & 1) asm volatile("" ::: "memory"); }
        __syncthreads();
    }
}
template <int PASS, int DIR>
__device__ __forceinline__ void lru_dir(const LAS unsigned char* xcl, const bf16x8 (&idf)[2], const bf16x8 (&wa)[2], const bf16x8 (&wx)[2], float ba, float bx, float sp8,
                                        float hc_in, float* hsp, float& Aout, float& Hout, float& edge, int c, int q, const bf16* Gp, bf16* Yp) {
    float Ac = 1.f, Hc = hc_in;
    float hn[4]; unsigned short gn[4];
    if (PASS == 3 && DIR == 1) {
#pragma unroll
        for (int r = 0; r < 4; ++r) { hn[r] = hsp[(7 * 4 + r) * 64]; gn[r] = Gp[(size_t)(16 * 7 + 4 * q + r) * INW]; }
    }
#pragma unroll 1
    for (int ti = 0; ti < 8; ++ti) {
        const int tt = DIR == 0 ? ti : 7 - ti;
        float hcur[4]; unsigned short gcur[4];
        if (PASS == 3 && DIR == 1) {
#pragma unroll
            for (int r = 0; r < 4; ++r) { hcur[r] = hn[r]; gcur[r] = gn[r]; }
            const int tn = tt > 0 ? tt - 1 : 0;
#pragma unroll
            for (int r = 0; r < 4; ++r) { hn[r] = hsp[(tn * 4 + r) * 64]; gn[r] = Gp[(size_t)(16 * tn + 4 * q + r) * INW]; }
        }
        f32x4 aI = (f32x4){0.f, 0.f, 0.f, 0.f}, aA = aI, aX = aI;
#pragma unroll
        for (int s = 0; s < 2; ++s) { const bf16x8 xf = *(const LAS bf16x8*)(xcl + (16 * tt) * XCS + 64 * s);
            aI = MFMA16(xf, idf[s], aI); aA = MFMA16(xf, wa[s], aA); aX = MFMA16(xf, wx[s], aX); }
        float av[4], uv[4];
#pragma unroll
        for (int r = 0; r < 4; ++r) {
            const float rg = __builtin_amdgcn_rcpf(1.0f + __builtin_amdgcn_exp2f(fmaf(aA[r], -1.4426950408889634f, ba)));
            const float ig = __builtin_amdgcn_rcpf(1.0f + __builtin_amdgcn_exp2f(fmaf(aX[r], -1.4426950408889634f, bx)));
            const float la = -sp8 * rg;
            const float aa = __builtin_amdgcn_exp2f(la * 1.4426950408889634f);
            const float t = -2.0f * la;
            const float ser = t * fmaf(-0.5f * t, fmaf(-0.33333334f * t, fmaf(-0.25f, t, 1.0f), 1.0f), 1.0f);
            const float om = t < 0.125f ? ser : fmaf(-aa, aa, 1.0f);
            av[r] = aa; uv[r] = __builtin_amdgcn_sqrtf(om) * (ig * aI[r]); }
        float pa[4], hl[4]; float P = 1.f, H = 0.f;
#pragma unroll
        for (int rr = 0; rr < 4; ++rr) { const int r = DIR == 0 ? rr : 3 - rr; H = av[r] * H + uv[r]; P *= av[r]; pa[r] = P; hl[r] = H; }
        float A = P, Hh = H, Ap, Hp, Ae, He, At, Ht;
        if (DIR == 0) {
            Ap = __shfl_up(A, 16); Hp = __shfl_up(Hh, 16); if (q >= 1) { Hh = A * Hp + Hh; A = Ap * A; }
            Ap = __shfl_up(A, 32); Hp = __shfl_up(Hh, 32); if (q >= 2) { Hh = A * Hp + Hh; A = Ap * A; }
            Ae = __shfl_up(A, 16); He = __shfl_up(Hh, 16); if (q == 0) { Ae = 1.f; He = 0.f; }
            At = __shfl(A, 48 + c); Ht = __shfl(Hh, 48 + c);
        } else {
            Ap = __shfl_down(A, 16); Hp = __shfl_down(Hh, 16); if (q <= 2) { Hh = A * Hp + Hh; A = Ap * A; }
            Ap = __shfl_down(A, 32); Hp = __shfl_down(Hh, 32); if (q <= 1) { Hh = A * Hp + Hh; A = Ap * A; }
            Ae = __shfl_down(A, 16); He = __shfl_down(Hh, 16); if (q == 3) { Ae = 1.f; He = 0.f; }
            At = __shfl(A, c); Ht = __shfl(Hh, c);
        }
        if (PASS == 3) {
            const float hin = Ae * Hc + He;
#pragma unroll
            for (int r = 0; r < 4; ++r) { const float hv = pa[r] * hin + hl[r];
                if (DIR == 0) hsp[(tt * 4 + r) * 64] = hv;
                else { const size_t tok = (size_t)(16 * tt + 4 * q + r); Yp[tok * DM] = (bf16)f2bf((hcur[r] + hv) * gelu_tanh(bf2f(gcur[r]))); }
                if (DIR == 0 && tt == 0 && r == 0) edge = hv;
                if (DIR == 1 && tt == 7 && r == 3) edge = hv; }
        }
        Hc = At * Hc + Ht; Ac = Ac * At;
    }
    Aout = Ac; Hout = Hc;
}

template <int PASS>
__device__ __forceinline__ void lru_item(const Args& a, LAS unsigned char* lds, int ci, int tid, int wave, int lane) {
    unsigned char* ws = a.ws;
    const int c = lane & 15, q = lane >> 4;
    const bf16* PROJ = (const bf16*)(ws + WS_PROJ);
    int seq, n, seqlen, seqtok0, nch;
    if (ci < 64) { seq = ci >> 1; n = ci & 1; seqlen = 256; seqtok0 = seq * 256; nch = 2; }
    else { seq = (ci - 64) >> 5; n = (ci - 64) & 31; seqlen = 4096; seqtok0 = TP + seq * 4096; nch = 32; }
    const bool isprompt = ci < 64;
    const int p0 = n * 128;
    {
        float w0[8], w1[8], w2[8], w3[8], bb[8];
#pragma unroll
        for (int e = 0; e < 8; ++e) { w0[e] = a.in[12][0 * 512 + 8 * lane + e]; w1[e] = a.in[12][1 * 512 + 8 * lane + e]; w2[e] = a.in[12][2 * 512 + 8 * lane + e]; w3[e] = a.in[12][3 * 512 + 8 * lane + e]; bb[e] = a.in[13][8 * lane + e]; }
        const int pb = p0 + 16 * wave;
        const bf16* base = PROJ + (size_t)seqtok0 * INW + 8 * lane;
#define LDROW(p) (((p) < 0 || (p) >= seqlen) ? (v4u){0u, 0u, 0u, 0u} : *(const v4u*)(base + (size_t)(p) * INW))
        v4u rows[19];
#pragma unroll
        for (int k = 0; k < 19; ++k) rows[k] = LDROW(pb - 2 + k);
#pragma unroll
        for (int i = 0; i < 16; ++i) {
            float o[8];
#pragma unroll
            for (int e = 0; e < 8; ++e) o[e] = fmaf(w3[e], bf2f((unsigned short)HW(rows[i + 3], e)), fmaf(w2[e], bf2f((unsigned short)HW(rows[i + 2], e)), fmaf(w1[e], bf2f((unsigned short)HW(rows[i + 1], e)), fmaf(w0[e], bf2f((unsigned short)HW(rows[i], e)), bb[e]))));
            *(LAS v4u*)(lds + (16 * wave + i) * XCS + 16 * lane) = (v4u){pk2(o[0], o[1]), pk2(o[2], o[3]), pk2(o[4], o[5]), pk2(o[6], o[7])};
        }
#undef LDROW
    }
    __syncthreads();
    const LAS unsigned char* xcl = lds + c * XCS + (64 * wave + 8 * q) * 2;
    const bf16* WL = (const bf16*)(ws + WS_WL);
    const size_t rowbase = (size_t)seqtok0 + p0;
    for (int rt = 0; rt < 4; ++rt) {
        const int dl = 16 * rt + c, d = 64 * wave + dl;
        bf16x8 idf[2];
#pragma unroll
        for (int s = 0; s < 2; ++s)
#pragma unroll
            for (int e = 0; e < 8; ++e) idf[s][e] = (32 * s + 8 * q + e == dl) ? (short)0x3F80 : (short)0;
        float* hs = a.out + (size_t)(blockIdx.x * NWAVES + wave) * 2048 + lane;
        float Af, Hf, Ab, Hb, ef = 0.f, eb = 0.f;
        float cf = 0.f, cb = 0.f;
        if (PASS == 3) { cf = ((const float*)(ws + WS_CAR))[(size_t)(ci * 2 + 0) * 512 + d]; cb = ((const float*)(ws + WS_CAR))[(size_t)(ci * 2 + 1) * 512 + d]; }
        const bf16* Gp = PROJ + rowbase * INW + 512 + d;
        bf16* Yp = (bf16*)(ws + WS_Y) + rowbase * DM + d;
        bf16x8 waf[2], wxf[2], wab[2], wxb[2];
#pragma unroll
        for (int s2 = 0; s2 < 2; ++s2) { const int o = dl * 64 + 32 * s2 + 8 * q;
            waf[s2] = *(const bf16x8*)(WL + (size_t)(0 * 8 + wave) * 4096 + o); wxf[s2] = *(const bf16x8*)(WL + (size_t)(1 * 8 + wave) * 4096 + o);
            wab[s2] = *(const bf16x8*)(WL + (size_t)(2 * 8 + wave) * 4096 + o); wxb[s2] = *(const bf16x8*)(WL + (size_t)(3 * 8 + wave) * 4096 + o); }
        const float baf = a.in[15][d], bxf = a.in[17][d], lmf = a.in[18][d], bab = a.in[20][d], bxb = a.in[22][d], lmb = a.in[23][d];
        lru_dir<PASS, 0>(xcl, idf, waf, wxf, -1.4426950408889634f * baf, -1.4426950408889634f * bxf, 8.0f * log1pf(__expf(-lmf)), cf, hs, Af, Hf, ef, c, q, Gp, Yp);
        lru_dir<PASS, 1>(xcl, idf, wab, wxb, -1.4426950408889634f * bab, -1.4426950408889634f * bxb, 8.0f * log1pf(__expf(-lmb)), cb, hs, Ab, Hb, eb, c, q, Gp, Yp);
        if (PASS == 1) {
            if (q == 0) { float* ag = (float*)(ws + WS_AGG) + (size_t)(ci * 2) * 1024 + d; ag[0] = Af; ag[512] = Hf; ag[1024] = Ab; ag[1536] = Hb; }
        } else {
            if (isprompt && n == 0 && q == 0) a.out[OFF_LF + seq * 512 + d] = ef;
            if (isprompt && n == nch - 1 && q == 3) a.out[OFF_LB + seq * 512 + d] = eb;
        }
    }
    __syncthreads();
}

__device__ __forceinline__ void phase_carries(const Args& a, int tid) {
    unsigned char* ws = a.ws;
    const int gtid = blockIdx.x * 512 + tid, GT = gridDim.x * 512;
    for (int task = gtid; task < 655360; task += GT) {
        const int dv = task & 127, dkg = (task >> 7) & 15, dir = (task >> 11) & 1, h = (task >> 12) & 3, sq = task >> 14;
        const bool isprompt = sq >= 8; const int seq = isprompt ? sq - 8 : sq, N = isprompt ? 2 : 32, cibase = isprompt ? seq * 2 : 64 + seq * 32;
        const float g = __expf(log_sigmoid_(dir ? a.in[25][h] : a.in[24][h]) * 128.0f);
        float S[8];
        if (isprompt) {
#pragma unroll
            for (int e = 0; e < 8; ++e) S[e] = 0.f;
        } else { const float* s0 = (dir ? a.in[5] : a.in[4]) + ((size_t)(seq * 4 + h) * 128 + dkg * 8) * 128 + dv;
#pragma unroll
            for (int e = 0; e < 8; ++e) S[e] = s0[e * 128]; }
        const size_t ibase = ((size_t)h * 2 + dir) * 16384 + ((size_t)dkg * 128 + dv) * 8;
        const bf16* kvp = (const bf16*)(ws + WS_KVT) + ibase; bf16* sbp = (bf16*)(ws + WS_SB) + ibase;
        for (int s0 = 0; s0 < N; s0 += 8) {
            v4u kv[8];
#pragma unroll
            for (int j = 0; j < 8; ++j) { const int step = s0 + j; const int n = dir ? N - 1 - step : step; const int ci = cibase + (step < N ? n : (dir ? 0 : N - 1));
                kv[j] = *(const v4u*)(kvp + (size_t)ci * 131072); }
#pragma unroll
            for (int j = 0; j < 8; ++j) { const int step = s0 + j;
                if (step < N) { const int n = dir ? N - 1 - step : step, ci = cibase + n;
                    *(v4u*)(sbp + (size_t)ci * 131072) = (v4u){pk2(S[0], S[1]), pk2(S[2], S[3]), pk2(S[4], S[5]), pk2(S[6], S[7])};
#pragma unroll
                    for (int e2 = 0; e2 < 8; ++e2) S[e2] = g * S[e2] + bf2f((unsigned short)HW(kv[j], e2)); } }
        }
        if (isprompt) { float* o = a.out + (dir ? OFF_RB : OFF_RF) + ((size_t)(seq * 4 + h) * 128 + dkg * 8) * 128 + dv;
#pragma unroll
            for (int e = 0; e < 8; ++e) o[e * 128] = S[e]; }
    }
    for (int task = gtid; task < 40960; task += GT) {
        const int d = task & 511, dir = (task >> 9) & 1, sq = task >> 10;
        const bool isprompt = sq >= 8; const int seq = isprompt ? sq - 8 : sq, N = isprompt ? 2 : 32, cibase = isprompt ? seq * 2 : 64 + seq * 32;
        float hcar = isprompt ? 0.f : (dir ? a.in[3] : a.in[2])[seq * 512 + d];
        for (int step = 0; step < N; ++step) {
            const int n = dir ? N - 1 - step : step, ci = cibase + n;
            ((float*)(ws + WS_CAR))[(size_t)(ci * 2 + dir) * 512 + d] = hcar;
            const float* ag = (const float*)(ws + WS_AGG) + ((size_t)(ci * 2 + dir) * 2) * 512 + d;
            hcar = ag[0] * hcar + ag[512];
        }
    }
}

__device__ __forceinline__ v4u ldg16(const bf16* p, bool ok) { return ok ? *(const v4u*)p : (v4u){0u, 0u, 0u, 0u}; }
__device__ __forceinline__ void phase_act(const Args& a, int half, int wave, int lane) {
    unsigned char* ws = a.ws;
    const bf16* __restrict__ GH = (const bf16*)(ws + WS_GH);
    bf16* __restrict__ U = (bf16*)(ws + WS_U);
    const int gw = blockIdx.x * NWAVES + wave, NGW = gridDim.x * NWAVES;
    const int p = lane >> 5;
    const bool tailsplit = (NGW == 2048);
    for (int kk = 0; kk < (tailsplit ? 4 : (7040 + NGW - 1) / NGW); ++kk) {
        int wt, nst = 16, soff = 0;
        if (!tailsplit) { wt = gw + kk * NGW; if (wt >= 7040) break; }
        else if (kk < 3) wt = gw + kk * 2048;
        else { if (gw >= 1792) break; wt = 6144 + (gw >> 1); nst = 8; soff = 8 * (gw & 1); }
        const int slab = wt % 11; int r = wt / 11;
        int tok0, ts, lat, steps0, nwalk;
        bool isimg;
        if (half == 1 || r >= 256) {
            if (half == 0) r -= 256;
            const int pair = r & 31, seg = (r >> 5) & 3, img = (r >> 7) + (half == 0 ? 0 : 3);
            const int gc = 2 * pair + p; steps0 = 16 * seg + soff; nwalk = 64; ts = 64; lat = 1; isimg = true;
            tok0 = TP + img * 4096 + steps0 * 64 + gc;
        } else {
            const int sp = r & 7, seq = r >> 3; steps0 = 32 * sp + 16 * p + soff; nwalk = 256; ts = 1; lat = 0; isimg = false;
            tok0 = seq * 256 + steps0;
        }
        const int ch0 = (slab * 32 + (lane & 31)) * 8;
        const int gcol = isimg ? (tok0 & 63) : 1;
        const bool okl = isimg && gcol > 0, okr = isimg && gcol < 63;
        float wk[9][8], bb[8];
#pragma unroll
        for (int k = 0; k < 9; ++k) { const int aa = k / 3, b = k % 3;
            const int src = isimg ? k : (3 + aa);
            const f32x4 x0 = *(const f32x4*)(a.in[31] + (size_t)src * FF + ch0), x1 = *(const f32x4*)(a.in[31] + (size_t)src * FF + ch0 + 4);
            const float z = (isimg || b == 1) ? 1.f : 0.f;
            wk[k][0] = x0[0] * z; wk[k][1] = x0[1] * z; wk[k][2] = x0[2] * z; wk[k][3] = x0[3] * z; wk[k][4] = x1[0] * z; wk[k][5] = x1[1] * z; wk[k][6] = x1[2] * z; wk[k][7] = x1[3] * z; }
        { const f32x4 x0 = *(const f32x4*)(a.in[32] + ch0), x1 = *(const f32x4*)(a.in[32] + ch0 + 4); bb[0] = x0[0]; bb[1] = x0[1]; bb[2] = x0[2]; bb[3] = x0[3]; bb[4] = x1[0]; bb[5] = x1[1]; bb[6] = x1[2]; bb[7] = x1[3]; }
        const bf16* gp = GH + (size_t)(tok0 - half * HALF_T) * FF + ch0;
        bf16* up = U + (size_t)tok0 * FF + ch0;
        const size_t gs = (size_t)ts * FF;
        v4u w0[3], w1[3], w2[3], w3[3];
        { const bool okp = steps0 > 0;
          w0[0] = ldg16(gp - gs - FF, okp && okl); w0[1] = ldg16(gp - gs, okp); w0[2] = ldg16(gp - gs + FF, okp && okr);
          w1[0] = ldg16(gp - FF, okl); w1[1] = *(const v4u*)gp; w1[2] = ldg16(gp + FF, okr); }
#pragma unroll 1
        for (int st = 0; st < nst; st += 2) {
            const bool ok2 = steps0 + st + 1 < nwalk, ok3 = steps0 + st + 2 < nwalk;
            const bf16* g2 = gp + (size_t)(st + 1) * gs; const bf16* g3 = g2 + gs;
            w2[0] = ldg16(g2 - FF, ok2 && okl); w2[1] = ldg16(g2, ok2); w2[2] = ldg16(g2 + FF, ok2 && okr);
            w3[0] = ldg16(g3 - FF, ok3 && okl); w3[1] = ldg16(g3, ok3); w3[2] = ldg16(g3 + FF, ok3 && okr);
            bf16* u0 = up + (size_t)st * gs; bf16* u1 = u0 + gs;
            const v4u uv0 = *(const v4u*)u0, uv1 = *(const v4u*)u1;
            float acc0[8], acc1[8];
#pragma unroll
            for (int e = 0; e < 8; ++e) { acc0[e] = bb[e]; acc1[e] = bb[e]; }
#pragma unroll
            for (int b = 0; b < 3; ++b)
#pragma unroll
                for (int e = 0; e < 8; ++e) {
                    { const float g0 = bf2f((unsigned short)HW(w0[b], e)), g1 = bf2f((unsigned short)HW(w1[b], e)), g2 = bf2f((unsigned short)HW(w2[b], e)), g3 = bf2f((unsigned short)HW(w3[b], e));
                    acc0[e] = fmaf(wk[6 + b][e], g2, fmaf(wk[3 + b][e], g1, fmaf(wk[0 + b][e], g0, acc0[e])));
                    acc1[e] = fmaf(wk[6 + b][e], g3, fmaf(wk[3 + b][e], g2, fmaf(wk[0 + b][e], g1, acc1[e]))); } }
            float o0[8], o1[8];
#pragma unroll
            for (int e = 0; e < 8; ++e) { o0[e] = gelu_tanh(acc0[e]) * bf2f((unsigned short)HW(uv0, e)); o1[e] = gelu_tanh(acc1[e]) * bf2f((unsigned short)HW(uv1, e)); }
            *(v4u*)u0 = (v4u){pk2(o0[0], o0[1]), pk2(o0[2], o0[3]), pk2(o0[4], o0[5]), pk2(o0[6], o0[7])};
            *(v4u*)u1 = (v4u){pk2(o1[0], o1[1]), pk2(o1[2], o1[3]), pk2(o1[4], o1[5]), pk2(o1[6], o1[7])};
#pragma unroll
            for (int b = 0; b < 3; ++b) { w0[b] = w2[b]; w1[b] = w3[b]; }
        }
    }
}
template <int PASS>
__device__ __forceinline__ void phase_mixer(const Args& a, LAS unsigned char* lds, int tid, int wave, int lane) {
    unsigned* ctr = (unsigned*)(a.ws + WS_BAR) + (PASS == 1 ? 3584 : 3648);
    volatile LAS int* slot = (volatile LAS int*)(lds + LDSCTL_OFF + 256);
    for (;;) {
        if (tid == 0) *slot = (int)__hip_atomic_fetch_add(ctr, 1u, __ATOMIC_RELAXED, __HIP_MEMORY_SCOPE_AGENT);
        __syncthreads();
        const int it = *slot;
        if (it >= NCHUNK + 4 * NCHUNK) break;
        asm volatile("" : "+v"(tid), "+v"(lane));
        if (it < NCHUNK) lru_item<PASS>(a, lds, it, tid, wave, lane);
        else { const int r = it - NCHUNK; ret_item<PASS>(a, lds, r >> 2, r & 3, tid, wave, lane); }
    }
}

__global__ void __launch_bounds__(512, 2) fwd(Args a) {
    extern __shared__ __attribute__((aligned(16))) unsigned char lds_raw[];
    LAS unsigned char* lds = (LAS unsigned char*)lds_raw;
    unsigned char* ws = a.ws;
    int tid = threadIdx.x, lane = tid & 63; const int wave = __builtin_amdgcn_readfirstlane(tid >> 6);
#define FRESH() do { tid = threadIdx.x; asm volatile("" : "+v"(tid)); lane = tid & 63; } while (0)
    for (int u = tid; u < (LDS_BYTES - LDSCTL_OFF) / 4; u += 512) ((LAS unsigned*)(lds + LDSCTL_OFF))[u] = 0u;
    __syncthreads();
    const XcdBarrier bar = xcd_barrier_post((unsigned*)(ws + WS_BAR), (volatile LAS unsigned*)(lds + LDSCTL_OFF + 64));
    const float* MOD = (const float*)(ws + WS_MOD);
    const int G = gridDim.x;
    const int lo = a.ph_lo, hi = a.ph_hi;
#ifndef PHMASK
#define PHMASK 0xffff
#endif
#define IN(k) ((((PHMASK) >> (k)) & 1) && lo <= (k) && (k) < hi)
#ifndef REPMASK
#define REPMASK 0u
#endif
#define NREP(k) ((((REPMASK) >> (k)) & 1u) ? 2 : 1)
#define SEAM(k) do { if (IN(k) && IN((k) + 1)) xcd_barrier(bar); } while (0)
    FRESH();
    for (int rep = 0; rep < NREP(0); ++rep) if (IN(0)) phase_prologue(a, lds, tid, wave, lane);
    if (IN(0) && IN(1)) { cg::grid_group grid = cg::this_grid(); grid.sync(); }
    FRESH();
    for (int rep = 0; rep < NREP(1); ++rep) if (IN(1)) phase_rownorm<0>(a.in[0], a.in[1], a.in[8], MOD + 1024, MOD + 0, (bf16*)(ws + WS_XN), nullptr, wave, lane);
    SEAM(1);
    FRESH();
    for (int rep = 0; rep < NREP(2); ++rep) if (IN(2)) { pg8::Gemm g{(const bf16*)(ws + WS_XN), (const bf16*)(ws + WS_WIN), TT, INW, DM}; pg8::StaticOrder S; S.init(TT, INW, G, (int)blockIdx.x);
        pg8::EpiBf16<0> E{(bf16*)(ws + WS_PROJ), INW, nullptr, 0, 0, 1.f};
        pg8::gemm_phase<pg8::EpiBf16<0>, pg8::StaticOrder, true, true>(lds, g, S, E); }
    SEAM(2);
    FRESH();
    for (int rep = 0; rep < NREP(3); ++rep) if (IN(3)) phase_mixer<1>(a, lds, tid, wave, lane);
    SEAM(3);
    FRESH();
    for (int rep = 0; rep < NREP(4); ++rep) if (IN(4)) phase_carries(a, tid);
    SEAM(4);
    FRESH();
    for (int rep = 0; rep < NREP(5); ++rep) if (IN(5)) phase_mixer<3>(a, lds, tid, wave, lane);
    SEAM(5);
    FRESH();
    for (int rep = 0; rep < NREP(6); ++rep) if (IN(6)) { pg8::Gemm g{(const bf16*)(ws + WS_Y), (const bf16*)(ws + WS_WOUT), TT, DM, DM}; pg8::StaticOrder S; S.init(TT, DM, G, (int)blockIdx.x);
        pg8::EpiBf16<0> E{(bf16*)(ws + WS_KVT), DM, nullptr, 0, 0, 1.f};
        pg8::gemm_phase<pg8::EpiBf16<0>, pg8::StaticOrder, true, true>(lds, g, S, E); }
    SEAM(6);
    FRESH();
    for (int rep = 0; rep < NREP(7); ++rep) if (IN(7)) phase_resnorm<0>(a.in[0], a.in[1], (const bf16*)(ws + WS_KVT), MOD + 2048, a.out, a.in[28], MOD + 4096, MOD + 3072, (bf16*)(ws + WS_XN), nullptr, wave, lane);
    SEAM(7);
#pragma unroll
    for (int half = 0; half < 2; ++half) {
        FRESH();
        if (IN(8 + 2 * half)) { pg8::Gemm g{(const bf16*)(ws + WS_XN) + (size_t)half * HALF_T * DM, (const bf16*)(ws + WS_WGU), HALF_T, FF2, DM}; pg8::StaticOrder S; S.init(HALF_T, FF2, G, (int)blockIdx.x);
            pg8::EpiBf16<0> E{(bf16*)(ws + WS_GH), FF, nullptr, FF, (size_t)((WS_U - WS_GH) / 2) + (size_t)half * HALF_T * FF, 1.f};
            pg8::gemm_phase<pg8::EpiBf16<0>, pg8::StaticOrder, true, true>(lds, g, S, E); }
        SEAM(8 + 2 * half);
        FRESH();
        if (IN(9 + 2 * half)) phase_act(a, half, wave, lane);
        SEAM(9 + 2 * half);
    }
    FRESH();
    for (int rep = 0; rep < NREP(12); ++rep) if (IN(12)) { pg8::Gemm g{(const bf16*)(ws + WS_U), (const bf16*)(ws + WS_WD), TT, DM, FF}; pg8::StaticOrder S; S.init(TT, DM, G, (int)blockIdx.x);
        pg8::EpiBf16<0> E{(bf16*)(ws + WS_XN), DM, nullptr, 0, 0, 1.f};
        pg8::gemm_phase<pg8::EpiBf16<0>, pg8::StaticOrder, true, true>(lds, g, S, E); }
    SEAM(12);
    FRESH();
    if (IN(13)) phase_resnorm<1>(a.out, a.out + (size_t)TP * DM, (const bf16*)(ws + WS_XN), MOD + 5120, nullptr, a.in[34], nullptr, nullptr, nullptr, a.out, wave, lane);
#undef IN
#undef SEAM
}

extern "C" void kernel_launch(void* const* d_in, const int* in_sizes, int n_in, void* d_out, int out_size,
                              void* d_ws, size_t ws_size, hipStream_t stream) {
    static int grid = 0;
    if (grid == 0) {
        int dev = 0, cus = 0, per_cu = 0;
        hipGetDevice(&dev);
        hipDeviceGetAttribute(&cus, hipDeviceAttributeMultiprocessorCount, dev);
        hipFuncSetAttribute((const void*)fwd, hipFuncAttributeMaxDynamicSharedMemorySize, LDS_BYTES);
        hipOccupancyMaxActiveBlocksPerMultiprocessor(&per_cu, (const void*)fwd, 512, LDS_BYTES);
        if (per_cu < 1) per_cu = 1;
        grid = cus * per_cu;
        if (n_in != 35 || ws_size < WS_END) fprintf(stderr, "kernel_launch: unexpected n_in %d / ws_size %zu\n", n_in, ws_size);
    }
    if (hipMemsetAsync((char*)d_ws + WS_BAR, 0, 16384, stream) != hipSuccess) fprintf(stderr, "kernel_launch: memset failed\n");
    Args a{};
    for (int i = 0; i < 35; ++i) a.in[i] = (const float*)d_in[i];
    a.out = (float*)d_out; a.ws = (unsigned char*)d_ws; a.ph_lo = 0; a.ph_hi = 14;
    void* args[] = {&a};
    hipError_t e = hipLaunchCooperativeKernel((const void*)fwd, dim3(grid), dim3(512), args, LDS_BYTES, stream);
    if (e != hipSuccess) fprintf(stderr, "cooperative launch failed: %s (grid %d)\n", hipGetErrorString(e), grid);
}
```

```cpp
#include <hip/hip_runtime.h>
#include <hip/hip_cooperative_groups.h>
#include <cstdio>
#include <cstdint>
namespace cg = cooperative_groups;
namespace pg8 {
#define PG8_LAS __attribute__((address_space(3)))
typedef unsigned short bf16_t;
typedef short bf16x8 __attribute__((ext_vector_type(8)));
typedef float f32x4 __attribute__((ext_vector_type(4)));
typedef unsigned u32x4 __attribute__((ext_vector_type(4)));
constexpr int BM = 256, BK = 64, HALF = 128, HTB = HALF * BK * 2  , STAGE_BYTES = 8 * HTB, NXCD = 8, WGM = 8;

__host__ __device__ __forceinline__ int lds_byte(int r, int c) { const int st = (r >> 4) * 2 + (c >> 5), rr = r & 15, cc = c & 31, ob = rr * 64 + cc * 2; return st * 1024 + (ob ^ (((ob >> 9) & 1) << 5)); }
__host__ __device__ __forceinline__ void stage_rc(int b, int& R, int& C) { const int st = b / 1024, sb = b % 1024, swz = sb ^ (((sb >> 9) & 1) << 5); R = (st >> 1) * 16 + swz / 64; C = (st & 1) * 32 + (swz % 64) / 2; }
__host__ __device__ __forceinline__ int perm32(int rho) { const int n = rho >> 4, i = rho & 15; return 8 * (i >> 2) + 4 * n + (i & 3); }

struct Unit { int pm, pn; };
struct Gemm { const bf16_t* A; const bf16_t* Bt; int M, N, K; int ld = 0; };

struct StaticOrder {
    int nM, nN, nwg, G, c;
    __host__ __device__ void init(int M, int N, int G_, int c_) { nM = M / BM; nN = N / BM; nwg = nM * nN; G = G_; c = c_; }
    __host__ __device__ bool next(int i, Unit& u) const {
        const long L = (long)i * G + c; if (L >= nwg) return false;
        int wgid = (int)L; { const int q = nwg / NXCD, r = nwg % NXCD, xcd = wgid % NXCD, off = wgid / NXCD; wgid = (xcd < r ? xcd * (q + 1) : r * (q + 1) + (xcd - r) * q) + off; }
        const int nig = WGM * nN, gid = wgid / nig, fm = gid * WGM, gsz = (nM - fm) < WGM ? (nM - fm) : WGM;
        u.pm = fm + ((wgid % nig) % gsz); u.pn = (wgid % nig) / gsz; return true;
    }
    __device__ __forceinline__ void a_ready(const Unit&) const {}
    __device__ __forceinline__ void done(const Unit&) const {}
};

__device__ __forceinline__ unsigned cvt_pk_bf16(float lo, float hi) { unsigned r; asm volatile("v_cvt_pk_bf16_f32 %0, %1, %2" : "=v"(r) : "v"(lo), "v"(hi)); return r; }
typedef float f32x2 __attribute__((ext_vector_type(2)));
__device__ __forceinline__ f32x2 gelu_pk(f32x2 v) {
    const f32x2 av = __builtin_elementwise_abs(v), d = av * 0.2316418882f + 1.0f;
    f32x2 t; t.x = __builtin_amdgcn_rcpf(d.x); t.y = __builtin_amdgcn_rcpf(d.y);
    f32x2 q = t * 0.5307027145f + (-0.7265760135f); q = q * t + 0.7107068705f; q = q * t + (-0.142248368f); q = q * t + 0.127414796f; q = q * t;
    const f32x2 s = (v * v) * (-0.72134752044f);
    f32x2 e; e.x = __builtin_amdgcn_exp2f(s.x); e.y = __builtin_amdgcn_exp2f(s.y);
    const f32x2 m = v * (q * e), r = v - m;
    f32x2 o; o.x = v.x < 0.f ? m.x : r.x; o.y = v.y < 0.f ? m.y : r.y; return o;
}

template <int ACT  > struct EpiBf16 {
    static constexpr bool PERM = true, AFTER_DRAIN = false; static_assert(ACT == 0 || ACT == 1, "EpiBf16: ACT is 0 (none) or 1 (gelu_pk)");
    bf16_t* O; int ldc; const float* bias; int split_cols; size_t split_stride; float scale0;
    __device__ __forceinline__ void operator()(const f32x4 (&acc)[2][2][4][2], const Unit& u, int wr, int wc, int fr, int fq) const {
        const int row0 = u.pm * BM + wr * 64 + fr; int colt = u.pn * BM; bf16_t* base = O;
        float sc = 1.f; if (split_cols) { const int t = colt / split_cols; base += (size_t)t * split_stride; colt -= t * split_cols; if (t == 0) sc = scale0; }
        const int col0 = colt + wc * 32 + 8 * fq, bcol0 = u.pn * BM + wc * 32 + 8 * fq;
        f32x4 bv[2][2];
#pragma unroll
        for (int bj = 0; bj < 2; ++bj)
#pragma unroll
            for (int n = 0; n < 2; ++n) bv[bj][n] = bias ? *(const f32x4*)(bias + bcol0 + bj * HALF + 4 * n) : (f32x4){0.f, 0.f, 0.f, 0.f};
#pragma unroll
        for (int ai = 0; ai < 2; ++ai)
#pragma unroll
            for (int m = 0; m < 4; ++m) { bf16_t* rowp = base + (size_t)(row0 + ai * HALF + m * 16) * ldc + col0;
#pragma unroll
                for (int bj = 0; bj < 2; ++bj) { f32x4 v0 = acc[ai][bj][m][0] + bv[bj][0], v1 = acc[ai][bj][m][1] + bv[bj][1];
                    if (ACT == 1) { f32x2 a = gelu_pk((f32x2){v0[0], v0[1]}), b = gelu_pk((f32x2){v0[2], v0[3]}), c = gelu_pk((f32x2){v1[0], v1[1]}), d = gelu_pk((f32x2){v1[2], v1[3]});
                        v0 = (f32x4){a.x, a.y, b.x, b.y}; v1 = (f32x4){c.x, c.y, d.x, d.y}; }
                    v0 = v0 * sc; v1 = v1 * sc; u32x4 w; w.x = cvt_pk_bf16(v0[0], v0[1]); w.y = cvt_pk_bf16(v0[2], v0[3]); w.z = cvt_pk_bf16(v1[0], v1[1]); w.w = cvt_pk_bf16(v1[2], v1[3]);
                    *(u32x4*)(rowp + bj * HALF) = w; } }
    }
};
template <class Epi, class Sched, bool ALIGN_EPI = false, bool SP2 = false>
__device__ __forceinline__ void gemm_phase(PG8_LAS unsigned char* lds, const Gemm g, const Sched& S, const Epi& E) {
    int tid_ = threadIdx.x; asm volatile("" : "+v"(tid_));
    const int tid = tid_, wid = __builtin_amdgcn_readfirstlane(tid >> 6), lane = tid & 63, wr = wid >> 2, wc = wid & 3, fr = lane & 15, fq = lane >> 4;
    const int K = g.K, nt = K / BK, LD = g.ld ? g.ld : g.K;
    unsigned voffA[2], voffB[2];
#pragma unroll
    for (int i = 0; i < 2; ++i) { int R, C; stage_rc(tid * 16 + i * 8192, R, C); const int Rb = Epi::PERM ? ((R & ~31) + perm32(R & 31)) : R;
        voffA[i] = (unsigned)(R * LD + C) * 2u; voffB[i] = (unsigned)(Rb * LD + C) * 2u; }
    const size_t kstep = (size_t)(BK * 2);
    const size_t hstep = (size_t)HALF * LD * 2;
    const size_t tstep = 2 * hstep;
    const unsigned ldsw = (unsigned)wid * 1024u;
    const int aoff = lds_byte(wr * 64 + fr, fq * 8), boff = lds_byte(wc * 32 + fr, fq * 8);
#define PG8_SA(b, h) (((b) * 2 + (h)) * HTB)
#define PG8_SB(b, h) ((4 + (b) * 2 + (h)) * HTB)
#define PG8_STAGE(bufoff, gbase, voff) do { _Pragma("unroll") for (int _i = 0; _i < 2; ++_i) \
        __builtin_amdgcn_global_load_lds((const unsigned*)((const char*)(gbase) + (voff)[_i]), (PG8_LAS unsigned*)(lds + (bufoff) + ldsw + _i * 8192), 16, 0, 0); } while (0)
#define PG8_LDA(dst, b, h) do { _Pragma("unroll") for (int m = 0; m < 4; ++m) _Pragma("unroll") for (int k = 0; k < 2; ++k) dst[m][k] = *(const PG8_LAS bf16x8*)(lds + PG8_SA(b, h) + aoff + m * 2048 + k * 1024); } while (0)
#define PG8_LDB(dst, b, h) do { _Pragma("unroll") for (int n = 0; n < 2; ++n) _Pragma("unroll") for (int k = 0; k < 2; ++k) dst[n][k] = *(const PG8_LAS bf16x8*)(lds + PG8_SB(b, h) + boff + n * 2048 + k * 1024); } while (0)
#define PG8_MMA(ai, bj, At, Bt) do { __builtin_amdgcn_s_setprio(1); _Pragma("unroll") for (int m = 0; m < 4; ++m) _Pragma("unroll") for (int n = 0; n < 2; ++n) _Pragma("unroll") for (int k = 0; k < 2; ++k) \
        acc[ai][bj][m][n] = __builtin_amdgcn_mfma_f32_16x16x32_bf16(Bt[n][k], At[m][k], acc[ai][bj][m][n], 0, 0, 0); __builtin_amdgcn_s_setprio(0); } while (0)
#define PG8_WAIT_V(n) asm volatile("s_waitcnt vmcnt(" #n ")" ::: "memory")
#define PG8_WAIT_L(n) asm volatile("s_waitcnt lgkmcnt(" #n ")" ::: "memory")
#define PG8_BAR __builtin_amdgcn_s_barrier()
#define PG8_SCHED __builtin_amdgcn_sched_barrier(0)
    Unit cur, nxt; int ui = 0;
    if (!S.next(0, cur)) return;
    f32x4 acc[2][2][4][2];
#pragma unroll
    for (int a = 0; a < 2; ++a)
#pragma unroll
        for (int b = 0; b < 2; ++b)
#pragma unroll
            for (int m = 0; m < 4; ++m)
#pragma unroll
                for (int n = 0; n < 2; ++n) acc[a][b][m][n] = (f32x4){0.f, 0.f, 0.f, 0.f};
    bf16x8 At[4][2], B0[2][2], B1[2][2];
    const char* cA = (const char*)g.A + (size_t)cur.pm * tstep; const char* cB = (const char*)g.Bt + (size_t)cur.pn * tstep;
    S.a_ready(cur);
    if constexpr (SP2) {
        PG8_STAGE(PG8_SB(0, 0), cB, voffB); PG8_STAGE(PG8_SB(0, 1), cB + hstep, voffB); PG8_STAGE(PG8_SA(0, 0), cA, voffA); PG8_STAGE(PG8_SA(0, 1), cA + hstep, voffA);
        if (wr == 1) PG8_BAR;
        PG8_WAIT_V(2); PG8_BAR;
        PG8_STAGE(PG8_SB(1, 0), cB + kstep, voffB); PG8_STAGE(PG8_SA(1, 0), cA + kstep, voffA); PG8_STAGE(PG8_SB(1, 1), cB + hstep + kstep, voffB);
        PG8_WAIT_V(6); PG8_BAR;
    } else {
        PG8_STAGE(PG8_SB(0, 0), cB, voffB); PG8_STAGE(PG8_SA(0, 0), cA, voffA); PG8_STAGE(PG8_SB(0, 1), cB + hstep, voffB); PG8_STAGE(PG8_SA(0, 1), cA + hstep, voffA);
        if (wr == 1) PG8_BAR;
        PG8_WAIT_V(4); PG8_BAR;
        PG8_STAGE(PG8_SB(1, 0), cB + kstep, voffB); PG8_STAGE(PG8_SA(1, 0), cA + kstep, voffA); PG8_STAGE(PG8_SB(1, 1), cB + hstep + kstep, voffB);
        PG8_WAIT_V(6); PG8_BAR;
    }
    for (;;) {
        const bool has_next = S.next(ui + 1, nxt);
        const char* nA = has_next ? (const char*)g.A + (size_t)nxt.pm * tstep : cA; const char* nB = has_next ? (const char*)g.Bt + (size_t)nxt.pn * tstep : cB;
        for (int t = 0; t < nt; t += 2) {
            const bool last = (t == nt - 2);
            const char* a1 = cA + (size_t)(t + 1) * kstep;
            const char* a2 = last ? nA : cA + (size_t)(t + 2) * kstep; const char* b2 = last ? nB : cB + (size_t)(t + 2) * kstep;
            const char* a3 = a2 + kstep; const char* b3 = b2 + kstep;
            if (last && has_next) S.a_ready(nxt);
            if constexpr (SP2) {
            PG8_LDB(B0, 0, 0); PG8_LDB(B1, 0, 1); PG8_SCHED; PG8_LDA(At, 0, 0); PG8_STAGE(PG8_SA(1, 1), a1 + hstep, voffA);
            PG8_WAIT_V(8); PG8_WAIT_L(0); PG8_BAR; PG8_MMA(0, 0, At, B0); PG8_MMA(0, 1, At, B1); PG8_BAR; PG8_SCHED;
            PG8_LDA(At, 0, 1); PG8_STAGE(PG8_SB(0, 0), b2, voffB); PG8_STAGE(PG8_SB(0, 1), b2 + hstep, voffB); PG8_STAGE(PG8_SA(0, 0), a2, voffA);
            PG8_WAIT_V(8); PG8_WAIT_L(0); PG8_BAR; PG8_MMA(1, 0, At, B0); PG8_MMA(1, 1, At, B1); PG8_BAR; PG8_SCHED;
            PG8_LDB(B0, 1, 0); PG8_LDB(B1, 1, 1); PG8_SCHED; PG8_LDA(At, 1, 0); PG8_STAGE(PG8_SA(0, 1), a2 + hstep, voffA);
            PG8_WAIT_V(8); PG8_WAIT_L(0); PG8_BAR; PG8_MMA(0, 0, At, B0); PG8_MMA(0, 1, At, B1); PG8_BAR; PG8_SCHED;
            PG8_LDA(At, 1, 1); PG8_STAGE(PG8_SB(1, 0), b3, voffB); PG8_STAGE(PG8_SB(1, 1), b3 + hstep, voffB); PG8_STAGE(PG8_SA(1, 0), a3, voffA);
            PG8_WAIT_V(8); PG8_WAIT_L(0); PG8_BAR; PG8_MMA(1, 0, At, B0); PG8_MMA(1, 1, At, B1); PG8_BAR; PG8_SCHED;
            } else {
            PG8_LDB(B0, 0, 0); PG8_SCHED; PG8_LDA(At, 0, 0); PG8_STAGE(PG8_SA(1, 1), a1 + hstep, voffA);
            PG8_WAIT_L(8); PG8_BAR; PG8_WAIT_L(0); PG8_MMA(0, 0, At, B0); PG8_BAR; PG8_SCHED;
            PG8_LDB(B1, 0, 1); PG8_STAGE(PG8_SB(0, 0), b2, voffB);
            PG8_BAR; PG8_WAIT_L(0); PG8_MMA(0, 1, At, B1); PG8_BAR;
            PG8_LDA(At, 0, 1); PG8_STAGE(PG8_SA(0, 0), a2, voffA);
            PG8_BAR; PG8_WAIT_L(0); PG8_MMA(1, 0, At, B0); PG8_BAR; PG8_SCHED;
            PG8_STAGE(PG8_SB(0, 1), b2 + hstep, voffB);
            PG8_WAIT_V(6); PG8_BAR; PG8_MMA(1, 1, At, B1); PG8_BAR;
            PG8_LDB(B0, 1, 0); PG8_SCHED; PG8_LDA(At, 1, 0); PG8_STAGE(PG8_SA(0, 1), a2 + hstep, voffA);
            PG8_WAIT_L(8); PG8_BAR; PG8_WAIT_L(0); PG8_MMA(0, 0, At, B0); PG8_BAR; PG8_SCHED;
            PG8_LDB(B1, 1, 1); PG8_STAGE(PG8_SB(1, 0), b3, voffB);
            PG8_BAR; PG8_WAIT_L(0); PG8_MMA(0, 1, At, B1); PG8_BAR;
            PG8_LDA(At, 1, 1); PG8_STAGE(PG8_SA(1, 0), a3, voffA);
            PG8_BAR; PG8_WAIT_L(0); PG8_MMA(1, 0, At, B0); PG8_BAR; PG8_SCHED;
            PG8_STAGE(PG8_SB(1, 1), b3 + hstep, voffB);
            PG8_WAIT_V(6); PG8_BAR; PG8_MMA(1, 1, At, B1); PG8_BAR;
            }
        }
        if constexpr (ALIGN_EPI) { if (wr == 0) PG8_BAR; }
        if constexpr (!Epi::AFTER_DRAIN) { E(acc, cur, wr, wc, fr, fq); S.done(cur); }
        if (!has_next) break;
#pragma unroll
        for (int a = 0; a < 2; ++a)
#pragma unroll
            for (int b = 0; b < 2; ++b)
#pragma unroll
                for (int m = 0; m < 4; ++m)
#pragma unroll
                    for (int n = 0; n < 2; ++n) acc[a][b][m][n] = (f32x4){0.f, 0.f, 0.f, 0.f};
        cur = nxt; cA = nA; cB = nB; ++ui;
        if constexpr (ALIGN_EPI) { if (wr == 1) PG8_BAR; }
    }
    PG8_WAIT_V(0);
    if constexpr (!ALIGN_EPI) { if (wr == 0) PG8_BAR; }
    PG8_BAR;
    if constexpr (Epi::AFTER_DRAIN) { E.fused(acc, cur, wr, wc, fr, fq, lds, wid, lane); S.done(cur); }
#undef PG8_SA
#undef PG8_SB
#undef PG8_STAGE
#undef PG8_LDA
#undef PG8_LDB
#undef PG8_MMA
#undef PG8_WAIT_V
#undef PG8_WAIT_L
#undef PG8_BAR
#undef PG8_SCHED
}
}
namespace pg8 {
struct EpiRes {
    static constexpr bool PERM = false, AFTER_DRAIN = false;
    const float* xp; const float* xs;
    float* out; const float* gate;
    __device__ __forceinline__ void operator()(const f32x4 (&acc)[2][2][4][2], const Unit& u, int wr, int wc, int fr, int fq) const {
        const int row0 = u.pm * BM + wr * 64 + fr, col0 = u.pn * BM + wc * 32 + 4 * fq;
        const int v = (u.pm * BM < 8192) ? 0 : 1 + ((u.pm * BM - 8192) >> 12);
        const float* g = gate + (size_t)v * 6144 + col0;
        f32x4 gv[2][2];
#pragma unroll
        for (int bj = 0; bj < 2; ++bj)
#pragma unroll
            for (int n = 0; n < 2; ++n) gv[bj][n] = *(const f32x4*)(g + bj * HALF + n * 16);
#pragma unroll
        for (int ai = 0; ai < 2; ++ai)
#pragma unroll
            for (int m = 0; m < 4; ++m) {
                const int row = row0 + ai * HALF + m * 16;
                const float* bp = (row < 8192 ? xp + (size_t)row * 1024 : xs + (size_t)(row - 8192) * 1024) + col0;
                float* op = out + (size_t)row * 1024 + col0;
#pragma unroll
                for (int bj = 0; bj < 2; ++bj)
#pragma unroll
                    for (int n = 0; n < 2; ++n) { const f32x4 b = *(const f32x4*)(bp + bj * HALF + n * 16); *(f32x4*)(op + bj * HALF + n * 16) = b + gv[bj][n] * acc[ai][bj][m][n]; }
            }
    }
};
}

constexpr int DM = 1024, TP = 8192, TSMP = 32768, TT = 40960, INW = 3072, FF = 2816, FF2 = 5632;
constexpr int NCHUNK = 320, HALF_T = 20480;
constexpr int OFF_LF = 41943040, OFF_LB = OFF_LF + 16384, OFF_RF = OFF_LB + 16384, OFF_RB = OFF_RF + 2097152;
constexpr size_t MiB = 1u << 20;
constexpr size_t WS_MOD = 0, WS_WL = 256 * 1024, WS_AGG = 1 * MiB, WS_CAR = 3 * MiB + 512 * 1024;
constexpr size_t WS_WIN = 5 * MiB, WS_WOUT = 11 * MiB, WS_WGU = 13 * MiB, WS_WD = 24 * MiB;
constexpr size_t WS_XN = 30 * MiB, WS_SB = 30 * MiB, WS_PROJ = 110 * MiB, WS_Y = 350 * MiB, WS_KVT = 430 * MiB;
constexpr size_t WS_GH = 110 * MiB, WS_U = 220 * MiB, WS_END = 510 * MiB;
constexpr int LDS_BYTES = 147456, LDSCTL_OFF = 143360;
constexpr size_t WS_BAR = 768 * 1024;
constexpr int NWAVES = 8;

#define GAS __attribute__((address_space(1)))
#define LAS __attribute__((address_space(3)))
typedef unsigned short bf16;
typedef unsigned v4u __attribute__((ext_vector_type(4)));
typedef unsigned v2u __attribute__((ext_vector_type(2)));
typedef float f32x4 __attribute__((ext_vector_type(4)));
typedef short bf16x8 __attribute__((ext_vector_type(8)));
#define LDS_WAIT() asm volatile("s_waitcnt lgkmcnt(0)" ::: "memory")
typedef float f32x2_t __attribute__((ext_vector_type(2)));
typedef __bf16 bf16x2_t __attribute__((ext_vector_type(2)));
__device__ __forceinline__ unsigned pk2(float lo, float hi) { const f32x2_t v = {lo, hi}; const bf16x2_t b = __builtin_convertvector(v, bf16x2_t); return __builtin_bit_cast(unsigned, b); }
__device__ __forceinline__ unsigned f2bf(float f) { return pk2(f, 0.f) & 0xffffu; }

__device__ __forceinline__ float bflo(unsigned w) { return __builtin_bit_cast(float, w << 16); }
__device__ __forceinline__ float bfhi(unsigned w) { return __builtin_bit_cast(float, w & 0xffff0000u); }
__device__ __forceinline__ float bf2f(unsigned short h) { return __builtin_bit_cast(float, ((unsigned)h) << 16); }
__device__ __forceinline__ float sigmoidf_(float x) { return 1.0f / (1.0f + __expf(-x)); }
__device__ __forceinline__ float siluf_(float x) { return x * __builtin_amdgcn_rcpf(1.0f + __builtin_amdgcn_exp2f(-1.4426950408889634f * x)); }
__device__ __forceinline__ float gelu_tanh(float x) { const float z = x * fmaf(0.044715f * x, x, 1.0f); return x * __builtin_amdgcn_rcpf(1.0f + __builtin_amdgcn_exp2f(-2.302208198f * z)); }

struct Args { const float* in[35]; float* out; unsigned char* ws; int ph_lo, ph_hi; };

#define XB_TMO      128
#define XB_XCNT(j)  (256  + 64 * (j))
#define XB_XSUB(j)  (1280 + 64 * (j))
#define XB_XGEN(j)  (2304 + 64 * (j))
#define XB_TOP      3328
#define XB_TOPGEN   3392
#define XCD_BAR_WORDS 3456
#define XB_SPIN_CAP (1u << 18)

__device__ __forceinline__ unsigned xb_ld(unsigned* p)              { return __hip_atomic_load(p, __ATOMIC_RELAXED, __HIP_MEMORY_SCOPE_AGENT); }
__device__ __forceinline__ unsigned xb_add(unsigned* p, unsigned v) { return __hip_atomic_fetch_add(p, v, __ATOMIC_RELAXED, __HIP_MEMORY_SCOPE_AGENT); }
__device__ __forceinline__ unsigned xb_xcc_id() { return (unsigned)__builtin_amdgcn_s_getreg((3 << 11) | 20) & 0xFu; }
#define XB_SPIN(cond, bar) do { unsigned _sp = 0; while (cond) { __builtin_amdgcn_s_sleep(1); \
    if ((++_sp & 255u) == 0u) { if (xb_ld(&(bar)[XB_TMO])) break; if (_sp > XB_SPIN_CAP) { atomicAdd(&(bar)[XB_TMO], 1u); break; } } } } while (0)

struct XcdBarrier {
    unsigned* bar; unsigned x;
    volatile LAS unsigned* st;
};

__device__ __forceinline__ XcdBarrier xcd_barrier_post(unsigned* bar, volatile LAS unsigned* st) {
    XcdBarrier b; b.bar = bar; b.x = xb_xcc_id(); b.st = st;
    if (threadIdx.x == 0) (void)xb_add(&bar[XB_XCNT(b.x)], 1u);
    return b;
}
__device__ __forceinline__ void xcd_barrier_complete(unsigned* bar, unsigned x, unsigned& nloc, unsigned& nx) {
    const unsigned G = gridDim.x * gridDim.y * gridDim.z;
    unsigned sum, cnt, mine, sp = 0u;
    for (;;) {
        sum = 0u; cnt = 0u; mine = 0u;
#pragma unroll
        for (unsigned j = 0; j < 16; ++j) { const unsigned c = xb_ld(&bar[XB_XCNT(j)]); sum += c; cnt += (c > 0u) ? 1u : 0u; mine = (j == x) ? c : mine; }
        if (sum == G) break;
        __builtin_amdgcn_s_sleep(1);
        if ((++sp & 255u) == 0u) { if (xb_ld(&bar[XB_TMO])) break; if (sp > XB_SPIN_CAP) { atomicAdd(&bar[XB_TMO], 1u); break; } }
    }
    nloc = mine > 0u ? mine : 1u; nx = cnt > 0u ? cnt : 1u;
}

__device__ __forceinline__ void xcd_barrier(const XcdBarrier& b) {
    asm volatile("s_waitcnt vmcnt(0)" ::: "memory");
    __syncthreads();
    if (threadIdx.x == 0) {
        unsigned* bar = b.bar;
        __builtin_amdgcn_s_waitcnt(0);
        unsigned nloc = b.st[0], nx = b.st[1];
        if (nloc == 0u) { xcd_barrier_complete(bar, b.x, nloc, nx); b.st[0] = nloc; b.st[1] = nx; }
        const unsigned old = xb_add(&bar[XB_XSUB(b.x)], 1u);
        const unsigned gen = old / nloc;
        if (old + 1u == (gen + 1u) * nloc) {
            __builtin_amdgcn_fence(__ATOMIC_RELEASE, "agent");
            asm volatile("s_waitcnt vmcnt(0)" ::: "memory");
            const unsigned og = xb_add(&bar[XB_TOP], 1u);
            const unsigned tg = og / nx;
            if (og + 1u == (tg + 1u) * nx) xb_add(&bar[XB_TOPGEN], 1u);
            else XB_SPIN(xb_ld(&bar[XB_TOPGEN]) == tg, bar);
            __builtin_amdgcn_fence(__ATOMIC_ACQUIRE, "agent");
            xb_add(&bar[XB_XGEN(b.x)], 1u);
            asm volatile("s_waitcnt vmcnt(0)" ::: "memory");
        } else {
            XB_SPIN(xb_ld(&bar[XB_XGEN(b.x)]) == gen, bar);
            __builtin_amdgcn_fence(__ATOMIC_ACQUIRE, "agent");
            asm volatile("s_waitcnt vmcnt(0)" ::: "memory");
        }
    }
    __syncthreads();
}
__device__ __forceinline__ float wave_sum(float v) {
#pragma unroll
    for (int o = 1; o < 64; o <<= 1) v += __shfl_xor(v, o);
    return v;
}
__device__ __forceinline__ void p0_transpose_item(const float* W, int K, int N, bf16* WT, int row_off, LAS float* scr, int item, int lane) {
    const int nblk = N / 32, kb = item / nblk, nb = item % nblk, k0 = 64 * kb, n0 = 32 * nb;
#pragma unroll 8
    for (int i = 0; i < 32; ++i) { const int kk = 2 * i + (lane >> 5); scr[kk * 33 + (lane & 31)] = W[(size_t)(k0 + kk) * N + n0 + (lane & 31)]; }
    LDS_WAIT(); asm volatile("" ::: "memory");
    const int c = lane & 7;
#pragma unroll
    for (int j = 0; j < 4; ++j) { const int n = (lane >> 3) + 8 * j; const LAS float* s = scr + (8 * c) * 33 + n;
        v4u o; o.x = pk2(s[0 * 33], s[1 * 33]); o.y = pk2(s[2 * 33], s[3 * 33]); o.z = pk2(s[4 * 33], s[5 * 33]); o.w = pk2(s[6 * 33], s[7 * 33]);
        *(v4u*)(WT + (size_t)(row_off + n0 + n) * K + k0 + 8 * c) = o; }
    LDS_WAIT(); asm volatile("" ::: "memory");
}
__device__ __forceinline__ int mod_index(int row) { return row < TP ? 0 : 1 + ((row - TP) >> 12); }

__device__ __forceinline__ void phase_prologue(const Args& a, LAS unsigned char* lds, int tid, int wave, int lane) {
    unsigned char* ws = a.ws;
    if (blockIdx.x < 96) {
        LAS float* sc = (LAS float*)lds;
        LAS float* red = (LAS float*)(lds + 9 * 1024 * 4);
        for (int i = tid; i < 9 * 1024; i += 512) { const int v = i >> 10, k = i & 1023; const float x = (v == 0) ? a.in[7][k] : a.in[6][(v - 1) * 1024 + k]; sc[i] = siluf_(x); }
        __syncthreads();
        const int col = blockIdx.x * 64 + lane;
        const float* wm = a.in[9] + col;
        float acc[9];
#pragma unroll
        for (int v = 0; v < 9; ++v) acc[v] = 0.f;
        const int kbeg = wave * 128;
#pragma unroll 8
        for (int kk = 0; kk < 128; ++kk) { const int k = kbeg + kk; const float wv = wm[(size_t)k * 6144];
#pragma unroll
            for (int v = 0; v < 9; ++v) acc[v] += sc[v * 1024 + k] * wv; }
#pragma unroll
        for (int v = 0; v < 9; ++v) red[(wave * 9 + v) * 64 + lane] = acc[v];
        __syncthreads();
        for (int i = tid; i < 9 * 64; i += 512) { const int v = i >> 6, l = i & 63; float s = 0.f;
#pragma unroll
            for (int w = 0; w < 8; ++w) s += red[(w * 9 + v) * 64 + l];
            const int cc = blockIdx.x * 64 + l; ((float*)(ws + WS_MOD))[v * 6144 + cc] = s + a.in[10][cc]; }
        __syncthreads();
    }
    LAS float* scr = (LAS float*)(lds + wave * 16384);
    const int gw = blockIdx.x * NWAVES + wave, NGW = gridDim.x * NWAVES;
    constexpr int I_IN = 16 * 96, I_OUT = 16 * 32, I_G = 16 * 88, I_D = 44 * 32, I_L = 64;
    constexpr int NITEMS = I_IN + I_OUT + 2 * I_G + I_D + I_L;
    for (int it = gw; it < NITEMS; it += NGW) {
        int r = it;
        if (r < I_IN) { p0_transpose_item(a.in[11], 1024, 3072, (bf16*)(ws + WS_WIN), 0, scr, r, lane); continue; } r -= I_IN;
        if (r < I_OUT) { p0_transpose_item(a.in[27], 1024, 1024, (bf16*)(ws + WS_WOUT), 0, scr, r, lane); continue; } r -= I_OUT;
        if (r < I_G) { p0_transpose_item(a.in[29], 1024, 2816, (bf16*)(ws + WS_WGU), 0, scr, r, lane); continue; } r -= I_G;
        if (r < I_G) { p0_transpose_item(a.in[30], 1024, 2816, (bf16*)(ws + WS_WGU), 2816, scr, r, lane); continue; } r -= I_G;
        if (r < I_D) { p0_transpose_item(a.in[33], 2816, 1024, (bf16*)(ws + WS_WD), 0, scr, r, lane); continue; } r -= I_D;
        { const int blk = r >> 1, sub = r & 1, mat = blk >> 3, nb = blk & 7;
          const float* src = (mat == 0 ? a.in[14] : mat == 1 ? a.in[16] : mat == 2 ? a.in[19] : a.in[21]) + nb * 4096;
          p0_transpose_item(src, 64, 64, (bf16*)(ws + WS_WL) + (size_t)(mat * 8 + nb) * 4096, 0, scr, sub, lane); }
    }
}

template <int MODE>
__device__ __forceinline__ void phase_rownorm(const float* xp, const float* xs, const float* w, const float* mod_scale, const float* mod_shift, bf16* obf, float* of32, int wave, int lane) {
    const int gw = blockIdx.x * NWAVES + wave, NGW = gridDim.x * NWAVES;
    f32x4 wv[4];
#pragma unroll
    for (int j = 0; j < 4; ++j) wv[j] = *(const f32x4*)(w + 4 * lane + 256 * j);
    for (int row0 = gw; row0 < TT; row0 += 2 * NGW) {
        const int row1 = row0 + NGW; const bool has1 = row1 < TT; const int r1 = has1 ? row1 : row0;
        const float* xr0 = (row0 < TP ? xp + (size_t)row0 * DM : xs + (size_t)(row0 - TP) * DM) + 4 * lane;
        const float* xr1 = (r1 < TP ? xp + (size_t)r1 * DM : xs + (size_t)(r1 - TP) * DM) + 4 * lane;
        f32x4 v0[4], v1[4]; float s0 = 0.f, s1 = 0.f;
#pragma unroll
        for (int j = 0; j < 4; ++j) { v0[j] = *(const f32x4*)(xr0 + 256 * j); v1[j] = *(const f32x4*)(xr1 + 256 * j); }
#pragma unroll
        for (int j = 0; j < 4; ++j) { s0 += (v0[j].x * v0[j].x + v0[j].y * v0[j].y) + (v0[j].z * v0[j].z + v0[j].w * v0[j].w); s1 += (v1[j].x * v1[j].x + v1[j].y * v1[j].y) + (v1[j].z * v1[j].z + v1[j].w * v1[j].w); }
        const float rs0 = 1.0f / sqrtf(wave_sum(s0) * (1.0f / DM) + 1e-6f), rs1 = 1.0f / sqrtf(wave_sum(s1) * (1.0f / DM) + 1e-6f);
#pragma unroll
        for (int k = 0; k < 2; ++k) {
            if (k == 1 && !has1) break;
            const int row = k ? row1 : row0; const float rstd = k ? rs1 : rs0;
            if (MODE == 0) {
                const int mv = mod_index(row);
                const float* sc = mod_scale + (size_t)mv * 6144 + 4 * lane; const float* sh = mod_shift + (size_t)mv * 6144 + 4 * lane;
                unsigned long long* o8 = (unsigned long long*)(obf + (size_t)row * DM) + lane;
#pragma unroll
                for (int j = 0; j < 4; ++j) { const f32x4 scv = *(const f32x4*)(sc + 256 * j), shv = *(const f32x4*)(sh + 256 * j);
                    const f32x4 y = (k ? v1[j] : v0[j]) * rstd * wv[j] * (scv + 1.0f) + shv;
                    o8[64 * j] = (unsigned long long)pk2(y.x, y.y) | ((unsigned long long)pk2(y.z, y.w) << 32); }
            } else {
                float* o = of32 + (size_t)row * DM + 4 * lane;
#pragma unroll
                for (int j = 0; j < 4; ++j) *(f32x4*)(o + 256 * j) = (k ? v1[j] : v0[j]) * rstd * wv[j];
            }
        }
    }
}

template <int MODE>
__device__ __forceinline__ void phase_resnorm(const float* xp, const float* xs, const bf16* tb, const float* gate, float* x1out, const float* w, const float* mod_scale, const float* mod_shift,
                                              bf16* obf, float* of32, int wave, int lane, const bf16* tbx = nullptr, int tbx_row0 = 0) {
    const int gw = blockIdx.x * NWAVES + wave, NGW = gridDim.x * NWAVES;
    f32x4 wv[4];
#pragma unroll
    for (int j = 0; j < 4; ++j) wv[j] = *(const f32x4*)(w + 4 * lane + 256 * j);
    for (int row0 = gw; row0 < TT; row0 += 2 * NGW) {
        const int row1 = row0 + NGW; const bool has1 = row1 < TT; const int r1 = has1 ? row1 : row0;
        const float* xr0 = (row0 < TP ? xp + (size_t)row0 * DM : xs + (size_t)(row0 - TP) * DM) + 4 * lane;
        const float* xr1 = (r1 < TP ? xp + (size_t)r1 * DM : xs + (size_t)(r1 - TP) * DM) + 4 * lane;
        const bf16* t0 = tb + (size_t)row0 * DM + 4 * lane; const bf16* t1 = tb + (size_t)r1 * DM + 4 * lane;
        f32x4 v0[4], v1[4]; v2u u0[4], u1[4];
#pragma unroll
        for (int j = 0; j < 4; ++j) { v0[j] = *(const f32x4*)(xr0 + 256 * j); v1[j] = *(const f32x4*)(xr1 + 256 * j); u0[j] = *(const v2u*)(t0 + 256 * j); u1[j] = *(const v2u*)(t1 + 256 * j); }
        const float* g0 = gate + (size_t)mod_index(row0) * 6144 + 4 * lane; const float* g1 = gate + (size_t)mod_index(r1) * 6144 + 4 * lane;
        v2u e0[4], e1[4]; const bool x0 = tbx && row0 >= tbx_row0, x1 = tbx && r1 >= tbx_row0;
#pragma unroll
        for (int j = 0; j < 4; ++j) { e0[j] = (v2u){0u, 0u}; e1[j] = (v2u){0u, 0u}; }
        if (x0) {
#pragma unroll
            for (int j = 0; j < 4; ++j) e0[j] = *(const v2u*)(tbx + (size_t)(row0 - tbx_row0) * DM + 4 * lane + 256 * j); }
        if (x1) {
#pragma unroll
            for (int j = 0; j < 4; ++j) e1[j] = *(const v2u*)(tbx + (size_t)(r1 - tbx_row0) * DM + 4 * lane + 256 * j); }
        float s0 = 0.f, s1 = 0.f;
#pragma unroll
        for (int j = 0; j < 4; ++j) { const f32x4 ga = *(const f32x4*)(g0 + 256 * j), gb = *(const f32x4*)(g1 + 256 * j);
            v0[j] = v0[j] + ga * ((f32x4){bflo(u0[j][0]), bfhi(u0[j][0]), bflo(u0[j][1]), bfhi(u0[j][1])} + (f32x4){bflo(e0[j][0]), bfhi(e0[j][0]), bflo(e0[j][1]), bfhi(e0[j][1])});
            v1[j] = v1[j] + gb * ((f32x4){bflo(u1[j][0]), bfhi(u1[j][0]), bflo(u1[j][1]), bfhi(u1[j][1])} + (f32x4){bflo(e1[j][0]), bfhi(e1[j][0]), bflo(e1[j][1]), bfhi(e1[j][1])});
            s0 += (v0[j].x * v0[j].x + v0[j].y * v0[j].y) + (v0[j].z * v0[j].z + v0[j].w * v0[j].w); s1 += (v1[j].x * v1[j].x + v1[j].y * v1[j].y) + (v1[j].z * v1[j].z + v1[j].w * v1[j].w); }
        const float rs0 = 1.0f / sqrtf(wave_sum(s0) * (1.0f / DM) + 1e-6f), rs1 = 1.0f / sqrtf(wave_sum(s1) * (1.0f / DM) + 1e-6f);
#pragma unroll
        for (int k = 0; k < 2; ++k) {
            if (k == 1 && !has1) break;
            const int row = k ? row1 : row0; const float rstd = k ? rs1 : rs0;
            if (x1out) { float* o = x1out + (size_t)row * DM + 4 * lane;
#pragma unroll
                for (int j = 0; j < 4; ++j) *(f32x4*)(o + 256 * j) = (k ? v1[j] : v0[j]); }
            if (MODE == 0) {
                const int mv = mod_index(row);
                const float* sc = mod_scale + (size_t)mv * 6144 + 4 * lane; const float* sh = mod_shift + (size_t)mv * 6144 + 4 * lane;
                unsigned long long* o8 = (unsigned long long*)(obf + (size_t)row * DM) + lane;
#pragma unroll
                for (int j = 0; j < 4; ++j) { const f32x4 scv = *(const f32x4*)(sc + 256 * j), shv = *(const f32x4*)(sh + 256 * j);
                    const f32x4 y = (k ? v1[j] : v0[j]) * rstd * wv[j] * (scv + 1.0f) + shv;
                    o8[64 * j] = (unsigned long long)pk2(y.x, y.y) | ((unsigned long long)pk2(y.z, y.w) << 32); }
            } else {
                float* o = of32 + (size_t)row * DM + 4 * lane;
#pragma unroll
                for (int j = 0; j < 4; ++j) *(f32x4*)(o + 256 * j) = (k ? v1[j] : v0[j]) * rstd * wv[j];
            }
        }
    }
}
constexpr int RS = 272;
constexpr int REG = 128 * RS;
constexpr int XCS = 1040;
#define MFMA16(a, b, c) __builtin_amdgcn_mfma_f32_16x16x32_bf16((a), (b), (c), 0, 0, 0)

__device__ __forceinline__ void mm128(f32x4 (&acc)[8], const LAS unsigned char* Aimg, const LAS unsigned char* Bimg, int wave, int c, int q) {
#pragma unroll
    for (int s = 0; s < 4; ++s) {
        const bf16x8 af = *(const LAS bf16x8*)(Aimg + (16 * wave + c) * RS + (32 * s + 8 * q) * 2);
#pragma unroll
        for (int t = 0; t < 8; ++t) { const bf16x8 bfr = *(const LAS bf16x8*)(Bimg + (16 * t + c) * RS + (32 * s + 8 * q) * 2); acc[t] = MFMA16(bfr, af, acc[t]); }
    }
}
__device__ __forceinline__ void mm128x2(f32x4 (&acc1)[8], f32x4 (&acc2)[8], const LAS unsigned char* Aimg, const LAS unsigned char* B1, const LAS unsigned char* B2, int wave, int c, int q) {
#pragma unroll
    for (int s = 0; s < 4; ++s) {
        const bf16x8 af = *(const LAS bf16x8*)(Aimg + (16 * wave + c) * RS + (32 * s + 8 * q) * 2);
#pragma unroll
        for (int t = 0; t < 8; ++t) { const bf16x8 b1 = *(const LAS bf16x8*)(B1 + (16 * t + c) * RS + (32 * s + 8 * q) * 2); acc1[t] = MFMA16(b1, af, acc1[t]);
                                      const bf16x8 b2 = *(const LAS bf16x8*)(B2 + (16 * t + c) * RS + (32 * s + 8 * q) * 2); acc2[t] = MFMA16(b2, af, acc2[t]); }
    }
}
__device__ __forceinline__ void load_rm(LAS unsigned char* img, const bf16* g, int pitch, int tid) {
#pragma unroll
    for (int i = 0; i < 4; ++i) { const int p = tid + 512 * i, row = p >> 4, cp = p & 15; const v4u v = *(const v4u*)(g + (size_t)row * pitch + cp * 8); *(LAS v4u*)(img + row * RS + cp * 16) = v; }
}
__device__ __forceinline__ void load_tiled(LAS unsigned char* img, const bf16* g, int tid) {
#pragma unroll
    for (int i = 0; i < 4; ++i) { const int p = tid + 512 * i, cp = p >> 7, row = p & 127; const v4u v = *(const v4u*)(g + (size_t)p * 8); *(LAS v4u*)(img + row * RS + cp * 16) = v; }
}
#define HW(v, e) (((e) & 1) ? ((v)[(e) >> 1] >> 16) : ((v)[(e) >> 1] & 0xffffu))
__device__ __forceinline__ void load_tr(LAS unsigned char* img, const bf16* g, int pitch, int wave, int lane) {
#pragma unroll
    for (int it = 0; it < 2; ++it) { const int dg = wave + 8 * it;
        const v4u a = *(const v4u*)(g + (size_t)(2 * lane) * pitch + dg * 8), b = *(const v4u*)(g + (size_t)(2 * lane + 1) * pitch + dg * 8);
#pragma unroll
        for (int e = 0; e < 8; ++e) { const unsigned lo = HW(a, e), hi = HW(b, e); *(LAS unsigned*)(img + (dg * 8 + e) * RS + lane * 4) = lo | (hi << 16); } }
}
__device__ __forceinline__ float log_sigmoid_(float x) { return -log1pf(__expf(-x)); }

template <int PASS>
__device__ __forceinline__ void ret_item(const Args& a, LAS unsigned char* lds, int ci, int h, int tid, int wave, int lane) {
    unsigned char* ws = a.ws;
    const int c = lane & 15, q = lane >> 4;
    const bf16* PROJ = (const bf16*)(ws + WS_PROJ);
    const size_t rowbase = (size_t)ci * 128;
    const bf16* Qg = PROJ + rowbase * INW + 1024 + h * 128;
    const bf16* Kg = PROJ + rowbase * INW + 1536 + h * 128;
    const bf16* Vg = PROJ + rowbase * INW + 2048 + h * 128;
    const float lf2 = log_sigmoid_(a.in[24][h]) * 1.4426950408889634f, lb2 = log_sigmoid_(a.in[25][h]) * 1.4426950408889634f;
    const float scale = 0.08838834764831845f;
    LAS unsigned char* R1 = lds; LAS unsigned char* R2 = lds + REG; LAS unsigned char* R3 = lds + 2 * REG; LAS unsigned char* R4 = lds + 3 * REG;
    if (PASS == 1) {
        const float j0 = (float)(2 * lane), j1 = (float)(2 * lane + 1);
        const float wf0 = scale * __builtin_amdgcn_exp2f(lf2 * (127.f - j0)), wf1 = scale * __builtin_amdgcn_exp2f(lf2 * (127.f - j1)), wb0 = scale * __builtin_amdgcn_exp2f(lb2 * j0), wb1 = scale * __builtin_amdgcn_exp2f(lb2 * j1);
        load_tr(R1, Kg, INW, wave, lane);
#pragma unroll
        for (int it = 0; it < 2; ++it) { const int dg = wave + 8 * it;
            const v4u va = *(const v4u*)(Vg + (size_t)(2 * lane) * INW + dg * 8), vb = *(const v4u*)(Vg + (size_t)(2 * lane + 1) * INW + dg * 8);
#pragma unroll
            for (int e = 0; e < 8; ++e) { const float lo = bf2f((unsigned short)HW(va, e)), hi = bf2f((unsigned short)HW(vb, e));
                *(LAS unsigned*)(R2 + (dg * 8 + e) * RS + lane * 4) = pk2(lo * wf0, hi * wf1);
                *(LAS unsigned*)(R3 + (dg * 8 + e) * RS + lane * 4) = pk2(lo * wb0, hi * wb1); } }
        __syncthreads();
        f32x4 af[8], ab[8];
#pragma unroll
        for (int t = 0; t < 8; ++t) { af[t] = (f32x4){0.f, 0.f, 0.f, 0.f}; ab[t] = (f32x4){0.f, 0.f, 0.f, 0.f}; }
        mm128(af, R2, R1, wave, c, q);
        mm128(ab, R3, R1, wave, c, q);
        bf16* KVT = (bf16*)(ws + WS_KVT) + ((size_t)(ci * 4 + h) * 2) * 16384 + ((q >> 1) * 128 + 16 * wave + c) * 8 + 4 * (q & 1);
#pragma unroll
        for (int t = 0; t < 8; ++t) { *(v2u*)(KVT + 2 * t * 1024) = (v2u){pk2(af[t][0], af[t][1]), pk2(af[t][2], af[t][3])};
                                      *(v2u*)(KVT + 16384 + 2 * t * 1024) = (v2u){pk2(ab[t][0], ab[t][1]), pk2(ab[t][2], ab[t][3])}; }
        __syncthreads();
    } else {
        const bf16* SB = (const bf16*)(ws + WS_SB) + ((size_t)(ci * 4 + h) * 2) * 16384;
        load_rm(R1, Qg, INW, tid);
        load_rm(R2, Kg, INW, tid);
        load_tr(R3, Vg, INW, wave, lane);
        load_tiled(R4, SB, tid);
        __syncthreads();
        f32x4 aS[8], aF[8];
#pragma unroll
        for (int t = 0; t < 8; ++t) { aS[t] = (f32x4){0.f, 0.f, 0.f, 0.f}; aF[t] = (f32x4){0.f, 0.f, 0.f, 0.f}; }
        mm128x2(aS, aF, R1, R2, R4, wave, c, q);
        __syncthreads();
        const int i = 16 * wave + c;
#pragma unroll
        for (int t = 0; t < 8; ++t) { float p[4];
#pragma unroll
            for (int r = 0; r < 4; ++r) { const int dl = i - (16 * t + 4 * q + r);
                const float ex = __builtin_amdgcn_exp2f(dl > 0 ? lf2 * (float)dl : lb2 * (float)(-dl));
                const float f = dl == 0 ? 2.0f : ex;
                p[r] = aS[t][r] * scale * f; }
            *(LAS v2u*)(R2 + i * RS + (16 * t + 4 * q) * 2) = (v2u){pk2(p[0], p[1]), pk2(p[2], p[3])}; }
        load_tiled(R4, SB + 16384, tid);
        __syncthreads();
        const float hf = __builtin_amdgcn_exp2f(lf2 * (float)(i + 1)), hb = __builtin_amdgcn_exp2f(lb2 * (float)(128 - i));
        f32x4 aB[8];
#pragma unroll
        for (int t = 0; t < 8; ++t) { aF[t] = aF[t] * hf; aB[t] = (f32x4){0.f, 0.f, 0.f, 0.f}; }
        mm128(aF, R2, R3, wave, c, q);
        mm128(aB, R1, R4, wave, c, q);
        f32x4 (&aO)[8] = aF;
        float s = 0.f;
#pragma unroll
        for (int t = 0; t < 8; ++t) { aO[t] = aO[t] + aB[t] * hb; s += (aO[t][0] + aO[t][1]) + (aO[t][2] + aO[t][3]); }
        s += __shfl_xor(s, 16); s += __shfl_xor(s, 32);
        const float mean = s * (1.0f / 128.0f); float v2 = 0.f;
#pragma unroll
        for (int t = 0; t < 8; ++t) { aO[t] = aO[t] - mean; v2 += (aO[t][0] * aO[t][0] + aO[t][1] * aO[t][1]) + (aO[t][2] * aO[t][2] + aO[t][3] * aO[t][3]); }
        v2 += __shfl_xor(v2, 16); v2 += __shfl_xor(v2, 32);
        const float rstd = 1.0f / sqrtf(v2 * (1.0f / 128.0f) + 1e-6f);
        const bf16* Gg = PROJ + (rowbase + i) * INW + 2560 + h * 128 + 4 * q;
        const float* gn = a.in[26] + h * 128 + 4 * q;
        bf16* Yp = (bf16*)(ws + WS_Y) + (rowbase + i) * DM + 512 + h * 128 + 4 * q;
#pragma unroll
        for (int t = 0; t < 8; ++t) { const v2u gv = *(const v2u*)(Gg + 16 * t); const f32x4 w = *(const f32x4*)(gn + 16 * t);
            const float y0 = aO[t][0] * rstd * w[0] * siluf_(bflo(gv[0])), y1 = aO[t][1] * rstd * w[1] * siluf_(bfhi(gv[0]));
            const float y2 = aO[t][2] * rstd * w[2] * siluf_(bflo(gv[1])), y3 = aO[t][3] * rstd * w[3] * siluf_(bfhi(gv[1]));
            *(v2u*)(Yp + 16 * t) = (v2u){pk2(y0, y1), pk2(y2, y3)};
            if (t & 1) asm volatile("" ::: "memory"); }
        __syncthreads();
    }
}
template <int PASS, int DIR>
__device__ __forceinline__ void lru_dir(const LAS unsigned char* xcl, const bf16x8 (&idf)[2], const bf16x8 (&wa)[2], const bf16x8 (&wx)[2], float ba, float bx, float sp8,
                                        float hc_in, float* hsp, float& Aout, float& Hout, float& edge, int c, int q, const bf16* Gp, bf16* Yp) {
    float Ac = 1.f, Hc = hc_in;
    float hn[4]; unsigned short gn[4];
    if (PASS == 3 && DIR == 1) {
#pragma unroll
        for (int r = 0; r < 4; ++r) { hn[r] = hsp[(7 * 4 + r) * 64]; gn[r] = Gp[(size_t)(16 * 7 + 4 * q + r) * INW]; }
    }
#pragma unroll 1
    for (int ti = 0; ti < 8; ++ti) {
        const int tt = DIR == 0 ? ti : 7 - ti;
        float hcur[4]; unsigned short gcur[4];
        if (PASS == 3 && DIR == 1) {
#pragma unroll
            for (int r = 0; r < 4; ++r) { hcur[r] = hn[r]; gcur[r] = gn[r]; }
            const int tn = tt > 0 ? tt - 1 : 0;
#pragma unroll
            for (int r = 0; r < 4; ++r) { hn[r] = hsp[(tn * 4 + r) * 64]; gn[r] = Gp[(size_t)(16 * tn + 4 * q + r) * INW]; }
        }
        f32x4 aI = (f32x4){0.f, 0.f, 0.f, 0.f}, aA = aI, aX = aI;
#pragma unroll
        for (int s = 0; s < 2; ++s) { const bf16x8 xf = *(const LAS bf16x8*)(xcl + (16 * tt) * XCS + 64 * s);
            aI = MFMA16(xf, idf[s], aI); aA = MFMA16(xf, wa[s], aA); aX = MFMA16(xf, wx[s], aX); }
        float av[4], uv[4];
#pragma unroll
        for (int r = 0; r < 4; ++r) {
            const float rg = __builtin_amdgcn_rcpf(1.0f + __builtin_amdgcn_exp2f(fmaf(aA[r], -1.4426950408889634f, ba)));
            const float ig = __builtin_amdgcn_rcpf(1.0f + __builtin_amdgcn_exp2f(fmaf(aX[r], -1.4426950408889634f, bx)));
            const float la = -sp8 * rg;
            const float aa = __builtin_amdgcn_exp2f(la * 1.4426950408889634f);
            const float t = -2.0f * la;
            const float ser = t * fmaf(-0.5f * t, fmaf(-0.33333334f * t, fmaf(-0.25f, t, 1.0f), 1.0f), 1.0f);
            const float om = t < 0.125f ? ser : fmaf(-aa, aa, 1.0f);
            av[r] = aa; uv[r] = __builtin_amdgcn_sqrtf(om) * (ig * aI[r]); }
        float pa[4], hl[4]; float P = 1.f, H = 0.f;
#pragma unroll
        for (int rr = 0; rr < 4; ++rr) { const int r = DIR == 0 ? rr : 3 - rr; H = av[r] * H + uv[r]; P *= av[r]; pa[r] = P; hl[r] = H; }
        float A = P, Hh = H, Ap, Hp, Ae, He, At, Ht;
        if (DIR == 0) {
            Ap = __shfl_up(A, 16); Hp = __shfl_up(Hh, 16); if (q >= 1) { Hh = A * Hp + Hh; A = Ap * A; }
            Ap = __shfl_up(A, 32); Hp = __shfl_up(Hh, 32); if (q >= 2) { Hh = A * Hp + Hh; A = Ap * A; }
            Ae = __shfl_up(A, 16); He = __shfl_up(Hh, 16); if (q == 0) { Ae = 1.f; He = 0.f; }
            At = __shfl(A, 48 + c); Ht = __shfl(Hh, 48 + c);
        } else {
            Ap = __shfl_down(A, 16); Hp = __shfl_down(Hh, 16); if (q <= 2) { Hh = A * Hp + Hh; A = Ap * A; }
            Ap = __shfl_down(A, 32); Hp = __shfl_down(Hh, 32); if (q <= 1) { Hh = A * Hp + Hh; A = Ap * A; }
            Ae = __shfl_down(A, 16); He = __shfl_down(Hh, 16); if (q == 3) { Ae = 1.f; He = 0.f; }
            At = __shfl(A, c); Ht = __shfl(Hh, c);
        }
        if (PASS == 3) {
            const float hin = Ae * Hc + He;
#pragma unroll
            for (int r = 0; r < 4; ++r) { const float hv = pa[r] * hin + hl[r];
                if (DIR == 0) hsp[(tt * 4 + r) * 64] = hv;
                else { const size_t tok = (size_t)(16 * tt + 4 * q + r); Yp[tok * DM] = (bf16)f2bf((hcur[r] + hv) * gelu_tanh(bf2f(gcur[r]))); }
                if (DIR == 0 && tt == 0 && r == 0) edge = hv;
                if (DIR == 1 && tt == 7 && r == 3) edge = hv; }
        }
        Hc = At * Hc + Ht; Ac = Ac * At;
    }
    Aout = Ac; Hout = Hc;
}

template <int PASS>
__device__ __forceinline__ void lru_item(const Args& a, LAS unsigned char* lds, int ci, int tid, int wave, int lane) {
    unsigned char* ws = a.ws;
    const int c = lane & 15, q = lane >> 4;
    const bf16* PROJ = (const bf16*)(ws + WS_PROJ);
    int seq, n, seqlen, seqtok0, nch;
    if (ci < 64) { seq = ci >> 1; n = ci & 1; seqlen = 256; seqtok0 = seq * 256; nch = 2; }
    else { seq = (ci - 64) >> 5; n = (ci - 64) & 31; seqlen = 4096; seqtok0 = TP + seq * 4096; nch = 32; }
    const bool isprompt = ci < 64;
    const int p0 = n * 128;
    {
        float w0[8], w1[8], w2[8], w3[8], bb[8];
#pragma unroll
        for (int e = 0; e < 8; ++e) { w0[e] = a.in[12][0 * 512 + 8 * lane + e]; w1[e] = a.in[12][1 * 512 + 8 * lane + e]; w2[e] = a.in[12][2 * 512 + 8 * lane + e]; w3[e] = a.in[12][3 * 512 + 8 * lane + e]; bb[e] = a.in[13][8 * lane + e]; }
        const int pb = p0 + 16 * wave;
        const bf16* base = PROJ + (size_t)seqtok0 * INW + 8 * lane;
#define LDROW(p) (((p) < 0 || (p) >= seqlen) ? (v4u){0u, 0u, 0u, 0u} : *(const v4u*)(base + (size_t)(p) * INW))
        v4u rows[19];
#pragma unroll
        for (int k = 0; k < 19; ++k) rows[k] = LDROW(pb - 2 + k);
#pragma unroll
        for (int i = 0; i < 16; ++i) {
            float o[8];
#pragma unroll
            for (int e = 0; e < 8; ++e) o[e] = fmaf(w3[e], bf2f((unsigned short)HW(rows[i + 3], e)), fmaf(w2[e], bf2f((unsigned short)HW(rows[i + 2], e)), fmaf(w1[e], bf2f((unsigned short)HW(rows[i + 1], e)), fmaf(w0[e], bf2f((unsigned short)HW(rows[i], e)), bb[e]))));
            *(LAS v4u*)(lds + (16 * wave + i) * XCS + 16 * lane) = (v4u){pk2(o[0], o[1]), pk2(o[2], o[3]), pk2(o[4], o[5]), pk2(o[6], o[7])};
        }
#undef LDROW
    }
    __syncthreads();
    const LAS unsigned char* xcl = lds + c * XCS + (64 * wave + 8 * q) * 2;
    const bf16* WL = (const bf16*)(ws + WS_WL);
    const size_t rowbase = (size_t)seqtok0 + p0;
    for (int rt = 0; rt < 4; ++rt) {
        const int dl = 16 * rt + c, d = 64 * wave + dl;
        bf16x8 idf[2];
#pragma unroll
        for (int s = 0; s < 2; ++s)
#pragma unroll
            for (int e = 0; e < 8; ++e) idf[s][e] = (32 * s + 8 * q + e == dl) ? (short)0x3F80 : (short)0;
        float* hs = a.out + (size_t)(blockIdx.x * NWAVES + wave) * 2048 + lane;
        float Af, Hf, Ab, Hb, ef = 0.f, eb = 0.f;
        float cf = 0.f, cb = 0.f;
        if (PASS == 3) { cf = ((const float*)(ws + WS_CAR))[(size_t)(ci * 2 + 0) * 512 + d]; cb = ((const float*)(ws + WS_CAR))[(size_t)(ci * 2 + 1) * 512 + d]; }
        const bf16* Gp = PROJ + rowbase * INW + 512 + d;
        bf16* Yp = (bf16*)(ws + WS_Y) + rowbase * DM + d;
        bf16x8 waf[2], wxf[2], wab[2], wxb[2];
#pragma unroll
        for (int s2 = 0; s2 < 2; ++s2) { const int o = dl * 64 + 32 * s2 + 8 * q;
            waf[s2] = *(const bf16x8*)(WL + (size_t)(0 * 8 + wave) * 4096 + o); wxf[s2] = *(const bf16x8*)(WL + (size_t)(1 * 8 + wave) * 4096 + o);
            wab[s2] = *(const bf16x8*)(WL + (size_t)(2 * 8 + wave) * 4096 + o); wxb[s2] = *(const bf16x8*)(WL + (size_t)(3 * 8 + wave) * 4096 + o); }
        const float baf = a.in[15][d], bxf = a.in[17][d], lmf = a.in[18][d], bab = a.in[20][d], bxb = a.in[22][d], lmb = a.in[23][d];
        lru_dir<PASS, 0>(xcl, idf, waf, wxf, -1.4426950408889634f * baf, -1.4426950408889634f * bxf, 8.0f * log1pf(__expf(-lmf)), cf, hs, Af, Hf, ef, c, q, Gp, Yp);
        lru_dir<PASS, 1>(xcl, idf, wab, wxb, -1.4426950408889634f * bab, -1.4426950408889634f * bxb, 8.0f * log1pf(__expf(-lmb)), cb, hs, Ab, Hb, eb, c, q, Gp, Yp);
        if (PASS == 1) {
            if (q == 0) { float* ag = (float*)(ws + WS_AGG) + (size_t)(ci * 2) * 1024 + d; ag[0] = Af; ag[512] = Hf; ag[1024] = Ab; ag[1536] = Hb; }
        } else {
            if (isprompt && n == 0 && q == 0) a.out[OFF_LF + seq * 512 + d] = ef;
            if (isprompt && n == nch - 1 && q == 3) a.out[OFF_LB + seq * 512 + d] = eb;
        }
    }
    __syncthreads();
}

__device__ __forceinline__ void phase_carries(const Args& a, int tid) {
    unsigned char* ws = a.ws;
    const int gtid = blockIdx.x * 512 + tid, GT = gridDim.x * 512;
    for (int task = gtid; task < 655360; task += GT) {
        const int dv = task & 127, dkg = (task >> 7) & 15, dir = (task >> 11) & 1, h = (task >> 12) & 3, sq = task >> 14;
        const bool isprompt = sq >= 8; const int seq = isprompt ? sq - 8 : sq, N = isprompt ? 2 : 32, cibase = isprompt ? seq * 2 : 64 + seq * 32;
        const float g = __expf(log_sigmoid_(dir ? a.in[25][h] : a.in[24][h]) * 128.0f);
        float S[8];
        if (isprompt) {
#pragma unroll
            for (int e = 0; e < 8; ++e) S[e] = 0.f;
        } else { const float* s0 = (dir ? a.in[5] : a.in[4]) + ((size_t)(seq * 4 + h) * 128 + dkg * 8) * 128 + dv;
#pragma unroll
            for (int e = 0; e < 8; ++e) S[e] = s0[e * 128]; }
        const size_t ibase = ((size_t)h * 2 + dir) * 16384 + ((size_t)dkg * 128 + dv) * 8;
        const bf16* kvp = (const bf16*)(ws + WS_KVT) + ibase; bf16* sbp = (bf16*)(ws + WS_SB) + ibase;
        for (int s0 = 0; s0 < N; s0 += 8) {
            v4u kv[8];
#pragma unroll
            for (int j = 0; j < 8; ++j) { const int step = s0 + j; const int n = dir ? N - 1 - step : step; const int ci = cibase + (step < N ? n : (dir ? 0 : N - 1));
                kv[j] = *(const v4u*)(kvp + (size_t)ci * 131072); }
#pragma unroll
            for (int j = 0; j < 8; ++j) { const int step = s0 + j;
                if (step < N) { const int n = dir ? N - 1 - step : step, ci = cibase + n;
                    *(v4u*)(sbp + (size_t)ci * 131072) = (v4u){pk2(S[0], S[1]), pk2(S[2], S[3]), pk2(S[4], S[5]), pk2(S[6], S[7])};
#pragma unroll
                    for (int e2 = 0; e2 < 8; ++e2) S[e2] = g * S[e2] + bf2f((unsigned short)HW(kv[j], e2)); } }
        }
        if (isprompt) { float* o = a.out + (dir ? OFF_RB : OFF_RF) + ((size_t)(seq * 4 + h) * 128 + dkg * 8) * 128 + dv;
#pragma unroll
            for (int e = 0; e < 8; ++e) o[e * 128] = S[e]; }
    }
    for (int task = gtid; task < 40960; task += GT) {
        const int d = task & 511, dir = (task >> 9) & 1, sq = task >> 10;
        const bool isprompt = sq >= 8; const int seq = isprompt ? sq - 8 : sq, N = isprompt ? 2 : 32, cibase = isprompt ? seq * 2 : 64 + seq * 32;
        float hcar = isprompt ? 0.f : (dir ? a.in[3] : a.in[2])[seq * 512 + d];
        for (int step = 0; step < N; ++step) {
            const int n = dir ? N - 1 - step : step, ci = cibase + n;
            ((float*)(ws + WS_CAR))[(size_t)(ci * 2 + dir) * 512 + d] = hcar;
            const float* ag = (const float*)(ws + WS_AGG) + ((size_t)(ci * 2 + dir) * 2) * 512 + d;
            hcar = ag[0] * hcar + ag[512];
        }
    }
}

__device__ __forceinline__ v4u ldg16(const bf16* p, bool ok) { return ok ? *(const v4u*)p : (v4u){0u, 0u, 0u, 0u}; }
__device__ __forceinline__ void phase_act(const Args& a, int half, int wave, int lane) {
    unsigned char* ws = a.ws;
    const bf16* __restrict__ GH = (const bf16*)(ws + WS_GH);
    bf16* __restrict__ U = (bf16*)(ws + WS_U);
    const int gw = blockIdx.x * NWAVES + wave, NGW = gridDim.x * NWAVES;
    const int p = lane >> 5;
    const bool tailsplit = (NGW == 2048);
    for (int kk = 0; kk < (tailsplit ? 4 : (7040 + NGW - 1) / NGW); ++kk) {
        int wt, nst = 16, soff = 0;
        if (!tailsplit) { wt = gw + kk * NGW; if (wt >= 7040) break; }
        else if (kk < 3) wt = gw + kk * 2048;
        else { if (gw >= 1792) break; wt = 6144 + (gw >> 1); nst = 8; soff = 8 * (gw & 1); }
        const int slab = wt % 11; int r = wt / 11;
        int tok0, ts, lat, steps0, nwalk;
        bool isimg;
        if (half == 1 || r >= 256) {
            if (half == 0) r -= 256;
            const int pair = r & 31, seg = (r >> 5) & 3, img = (r >> 7) + (half == 0 ? 0 : 3);
            const int gc = 2 * pair + p; steps0 = 16 * seg + soff; nwalk = 64; ts = 64; lat = 1; isimg = true;
            tok0 = TP + img * 4096 + steps0 * 64 + gc;
        } else {
            const int sp = r & 7, seq = r >> 3; steps0 = 32 * sp + 16 * p + soff; nwalk = 256; ts = 1; lat = 0; isimg = false;
            tok0 = seq * 256 + steps0;
        }
        const int ch0 = (slab * 32 + (lane & 31)) * 8;
        const int gcol = isimg ? (tok0 & 63) : 1;
        const bool okl = isimg && gcol > 0, okr = isimg && gcol < 63;
        float wk[9][8], bb[8];
#pragma unroll
        for (int k = 0; k < 9; ++k) { const int aa = k / 3, b = k % 3;
            const int src = isimg ? k : (3 + aa);
            const f32x4 x0 = *(const f32x4*)(a.in[31] + (size_t)src * FF + ch0), x1 = *(const f32x4*)(a.in[31] + (size_t)src * FF + ch0 + 4);
            const float z = (isimg || b == 1) ? 1.f : 0.f;
            wk[k][0] = x0[0] * z; wk[k][1] = x0[1] * z; wk[k][2] = x0[2] * z; wk[k][3] = x0[3] * z; wk[k][4] = x1[0] * z; wk[k][5] = x1[1] * z; wk[k][6] = x1[2] * z; wk[k][7] = x1[3] * z; }
        { const f32x4 x0 = *(const f32x4*)(a.in[32] + ch0), x1 = *(const f32x4*)(a.in[32] + ch0 + 4); bb[0] = x0[0]; bb[1] = x0[1]; bb[2] = x0[2]; bb[3] = x0[3]; bb[4] = x1[0]; bb[5] = x1[1]; bb[6] = x1[2]; bb[7] = x1[3]; }
        const bf16* gp = GH + (size_t)(tok0 - half * HALF_T) * FF + ch0;
        bf16* up = U + (size_t)tok0 * FF + ch0;
        const size_t gs = (size_t)ts * FF;
        v4u w0[3], w1[3], w2[3], w3[3];
        { const bool okp = steps0 > 0;
          w0[0] = ldg16(gp - gs - FF, okp && okl); w0[1] = ldg16(gp - gs, okp); w0[2] = ldg16(gp - gs + FF, okp && okr);
          w1[0] = ldg16(gp - FF, okl); w1[1] = *(const v4u*)gp; w1[2] = ldg16(gp + FF, okr); }
#pragma unroll 1
        for (int st = 0; st < nst; st += 2) {
            const bool ok2 = steps0 + st + 1 < nwalk, ok3 = steps0 + st + 2 < nwalk;
            const bf16* g2 = gp + (size_t)(st + 1) * gs; const bf16* g3 = g2 + gs;
            w2[0] = ldg16(g2 - FF, ok2 && okl); w2[1] = ldg16(g2, ok2); w2[2] = ldg16(g2 + FF, ok2 && okr);
            w3[0] = ldg16(g3 - FF, ok3 && okl); w3[1] = ldg16(g3, ok3); w3[2] = ldg16(g3 + FF, ok3 && okr);
            bf16* u0 = up + (size_t)st * gs; bf16* u1 = u0 + gs;
            const v4u uv0 = *(const v4u*)u0, uv1 = *(const v4u*)u1;
            float acc0[8], acc1[8];
#pragma unroll
            for (int e = 0; e < 8; ++e) { acc0[e] = bb[e]; acc1[e] = bb[e]; }
#pragma unroll
            for (int b = 0; b < 3; ++b)
#pragma unroll
                for (int e = 0; e < 8; ++e) {
                    { const float g0 = bf2f((unsigned short)HW(w0[b], e)), g1 = bf2f((unsigned short)HW(w1[b], e)), g2 = bf2f((unsigned short)HW(w2[b], e)), g3 = bf2f((unsigned short)HW(w3[b], e));
                    acc0[e] = fmaf(wk[6 + b][e], g2, fmaf(wk[3 + b][e], g1, fmaf(wk[0 + b][e], g0, acc0[e])));
                    acc1[e] = fmaf(wk[6 + b][e], g3, fmaf(wk[3 + b][e], g2, fmaf(wk[0 + b][e], g1, acc1[e]))); } }
            float o0[8], o1[8];
#pragma unroll
            for (int e = 0; e < 8; ++e) { o0[e] = gelu_tanh(acc0[e]) * bf2f((unsigned short)HW(uv0, e)); o1[e] = gelu_tanh(acc1[e]) * bf2f((unsigned short)HW(uv1, e)); }
            *(v4u*)u0 = (v4u){pk2(o0[0], o0[1]), pk2(o0[2], o0[3]), pk2(o0[4], o0[5]), pk2(o0[6], o0[7])};
            *(v4u*)u1 = (v4u){pk2(o1[0], o1[1]), pk2(o1[2], o1[3]), pk2(o1[4], o1[5]), pk2(o1[6], o1[7])};
#pragma unroll
            for (int b = 0; b < 3; ++b) { w0[b] = w2[b]; w1[b] = w3[b]; }
        }
    }
}
template <int PASS>
__device__ __forceinline__ void phase_mixer(const Args& a, LAS unsigned char* lds, int tid, int wave, int lane) {
    unsigned* ctr = (unsigned*)(a.ws + WS_BAR) + (PASS == 1 ? 3584 : 3648);
    volatile LAS int* slot = (volatile LAS int*)(lds + LDSCTL_OFF + 256);
    for (;;) {
        if (tid == 0) *slot = (int)__hip_atomic_fetch_add(ctr, 1u, __ATOMIC_RELAXED, __HIP_MEMORY_SCOPE_AGENT);
        __syncthreads();
        const int it = *slot;
        if (it >= NCHUNK + 4 * NCHUNK) break;
        asm volatile("" : "+v"(tid), "+v"(lane));
        if (it < NCHUNK) lru_item<PASS>(a, lds, it, tid, wave, lane);
        else { const int r = it - NCHUNK; ret_item<PASS>(a, lds, r >> 2, r & 3, tid, wave, lane); }
    }
}

__global__ void __launch_bounds__(512, 2) fwd(Args a) {
    extern __shared__ __attribute__((aligned(16))) unsigned char lds_raw[];
    LAS unsigned char* lds = (LAS unsigned char*)lds_raw;
    unsigned char* ws = a.ws;
    int tid = threadIdx.x, lane = tid & 63; const int wave = __builtin_amdgcn_readfirstlane(tid >> 6);
#define FRESH() do { tid = threadIdx.x; asm volatile("" : "+v"(tid)); lane = tid & 63; } while (0)
    for (int u = tid; u < (LDS_BYTES - LDSCTL_OFF) / 4; u += 512) ((LAS unsigned*)(lds + LDSCTL_OFF))[u] = 0u;
    __syncthreads();
    const XcdBarrier bar = xcd_barrier_post((unsigned*)(ws + WS_BAR), (volatile LAS unsigned*)(lds + LDSCTL_OFF + 64));
    const float* MOD = (const float*)(ws + WS_MOD);
    const int G = gridDim.x;
    const int lo = a.ph_lo, hi = a.ph_hi;
#ifndef PHMASK
#define PHMASK 0xffff
#endif
#define IN(k) ((((PHMASK) >> (k)) & 1) && lo <= (k) && (k) < hi)
#ifndef REPMASK
#define REPMASK 0u
#endif
#define NREP(k) ((((REPMASK) >> (k)) & 1u) ? 2 : 1)
#define SEAM(k) do { if (IN(k) && IN((k) + 1)) xcd_barrier(bar); } while (0)
    FRESH();
    for (int rep = 0; rep < NREP(0); ++rep) if (IN(0)) phase_prologue(a, lds, tid, wave, lane);
    if (IN(0) && IN(1)) { cg::grid_group grid = cg::this_grid(); grid.sync(); }
    FRESH();
    for (int rep = 0; rep < NREP(1); ++rep) if (IN(1)) phase_rownorm<0>(a.in[0], a.in[1], a.in[8], MOD + 1024, MOD + 0, (bf16*)(ws + WS_XN), nullptr, wave, lane);
    SEAM(1);
    FRESH();
    for (int rep = 0; rep < NREP(2); ++rep) if (IN(2)) { pg8::Gemm g{(const bf16*)(ws + WS_XN), (const bf16*)(ws + WS_WIN), TT, INW, DM}; pg8::StaticOrder S; S.init(TT, INW, G, (int)blockIdx.x);
        pg8::EpiBf16<0> E{(bf16*)(ws + WS_PROJ), INW, nullptr, 0, 0, 1.f};
        pg8::gemm_phase<pg8::EpiBf16<0>, pg8::StaticOrder, true, true>(lds, g, S, E); }
    SEAM(2);
    FRESH();
    for (int rep = 0; rep < NREP(3); ++rep) if (IN(3)) phase_mixer<1>(a, lds, tid, wave, lane);
    SEAM(3);
    FRESH();
    for (int rep = 0; rep < NREP(4); ++rep) if (IN(4)) phase_carries(a, tid);
    SEAM(4);
    FRESH();
    for (int rep = 0; rep < NREP(5); ++rep) if (IN(5)) phase_mixer<3>(a, lds, tid, wave, lane);
    SEAM(5);
    FRESH();
    for (int rep = 0; rep < NREP(6); ++rep) if (IN(6)) { pg8::Gemm g{(const bf16*)(ws + WS_Y), (const bf16*)(ws + WS_WOUT), TT, DM, DM}; pg8::StaticOrder S; S.init(TT, DM, G, (int)blockIdx.x);
        pg8::EpiBf16<0> E{(bf16*)(ws + WS_KVT), DM, nullptr, 0, 0, 1.f};
        pg8::gemm_phase<pg8::EpiBf16<0>, pg8::StaticOrder, true, true>(lds, g, S, E); }
    SEAM(6);
    FRESH();
    for (int rep = 0; rep < NREP(7); ++rep) if (IN(7)) phase_resnorm<0>(a.in[0], a.in[1], (const bf16*)(ws + WS_KVT), MOD + 2048, a.out, a.in[28], MOD + 4096, MOD + 3072, (bf16*)(ws + WS_XN), nullptr, wave, lane);
    SEAM(7);
#pragma unroll
    for (int half = 0; half < 2; ++half) {
        FRESH();
        if (IN(8 + 2 * half)) { pg8::Gemm g{(const bf16*)(ws + WS_XN) + (size_t)half * HALF_T * DM, (const bf16*)(ws + WS_WGU), HALF_T, FF2, DM}; pg8::StaticOrder S; S.init(HALF_T, FF2, G, (int)blockIdx.x);
            pg8::EpiBf16<0> E{(bf16*)(ws + WS_GH), FF, nullptr, FF, (size_t)((WS_U - WS_GH) / 2) + (size_t)half * HALF_T * FF, 1.f};
            pg8::gemm_phase<pg8::EpiBf16<0>, pg8::StaticOrder, true, true>(lds, g, S, E); }
        SEAM(8 + 2 * half);
        FRESH();
        if (IN(9 + 2 * half)) phase_act(a, half, wave, lane);
        SEAM(9 + 2 * half);
    }
    FRESH();
    constexpr int PA_ROWS = 32768;
    const bool split12 = (G == 256);
    if (IN(12)) {
        { pg8::Gemm g{(const bf16*)(ws + WS_U), (const bf16*)(ws + WS_WD), split12 ? PA_ROWS : TT, DM, FF}; pg8::StaticOrder S; S.init(split12 ? PA_ROWS : TT, DM, G, (int)blockIdx.x);
          pg8::EpiBf16<0> E{(bf16*)(ws + WS_XN), DM, nullptr, 0, 0, 1.f};
          pg8::gemm_phase<pg8::EpiBf16<0>, pg8::StaticOrder, true, true>(lds, g, S, E); }
        if (split12) {
            FRESH();
            const int u = (int)blockIdx.x >> 1, kh = (int)blockIdx.x & 1, pml = u >> 2, pn = u & 3;
            pg8::Gemm g{(const bf16*)(ws + WS_U) + (size_t)(PA_ROWS + pml * 256) * FF + kh * (FF / 2), (const bf16*)(ws + WS_WD) + (size_t)(pn * 256) * FF + kh * (FF / 2), 256, 256, FF / 2, FF};
            pg8::StaticOrder S; S.init(256, 256, 1, 0);
            bf16* obase = kh ? (bf16*)(ws + WS_GH) + (size_t)(pml * 256) * DM + pn * 256 : (bf16*)(ws + WS_XN) + (size_t)(PA_ROWS + pml * 256) * DM + pn * 256;
            pg8::EpiBf16<0> E{obase, DM, nullptr, 0, 0, 1.f};
            pg8::gemm_phase<pg8::EpiBf16<0>, pg8::StaticOrder, true, true>(lds, g, S, E);
        }
    }
    SEAM(12);
    FRESH();
    if (IN(13)) phase_resnorm<1>(a.out, a.out + (size_t)TP * DM, (const bf16*)(ws + WS_XN), MOD + 5120, nullptr, a.in[34], nullptr, nullptr, nullptr, a.out, wave, lane,
                                 split12 ? (const bf16*)(ws + WS_GH) : nullptr, PA_ROWS);
#undef IN
#undef SEAM
}

extern "C" void kernel_launch(void* const* d_in, const int* in_sizes, int n_in, void* d_out, int out_size,
                              void* d_ws, size_t ws_size, hipStream_t stream) {
    static int grid = 0;
    if (grid == 0) {
        int dev = 0, cus = 0, per_cu = 0;
        hipGetDevice(&dev);
        hipDeviceGetAttribute(&cus, hipDeviceAttributeMultiprocessorCount, dev);
        hipFuncSetAttribute((const void*)fwd, hipFuncAttributeMaxDynamicSharedMemorySize, LDS_BYTES);
        hipOccupancyMaxActiveBlocksPerMultiprocessor(&per_cu, (const void*)fwd, 512, LDS_BYTES);
        if (per_cu < 1) per_cu = 1;
        grid = cus * per_cu;
        if (n_in != 35 || ws_size < WS_END) fprintf(stderr, "kernel_launch: unexpected n_in %d / ws_size %zu\n", n_in, ws_size);
    }
    if (hipMemsetAsync((char*)d_ws + WS_BAR, 0, 16384, stream) != hipSuccess) fprintf(stderr, "kernel_launch: memset failed\n");
    Args a{};
    for (int i = 0; i < 35; ++i) a.in[i] = (const float*)d_in[i];
    a.out = (float*)d_out; a.ws = (unsigned char*)d_ws; a.ph_lo = 0; a.ph_hi = 14;
    void* args[] = {&a};
    hipError_t e = hipLaunchCooperativeKernel((const void*)fwd, dim3(grid), dim3(512), args, LDS_BYTES, stream);
    if (e != hipSuccess) fprintf(stderr, "cooperative launch failed: %s (grid %d)\n", hipGetErrorString(e), grid);
}
```

```cpp
#include <hip/hip_runtime.h>
#include <hip/hip_cooperative_groups.h>
#include <cstdio>
#include <cstdint>
namespace cg = cooperative_groups;
namespace pg8 {
#define PG8_LAS __attribute__((address_space(3)))
typedef unsigned short bf16_t;
typedef short bf16x8 __attribute__((ext_vector_type(8)));
typedef float f32x4 __attribute__((ext_vector_type(4)));
typedef unsigned u32x4 __attribute__((ext_vector_type(4)));
constexpr int BM = 256, BK = 64, HALF = 128, HTB = HALF * BK * 2  , STAGE_BYTES = 8 * HTB, NXCD = 8, WGM = 8;

__host__ __device__ __forceinline__ int lds_byte(int r, int c) { const int st = (r >> 4) * 2 + (c >> 5), rr = r & 15, cc = c & 31, ob = rr * 64 + cc * 2; return st * 1024 + (ob ^ (((ob >> 9) & 1) << 5)); }
__host__ __device__ __forceinline__ void stage_rc(int b, int& R, int& C) { const int st = b / 1024, sb = b % 1024, swz = sb ^ (((sb >> 9) & 1) << 5); R = (st >> 1) * 16 + swz / 64; C = (st & 1) * 32 + (swz % 64) / 2; }
__host__ __device__ __forceinline__ int perm32(int rho) { const int n = rho >> 4, i = rho & 15; return 8 * (i >> 2) + 4 * n + (i & 3); }

struct Unit { int pm, pn; };
struct Gemm { const bf16_t* A; const bf16_t* Bt; int M, N, K; int ld = 0; };

struct StaticOrder {
    int nM, nN, nwg, G, c;
    __host__ __device__ void init(int M, int N, int G_, int c_) { nM = M / BM; nN = N / BM; nwg = nM * nN; G = G_; c = c_; }
    __host__ __device__ bool next(int i, Unit& u) const {
        const long L = (long)i * G + c; if (L >= nwg) return false;
        int wgid = (int)L; { const int q = nwg / NXCD, r = nwg % NXCD, xcd = wgid % NXCD, off = wgid / NXCD; wgid = (xcd < r ? xcd * (q + 1) : r * (q + 1) + (xcd - r) * q) + off; }
        const int nig = WGM * nN, gid = wgid / nig, fm = gid * WGM, gsz = (nM - fm) < WGM ? (nM - fm) : WGM;
        u.pm = fm + ((wgid % nig) % gsz); u.pn = (wgid % nig) / gsz; return true;
    }
    __device__ __forceinline__ void a_ready(const Unit&) const {}
    __device__ __forceinline__ void done(const Unit&) const {}
};

__device__ __forceinline__ unsigned cvt_pk_bf16(float lo, float hi) { unsigned r; asm volatile("v_cvt_pk_bf16_f32 %0, %1, %2" : "=v"(r) : "v"(lo), "v"(hi)); return r; }
typedef float f32x2 __attribute__((ext_vector_type(2)));
__device__ __forceinline__ f32x2 gelu_pk(f32x2 v) {
    const f32x2 av = __builtin_elementwise_abs(v), d = av * 0.2316418882f + 1.0f;
    f32x2 t; t.x = __builtin_amdgcn_rcpf(d.x); t.y = __builtin_amdgcn_rcpf(d.y);
    f32x2 q = t * 0.5307027145f + (-0.7265760135f); q = q * t + 0.7107068705f; q = q * t + (-0.142248368f); q = q * t + 0.127414796f; q = q * t;
    const f32x2 s = (v * v) * (-0.72134752044f);
    f32x2 e; e.x = __builtin_amdgcn_exp2f(s.x); e.y = __builtin_amdgcn_exp2f(s.y);
    const f32x2 m = v * (q * e), r = v - m;
    f32x2 o; o.x = v.x < 0.f ? m.x : r.x; o.y = v.y < 0.f ? m.y : r.y; return o;
}

template <int ACT  > struct EpiBf16 {
    static constexpr bool PERM = true, AFTER_DRAIN = false; static_assert(ACT == 0 || ACT == 1, "EpiBf16: ACT is 0 (none) or 1 (gelu_pk)");
    bf16_t* O; int ldc; const float* bias; int split_cols; size_t split_stride; float scale0;
    __device__ __forceinline__ void operator()(const f32x4 (&acc)[2][2][4][2], const Unit& u, int wr, int wc, int fr, int fq) const {
        const int row0 = u.pm * BM + wr * 64 + fr; int colt = u.pn * BM; bf16_t* base = O;
        float sc = 1.f; if (split_cols) { const int t = colt / split_cols; base += (size_t)t * split_stride; colt -= t * split_cols; if (t == 0) sc = scale0; }
        const int col0 = colt + wc * 32 + 8 * fq, bcol0 = u.pn * BM + wc * 32 + 8 * fq;
        f32x4 bv[2][2];
#pragma unroll
        for (int bj = 0; bj < 2; ++bj)
#pragma unroll
            for (int n = 0; n < 2; ++n) bv[bj][n] = bias ? *(const f32x4*)(bias + bcol0 + bj * HALF + 4 * n) : (f32x4){0.f, 0.f, 0.f, 0.f};
#pragma unroll
        for (int ai = 0; ai < 2; ++ai)
#pragma unroll
            for (int m = 0; m < 4; ++m) { bf16_t* rowp = base + (size_t)(row0 + ai * HALF + m * 16) * ldc + col0;
#pragma unroll
                for (int bj = 0; bj < 2; ++bj) { f32x4 v0 = acc[ai][bj][m][0] + bv[bj][0], v1 = acc[ai][bj][m][1] + bv[bj][1];
                    if (ACT == 1) { f32x2 a = gelu_pk((f32x2){v0[0], v0[1]}), b = gelu_pk((f32x2){v0[2], v0[3]}), c = gelu_pk((f32x2){v1[0], v1[1]}), d = gelu_pk((f32x2){v1[2], v1[3]});
                        v0 = (f32x4){a.x, a.y, b.x, b.y}; v1 = (f32x4){c.x, c.y, d.x, d.y}; }
                    v0 = v0 * sc; v1 = v1 * sc; u32x4 w; w.x = cvt_pk_bf16(v0[0], v0[1]); w.y = cvt_pk_bf16(v0[2], v0[3]); w.z = cvt_pk_bf16(v1[0], v1[1]); w.w = cvt_pk_bf16(v1[2], v1[3]);
                    *(u32x4*)(rowp + bj * HALF) = w; } }
    }
};
template <class Epi, class Sched, bool ALIGN_EPI = false, bool SP2 = false>
__device__ __forceinline__ void gemm_phase(PG8_LAS unsigned char* lds, const Gemm g, const Sched& S, const Epi& E) {
    int tid_ = threadIdx.x; asm volatile("" : "+v"(tid_));
    const int tid = tid_, wid = __builtin_amdgcn_readfirstlane(tid >> 6), lane = tid & 63, wr = wid >> 2, wc = wid & 3, fr = lane & 15, fq = lane >> 4;
    const int K = g.K, nt = K / BK, LD = g.ld ? g.ld : g.K;
    unsigned voffA[2], voffB[2];
#pragma unroll
    for (int i = 0; i < 2; ++i) { int R, C; stage_rc(tid * 16 + i * 8192, R, C); const int Rb = Epi::PERM ? ((R & ~31) + perm32(R & 31)) : R;
        voffA[i] = (unsigned)(R * LD + C) * 2u; voffB[i] = (unsigned)(Rb * LD + C) * 2u; }
    const size_t kstep = (size_t)(BK * 2);
    const size_t hstep = (size_t)HALF * LD * 2;
    const size_t tstep = 2 * hstep;
    const unsigned ldsw = (unsigned)wid * 1024u;
    const int aoff = lds_byte(wr * 64 + fr, fq * 8), boff = lds_byte(wc * 32 + fr, fq * 8);
#define PG8_SA(b, h) (((b) * 2 + (h)) * HTB)
#define PG8_SB(b, h) ((4 + (b) * 2 + (h)) * HTB)
#define PG8_STAGE(bufoff, gbase, voff) do { _Pragma("unroll") for (int _i = 0; _i < 2; ++_i) \
        __builtin_amdgcn_global_load_lds((const unsigned*)((const char*)(gbase) + (voff)[_i]), (PG8_LAS unsigned*)(lds + (bufoff) + ldsw + _i * 8192), 16, 0, 0); } while (0)
#define PG8_LDA(dst, b, h) do { _Pragma("unroll") for (int m = 0; m < 4; ++m) _Pragma("unroll") for (int k = 0; k < 2; ++k) dst[m][k] = *(const PG8_LAS bf16x8*)(lds + PG8_SA(b, h) + aoff + m * 2048 + k * 1024); } while (0)
#define PG8_LDB(dst, b, h) do { _Pragma("unroll") for (int n = 0; n < 2; ++n) _Pragma("unroll") for (int k = 0; k < 2; ++k) dst[n][k] = *(const PG8_LAS bf16x8*)(lds + PG8_SB(b, h) + boff + n * 2048 + k * 1024); } while (0)
#define PG8_MMA(ai, bj, At, Bt) do { __builtin_amdgcn_s_setprio(1); _Pragma("unroll") for (int m = 0; m < 4; ++m) _Pragma("unroll") for (int n = 0; n < 2; ++n) _Pragma("unroll") for (int k = 0; k < 2; ++k) \
        acc[ai][bj][m][n] = __builtin_amdgcn_mfma_f32_16x16x32_bf16(Bt[n][k], At[m][k], acc[ai][bj][m][n], 0, 0, 0); __builtin_amdgcn_s_setprio(0); } while (0)
#define PG8_WAIT_V(n) asm volatile("s_waitcnt vmcnt(" #n ")" ::: "memory")
#define PG8_WAIT_L(n) asm volatile("s_waitcnt lgkmcnt(" #n ")" ::: "memory")
#define PG8_BAR __builtin_amdgcn_s_barrier()
#define PG8_SCHED __builtin_amdgcn_sched_barrier(0)
    Unit cur, nxt; int ui = 0;
    if (!S.next(0, cur)) return;
    f32x4 acc[2][2][4][2];
#pragma unroll
    for (int a = 0; a < 2; ++a)
#pragma unroll
        for (int b = 0; b < 2; ++b)
#pragma unroll
            for (int m = 0; m < 4; ++m)
#pragma unroll
                for (int n = 0; n < 2; ++n) acc[a][b][m][n] = (f32x4){0.f, 0.f, 0.f, 0.f};
    bf16x8 At[4][2], B0[2][2], B1[2][2];
    const char* cA = (const char*)g.A + (size_t)cur.pm * tstep; const char* cB = (const char*)g.Bt + (size_t)cur.pn * tstep;
    S.a_ready(cur);
    if constexpr (SP2) {
        PG8_STAGE(PG8_SB(0, 0), cB, voffB); PG8_STAGE(PG8_SB(0, 1), cB + hstep, voffB); PG8_STAGE(PG8_SA(0, 0), cA, voffA); PG8_STAGE(PG8_SA(0, 1), cA + hstep, voffA);
        if (wr == 1) PG8_BAR;
        PG8_WAIT_V(2); PG8_BAR;
        PG8_STAGE(PG8_SB(1, 0), cB + kstep, voffB); PG8_STAGE(PG8_SA(1, 0), cA + kstep, voffA); PG8_STAGE(PG8_SB(1, 1), cB + hstep + kstep, voffB);
        PG8_WAIT_V(6); PG8_BAR;
    } else {
        PG8_STAGE(PG8_SB(0, 0), cB, voffB); PG8_STAGE(PG8_SA(0, 0), cA, voffA); PG8_STAGE(PG8_SB(0, 1), cB + hstep, voffB); PG8_STAGE(PG8_SA(0, 1), cA + hstep, voffA);
        if (wr == 1) PG8_BAR;
        PG8_WAIT_V(4); PG8_BAR;
        PG8_STAGE(PG8_SB(1, 0), cB + kstep, voffB); PG8_STAGE(PG8_SA(1, 0), cA + kstep, voffA); PG8_STAGE(PG8_SB(1, 1), cB + hstep + kstep, voffB);
        PG8_WAIT_V(6); PG8_BAR;
    }
    for (;;) {
        const bool has_next = S.next(ui + 1, nxt);
        const char* nA = has_next ? (const char*)g.A + (size_t)nxt.pm * tstep : cA; const char* nB = has_next ? (const char*)g.Bt + (size_t)nxt.pn * tstep : cB;
        for (int t = 0; t < nt; t += 2) {
            const bool last = (t == nt - 2);
            const char* a1 = cA + (size_t)(t + 1) * kstep;
            const char* a2 = last ? nA : cA + (size_t)(t + 2) * kstep; const char* b2 = last ? nB : cB + (size_t)(t + 2) * kstep;
            const char* a3 = a2 + kstep; const char* b3 = b2 + kstep;
            if (last && has_next) S.a_ready(nxt);
            if constexpr (SP2) {
            PG8_LDB(B0, 0, 0); PG8_LDB(B1, 0, 1); PG8_SCHED; PG8_LDA(At, 0, 0); PG8_STAGE(PG8_SA(1, 1), a1 + hstep, voffA);
            PG8_WAIT_V(8); PG8_WAIT_L(0); PG8_BAR; PG8_MMA(0, 0, At, B0); PG8_MMA(0, 1, At, B1); PG8_BAR; PG8_SCHED;
            PG8_LDA(At, 0, 1); PG8_STAGE(PG8_SB(0, 0), b2, voffB); PG8_STAGE(PG8_SB(0, 1), b2 + hstep, voffB); PG8_STAGE(PG8_SA(0, 0), a2, voffA);
            PG8_WAIT_V(8); PG8_WAIT_L(0); PG8_BAR; PG8_MMA(1, 0, At, B0); PG8_MMA(1, 1, At, B1); PG8_BAR; PG8_SCHED;
            PG8_LDB(B0, 1, 0); PG8_LDB(B1, 1, 1); PG8_SCHED; PG8_LDA(At, 1, 0); PG8_STAGE(PG8_SA(0, 1), a2 + hstep, voffA);
            PG8_WAIT_V(8); PG8_WAIT_L(0); PG8_BAR; PG8_MMA(0, 0, At, B0); PG8_MMA(0, 1, At, B1); PG8_BAR; PG8_SCHED;
            PG8_LDA(At, 1, 1); PG8_STAGE(PG8_SB(1, 0), b3, voffB); PG8_STAGE(PG8_SB(1, 1), b3 + hstep, voffB); PG8_STAGE(PG8_SA(1, 0), a3, voffA);
            PG8_WAIT_V(8); PG8_WAIT_L(0); PG8_BAR; PG8_MMA(1, 0, At, B0); PG8_MMA(1, 1, At, B1); PG8_BAR; PG8_SCHED;
            } else {
            PG8_LDB(B0, 0, 0); PG8_SCHED; PG8_LDA(At, 0, 0); PG8_STAGE(PG8_SA(1, 1), a1 + hstep, voffA);
            PG8_WAIT_L(8); PG8_BAR; PG8_WAIT_L(0); PG8_MMA(0, 0, At, B0); PG8_BAR; PG8_SCHED;
            PG8_LDB(B1, 0, 1); PG8_STAGE(PG8_SB(0, 0), b2, voffB);
            PG8_BAR; PG8_WAIT_L(0); PG8_MMA(0, 1, At, B1); PG8_BAR;
            PG8_LDA(At, 0, 1); PG8_STAGE(PG8_SA(0, 0), a2, voffA);
            PG8_BAR; PG8_WAIT_L(0); PG8_MMA(1, 0, At, B0); PG8_BAR; PG8_SCHED;
            PG8_STAGE(PG8_SB(0, 1), b2 + hstep, voffB);
            PG8_WAIT_V(6); PG8_BAR; PG8_MMA(1, 1, At, B1); PG8_BAR;
            PG8_LDB(B0, 1, 0); PG8_SCHED; PG8_LDA(At, 1, 0); PG8_STAGE(PG8_SA(0, 1), a2 + hstep, voffA);
            PG8_WAIT_L(8); PG8_BAR; PG8_WAIT_L(0); PG8_MMA(0, 0, At, B0); PG8_BAR; PG8_SCHED;
            PG8_LDB(B1, 1, 1); PG8_STAGE(PG8_SB(1, 0), b3, voffB);
            PG8_BAR; PG8_WAIT_L(0); PG8_MMA(0, 1, At, B1); PG8_BAR;
            PG8_LDA(At, 1, 1); PG8_STAGE(PG8_SA(1, 0), a3, voffA);
            PG8_BAR; PG8_WAIT_L(0); PG8_MMA(1, 0, At, B0); PG8_BAR; PG8_SCHED;
            PG8_STAGE(PG8_SB(1, 1), b3 + hstep, voffB);
            PG8_WAIT_V(6); PG8_BAR; PG8_MMA(1, 1, At, B1); PG8_BAR;
            }
        }
        if constexpr (ALIGN_EPI) { if (wr == 0) PG8_BAR; }
        if constexpr (!Epi::AFTER_DRAIN) { E(acc, cur, wr, wc, fr, fq); S.done(cur); }
        if (!has_next) break;
#pragma unroll
        for (int a = 0; a < 2; ++a)
#pragma unroll
            for (int b = 0; b < 2; ++b)
#pragma unroll
                for (int m = 0; m < 4; ++m)
#pragma unroll
                    for (int n = 0; n < 2; ++n) acc[a][b][m][n] = (f32x4){0.f, 0.f, 0.f, 0.f};
        cur = nxt; cA = nA; cB = nB; ++ui;
        if constexpr (ALIGN_EPI) { if (wr == 1) PG8_BAR; }
    }
    PG8_WAIT_V(0);
    if constexpr (!ALIGN_EPI) { if (wr == 0) PG8_BAR; }
    PG8_BAR;
    if constexpr (Epi::AFTER_DRAIN) { E.fused(acc, cur, wr, wc, fr, fq, lds, wid, lane); S.done(cur); }
#undef PG8_SA
#undef PG8_SB
#undef PG8_STAGE
#undef PG8_LDA
#undef PG8_LDB
#undef PG8_MMA
#undef PG8_WAIT_V
#undef PG8_WAIT_L
#undef PG8_BAR
#undef PG8_SCHED
}
}
namespace pg8 {
struct EpiRes {
    static constexpr bool PERM = false, AFTER_DRAIN = false;
    const float* xp; const float* xs;
    float* out; const float* gate;
    __device__ __forceinline__ void operator()(const f32x4 (&acc)[2][2][4][2], const Unit& u, int wr, int wc, int fr, int fq) const {
        const int row0 = u.pm * BM + wr * 64 + fr, col0 = u.pn * BM + wc * 32 + 4 * fq;
        const int v = (u.pm * BM < 8192) ? 0 : 1 + ((u.pm * BM - 8192) >> 12);
        const float* g = gate + (size_t)v * 6144 + col0;
        f32x4 gv[2][2];
#pragma unroll
        for (int bj = 0; bj < 2; ++bj)
#pragma unroll
            for (int n = 0; n < 2; ++n) gv[bj][n] = *(const f32x4*)(g + bj * HALF + n * 16);
#pragma unroll
        for (int ai = 0; ai < 2; ++ai)
#pragma unroll
            for (int m = 0; m < 4; ++m) {
                const int row = row0 + ai * HALF + m * 16;
                const float* bp = (row < 8192 ? xp + (size_t)row * 1024 : xs + (size_t)(row - 8192) * 1024) + col0;
                float* op = out + (size_t)row * 1024 + col0;
#pragma unroll
                for (int bj = 0; bj < 2; ++bj)
#pragma unroll
                    for (int n = 0; n < 2; ++n) { const f32x4 b = *(const f32x4*)(bp + bj * HALF + n * 16); *(f32x4*)(op + bj * HALF + n * 16) = b + gv[bj][n] * acc[ai][bj][m][n]; }
            }
    }
};
}

constexpr int DM = 1024, TP = 8192, TSMP = 32768, TT = 40960, INW = 3072, FF = 2816, FF2 = 5632;
constexpr int NCHUNK = 320, HALF_T = 20480;
constexpr int OFF_LF = 41943040, OFF_LB = OFF_LF + 16384, OFF_RF = OFF_LB + 16384, OFF_RB = OFF_RF + 2097152;
constexpr size_t MiB = 1u << 20;
constexpr size_t WS_MOD = 0, WS_WL = 256 * 1024, WS_AGG = 1 * MiB, WS_CAR = 3 * MiB + 512 * 1024;
constexpr size_t WS_WIN = 5 * MiB, WS_WOUT = 11 * MiB, WS_WGU = 13 * MiB, WS_WD = 24 * MiB;
constexpr size_t WS_XN = 30 * MiB, WS_SB = 30 * MiB, WS_PROJ = 110 * MiB, WS_Y = 350 * MiB, WS_KVT = 430 * MiB;
constexpr size_t WS_GH = 110 * MiB, WS_U = 220 * MiB, WS_END = 510 * MiB;
constexpr int LDS_BYTES = 155648, LDSCTL_OFF = 151552;
constexpr size_t WS_BAR = 768 * 1024;
constexpr int NWAVES = 8;

#define GAS __attribute__((address_space(1)))
#define LAS __attribute__((address_space(3)))
typedef unsigned short bf16;
typedef unsigned v4u __attribute__((ext_vector_type(4)));
typedef unsigned v2u __attribute__((ext_vector_type(2)));
typedef float f32x4 __attribute__((ext_vector_type(4)));
typedef short bf16x8 __attribute__((ext_vector_type(8)));
#define LDS_WAIT() asm volatile("s_waitcnt lgkmcnt(0)" ::: "memory")
typedef float f32x2_t __attribute__((ext_vector_type(2)));
typedef __bf16 bf16x2_t __attribute__((ext_vector_type(2)));
__device__ __forceinline__ unsigned pk2(float lo, float hi) { const f32x2_t v = {lo, hi}; const bf16x2_t b = __builtin_convertvector(v, bf16x2_t); return __builtin_bit_cast(unsigned, b); }
__device__ __forceinline__ unsigned f2bf(float f) { return pk2(f, 0.f) & 0xffffu; }

__device__ __forceinline__ float bflo(unsigned w) { return __builtin_bit_cast(float, w << 16); }
__device__ __forceinline__ float bfhi(unsigned w) { return __builtin_bit_cast(float, w & 0xffff0000u); }
__device__ __forceinline__ float bf2f(unsigned short h) { return __builtin_bit_cast(float, ((unsigned)h) << 16); }
__device__ __forceinline__ float sigmoidf_(float x) { return 1.0f / (1.0f + __expf(-x)); }
__device__ __forceinline__ float siluf_(float x) { return x * __builtin_amdgcn_rcpf(1.0f + __builtin_amdgcn_exp2f(-1.4426950408889634f * x)); }
__device__ __forceinline__ float gelu_tanh(float x) { const float z = x * fmaf(0.044715f * x, x, 1.0f); return x * __builtin_amdgcn_rcpf(1.0f + __builtin_amdgcn_exp2f(-2.302208198f * z)); }

struct Args { const float* in[35]; float* out; unsigned char* ws; int ph_lo, ph_hi; };

#define XB_TMO      128
#define XB_XCNT(j)  (256  + 64 * (j))
#define XB_XSUB(j)  (1280 + 64 * (j))
#define XB_XGEN(j)  (2304 + 64 * (j))
#define XB_TOP      3328
#define XB_TOPGEN   3392
#define XCD_BAR_WORDS 3456
#define XB_SPIN_CAP (1u << 18)

__device__ __forceinline__ unsigned xb_ld(unsigned* p)              { return __hip_atomic_load(p, __ATOMIC_RELAXED, __HIP_MEMORY_SCOPE_AGENT); }
__device__ __forceinline__ unsigned xb_add(unsigned* p, unsigned v) { return __hip_atomic_fetch_add(p, v, __ATOMIC_RELAXED, __HIP_MEMORY_SCOPE_AGENT); }
__device__ __forceinline__ unsigned xb_xcc_id() { return (unsigned)__builtin_amdgcn_s_getreg((3 << 11) | 20) & 0xFu; }
#define XB_SPIN(cond, bar) do { unsigned _sp = 0; while (cond) { __builtin_amdgcn_s_sleep(1); \
    if ((++_sp & 255u) == 0u) { if (xb_ld(&(bar)[XB_TMO])) break; if (_sp > XB_SPIN_CAP) { atomicAdd(&(bar)[XB_TMO], 1u); break; } } } } while (0)

struct XcdBarrier {
    unsigned* bar; unsigned x;
    volatile LAS unsigned* st;
};

__device__ __forceinline__ XcdBarrier xcd_barrier_post(unsigned* bar, volatile LAS unsigned* st) {
    XcdBarrier b; b.bar = bar; b.x = xb_xcc_id(); b.st = st;
    if (threadIdx.x == 0) (void)xb_add(&bar[XB_XCNT(b.x)], 1u);
    return b;
}
__device__ __forceinline__ void xcd_barrier_complete(unsigned* bar, unsigned x, unsigned& nloc, unsigned& nx) {
    const unsigned G = gridDim.x * gridDim.y * gridDim.z;
    unsigned sum, cnt, mine, sp = 0u;
    for (;;) {
        sum = 0u; cnt = 0u; mine = 0u;
#pragma unroll
        for (unsigned j = 0; j < 16; ++j) { const unsigned c = xb_ld(&bar[XB_XCNT(j)]); sum += c; cnt += (c > 0u) ? 1u : 0u; mine = (j == x) ? c : mine; }
        if (sum == G) break;
        __builtin_amdgcn_s_sleep(1);
        if ((++sp & 255u) == 0u) { if (xb_ld(&bar[XB_TMO])) break; if (sp > XB_SPIN_CAP) { atomicAdd(&bar[XB_TMO], 1u); break; } }
    }
    nloc = mine > 0u ? mine : 1u; nx = cnt > 0u ? cnt : 1u;
}

__device__ __forceinline__ void xcd_barrier(const XcdBarrier& b) {
    asm volatile("s_waitcnt vmcnt(0)" ::: "memory");
    __syncthreads();
    if (threadIdx.x == 0) {
        unsigned* bar = b.bar;
        __builtin_amdgcn_s_waitcnt(0);
        unsigned nloc = b.st[0], nx = b.st[1];
        if (nloc == 0u) { xcd_barrier_complete(bar, b.x, nloc, nx); b.st[0] = nloc; b.st[1] = nx; }
        const unsigned old = xb_add(&bar[XB_XSUB(b.x)], 1u);
        const unsigned gen = old / nloc;
        if (old + 1u == (gen + 1u) * nloc) {
            __builtin_amdgcn_fence(__ATOMIC_RELEASE, "agent");
            asm volatile("s_waitcnt vmcnt(0)" ::: "memory");
            const unsigned og = xb_add(&bar[XB_TOP], 1u);
            const unsigned tg = og / nx;
            if (og + 1u == (tg + 1u) * nx) xb_add(&bar[XB_TOPGEN], 1u);
            else XB_SPIN(xb_ld(&bar[XB_TOPGEN]) == tg, bar);
            __builtin_amdgcn_fence(__ATOMIC_ACQUIRE, "agent");
            xb_add(&bar[XB_XGEN(b.x)], 1u);
            asm volatile("s_waitcnt vmcnt(0)" ::: "memory");
        } else {
            XB_SPIN(xb_ld(&bar[XB_XGEN(b.x)]) == gen, bar);
            __builtin_amdgcn_fence(__ATOMIC_ACQUIRE, "agent");
            asm volatile("s_waitcnt vmcnt(0)" ::: "memory");
        }
    }
    __syncthreads();
}
__device__ __forceinline__ float wave_sum(float v) {
#pragma unroll
    for (int o = 1; o < 64; o <<= 1) v += __shfl_xor(v, o);
    return v;
}
__device__ __forceinline__ void p0_transpose_item(const float* W, int K, int N, bf16* WT, int row_off, LAS float* scr, int item, int lane) {
    const int nblk = N / 32, kb = item / nblk, nb = item % nblk, k0 = 64 * kb, n0 = 32 * nb;
#pragma unroll 8
    for (int i = 0; i < 32; ++i) { const int kk = 2 * i + (lane >> 5); scr[kk * 33 + (lane & 31)] = W[(size_t)(k0 + kk) * N + n0 + (lane & 31)]; }
    LDS_WAIT(); asm volatile("" ::: "memory");
    const int c = lane & 7;
#pragma unroll
    for (int j = 0; j < 4; ++j) { const int n = (lane >> 3) + 8 * j; const LAS float* s = scr + (8 * c) * 33 + n;
        v4u o; o.x = pk2(s[0 * 33], s[1 * 33]); o.y = pk2(s[2 * 33], s[3 * 33]); o.z = pk2(s[4 * 33], s[5 * 33]); o.w = pk2(s[6 * 33], s[7 * 33]);
        *(v4u*)(WT + (size_t)(row_off + n0 + n) * K + k0 + 8 * c) = o; }
    LDS_WAIT(); asm volatile("" ::: "memory");
}
__device__ __forceinline__ int mod_index(int row) { return row < TP ? 0 : 1 + ((row - TP) >> 12); }

__device__ __forceinline__ void phase_prologue(const Args& a, LAS unsigned char* lds, int tid, int wave, int lane) {
    unsigned char* ws = a.ws;
    if (blockIdx.x < 96) {
        LAS float* sc = (LAS float*)lds;
        LAS float* red = (LAS float*)(lds + 9 * 1024 * 4);
        for (int i = tid; i < 9 * 1024; i += 512) { const int v = i >> 10, k = i & 1023; const float x = (v == 0) ? a.in[7][k] : a.in[6][(v - 1) * 1024 + k]; sc[i] = siluf_(x); }
        __syncthreads();
        const int col = blockIdx.x * 64 + lane;
        const float* wm = a.in[9] + col;
        float acc[9];
#pragma unroll
        for (int v = 0; v < 9; ++v) acc[v] = 0.f;
        const int kbeg = wave * 128;
#pragma unroll 8
        for (int kk = 0; kk < 128; ++kk) { const int k = kbeg + kk; const float wv = wm[(size_t)k * 6144];
#pragma unroll
            for (int v = 0; v < 9; ++v) acc[v] += sc[v * 1024 + k] * wv; }
#pragma unroll
        for (int v = 0; v < 9; ++v) red[(wave * 9 + v) * 64 + lane] = acc[v];
        __syncthreads();
        for (int i = tid; i < 9 * 64; i += 512) { const int v = i >> 6, l = i & 63; float s = 0.f;
#pragma unroll
            for (int w = 0; w < 8; ++w) s += red[(w * 9 + v) * 64 + l];
            const int cc = blockIdx.x * 64 + l; ((float*)(ws + WS_MOD))[v * 6144 + cc] = s + a.in[10][cc]; }
        __syncthreads();
    }
    LAS float* scr = (LAS float*)(lds + wave * 16384);
    const int gw = blockIdx.x * NWAVES + wave, NGW = gridDim.x * NWAVES;
    constexpr int I_IN = 16 * 96, I_OUT = 16 * 32, I_G = 16 * 88, I_D = 44 * 32, I_L = 64;
    constexpr int NITEMS = I_IN + I_OUT + 2 * I_G + I_D + I_L;
    for (int it = gw; it < NITEMS; it += NGW) {
        int r = it;
        if (r < I_IN) { p0_transpose_item(a.in[11], 1024, 3072, (bf16*)(ws + WS_WIN), 0, scr, r, lane); continue; } r -= I_IN;
        if (r < I_OUT) { p0_transpose_item(a.in[27], 1024, 1024, (bf16*)(ws + WS_WOUT), 0, scr, r, lane); continue; } r -= I_OUT;
        if (r < I_G) { p0_transpose_item(a.in[29], 1024, 2816, (bf16*)(ws + WS_WGU), 0, scr, r, lane); continue; } r -= I_G;
        if (r < I_G) { p0_transpose_item(a.in[30], 1024, 2816, (bf16*)(ws + WS_WGU), 2816, scr, r, lane); continue; } r -= I_G;
        if (r < I_D) { p0_transpose_item(a.in[33], 2816, 1024, (bf16*)(ws + WS_WD), 0, scr, r, lane); continue; } r -= I_D;
        { const int blk = r >> 1, sub = r & 1, mat = blk >> 3, nb = blk & 7;
          const float* src = (mat == 0 ? a.in[14] : mat == 1 ? a.in[16] : mat == 2 ? a.in[19] : a.in[21]) + nb * 4096;
          p0_transpose_item(src, 64, 64, (bf16*)(ws + WS_WL) + (size_t)(mat * 8 + nb) * 4096, 0, scr, sub, lane); }
    }
}

template <int MODE>
__device__ __forceinline__ void phase_rownorm(const float* xp, const float* xs, const float* w, const float* mod_scale, const float* mod_shift, bf16* obf, float* of32, int wave, int lane) {
    const int gw = blockIdx.x * NWAVES + wave, NGW = gridDim.x * NWAVES;
    f32x4 wv[4];
#pragma unroll
    for (int j = 0; j < 4; ++j) wv[j] = *(const f32x4*)(w + 4 * lane + 256 * j);
    for (int row0 = gw; row0 < TT; row0 += 2 * NGW) {
        const int row1 = row0 + NGW; const bool has1 = row1 < TT; const int r1 = has1 ? row1 : row0;
        const float* xr0 = (row0 < TP ? xp + (size_t)row0 * DM : xs + (size_t)(row0 - TP) * DM) + 4 * lane;
        const float* xr1 = (r1 < TP ? xp + (size_t)r1 * DM : xs + (size_t)(r1 - TP) * DM) + 4 * lane;
        f32x4 v0[4], v1[4]; float s0 = 0.f, s1 = 0.f;
#pragma unroll
        for (int j = 0; j < 4; ++j) { v0[j] = *(const f32x4*)(xr0 + 256 * j); v1[j] = *(const f32x4*)(xr1 + 256 * j); }
#pragma unroll
        for (int j = 0; j < 4; ++j) { s0 += (v0[j].x * v0[j].x + v0[j].y * v0[j].y) + (v0[j].z * v0[j].z + v0[j].w * v0[j].w); s1 += (v1[j].x * v1[j].x + v1[j].y * v1[j].y) + (v1[j].z * v1[j].z + v1[j].w * v1[j].w); }
        const float rs0 = 1.0f / sqrtf(wave_sum(s0) * (1.0f / DM) + 1e-6f), rs1 = 1.0f / sqrtf(wave_sum(s1) * (1.0f / DM) + 1e-6f);
#pragma unroll
        for (int k = 0; k < 2; ++k) {
            if (k == 1 && !has1) break;
            const int row = k ? row1 : row0; const float rstd = k ? rs1 : rs0;
            if (MODE == 0) {
                const int mv = mod_index(row);
                const float* sc = mod_scale + (size_t)mv * 6144 + 4 * lane; const float* sh = mod_shift + (size_t)mv * 6144 + 4 * lane;
                unsigned long long* o8 = (unsigned long long*)(obf + (size_t)row * DM) + lane;
#pragma unroll
                for (int j = 0; j < 4; ++j) { const f32x4 scv = *(const f32x4*)(sc + 256 * j), shv = *(const f32x4*)(sh + 256 * j);
                    const f32x4 y = (k ? v1[j] : v0[j]) * rstd * wv[j] * (scv + 1.0f) + shv;
                    o8[64 * j] = (unsigned long long)pk2(y.x, y.y) | ((unsigned long long)pk2(y.z, y.w) << 32); }
            } else {
                float* o = of32 + (size_t)row * DM + 4 * lane;
#pragma unroll
                for (int j = 0; j < 4; ++j) *(f32x4*)(o + 256 * j) = (k ? v1[j] : v0[j]) * rstd * wv[j];
            }
        }
    }
}

template <int MODE>
__device__ __forceinline__ void phase_resnorm(const float* xp, const float* xs, const bf16* tb, const float* gate, float* x1out, const float* w, const float* mod_scale, const float* mod_shift,
                                              bf16* obf, float* of32, int wave, int lane, const bf16* tbx = nullptr, int tbx_row0 = 0) {
    const int gw = blockIdx.x * NWAVES + wave, NGW = gridDim.x * NWAVES;
    f32x4 wv[4];
#pragma unroll
    for (int j = 0; j < 4; ++j) wv[j] = *(const f32x4*)(w + 4 * lane + 256 * j);
    for (int row0 = gw; row0 < TT; row0 += 2 * NGW) {
        const int row1 = row0 + NGW; const bool has1 = row1 < TT; const int r1 = has1 ? row1 : row0;
        const float* xr0 = (row0 < TP ? xp + (size_t)row0 * DM : xs + (size_t)(row0 - TP) * DM) + 4 * lane;
        const float* xr1 = (r1 < TP ? xp + (size_t)r1 * DM : xs + (size_t)(r1 - TP) * DM) + 4 * lane;
        const bf16* t0 = tb + (size_t)row0 * DM + 4 * lane; const bf16* t1 = tb + (size_t)r1 * DM + 4 * lane;
        f32x4 v0[4], v1[4]; v2u u0[4], u1[4];
#pragma unroll
        for (int j = 0; j < 4; ++j) { v0[j] = *(const f32x4*)(xr0 + 256 * j); v1[j] = *(const f32x4*)(xr1 + 256 * j); u0[j] = *(const v2u*)(t0 + 256 * j); u1[j] = *(const v2u*)(t1 + 256 * j); }
        const float* g0 = gate + (size_t)mod_index(row0) * 6144 + 4 * lane; const float* g1 = gate + (size_t)mod_index(r1) * 6144 + 4 * lane;
        v2u e0[4], e1[4]; const bool x0 = tbx && row0 >= tbx_row0, x1 = tbx && r1 >= tbx_row0;
#pragma unroll
        for (int j = 0; j < 4; ++j) { e0[j] = (v2u){0u, 0u}; e1[j] = (v2u){0u, 0u}; }
        if (x0) {
#pragma unroll
            for (int j = 0; j < 4; ++j) e0[j] = *(const v2u*)(tbx + (size_t)(row0 - tbx_row0) * DM + 4 * lane + 256 * j); }
        if (x1) {
#pragma unroll
            for (int j = 0; j < 4; ++j) e1[j] = *(const v2u*)(tbx + (size_t)(r1 - tbx_row0) * DM + 4 * lane + 256 * j); }
        float s0 = 0.f, s1 = 0.f;
#pragma unroll
        for (int j = 0; j < 4; ++j) { const f32x4 ga = *(const f32x4*)(g0 + 256 * j), gb = *(const f32x4*)(g1 + 256 * j);
            v0[j] = v0[j] + ga * ((f32x4){bflo(u0[j][0]), bfhi(u0[j][0]), bflo(u0[j][1]), bfhi(u0[j][1])} + (f32x4){bflo(e0[j][0]), bfhi(e0[j][0]), bflo(e0[j][1]), bfhi(e0[j][1])});
            v1[j] = v1[j] + gb * ((f32x4){bflo(u1[j][0]), bfhi(u1[j][0]), bflo(u1[j][1]), bfhi(u1[j][1])} + (f32x4){bflo(e1[j][0]), bfhi(e1[j][0]), bflo(e1[j][1]), bfhi(e1[j][1])});
            s0 += (v0[j].x * v0[j].x + v0[j].y * v0[j].y) + (v0[j].z * v0[j].z + v0[j].w * v0[j].w); s1 += (v1[j].x * v1[j].x + v1[j].y * v1[j].y) + (v1[j].z * v1[j].z + v1[j].w * v1[j].w); }
        const float rs0 = 1.0f / sqrtf(wave_sum(s0) * (1.0f / DM) + 1e-6f), rs1 = 1.0f / sqrtf(wave_sum(s1) * (1.0f / DM) + 1e-6f);
#pragma unroll
        for (int k = 0; k < 2; ++k) {
            if (k == 1 && !has1) break;
            const int row = k ? row1 : row0; const float rstd = k ? rs1 : rs0;
            if (x1out) { float* o = x1out + (size_t)row * DM + 4 * lane;
#pragma unroll
                for (int j = 0; j < 4; ++j) *(f32x4*)(o + 256 * j) = (k ? v1[j] : v0[j]); }
            if (MODE == 0) {
                const int mv = mod_index(row);
                const float* sc = mod_scale + (size_t)mv * 6144 + 4 * lane; const float* sh = mod_shift + (size_t)mv * 6144 + 4 * lane;
                unsigned long long* o8 = (unsigned long long*)(obf + (size_t)row * DM) + lane;
#pragma unroll
                for (int j = 0; j < 4; ++j) { const f32x4 scv = *(const f32x4*)(sc + 256 * j), shv = *(const f32x4*)(sh + 256 * j);
                    const f32x4 y = (k ? v1[j] : v0[j]) * rstd * wv[j] * (scv + 1.0f) + shv;
                    o8[64 * j] = (unsigned long long)pk2(y.x, y.y) | ((unsigned long long)pk2(y.z, y.w) << 32); }
            } else {
                float* o = of32 + (size_t)row * DM + 4 * lane;
#pragma unroll
                for (int j = 0; j < 4; ++j) *(f32x4*)(o + 256 * j) = (k ? v1[j] : v0[j]) * rstd * wv[j];
            }
        }
    }
}
constexpr int RS = 288;
constexpr int REG = 128 * RS;
constexpr int XCS = 1056;
#define MFMA16(a, b, c) __builtin_amdgcn_mfma_f32_16x16x32_bf16((a), (b), (c), 0, 0, 0)

__device__ __forceinline__ void mm128(f32x4 (&acc)[8], const LAS unsigned char* Aimg, const LAS unsigned char* Bimg, int wave, int c, int q) {
#pragma unroll
    for (int s = 0; s < 4; ++s) {
        const bf16x8 af = *(const LAS bf16x8*)(Aimg + (16 * wave + c) * RS + (32 * s + 8 * q) * 2);
#pragma unroll
        for (int t = 0; t < 8; ++t) { const bf16x8 bfr = *(const LAS bf16x8*)(Bimg + (16 * t + c) * RS + (32 * s + 8 * q) * 2); acc[t] = MFMA16(bfr, af, acc[t]); }
    }
}
__device__ __forceinline__ void mm128x2(f32x4 (&acc1)[8], f32x4 (&acc2)[8], const LAS unsigned char* Aimg, const LAS unsigned char* B1, const LAS unsigned char* B2, int wave, int c, int q) {
#pragma unroll
    for (int s = 0; s < 4; ++s) {
        const bf16x8 af = *(const LAS bf16x8*)(Aimg + (16 * wave + c) * RS + (32 * s + 8 * q) * 2);
#pragma unroll
        for (int t = 0; t < 8; ++t) { const bf16x8 b1 = *(const LAS bf16x8*)(B1 + (16 * t + c) * RS + (32 * s + 8 * q) * 2); acc1[t] = MFMA16(b1, af, acc1[t]);
                                      const bf16x8 b2 = *(const LAS bf16x8*)(B2 + (16 * t + c) * RS + (32 * s + 8 * q) * 2); acc2[t] = MFMA16(b2, af, acc2[t]); }
    }
}
__device__ __forceinline__ void load_rm(LAS unsigned char* img, const bf16* g, int pitch, int tid) {
#pragma unroll
    for (int i = 0; i < 4; ++i) { const int p = tid + 512 * i, row = p >> 4, cp = p & 15; const v4u v = *(const v4u*)(g + (size_t)row * pitch + cp * 8); *(LAS v4u*)(img + row * RS + cp * 16) = v; }
}
__device__ __forceinline__ void load_tiled(LAS unsigned char* img, const bf16* g, int tid) {
#pragma unroll
    for (int i = 0; i < 4; ++i) { const int p = tid + 512 * i, cp = p >> 7, row = p & 127; const v4u v = *(const v4u*)(g + (size_t)p * 8); *(LAS v4u*)(img + row * RS + cp * 16) = v; }
}
#define HW(v, e) (((e) & 1) ? ((v)[(e) >> 1] >> 16) : ((v)[(e) >> 1] & 0xffffu))
__device__ __forceinline__ void load_tr(LAS unsigned char* img, const bf16* g, int pitch, int wave, int lane) {
#pragma unroll
    for (int it = 0; it < 2; ++it) { const int dg = wave + 8 * it;
        const v4u a = *(const v4u*)(g + (size_t)(2 * lane) * pitch + dg * 8), b = *(const v4u*)(g + (size_t)(2 * lane + 1) * pitch + dg * 8);
#pragma unroll
        for (int e = 0; e < 8; ++e) { const unsigned lo = HW(a, e), hi = HW(b, e); *(LAS unsigned*)(img + (dg * 8 + e) * RS + lane * 4) = lo | (hi << 16); } }
}
__device__ __forceinline__ float log_sigmoid_(float x) { return -log1pf(__expf(-x)); }

template <int PASS>
__device__ __forceinline__ void ret_item(const Args& a, LAS unsigned char* lds, int ci, int h, int tid, int wave, int lane) {
    unsigned char* ws = a.ws;
    const int c = lane & 15, q = lane >> 4;
    const bf16* PROJ = (const bf16*)(ws + WS_PROJ);
    const size_t rowbase = (size_t)ci * 128;
    const bf16* Qg = PROJ + rowbase * INW + 1024 + h * 128;
    const bf16* Kg = PROJ + rowbase * INW + 1536 + h * 128;
    const bf16* Vg = PROJ + rowbase * INW + 2048 + h * 128;
    const float lf2 = log_sigmoid_(a.in[24][h]) * 1.4426950408889634f, lb2 = log_sigmoid_(a.in[25][h]) * 1.4426950408889634f;
    const float scale = 0.08838834764831845f;
    LAS unsigned char* R1 = lds; LAS unsigned char* R2 = lds + REG; LAS unsigned char* R3 = lds + 2 * REG; LAS unsigned char* R4 = lds + 3 * REG;
    if (PASS == 1) {
        const float j0 = (float)(2 * lane), j1 = (float)(2 * lane + 1);
        const float wf0 = scale * __builtin_amdgcn_exp2f(lf2 * (127.f - j0)), wf1 = scale * __builtin_amdgcn_exp2f(lf2 * (127.f - j1)), wb0 = scale * __builtin_amdgcn_exp2f(lb2 * j0), wb1 = scale * __builtin_amdgcn_exp2f(lb2 * j1);
        load_tr(R1, Kg, INW, wave, lane);
#pragma unroll
        for (int it = 0; it < 2; ++it) { const int dg = wave + 8 * it;
            const v4u va = *(const v4u*)(Vg + (size_t)(2 * lane) * INW + dg * 8), vb = *(const v4u*)(Vg + (size_t)(2 * lane + 1) * INW + dg * 8);
#pragma unroll
            for (int e = 0; e < 8; ++e) { const float lo = bf2f((unsigned short)HW(va, e)), hi = bf2f((unsigned short)HW(vb, e));
                *(LAS unsigned*)(R2 + (dg * 8 + e) * RS + lane * 4) = pk2(lo * wf0, hi * wf1);
                *(LAS unsigned*)(R3 + (dg * 8 + e) * RS + lane * 4) = pk2(lo * wb0, hi * wb1); } }
        __syncthreads();
        f32x4 af[8], ab[8];
#pragma unroll
        for (int t = 0; t < 8; ++t) { af[t] = (f32x4){0.f, 0.f, 0.f, 0.f}; ab[t] = (f32x4){0.f, 0.f, 0.f, 0.f}; }
        mm128(af, R2, R1, wave, c, q);
        mm128(ab, R3, R1, wave, c, q);
        bf16* KVT = (bf16*)(ws + WS_KVT) + ((size_t)(ci * 4 + h) * 2) * 16384 + ((q >> 1) * 128 + 16 * wave + c) * 8 + 4 * (q & 1);
#pragma unroll
        for (int t = 0; t < 8; ++t) { *(v2u*)(KVT + 2 * t * 1024) = (v2u){pk2(af[t][0], af[t][1]), pk2(af[t][2], af[t][3])};
                                      *(v2u*)(KVT + 16384 + 2 * t * 1024) = (v2u){pk2(ab[t][0], ab[t][1]), pk2(ab[t][2], ab[t][3])}; }
        __syncthreads();
    } else {
        const bf16* SB = (const bf16*)(ws + WS_SB) + ((size_t)(ci * 4 + h) * 2) * 16384;
        load_rm(R1, Qg, INW, tid);
        load_rm(R2, Kg, INW, tid);
        load_tr(R3, Vg, INW, wave, lane);
        load_tiled(R4, SB, tid);
        __syncthreads();
        f32x4 aS[8], aF[8];
#pragma unroll
        for (int t = 0; t < 8; ++t) { aS[t] = (f32x4){0.f, 0.f, 0.f, 0.f}; aF[t] = (f32x4){0.f, 0.f, 0.f, 0.f}; }
        mm128x2(aS, aF, R1, R2, R4, wave, c, q);
        __syncthreads();
        const int i = 16 * wave + c;
#pragma unroll
        for (int t = 0; t < 8; ++t) { float p[4];
#pragma unroll
            for (int r = 0; r < 4; ++r) { const int dl = i - (16 * t + 4 * q + r);
                const float ex = __builtin_amdgcn_exp2f(dl > 0 ? lf2 * (float)dl : lb2 * (float)(-dl));
                const float f = dl == 0 ? 2.0f : ex;
                p[r] = aS[t][r] * scale * f; }
            *(LAS v2u*)(R2 + i * RS + (16 * t + 4 * q) * 2) = (v2u){pk2(p[0], p[1]), pk2(p[2], p[3])}; }
        load_tiled(R4, SB + 16384, tid);
        __syncthreads();
        const float hf = __builtin_amdgcn_exp2f(lf2 * (float)(i + 1)), hb = __builtin_amdgcn_exp2f(lb2 * (float)(128 - i));
        f32x4 aB[8];
#pragma unroll
        for (int t = 0; t < 8; ++t) { aF[t] = aF[t] * hf; aB[t] = (f32x4){0.f, 0.f, 0.f, 0.f}; }
        mm128(aF, R2, R3, wave, c, q);
        mm128(aB, R1, R4, wave, c, q);
        f32x4 (&aO)[8] = aF;
        float s = 0.f;
#pragma unroll
        for (int t = 0; t < 8; ++t) { aO[t] = aO[t] + aB[t] * hb; s += (aO[t][0] + aO[t][1]) + (aO[t][2] + aO[t][3]); }
        s += __shfl_xor(s, 16); s += __shfl_xor(s, 32);
        const float mean = s * (1.0f / 128.0f); float v2 = 0.f;
#pragma unroll
        for (int t = 0; t < 8; ++t) { aO[t] = aO[t] - mean; v2 += (aO[t][0] * aO[t][0] + aO[t][1] * aO[t][1]) + (aO[t][2] * aO[t][2] + aO[t][3] * aO[t][3]); }
        v2 += __shfl_xor(v2, 16); v2 += __shfl_xor(v2, 32);
        const float rstd = 1.0f / sqrtf(v2 * (1.0f / 128.0f) + 1e-6f);
        const bf16* Gg = PROJ + (rowbase + i) * INW + 2560 + h * 128 + 4 * q;
        const float* gn = a.in[26] + h * 128 + 4 * q;
        bf16* Yp = (bf16*)(ws + WS_Y) + (rowbase + i) * DM + 512 + h * 128 + 4 * q;
#pragma unroll
        for (int t = 0; t < 8; ++t) { const v2u gv = *(const v2u*)(Gg + 16 * t); const f32x4 w = *(const f32x4*)(gn + 16 * t);
            const float y0 = aO[t][0] * rstd * w[0] * siluf_(bflo(gv[0])), y1 = aO[t][1] * rstd * w[1] * siluf_(bfhi(gv[0]));
            const float y2 = aO[t][2] * rstd * w[2] * siluf_(bflo(gv[1])), y3 = aO[t][3] * rstd * w[3] * siluf_(bfhi(gv[1]));
            *(v2u*)(Yp + 16 * t) = (v2u){pk2(y0, y1), pk2(y2, y3)};
            if (t & 1) asm volatile("" ::: "memory"); }
        __syncthreads();
    }
}
template <int PASS, int DIR>
__device__ __forceinline__ void lru_dir(const LAS unsigned char* xcl, const bf16x8 (&idf)[2], const bf16x8 (&wa)[2], const bf16x8 (&wx)[2], float ba, float bx, float sp8,
                                        float hc_in, float* hsp, float& Aout, float& Hout, float& edge, int c, int q, const bf16* Gp, bf16* Yp) {
    float Ac = 1.f, Hc = hc_in;
    float hn[4]; unsigned short gn[4];
    if (PASS == 3 && DIR == 1) {
#pragma unroll
        for (int r = 0; r < 4; ++r) { hn[r] = hsp[(7 * 4 + r) * 64]; gn[r] = Gp[(size_t)(16 * 7 + 4 * q + r) * INW]; }
    }
#pragma unroll 1
    for (int ti = 0; ti < 8; ++ti) {
        const int tt = DIR == 0 ? ti : 7 - ti;
        float hcur[4]; unsigned short gcur[4];
        if (PASS == 3 && DIR == 1) {
#pragma unroll
            for (int r = 0; r < 4; ++r) { hcur[r] = hn[r]; gcur[r] = gn[r]; }
            const int tn = tt > 0 ? tt - 1 : 0;
#pragma unroll
            for (int r = 0; r < 4; ++r) { hn[r] = hsp[(tn * 4 + r) * 64]; gn[r] = Gp[(size_t)(16 * tn + 4 * q + r) * INW]; }
        }
        f32x4 aI = (f32x4){0.f, 0.f, 0.f, 0.f}, aA = aI, aX = aI;
#pragma unroll
        for (int s = 0; s < 2; ++s) { const bf16x8 xf = *(const LAS bf16x8*)(xcl + (16 * tt) * XCS + 64 * s);
            aI = MFMA16(xf, idf[s], aI); aA = MFMA16(xf, wa[s], aA); aX = MFMA16(xf, wx[s], aX); }
        float av[4], uv[4];
#pragma unroll
        for (int r = 0; r < 4; ++r) {
            const float rg = __builtin_amdgcn_rcpf(1.0f + __builtin_amdgcn_exp2f(fmaf(aA[r], -1.4426950408889634f, ba)));
            const float ig = __builtin_amdgcn_rcpf(1.0f + __builtin_amdgcn_exp2f(fmaf(aX[r], -1.4426950408889634f, bx)));
            const float la = -sp8 * rg;
            const float aa = __builtin_amdgcn_exp2f(la * 1.4426950408889634f);
            const float t = -2.0f * la;
            const float ser = t * fmaf(-0.5f * t, fmaf(-0.33333334f * t, fmaf(-0.25f, t, 1.0f), 1.0f), 1.0f);
            const float om = t < 0.125f ? ser : fmaf(-aa, aa, 1.0f);
            av[r] = aa; uv[r] = __builtin_amdgcn_sqrtf(om) * (ig * aI[r]); }
        float pa[4], hl[4]; float P = 1.f, H = 0.f;
#pragma unroll
        for (int rr = 0; rr < 4; ++rr) { const int r = DIR == 0 ? rr : 3 - rr; H = av[r] * H + uv[r]; P *= av[r]; pa[r] = P; hl[r] = H; }
        float A = P, Hh = H, Ap, Hp, Ae, He, At, Ht;
        if (DIR == 0) {
            Ap = __shfl_up(A, 16); Hp = __shfl_up(Hh, 16); if (q >= 1) { Hh = A * Hp + Hh; A = Ap * A; }
            Ap = __shfl_up(A, 32); Hp = __shfl_up(Hh, 32); if (q >= 2) { Hh = A * Hp + Hh; A = Ap * A; }
            Ae = __shfl_up(A, 16); He = __shfl_up(Hh, 16); if (q == 0) { Ae = 1.f; He = 0.f; }
            At = __shfl(A, 48 + c); Ht = __shfl(Hh, 48 + c);
        } else {
            Ap = __shfl_down(A, 16); Hp = __shfl_down(Hh, 16); if (q <= 2) { Hh = A * Hp + Hh; A = Ap * A; }
            Ap = __shfl_down(A, 32); Hp = __shfl_down(Hh, 32); if (q <= 1) { Hh = A * Hp + Hh; A = Ap * A; }
            Ae = __shfl_down(A, 16); He = __shfl_down(Hh, 16); if (q == 3) { Ae = 1.f; He = 0.f; }
            At = __shfl(A, c); Ht = __shfl(Hh, c);
        }
        if (PASS == 3) {
            const float hin = Ae * Hc + He;
#pragma unroll
            for (int r = 0; r < 4; ++r) { const float hv = pa[r] * hin + hl[r];
                if (DIR == 0) hsp[(tt * 4 + r) * 64] = hv;
                else { const size_t tok = (size_t)(16 * tt + 4 * q + r); Yp[tok * DM] = (bf16)f2bf((hcur[r] + hv) * gelu_tanh(bf2f(gcur[r]))); }
                if (DIR == 0 && tt == 0 && r == 0) edge = hv;
                if (DIR == 1 && tt == 7 && r == 3) edge = hv; }
        }
        Hc = At * Hc + Ht; Ac = Ac * At;
    }
    Aout = Ac; Hout = Hc;
}

template <int PASS>
__device__ __forceinline__ void lru_item(const Args& a, LAS unsigned char* lds, int ci, int tid, int wave, int lane) {
    unsigned char* ws = a.ws;
    const int c = lane & 15, q = lane >> 4;
    const bf16* PROJ = (const bf16*)(ws + WS_PROJ);
    int seq, n, seqlen, seqtok0, nch;
    if (ci < 64) { seq = ci >> 1; n = ci & 1; seqlen = 256; seqtok0 = seq * 256; nch = 2; }
    else { seq = (ci - 64) >> 5; n = (ci - 64) & 31; seqlen = 4096; seqtok0 = TP + seq * 4096; nch = 32; }
    const bool isprompt = ci < 64;
    const int p0 = n * 128;
    {
        float w0[8], w1[8], w2[8], w3[8], bb[8];
#pragma unroll
        for (int e = 0; e < 8; ++e) { w0[e] = a.in[12][0 * 512 + 8 * lane + e]; w1[e] = a.in[12][1 * 512 + 8 * lane + e]; w2[e] = a.in[12][2 * 512 + 8 * lane + e]; w3[e] = a.in[12][3 * 512 + 8 * lane + e]; bb[e] = a.in[13][8 * lane + e]; }
        const int pb = p0 + 16 * wave;
        const bf16* base = PROJ + (size_t)seqtok0 * INW + 8 * lane;
#define LDROW(p) (((p) < 0 || (p) >= seqlen) ? (v4u){0u, 0u, 0u, 0u} : *(const v4u*)(base + (size_t)(p) * INW))
        v4u rows[19];
#pragma unroll
        for (int k = 0; k < 19; ++k) rows[k] = LDROW(pb - 2 + k);
#pragma unroll
        for (int i = 0; i < 16; ++i) {
            float o[8];
#pragma unroll
            for (int e = 0; e < 8; ++e) o[e] = fmaf(w3[e], bf2f((unsigned short)HW(rows[i + 3], e)), fmaf(w2[e], bf2f((unsigned short)HW(rows[i + 2], e)), fmaf(w1[e], bf2f((unsigned short)HW(rows[i + 1], e)), fmaf(w0[e], bf2f((unsigned short)HW(rows[i], e)), bb[e]))));
            *(LAS v4u*)(lds + (16 * wave + i) * XCS + 16 * lane) = (v4u){pk2(o[0], o[1]), pk2(o[2], o[3]), pk2(o[4], o[5]), pk2(o[6], o[7])};
        }
#undef LDROW
    }
    __syncthreads();
    const LAS unsigned char* xcl = lds + c * XCS + (64 * wave + 8 * q) * 2;
    const bf16* WL = (const bf16*)(ws + WS_WL);
    const size_t rowbase = (size_t)seqtok0 + p0;
    for (int rt = 0; rt < 4; ++rt) {
        const int dl = 16 * rt + c, d = 64 * wave + dl;
        bf16x8 idf[2];
#pragma unroll
        for (int s = 0; s < 2; ++s)
#pragma unroll
            for (int e = 0; e < 8; ++e) idf[s][e] = (32 * s + 8 * q + e == dl) ? (short)0x3F80 : (short)0;
        float* hs = a.out + (size_t)(blockIdx.x * NWAVES + wave) * 2048 + lane;
        float Af, Hf, Ab, Hb, ef = 0.f, eb = 0.f;
        float cf = 0.f, cb = 0.f;
        if (PASS == 3) { cf = ((const float*)(ws + WS_CAR))[(size_t)(ci * 2 + 0) * 512 + d]; cb = ((const float*)(ws + WS_CAR))[(size_t)(ci * 2 + 1) * 512 + d]; }
        const bf16* Gp = PROJ + rowbase * INW + 512 + d;
        bf16* Yp = (bf16*)(ws + WS_Y) + rowbase * DM + d;
        bf16x8 waf[2], wxf[2], wab[2], wxb[2];
#pragma unroll
        for (int s2 = 0; s2 < 2; ++s2) { const int o = dl * 64 + 32 * s2 + 8 * q;
            waf[s2] = *(const bf16x8*)(WL + (size_t)(0 * 8 + wave) * 4096 + o); wxf[s2] = *(const bf16x8*)(WL + (size_t)(1 * 8 + wave) * 4096 + o);
            wab[s2] = *(const bf16x8*)(WL + (size_t)(2 * 8 + wave) * 4096 + o); wxb[s2] = *(const bf16x8*)(WL + (size_t)(3 * 8 + wave) * 4096 + o); }
        const float baf = a.in[15][d], bxf = a.in[17][d], lmf = a.in[18][d], bab = a.in[20][d], bxb = a.in[22][d], lmb = a.in[23][d];
        lru_dir<PASS, 0>(xcl, idf, waf, wxf, -1.4426950408889634f * baf, -1.4426950408889634f * bxf, 8.0f * log1pf(__expf(-lmf)), cf, hs, Af, Hf, ef, c, q, Gp, Yp);
        lru_dir<PASS, 1>(xcl, idf, wab, wxb, -1.4426950408889634f * bab, -1.4426950408889634f * bxb, 8.0f * log1pf(__expf(-lmb)), cb, hs, Ab, Hb, eb, c, q, Gp, Yp);
        if (PASS == 1) {
            if (q == 0) { float* ag = (float*)(ws + WS_AGG) + (size_t)(ci * 2) * 1024 + d; ag[0] = Af; ag[512] = Hf; ag[1024] = Ab; ag[1536] = Hb; }
        } else {
            if (isprompt && n == 0 && q == 0) a.out[OFF_LF + seq * 512 + d] = ef;
            if (isprompt && n == nch - 1 && q == 3) a.out[OFF_LB + seq * 512 + d] = eb;
        }
    }
    __syncthreads();
}

__device__ __forceinline__ void phase_carries(const Args& a, int tid) {
    unsigned char* ws = a.ws;
    const int gtid = blockIdx.x * 512 + tid, GT = gridDim.x * 512;
    for (int task = gtid; task < 655360; task += GT) {
        const int dv = task & 127, dkg = (task >> 7) & 15, dir = (task >> 11) & 1, h = (task >> 12) & 3, sq = task >> 14;
        const bool isprompt = sq >= 8; const int seq = isprompt ? sq - 8 : sq, N = isprompt ? 2 : 32, cibase = isprompt ? seq * 2 : 64 + seq * 32;
        const float g = __expf(log_sigmoid_(dir ? a.in[25][h] : a.in[24][h]) * 128.0f);
        float S[8];
        if (isprompt) {
#pragma unroll
            for (int e = 0; e < 8; ++e) S[e] = 0.f;
        } else { const float* s0 = (dir ? a.in[5] : a.in[4]) + ((size_t)(seq * 4 + h) * 128 + dkg * 8) * 128 + dv;
#pragma unroll
            for (int e = 0; e < 8; ++e) S[e] = s0[e * 128]; }
        const size_t ibase = ((size_t)h * 2 + dir) * 16384 + ((size_t)dkg * 128 + dv) * 8;
        const bf16* kvp = (const bf16*)(ws + WS_KVT) + ibase; bf16* sbp = (bf16*)(ws + WS_SB) + ibase;
        for (int s0 = 0; s0 < N; s0 += 8) {
            v4u kv[8];
#pragma unroll
            for (int j = 0; j < 8; ++j) { const int step = s0 + j; const int n = dir ? N - 1 - step : step; const int ci = cibase + (step < N ? n : (dir ? 0 : N - 1));
                kv[j] = *(const v4u*)(kvp + (size_t)ci * 131072); }
#pragma unroll
            for (int j = 0; j < 8; ++j) { const int step = s0 + j;
                if (step < N) { const int n = dir ? N - 1 - step : step, ci = cibase + n;
                    *(v4u*)(sbp + (size_t)ci * 131072) = (v4u){pk2(S[0], S[1]), pk2(S[2], S[3]), pk2(S[4], S[5]), pk2(S[6], S[7])};
#pragma unroll
                    for (int e2 = 0; e2 < 8; ++e2) S[e2] = g * S[e2] + bf2f((unsigned short)HW(kv[j], e2)); } }
        }
        if (isprompt) { float* o = a.out + (dir ? OFF_RB : OFF_RF) + ((size_t)(seq * 4 + h) * 128 + dkg * 8) * 128 + dv;
#pragma unroll
            for (int e = 0; e < 8; ++e) o[e * 128] = S[e]; }
    }
    for (int task = gtid; task < 40960; task += GT) {
        const int d = task & 511, dir = (task >> 9) & 1, sq = task >> 10;
        const bool isprompt = sq >= 8; const int seq = isprompt ? sq - 8 : sq, N = isprompt ? 2 : 32, cibase = isprompt ? seq * 2 : 64 + seq * 32;
        float hcar = isprompt ? 0.f : (dir ? a.in[3] : a.in[2])[seq * 512 + d];
        for (int step = 0; step < N; ++step) {
            const int n = dir ? N - 1 - step : step, ci = cibase + n;
            ((float*)(ws + WS_CAR))[(size_t)(ci * 2 + dir) * 512 + d] = hcar;
            const float* ag = (const float*)(ws + WS_AGG) + ((size_t)(ci * 2 + dir) * 2) * 512 + d;
            hcar = ag[0] * hcar + ag[512];
        }
    }
}

__device__ __forceinline__ v4u ldg16(const bf16* p, bool ok) { return ok ? *(const v4u*)p : (v4u){0u, 0u, 0u, 0u}; }
__device__ __forceinline__ void phase_act(const Args& a, int half, int wave, int lane) {
    unsigned char* ws = a.ws;
    const bf16* __restrict__ GH = (const bf16*)(ws + WS_GH);
    bf16* __restrict__ U = (bf16*)(ws + WS_U);
    const int gw = blockIdx.x * NWAVES + wave, NGW = gridDim.x * NWAVES;
    const int p = lane >> 5;
    const bool tailsplit = (NGW == 2048);
    for (int kk = 0; kk < (tailsplit ? 4 : (7040 + NGW - 1) / NGW); ++kk) {
        int wt, nst = 16, soff = 0;
        if (!tailsplit) { wt = gw + kk * NGW; if (wt >= 7040) break; }
        else if (kk < 3) wt = gw + kk * 2048;
        else { if (gw >= 1792) break; wt = 6144 + (gw >> 1); nst = 8; soff = 8 * (gw & 1); }
        const int slab = wt % 11; int r = wt / 11;
        int tok0, ts, lat, steps0, nwalk;
        bool isimg;
        if (half == 1 || r >= 256) {
            if (half == 0) r -= 256;
            const int pair = r & 31, seg = (r >> 5) & 3, img = (r >> 7) + (half == 0 ? 0 : 3);
            const int gc = 2 * pair + p; steps0 = 16 * seg + soff; nwalk = 64; ts = 64; lat = 1; isimg = true;
            tok0 = TP + img * 4096 + steps0 * 64 + gc;
        } else {
            const int sp = r & 7, seq = r >> 3; steps0 = 32 * sp + 16 * p + soff; nwalk = 256; ts = 1; lat = 0; isimg = false;
            tok0 = seq * 256 + steps0;
        }
        const int ch0 = (slab * 32 + (lane & 31)) * 8;
        const int gcol = isimg ? (tok0 & 63) : 1;
        const bool okl = isimg && gcol > 0, okr = isimg && gcol < 63;
        float wk[9][8], bb[8];
#pragma unroll
        for (int k = 0; k < 9; ++k) { const int aa = k / 3, b = k % 3;
            const int src = isimg ? k : (3 + aa);
            const f32x4 x0 = *(const f32x4*)(a.in[31] + (size_t)src * FF + ch0), x1 = *(const f32x4*)(a.in[31] + (size_t)src * FF + ch0 + 4);
            const float z = (isimg || b == 1) ? 1.f : 0.f;
            wk[k][0] = x0[0] * z; wk[k][1] = x0[1] * z; wk[k][2] = x0[2] * z; wk[k][3] = x0[3] * z; wk[k][4] = x1[0] * z; wk[k][5] = x1[1] * z; wk[k][6] = x1[2] * z; wk[k][7] = x1[3] * z; }
        { const f32x4 x0 = *(const f32x4*)(a.in[32] + ch0), x1 = *(const f32x4*)(a.in[32] + ch0 + 4); bb[0] = x0[0]; bb[1] = x0[1]; bb[2] = x0[2]; bb[3] = x0[3]; bb[4] = x1[0]; bb[5] = x1[1]; bb[6] = x1[2]; bb[7] = x1[3]; }
        const bf16* gp = GH + (size_t)(tok0 - half * HALF_T) * FF + ch0;
        bf16* up = U + (size_t)tok0 * FF + ch0;
        const size_t gs = (size_t)ts * FF;
        v4u w0[3], w1[3], w2[3], w3[3];
        { const bool okp = steps0 > 0;
          w0[0] = ldg16(gp - gs - FF, okp && okl); w0[1] = ldg16(gp - gs, okp); w0[2] = ldg16(gp - gs + FF, okp && okr);
          w1[0] = ldg16(gp - FF, okl); w1[1] = *(const v4u*)gp; w1[2] = ldg16(gp + FF, okr); }
#pragma unroll 1
        for (int st = 0; st < nst; st += 2) {
            const bool ok2 = steps0 + st + 1 < nwalk, ok3 = steps0 + st + 2 < nwalk;
            const bf16* g2 = gp + (size_t)(st + 1) * gs; const bf16* g3 = g2 + gs;
            w2[0] = ldg16(g2 - FF, ok2 && okl); w2[1] = ldg16(g2, ok2); w2[2] = ldg16(g2 + FF, ok2 && okr);
            w3[0] = ldg16(g3 - FF, ok3 && okl); w3[1] = ldg16(g3, ok3); w3[2] = ldg16(g3 + FF, ok3 && okr);
            bf16* u0 = up + (size_t)st * gs; bf16* u1 = u0 + gs;
            const v4u uv0 = *(const v4u*)u0, uv1 = *(const v4u*)u1;
            float acc0[8], acc1[8];
#pragma unroll
            for (int e = 0; e < 8; ++e) { acc0[e] = bb[e]; acc1[e] = bb[e]; }
#pragma unroll
            for (int b = 0; b < 3; ++b)
#pragma unroll
                for (int e = 0; e < 8; ++e) {
                    { const float g0 = bf2f((unsigned short)HW(w0[b], e)), g1 = bf2f((unsigned short)HW(w1[b], e)), g2 = bf2f((unsigned short)HW(w2[b], e)), g3 = bf2f((unsigned short)HW(w3[b], e));
                    acc0[e] = fmaf(wk[6 + b][e], g2, fmaf(wk[3 + b][e], g1, fmaf(wk[0 + b][e], g0, acc0[e])));
                    acc1[e] = fmaf(wk[6 + b][e], g3, fmaf(wk[3 + b][e], g2, fmaf(wk[0 + b][e], g1, acc1[e]))); } }
            float o0[8], o1[8];
#pragma unroll
            for (int e = 0; e < 8; ++e) { o0[e] = gelu_tanh(acc0[e]) * bf2f((unsigned short)HW(uv0, e)); o1[e] = gelu_tanh(acc1[e]) * bf2f((unsigned short)HW(uv1, e)); }
            *(v4u*)u0 = (v4u){pk2(o0[0], o0[1]), pk2(o0[2], o0[3]), pk2(o0[4], o0[5]), pk2(o0[6], o0[7])};
            *(v4u*)u1 = (v4u){pk2(o1[0], o1[1]), pk2(o1[2], o1[3]), pk2(o1[4], o1[5]), pk2(o1[6], o1[7])};
#pragma unroll
            for (int b = 0; b < 3; ++b) { w0[b] = w2[b]; w1[b] = w3[b]; }
        }
    }
}
template <int PASS>
__device__ __forceinline__ void phase_mixer(const Args& a, LAS unsigned char* lds, int tid, int wave, int lane) {
    unsigned* ctr = (unsigned*)(a.ws + WS_BAR) + (PASS == 1 ? 3584 : 3648);
    volatile LAS int* slot = (volatile LAS int*)(lds + LDSCTL_OFF + 256);
    for (;;) {
        if (tid == 0) *slot = (int)__hip_atomic_fetch_add(ctr, 1u, __ATOMIC_RELAXED, __HIP_MEMORY_SCOPE_AGENT);
        __syncthreads();
        const int it = *slot;
        if (it >= NCHUNK + 4 * NCHUNK) break;
        asm volatile("" : "+v"(tid), "+v"(lane));
        if (it < NCHUNK) lru_item<PASS>(a, lds, it, tid, wave, lane);
        else { const int r = it - NCHUNK; ret_item<PASS>(a, lds, r >> 2, r & 3, tid, wave, lane); }
    }
}

__global__ void __launch_bounds__(512, 2) fwd(Args a) {
    extern __shared__ __attribute__((aligned(16))) unsigned char lds_raw[];
    LAS unsigned char* lds = (LAS unsigned char*)lds_raw;
    unsigned char* ws = a.ws;
    int tid = threadIdx.x, lane = tid & 63; const int wave = __builtin_amdgcn_readfirstlane(tid >> 6);
#define FRESH() do { tid = threadIdx.x; asm volatile("" : "+v"(tid)); lane = tid & 63; } while (0)
    for (int u = tid; u < (LDS_BYTES - LDSCTL_OFF) / 4; u += 512) ((LAS unsigned*)(lds + LDSCTL_OFF))[u] = 0u;
    __syncthreads();
    const XcdBarrier bar = xcd_barrier_post((unsigned*)(ws + WS_BAR), (volatile LAS unsigned*)(lds + LDSCTL_OFF + 64));
    const float* MOD = (const float*)(ws + WS_MOD);
    const int G = gridDim.x;
    const int lo = a.ph_lo, hi = a.ph_hi;
#ifndef PHMASK
#define PHMASK 0xffff
#endif
#define IN(k) ((((PHMASK) >> (k)) & 1) && lo <= (k) && (k) < hi)
#ifndef REPMASK
#define REPMASK 0u
#endif
#define NREP(k) ((((REPMASK) >> (k)) & 1u) ? 2 : 1)
#define SEAM(k) do { if (IN(k) && IN((k) + 1)) xcd_barrier(bar); } while (0)
    FRESH();
    for (int rep = 0; rep < NREP(0); ++rep) if (IN(0)) phase_prologue(a, lds, tid, wave, lane);
    if (IN(0) && IN(1)) { cg::grid_group grid = cg::this_grid(); grid.sync(); }
    FRESH();
    for (int rep = 0; rep < NREP(1); ++rep) if (IN(1)) phase_rownorm<0>(a.in[0], a.in[1], a.in[8], MOD + 1024, MOD + 0, (bf16*)(ws + WS_XN), nullptr, wave, lane);
    SEAM(1);
    FRESH();
    for (int rep = 0; rep < NREP(2); ++rep) if (IN(2)) { pg8::Gemm g{(const bf16*)(ws + WS_XN), (const bf16*)(ws + WS_WIN), TT, INW, DM}; pg8::StaticOrder S; S.init(TT, INW, G, (int)blockIdx.x);
        pg8::EpiBf16<0> E{(bf16*)(ws + WS_PROJ), INW, nullptr, 0, 0, 1.f};
        pg8::gemm_phase<pg8::EpiBf16<0>, pg8::StaticOrder, true, true>(lds, g, S, E); }
    SEAM(2);
    FRESH();
    for (int rep = 0; rep < NREP(3); ++rep) if (IN(3)) phase_mixer<1>(a, lds, tid, wave, lane);
    SEAM(3);
    FRESH();
    for (int rep = 0; rep < NREP(4); ++rep) if (IN(4)) phase_carries(a, tid);
    SEAM(4);
    FRESH();
    for (int rep = 0; rep < NREP(5); ++rep) if (IN(5)) phase_mixer<3>(a, lds, tid, wave, lane);
    SEAM(5);
    FRESH();
    for (int rep = 0; rep < NREP(6); ++rep) if (IN(6)) { pg8::Gemm g{(const bf16*)(ws + WS_Y), (const bf16*)(ws + WS_WOUT), TT, DM, DM}; pg8::StaticOrder S; S.init(TT, DM, G, (int)blockIdx.x);
        pg8::EpiBf16<0> E{(bf16*)(ws + WS_KVT), DM, nullptr, 0, 0, 1.f};
        pg8::gemm_phase<pg8::EpiBf16<0>, pg8::StaticOrder, true, true>(lds, g, S, E); }
    SEAM(6);
    FRESH();
    for (int rep = 0; rep < NREP(7); ++rep) if (IN(7)) phase_resnorm<0>(a.in[0], a.in[1], (const bf16*)(ws + WS_KVT), MOD + 2048, a.out, a.in[28], MOD + 4096, MOD + 3072, (bf16*)(ws + WS_XN), nullptr, wave, lane);
    SEAM(7);
#pragma unroll
    for (int half = 0; half < 2; ++half) {
        FRESH();
        if (IN(8 + 2 * half)) { pg8::Gemm g{(const bf16*)(ws + WS_XN) + (size_t)half * HALF_T * DM, (const bf16*)(ws + WS_WGU), HALF_T, FF2, DM}; pg8::StaticOrder S; S.init(HALF_T, FF2, G, (int)blockIdx.x);
            pg8::EpiBf16<0> E{(bf16*)(ws + WS_GH), FF, nullptr, FF, (size_t)((WS_U - WS_GH) / 2) + (size_t)half * HALF_T * FF, 1.f};
            pg8::gemm_phase<pg8::EpiBf16<0>, pg8::StaticOrder, true, true>(lds, g, S, E); }
        SEAM(8 + 2 * half);
        FRESH();
        if (IN(9 + 2 * half)) phase_act(a, half, wave, lane);
        SEAM(9 + 2 * half);
    }
    FRESH();
    constexpr int PA_ROWS = 32768;
    const bool split12 = (G == 256);
    if (IN(12)) {
        { pg8::Gemm g{(const bf16*)(ws + WS_U), (const bf16*)(ws + WS_WD), split12 ? PA_ROWS : TT, DM, FF}; pg8::StaticOrder S; S.init(split12 ? PA_ROWS : TT, DM, G, (int)blockIdx.x);
          pg8::EpiBf16<0> E{(bf16*)(ws + WS_XN), DM, nullptr, 0, 0, 1.f};
          pg8::gemm_phase<pg8::EpiBf16<0>, pg8::StaticOrder, true, true>(lds, g, S, E); }
        if (split12) {
            FRESH();
            const int u = (int)blockIdx.x >> 1, kh = (int)blockIdx.x & 1, pml = u >> 2, pn = u & 3;
            pg8::Gemm g{(const bf16*)(ws + WS_U) + (size_t)(PA_ROWS + pml * 256) * FF + kh * (FF / 2), (const bf16*)(ws + WS_WD) + (size_t)(pn * 256) * FF + kh * (FF / 2), 256, 256, FF / 2, FF};
            pg8::StaticOrder S; S.init(256, 256, 1, 0);
            bf16* obase = kh ? (bf16*)(ws + WS_GH) + (size_t)(pml * 256) * DM + pn * 256 : (bf16*)(ws + WS_XN) + (size_t)(PA_ROWS + pml * 256) * DM + pn * 256;
            pg8::EpiBf16<0> E{obase, DM, nullptr, 0, 0, 1.f};
            pg8::gemm_phase<pg8::EpiBf16<0>, pg8::StaticOrder, true, true>(lds, g, S, E);
        }
    }
    SEAM(12);
    FRESH();
    if (IN(13)) phase_resnorm<1>(a.out, a.out + (size_t)TP * DM, (const bf16*)(ws + WS_XN), MOD + 5120, nullptr, a.in[34], nullptr, nullptr, nullptr, a.out, wave, lane,
                                 split12 ? (const bf16*)(ws + WS_GH) : nullptr, PA_ROWS);
#undef IN
#undef SEAM
}

extern "C" void kernel_launch(void* const* d_in, const int* in_sizes, int n_in, void* d_out, int out_size,
                              void* d_ws, size_t ws_size, hipStream_t stream) {
    static int grid = 0;
    if (grid == 0) {
        int dev = 0, cus = 0, per_cu = 0;
        hipGetDevice(&dev);
        hipDeviceGetAttribute(&cus, hipDeviceAttributeMultiprocessorCount, dev);
        hipFuncSetAttribute((const void*)fwd, hipFuncAttributeMaxDynamicSharedMemorySize, LDS_BYTES);
        hipOccupancyMaxActiveBlocksPerMultiprocessor(&per_cu, (const void*)fwd, 512, LDS_BYTES);
        if (per_cu < 1) per_cu = 1;
        grid = cus * per_cu;
        if (n_in != 35 || ws_size < WS_END) fprintf(stderr, "kernel_launch: unexpected n_in %d / ws_size %zu\n", n_in, ws_size);
    }
    if (hipMemsetAsync((char*)d_ws + WS_BAR, 0, 16384, stream) != hipSuccess) fprintf(stderr, "kernel_launch: memset failed\n");
    Args a{};
    for (int i = 0; i < 35; ++i) a.in[i] = (const float*)d_in[i];
    a.out = (float*)d_out; a.ws = (unsigned char*)d_ws; a.ph_lo = 0; a.ph_hi = 14;
    void* args[] = {&a};
    hipError_t e = hipLaunchCooperativeKernel((const void*)fwd, dim3(grid), dim3(512), args, LDS_BYTES, stream);
    if (e != hipSuccess) fprintf(stderr, "cooperative launch failed: %s (grid %d)\n", hipGetErrorString(e), grid);
}
```

```cpp
#include <hip/hip_runtime.h>
#include <hip/hip_cooperative_groups.h>
#include <cstdio>
#include <cstdint>
namespace cg = cooperative_groups;
namespace pg8 {
#define PG8_LAS __attribute__((address_space(3)))
typedef unsigned short bf16_t;
typedef short bf16x8 __attribute__((ext_vector_type(8)));
typedef float f32x4 __attribute__((ext_vector_type(4)));
typedef unsigned u32x4 __attribute__((ext_vector_type(4)));
constexpr int BM = 256, BK = 64, HALF = 128, HTB = HALF * BK * 2  , STAGE_BYTES = 8 * HTB, NXCD = 8, WGM = 8;

__host__ __device__ __forceinline__ int lds_byte(int r, int c) { const int st = (r >> 4) * 2 + (c >> 5), rr = r & 15, cc = c & 31, ob = rr * 64 + cc * 2; return st * 1024 + (ob ^ (((ob >> 9) & 1) << 5)); }
__host__ __device__ __forceinline__ void stage_rc(int b, int& R, int& C) { const int st = b / 1024, sb = b % 1024, swz = sb ^ (((sb >> 9) & 1) << 5); R = (st >> 1) * 16 + swz / 64; C = (st & 1) * 32 + (swz % 64) / 2; }
__host__ __device__ __forceinline__ int perm32(int rho) { const int n = rho >> 4, i = rho & 15; return 8 * (i >> 2) + 4 * n + (i & 3); }

struct Unit { int pm, pn; };
struct Gemm { const bf16_t* A; const bf16_t* Bt; int M, N, K; int ld = 0; };

struct StaticOrder {
    int nM, nN, nwg, G, c;
    __host__ __device__ void init(int M, int N, int G_, int c_) { nM = M / BM; nN = N / BM; nwg = nM * nN; G = G_; c = c_; }
    __host__ __device__ bool next(int i, Unit& u) const {
        const long L = (long)i * G + c; if (L >= nwg) return false;
        int wgid = (int)L; { const int q = nwg / NXCD, r = nwg % NXCD, xcd = wgid % NXCD, off = wgid / NXCD; wgid = (xcd < r ? xcd * (q + 1) : r * (q + 1) + (xcd - r) * q) + off; }
        const int nig = WGM * nN, gid = wgid / nig, fm = gid * WGM, gsz = (nM - fm) < WGM ? (nM - fm) : WGM;
        u.pm = fm + ((wgid % nig) % gsz); u.pn = (wgid % nig) / gsz; return true;
    }
    __device__ __forceinline__ void a_ready(const Unit&) const {}
    __device__ __forceinline__ void done(const Unit&) const {}
};

__device__ __forceinline__ unsigned cvt_pk_bf16(float lo, float hi) { unsigned r; asm volatile("v_cvt_pk_bf16_f32 %0, %1, %2" : "=v"(r) : "v"(lo), "v"(hi)); return r; }
typedef float f32x2 __attribute__((ext_vector_type(2)));
__device__ __forceinline__ f32x2 gelu_pk(f32x2 v) {
    const f32x2 av = __builtin_elementwise_abs(v), d = av * 0.2316418882f + 1.0f;
    f32x2 t; t.x = __builtin_amdgcn_rcpf(d.x); t.y = __builtin_amdgcn_rcpf(d.y);
    f32x2 q = t * 0.5307027145f + (-0.7265760135f); q = q * t + 0.7107068705f; q = q * t + (-0.142248368f); q = q * t + 0.127414796f; q = q * t;
    const f32x2 s = (v * v) * (-0.72134752044f);
    f32x2 e; e.x = __builtin_amdgcn_exp2f(s.x); e.y = __builtin_amdgcn_exp2f(s.y);
    const f32x2 m = v * (q * e), r = v - m;
    f32x2 o; o.x = v.x < 0.f ? m.x : r.x; o.y = v.y < 0.f ? m.y : r.y; return o;
}

template <int ACT  > struct EpiBf16 {
    static constexpr bool PERM = true, AFTER_DRAIN = false; static_assert(ACT == 0 || ACT == 1, "EpiBf16: ACT is 0 (none) or 1 (gelu_pk)");
    bf16_t* O; int ldc; const float* bias; int split_cols; size_t split_stride; float scale0;
    __device__ __forceinline__ void operator()(const f32x4 (&acc)[2][2][4][2], const Unit& u, int wr, int wc, int fr, int fq) const {
        const int row0 = u.pm * BM + wr * 64 + fr; int colt = u.pn * BM; bf16_t* base = O;
        float sc = 1.f; if (split_cols) { const int t = colt / split_cols; base += (size_t)t * split_stride; colt -= t * split_cols; if (t == 0) sc = scale0; }
        const int col0 = colt + wc * 32 + 8 * fq, bcol0 = u.pn * BM + wc * 32 + 8 * fq;
        f32x4 bv[2][2];
#pragma unroll
        for (int bj = 0; bj < 2; ++bj)
#pragma unroll
            for (int n = 0; n < 2; ++n) bv[bj][n] = bias ? *(const f32x4*)(bias + bcol0 + bj * HALF + 4 * n) : (f32x4){0.f, 0.f, 0.f, 0.f};
#pragma unroll
        for (int ai = 0; ai < 2; ++ai)
#pragma unroll
            for (int m = 0; m < 4; ++m) { bf16_t* rowp = base + (size_t)(row0 + ai * HALF + m * 16) * ldc + col0;
#pragma unroll
                for (int bj = 0; bj < 2; ++bj) { f32x4 v0 = acc[ai][bj][m][0] + bv[bj][0], v1 = acc[ai][bj][m][1] + bv[bj][1];
                    if (ACT == 1) { f32x2 a = gelu_pk((f32x2){v0[0], v0[1]}), b = gelu_pk((f32x2){v0[2], v0[3]}), c = gelu_pk((f32x2){v1[0], v1[1]}), d = gelu_pk((f32x2){v1[2], v1[3]});
                        v0 = (f32x4){a.x, a.y, b.x, b.y}; v1 = (f32x4){c.x, c.y, d.x, d.y}; }
                    v0 = v0 * sc; v1 = v1 * sc; u32x4 w; w.x = cvt_pk_bf16(v0[0], v0[1]); w.y = cvt_pk_bf16(v0[2], v0[3]); w.z = cvt_pk_bf16(v1[0], v1[1]); w.w = cvt_pk_bf16(v1[2], v1[3]);
                    *(u32x4*)(rowp + bj * HALF) = w; } }
    }
};
template <class Epi, class Sched, bool ALIGN_EPI = false, bool SP2 = false>
__device__ __forceinline__ void gemm_phase(PG8_LAS unsigned char* lds, const Gemm g, const Sched& S, const Epi& E) {
    int tid_ = threadIdx.x; asm volatile("" : "+v"(tid_));
    const int tid = tid_, wid = __builtin_amdgcn_readfirstlane(tid >> 6), lane = tid & 63, wr = wid >> 2, wc = wid & 3, fr = lane & 15, fq = lane >> 4;
    const int K = g.K, nt = K / BK, LD = g.ld ? g.ld : g.K;
    unsigned voffA[2], voffB[2];
#pragma unroll
    for (int i = 0; i < 2; ++i) { int R, C; stage_rc(tid * 16 + i * 8192, R, C); const int Rb = Epi::PERM ? ((R & ~31) + perm32(R & 31)) : R;
        voffA[i] = (unsigned)(R * LD + C) * 2u; voffB[i] = (unsigned)(Rb * LD + C) * 2u; }
    const size_t kstep = (size_t)(BK * 2);
    const size_t hstep = (size_t)HALF * LD * 2;
    const size_t tstep = 2 * hstep;
    const unsigned ldsw = (unsigned)wid * 1024u;
    const int aoff = lds_byte(wr * 64 + fr, fq * 8), boff = lds_byte(wc * 32 + fr, fq * 8);
#define PG8_SA(b, h) (((b) * 2 + (h)) * HTB)
#define PG8_SB(b, h) ((4 + (b) * 2 + (h)) * HTB)
#define PG8_STAGE(bufoff, gbase, voff) do { _Pragma("unroll") for (int _i = 0; _i < 2; ++_i) \
        __builtin_amdgcn_global_load_lds((const unsigned*)((const char*)(gbase) + (voff)[_i]), (PG8_LAS unsigned*)(lds + (bufoff) + ldsw + _i * 8192), 16, 0, 0); } while (0)
#define PG8_LDA(dst, b, h) do { _Pragma("unroll") for (int m = 0; m < 4; ++m) _Pragma("unroll") for (int k = 0; k < 2; ++k) dst[m][k] = *(const PG8_LAS bf16x8*)(lds + PG8_SA(b, h) + aoff + m * 2048 + k * 1024); } while (0)
#define PG8_LDB(dst, b, h) do { _Pragma("unroll") for (int n = 0; n < 2; ++n) _Pragma("unroll") for (int k = 0; k < 2; ++k) dst[n][k] = *(const PG8_LAS bf16x8*)(lds + PG8_SB(b, h) + boff + n * 2048 + k * 1024); } while (0)
#define PG8_MMA(ai, bj, At, Bt) do { __builtin_amdgcn_s_setprio(1); _Pragma("unroll") for (int m = 0; m < 4; ++m) _Pragma("unroll") for (int n = 0; n < 2; ++n) _Pragma("unroll") for (int k = 0; k < 2; ++k) \
        acc[ai][bj][m][n] = __builtin_amdgcn_mfma_f32_16x16x32_bf16(Bt[n][k], At[m][k], acc[ai][bj][m][n], 0, 0, 0); __builtin_amdgcn_s_setprio(0); } while (0)
#define PG8_WAIT_V(n) asm volatile("s_waitcnt vmcnt(" #n ")" ::: "memory")
#define PG8_WAIT_L(n) asm volatile("s_waitcnt lgkmcnt(" #n ")" ::: "memory")
#define PG8_BAR __builtin_amdgcn_s_barrier()
#define PG8_SCHED __builtin_amdgcn_sched_barrier(0)
    Unit cur, nxt; int ui = 0;
    if (!S.next(0, cur)) return;
    f32x4 acc[2][2][4][2];
#pragma unroll
    for (int a = 0; a < 2; ++a)
#pragma unroll
        for (int b = 0; b < 2; ++b)
#pragma unroll
            for (int m = 0; m < 4; ++m)
#pragma unroll
                for (int n = 0; n < 2; ++n) acc[a][b][m][n] = (f32x4){0.f, 0.f, 0.f, 0.f};
    bf16x8 At[4][2], B0[2][2], B1[2][2];
    const char* cA = (const char*)g.A + (size_t)cur.pm * tstep; const char* cB = (const char*)g.Bt + (size_t)cur.pn * tstep;
    S.a_ready(cur);
    if constexpr (SP2) {
        PG8_STAGE(PG8_SB(0, 0), cB, voffB); PG8_STAGE(PG8_SB(0, 1), cB + hstep, voffB); PG8_STAGE(PG8_SA(0, 0), cA, voffA); PG8_STAGE(PG8_SA(0, 1), cA + hstep, voffA);
        if (wr == 1) PG8_BAR;
        PG8_WAIT_V(2); PG8_BAR;
        PG8_STAGE(PG8_SB(1, 0), cB + kstep, voffB); PG8_STAGE(PG8_SA(1, 0), cA + kstep, voffA); PG8_STAGE(PG8_SB(1, 1), cB + hstep + kstep, voffB);
        PG8_WAIT_V(6); PG8_BAR;
    } else {
        PG8_STAGE(PG8_SB(0, 0), cB, voffB); PG8_STAGE(PG8_SA(0, 0), cA, voffA); PG8_STAGE(PG8_SB(0, 1), cB + hstep, voffB); PG8_STAGE(PG8_SA(0, 1), cA + hstep, voffA);
        if (wr == 1) PG8_BAR;
        PG8_WAIT_V(4); PG8_BAR;
        PG8_STAGE(PG8_SB(1, 0), cB + kstep, voffB); PG8_STAGE(PG8_SA(1, 0), cA + kstep, voffA); PG8_STAGE(PG8_SB(1, 1), cB + hstep + kstep, voffB);
        PG8_WAIT_V(6); PG8_BAR;
    }
    for (;;) {
        const bool has_next = S.next(ui + 1, nxt);
        const char* nA = has_next ? (const char*)g.A + (size_t)nxt.pm * tstep : cA; const char* nB = has_next ? (const char*)g.Bt + (size_t)nxt.pn * tstep : cB;
        for (int t = 0; t < nt; t += 2) {
            const bool last = (t == nt - 2);
            const char* a1 = cA + (size_t)(t + 1) * kstep;
            const char* a2 = last ? nA : cA + (size_t)(t + 2) * kstep; const char* b2 = last ? nB : cB + (size_t)(t + 2) * kstep;
            const char* a3 = a2 + kstep; const char* b3 = b2 + kstep;
            if (last && has_next) S.a_ready(nxt);
            if constexpr (SP2) {
            PG8_LDB(B0, 0, 0); PG8_LDB(B1, 0, 1); PG8_SCHED; PG8_LDA(At, 0, 0); PG8_STAGE(PG8_SA(1, 1), a1 + hstep, voffA);
            PG8_WAIT_V(8); PG8_WAIT_L(0); PG8_BAR; PG8_MMA(0, 0, At, B0); PG8_MMA(0, 1, At, B1); PG8_BAR; PG8_SCHED;
            PG8_LDA(At, 0, 1); PG8_STAGE(PG8_SB(0, 0), b2, voffB); PG8_STAGE(PG8_SB(0, 1), b2 + hstep, voffB); PG8_STAGE(PG8_SA(0, 0), a2, voffA);
            PG8_WAIT_V(8); PG8_WAIT_L(0); PG8_BAR; PG8_MMA(1, 0, At, B0); PG8_MMA(1, 1, At, B1); PG8_BAR; PG8_SCHED;
            PG8_LDB(B0, 1, 0); PG8_LDB(B1, 1, 1); PG8_SCHED; PG8_LDA(At, 1, 0); PG8_STAGE(PG8_SA(0, 1), a2 + hstep, voffA);
            PG8_WAIT_V(8); PG8_WAIT_L(0); PG8_BAR; PG8_MMA(0, 0, At, B0); PG8_MMA(0, 1, At, B1); PG8_BAR; PG8_SCHED;
            PG8_LDA(At, 1, 1); PG8_STAGE(PG8_SB(1, 0), b3, voffB); PG8_STAGE(PG8_SB(1, 1), b3 + hstep, voffB); PG8_STAGE(PG8_SA(1, 0), a3, voffA);
            PG8_WAIT_V(8); PG8_WAIT_L(0); PG8_BAR; PG8_MMA(1, 0, At, B0); PG8_MMA(1, 1, At, B1); PG8_BAR; PG8_SCHED;
            } else {
            PG8_LDB(B0, 0, 0); PG8_SCHED; PG8_LDA(At, 0, 0); PG8_STAGE(PG8_SA(1, 1), a1 + hstep, voffA);
            PG8_WAIT_L(8); PG8_BAR; PG8_WAIT_L(0); PG8_MMA(0, 0, At, B0); PG8_BAR; PG8_SCHED;
            PG8_LDB(B1, 0, 1); PG8_STAGE(PG8_SB(0, 0), b2, voffB);
            PG8_BAR; PG8_WAIT_L(0); PG8_MMA(0, 1, At, B1); PG8_BAR;
            PG8_LDA(At, 0, 1); PG8_STAGE(PG8_SA(0, 0), a2, voffA);
            PG8_BAR; PG8_WAIT_L(0); PG8_MMA(1, 0, At, B0); PG8_BAR; PG8_SCHED;
            PG8_STAGE(PG8_SB(0, 1), b2 + hstep, voffB);
            PG8_WAIT_V(6); PG8_BAR; PG8_MMA(1, 1, At, B1); PG8_BAR;
            PG8_LDB(B0, 1, 0); PG8_SCHED; PG8_LDA(At, 1, 0); PG8_STAGE(PG8_SA(0, 1), a2 + hstep, voffA);
            PG8_WAIT_L(8); PG8_BAR; PG8_WAIT_L(0); PG8_MMA(0, 0, At, B0); PG8_BAR; PG8_SCHED;
            PG8_LDB(B1, 1, 1); PG8_STAGE(PG8_SB(1, 0), b3, voffB);
            PG8_BAR; PG8_WAIT_L(0); PG8_MMA(0, 1, At, B1); PG8_BAR;
            PG8_LDA(At, 1, 1); PG8_STAGE(PG8_SA(1, 0), a3, voffA);
            PG8_BAR; PG8_WAIT_L(0); PG8_MMA(1, 0, At, B0); PG8_BAR; PG8_SCHED;
            PG8_STAGE(PG8_SB(1, 1), b3 + hstep, voffB);
            PG8_WAIT_V(6); PG8_BAR; PG8_MMA(1, 1, At, B1); PG8_BAR;
            }
        }
        if constexpr (ALIGN_EPI) { if (wr == 0) PG8_BAR; }
        if constexpr (!Epi::AFTER_DRAIN) { E(acc, cur, wr, wc, fr, fq); S.done(cur); }
        if (!has_next) break;
#pragma unroll
        for (int a = 0; a < 2; ++a)
#pragma unroll
            for (int b = 0; b < 2; ++b)
#pragma unroll
                for (int m = 0; m < 4; ++m)
#pragma unroll
                    for (int n = 0; n < 2; ++n) acc[a][b][m][n] = (f32x4){0.f, 0.f, 0.f, 0.f};
        cur = nxt; cA = nA; cB = nB; ++ui;
        if constexpr (ALIGN_EPI) { if (wr == 1) PG8_BAR; }
    }
    PG8_WAIT_V(0);
    if constexpr (!ALIGN_EPI) { if (wr == 0) PG8_BAR; }
    PG8_BAR;
    if constexpr (Epi::AFTER_DRAIN) { E.fused(acc, cur, wr, wc, fr, fq, lds, wid, lane); S.done(cur); }
#undef PG8_SA
#undef PG8_SB
#undef PG8_STAGE
#undef PG8_LDA
#undef PG8_LDB
#undef PG8_MMA
#undef PG8_WAIT_V
#undef PG8_WAIT_L
#undef PG8_BAR
#undef PG8_SCHED
}
}
namespace pg8 {
struct EpiRes {
    static constexpr bool PERM = false, AFTER_DRAIN = false;
    const float* xp; const float* xs;
    float* out; const float* gate;
    __device__ __forceinline__ void operator()(const f32x4 (&acc)[2][2][4][2], const Unit& u, int wr, int wc, int fr, int fq) const {
        const int row0 = u.pm * BM + wr * 64 + fr, col0 = u.pn * BM + wc * 32 + 4 * fq;
        const int v = (u.pm * BM < 8192) ? 0 : 1 + ((u.pm * BM - 8192) >> 12);
        const float* g = gate + (size_t)v * 6144 + col0;
        f32x4 gv[2][2];
#pragma unroll
        for (int bj = 0; bj < 2; ++bj)
#pragma unroll
            for (int n = 0; n < 2; ++n) gv[bj][n] = *(const f32x4*)(g + bj * HALF + n * 16);
#pragma unroll
        for (int ai = 0; ai < 2; ++ai)
#pragma unroll
            for (int m = 0; m < 4; ++m) {
                const int row = row0 + ai * HALF + m * 16;
                const float* bp = (row < 8192 ? xp + (size_t)row * 1024 : xs + (size_t)(row - 8192) * 1024) + col0;
                float* op = out + (size_t)row * 1024 + col0;
#pragma unroll
                for (int bj = 0; bj < 2; ++bj)
#pragma unroll
                    for (int n = 0; n < 2; ++n) { const f32x4 b = *(const f32x4*)(bp + bj * HALF + n * 16); *(f32x4*)(op + bj * HALF + n * 16) = b + gv[bj][n] * acc[ai][bj][m][n]; }
            }
    }
};
}

constexpr int DM = 1024, TP = 8192, TSMP = 32768, TT = 40960, INW = 3072, FF = 2816, FF2 = 5632;
constexpr int NCHUNK = 320, HALF_T = 20480;
constexpr int OFF_LF = 41943040, OFF_LB = OFF_LF + 16384, OFF_RF = OFF_LB + 16384, OFF_RB = OFF_RF + 2097152;
constexpr size_t MiB = 1u << 20;
constexpr size_t WS_MOD = 0, WS_WL = 256 * 1024, WS_AGG = 1 * MiB, WS_CAR = 3 * MiB + 512 * 1024;
constexpr size_t WS_WIN = 5 * MiB, WS_WOUT = 11 * MiB, WS_WGU = 13 * MiB, WS_WD = 24 * MiB;
constexpr size_t WS_XN = 30 * MiB, WS_SB = 30 * MiB, WS_PROJ = 110 * MiB, WS_Y = 350 * MiB, WS_KVT = 430 * MiB;
constexpr size_t WS_GH = 110 * MiB, WS_U = 220 * MiB, WS_END = 510 * MiB;
constexpr int LDS_BYTES = 155648, LDSCTL_OFF = 151552;
constexpr size_t WS_BAR = 768 * 1024;
constexpr int NWAVES = 8;

#define GAS __attribute__((address_space(1)))
#define LAS __attribute__((address_space(3)))
typedef unsigned short bf16;
typedef unsigned v4u __attribute__((ext_vector_type(4)));
typedef unsigned v2u __attribute__((ext_vector_type(2)));
typedef float f32x4 __attribute__((ext_vector_type(4)));
typedef short bf16x8 __attribute__((ext_vector_type(8)));
#define LDS_WAIT() asm volatile("s_waitcnt lgkmcnt(0)" ::: "memory")
typedef float f32x2_t __attribute__((ext_vector_type(2)));
typedef __bf16 bf16x2_t __attribute__((ext_vector_type(2)));
__device__ __forceinline__ unsigned pk2(float lo, float hi) { const f32x2_t v = {lo, hi}; const bf16x2_t b = __builtin_convertvector(v, bf16x2_t); return __builtin_bit_cast(unsigned, b); }
__device__ __forceinline__ unsigned f2bf(float f) { return pk2(f, 0.f) & 0xffffu; }

__device__ __forceinline__ float bflo(unsigned w) { return __builtin_bit_cast(float, w << 16); }
__device__ __forceinline__ float bfhi(unsigned w) { return __builtin_bit_cast(float, w & 0xffff0000u); }
__device__ __forceinline__ float bf2f(unsigned short h) { return __builtin_bit_cast(float, ((unsigned)h) << 16); }
__device__ __forceinline__ float sigmoidf_(float x) { return 1.0f / (1.0f + __expf(-x)); }
__device__ __forceinline__ float siluf_(float x) { return x * __builtin_amdgcn_rcpf(1.0f + __builtin_amdgcn_exp2f(-1.4426950408889634f * x)); }
__device__ __forceinline__ float gelu_tanh(float x) { const float z = x * fmaf(0.044715f * x, x, 1.0f); return x * __builtin_amdgcn_rcpf(1.0f + __builtin_amdgcn_exp2f(-2.302208198f * z)); }

struct Args { const float* in[35]; float* out; unsigned char* ws; int ph_lo, ph_hi; };

#define XB_TMO      128
#define XB_XCNT(j)  (256  + 64 * (j))
#define XB_XSUB(j)  (1280 + 64 * (j))
#define XB_XGEN(j)  (2304 + 64 * (j))
#define XB_TOP      3328
#define XB_TOPGEN   3392
#define XCD_BAR_WORDS 3456
#define XB_SPIN_CAP (1u << 18)

__device__ __forceinline__ unsigned xb_ld(unsigned* p)              { return __hip_atomic_load(p, __ATOMIC_RELAXED, __HIP_MEMORY_SCOPE_AGENT); }
__device__ __forceinline__ unsigned xb_add(unsigned* p, unsigned v) { return __hip_atomic_fetch_add(p, v, __ATOMIC_RELAXED, __HIP_MEMORY_SCOPE_AGENT); }
__device__ __forceinline__ unsigned xb_xcc_id() { return (unsigned)__builtin_amdgcn_s_getreg((3 << 11) | 20) & 0xFu; }
#define XB_SPIN(cond, bar) do { unsigned _sp = 0; while (cond) { __builtin_amdgcn_s_sleep(1); \
    if ((++_sp & 255u) == 0u) { if (xb_ld(&(bar)[XB_TMO])) break; if (_sp > XB_SPIN_CAP) { atomicAdd(&(bar)[XB_TMO], 1u); break; } } } } while (0)

struct XcdBarrier {
    unsigned* bar; unsigned x;
    volatile LAS unsigned* st;
};

__device__ __forceinline__ XcdBarrier xcd_barrier_post(unsigned* bar, volatile LAS unsigned* st) {
    XcdBarrier b; b.bar = bar; b.x = xb_xcc_id(); b.st = st;
    if (threadIdx.x == 0) (void)xb_add(&bar[XB_XCNT(b.x)], 1u);
    return b;
}
__device__ __forceinline__ void xcd_barrier_complete(unsigned* bar, unsigned x, unsigned& nloc, unsigned& nx) {
    const unsigned G = gridDim.x * gridDim.y * gridDim.z;
    unsigned sum, cnt, mine, sp = 0u;
    for (;;) {
        sum = 0u; cnt = 0u; mine = 0u;
#pragma unroll
        for (unsigned j = 0; j < 16; ++j) { const unsigned c = xb_ld(&bar[XB_XCNT(j)]); sum += c; cnt += (c > 0u) ? 1u : 0u; mine = (j == x) ? c : mine; }
        if (sum == G) break;
        __builtin_amdgcn_s_sleep(1);
        if ((++sp & 255u) == 0u) { if (xb_ld(&bar[XB_TMO])) break; if (sp > XB_SPIN_CAP) { atomicAdd(&bar[XB_TMO], 1u); break; } }
    }
    nloc = mine > 0u ? mine : 1u; nx = cnt > 0u ? cnt : 1u;
}

__device__ __forceinline__ void xcd_barrier(const XcdBarrier& b) {
    asm volatile("s_waitcnt vmcnt(0)" ::: "memory");
    __syncthreads();
    if (threadIdx.x == 0) {
        unsigned* bar = b.bar;
        __builtin_amdgcn_s_waitcnt(0);
        unsigned nloc = b.st[0], nx = b.st[1];
        if (nloc == 0u) { xcd_barrier_complete(bar, b.x, nloc, nx); b.st[0] = nloc; b.st[1] = nx; }
        const unsigned old = xb_add(&bar[XB_XSUB(b.x)], 1u);
        const unsigned gen = old / nloc;
        if (old + 1u == (gen + 1u) * nloc) {
            __builtin_amdgcn_fence(__ATOMIC_RELEASE, "agent");
            asm volatile("s_waitcnt vmcnt(0)" ::: "memory");
            const unsigned og = xb_add(&bar[XB_TOP], 1u);
            const unsigned tg = og / nx;
            if (og + 1u == (tg + 1u) * nx) xb_add(&bar[XB_TOPGEN], 1u);
            else XB_SPIN(xb_ld(&bar[XB_TOPGEN]) == tg, bar);
            __builtin_amdgcn_fence(__ATOMIC_ACQUIRE, "agent");
            xb_add(&bar[XB_XGEN(b.x)], 1u);
            asm volatile("s_waitcnt vmcnt(0)" ::: "memory");
        } else {
            XB_SPIN(xb_ld(&bar[XB_XGEN(b.x)]) == gen, bar);
            __builtin_amdgcn_fence(__ATOMIC_ACQUIRE, "agent");
            asm volatile("s_waitcnt vmcnt(0)" ::: "memory");
        }
    }
    __syncthreads();
}
__device__ __forceinline__ float wave_sum(float v) {
#pragma unroll
    for (int o = 1; o < 64; o <<= 1) v += __shfl_xor(v, o);
    return v;
}
__device__ __forceinline__ void p0_transpose_item(const float* W, int K, int N, bf16* WT, int row_off, LAS float* scr, int item, int lane) {
    const int nblk = N / 32, kb = item / nblk, nb = item % nblk, k0 = 64 * kb, n0 = 32 * nb;
#pragma unroll 8
    for (int i = 0; i < 32; ++i) { const int kk = 2 * i + (lane >> 5); scr[kk * 33 + (lane & 31)] = W[(size_t)(k0 + kk) * N + n0 + (lane & 31)]; }
    LDS_WAIT(); asm volatile("" ::: "memory");
    const int c = lane & 7;
#pragma unroll
    for (int j = 0; j < 4; ++j) { const int n = (lane >> 3) + 8 * j; const LAS float* s = scr + (8 * c) * 33 + n;
        v4u o; o.x = pk2(s[0 * 33], s[1 * 33]); o.y = pk2(s[2 * 33], s[3 * 33]); o.z = pk2(s[4 * 33], s[5 * 33]); o.w = pk2(s[6 * 33], s[7 * 33]);
        *(v4u*)(WT + (size_t)(row_off + n0 + n) * K + k0 + 8 * c) = o; }
    LDS_WAIT(); asm volatile("" ::: "memory");
}
__device__ __forceinline__ int mod_index(int row) { return row < TP ? 0 : 1 + ((row - TP) >> 12); }

__device__ __forceinline__ void phase_prologue(const Args& a, LAS unsigned char* lds, int tid, int wave, int lane) {
    unsigned char* ws = a.ws;
    if (blockIdx.x < 96) {
        LAS float* sc = (LAS float*)lds;
        LAS float* red = (LAS float*)(lds + 9 * 1024 * 4);
        for (int i = tid; i < 9 * 1024; i += 512) { const int v = i >> 10, k = i & 1023; const float x = (v == 0) ? a.in[7][k] : a.in[6][(v - 1) * 1024 + k]; sc[i] = siluf_(x); }
        __syncthreads();
        const int col = blockIdx.x * 64 + lane;
        const float* wm = a.in[9] + col;
        float acc[9];
#pragma unroll
        for (int v = 0; v < 9; ++v) acc[v] = 0.f;
        const int kbeg = wave * 128;
#pragma unroll 8
        for (int kk = 0; kk < 128; ++kk) { const int k = kbeg + kk; const float wv = wm[(size_t)k * 6144];
#pragma unroll
            for (int v = 0; v < 9; ++v) acc[v] += sc[v * 1024 + k] * wv; }
#pragma unroll
        for (int v = 0; v < 9; ++v) red[(wave * 9 + v) * 64 + lane] = acc[v];
        __syncthreads();
        for (int i = tid; i < 9 * 64; i += 512) { const int v = i >> 6, l = i & 63; float s = 0.f;
#pragma unroll
            for (int w = 0; w < 8; ++w) s += red[(w * 9 + v) * 64 + l];
            const int cc = blockIdx.x * 64 + l; ((float*)(ws + WS_MOD))[v * 6144 + cc] = s + a.in[10][cc]; }
        __syncthreads();
    }
    LAS float* scr = (LAS float*)(lds + wave * 16384);
    const int gw = blockIdx.x * NWAVES + wave, NGW = gridDim.x * NWAVES;
    constexpr int I_IN = 16 * 96, I_OUT = 16 * 32, I_G = 16 * 88, I_D = 44 * 32, I_L = 64;
    constexpr int NITEMS = I_IN + I_OUT + 2 * I_G + I_D + I_L;
    for (int it = gw; it < NITEMS; it += NGW) {
        int r = it;
        if (r < I_IN) { p0_transpose_item(a.in[11], 1024, 3072, (bf16*)(ws + WS_WIN), 0, scr, r, lane); continue; } r -= I_IN;
        if (r < I_OUT) { p0_transpose_item(a.in[27], 1024, 1024, (bf16*)(ws + WS_WOUT), 0, scr, r, lane); continue; } r -= I_OUT;
        if (r < I_G) { p0_transpose_item(a.in[29], 1024, 2816, (bf16*)(ws + WS_WGU), 0, scr, r, lane); continue; } r -= I_G;
        if (r < I_G) { p0_transpose_item(a.in[30], 1024, 2816, (bf16*)(ws + WS_WGU), 2816, scr, r, lane); continue; } r -= I_G;
        if (r < I_D) { p0_transpose_item(a.in[33], 2816, 1024, (bf16*)(ws + WS_WD), 0, scr, r, lane); continue; } r -= I_D;
        { const int blk = r >> 1, sub = r & 1, mat = blk >> 3, nb = blk & 7;
          const float* src = (mat == 0 ? a.in[14] : mat == 1 ? a.in[16] : mat == 2 ? a.in[19] : a.in[21]) + nb * 4096;
          p0_transpose_item(src, 64, 64, (bf16*)(ws + WS_WL) + (size_t)(mat * 8 + nb) * 4096, 0, scr, sub, lane); }
    }
}

template <int MODE>
__device__ __forceinline__ void phase_rownorm(const float* xp, const float* xs, const float* w, const float* mod_scale, const float* mod_shift, bf16* obf, float* of32, int wave, int lane) {
    const int gw = blockIdx.x * NWAVES + wave, NGW = gridDim.x * NWAVES;
    f32x4 wv[4];
#pragma unroll
    for (int j = 0; j < 4; ++j) wv[j] = *(const f32x4*)(w + 4 * lane + 256 * j);
    for (int row0 = gw; row0 < TT; row0 += 2 * NGW) {
        const int row1 = row0 + NGW; const bool has1 = row1 < TT; const int r1 = has1 ? row1 : row0;
        const float* xr0 = (row0 < TP ? xp + (size_t)row0 * DM : xs + (size_t)(row0 - TP) * DM) + 4 * lane;
        const float* xr1 = (r1 < TP ? xp + (size_t)r1 * DM : xs + (size_t)(r1 - TP) * DM) + 4 * lane;
        f32x4 v0[4], v1[4]; float s0 = 0.f, s1 = 0.f;
#pragma unroll
        for (int j = 0; j < 4; ++j) { v0[j] = *(const f32x4*)(xr0 + 256 * j); v1[j] = *(const f32x4*)(xr1 + 256 * j); }
#pragma unroll
        for (int j = 0; j < 4; ++j) { s0 += (v0[j].x * v0[j].x + v0[j].y * v0[j].y) + (v0[j].z * v0[j].z + v0[j].w * v0[j].w); s1 += (v1[j].x * v1[j].x + v1[j].y * v1[j].y) + (v1[j].z * v1[j].z + v1[j].w * v1[j].w); }
        const float rs0 = 1.0f / sqrtf(wave_sum(s0) * (1.0f / DM) + 1e-6f), rs1 = 1.0f / sqrtf(wave_sum(s1) * (1.0f / DM) + 1e-6f);
#pragma unroll
        for (int k = 0; k < 2; ++k) {
            if (k == 1 && !has1) break;
            const int row = k ? row1 : row0; const float rstd = k ? rs1 : rs0;
            if (MODE == 0) {
                const int mv = mod_index(row);
                const float* sc = mod_scale + (size_t)mv * 6144 + 4 * lane; const float* sh = mod_shift + (size_t)mv * 6144 + 4 * lane;
                unsigned long long* o8 = (unsigned long long*)(obf + (size_t)row * DM) + lane;
#pragma unroll
                for (int j = 0; j < 4; ++j) { const f32x4 scv = *(const f32x4*)(sc + 256 * j), shv = *(const f32x4*)(sh + 256 * j);
                    const f32x4 y = (k ? v1[j] : v0[j]) * rstd * wv[j] * (scv + 1.0f) + shv;
                    o8[64 * j] = (unsigned long long)pk2(y.x, y.y) | ((unsigned long long)pk2(y.z, y.w) << 32); }
            } else {
                float* o = of32 + (size_t)row * DM + 4 * lane;
#pragma unroll
                for (int j = 0; j < 4; ++j) *(f32x4*)(o + 256 * j) = (k ? v1[j] : v0[j]) * rstd * wv[j];
            }
        }
    }
}

template <int MODE>
__device__ __forceinline__ void phase_resnorm(const float* xp, const float* xs, const bf16* tb, const float* gate, float* x1out, const float* w, const float* mod_scale, const float* mod_shift,
                                              bf16* obf, float* of32, int wave, int lane, const bf16* tbx = nullptr, int tbx_row0 = 0) {
    const int gw = blockIdx.x * NWAVES + wave, NGW = gridDim.x * NWAVES;
    f32x4 wv[4];
#pragma unroll
    for (int j = 0; j < 4; ++j) wv[j] = *(const f32x4*)(w + 4 * lane + 256 * j);
    for (int row0 = gw; row0 < TT; row0 += 2 * NGW) {
        const int row1 = row0 + NGW; const bool has1 = row1 < TT; const int r1 = has1 ? row1 : row0;
        const float* xr0 = (row0 < TP ? xp + (size_t)row0 * DM : xs + (size_t)(row0 - TP) * DM) + 4 * lane;
        const float* xr1 = (r1 < TP ? xp + (size_t)r1 * DM : xs + (size_t)(r1 - TP) * DM) + 4 * lane;
        const bf16* t0 = tb + (size_t)row0 * DM + 4 * lane; const bf16* t1 = tb + (size_t)r1 * DM + 4 * lane;
        f32x4 v0[4], v1[4]; v2u u0[4], u1[4];
#pragma unroll
        for (int j = 0; j < 4; ++j) { v0[j] = *(const f32x4*)(xr0 + 256 * j); v1[j] = *(const f32x4*)(xr1 + 256 * j); u0[j] = *(const v2u*)(t0 + 256 * j); u1[j] = *(const v2u*)(t1 + 256 * j); }
        const float* g0 = gate + (size_t)mod_index(row0) * 6144 + 4 * lane; const float* g1 = gate + (size_t)mod_index(r1) * 6144 + 4 * lane;
        v2u e0[4], e1[4]; const bool x0 = tbx && row0 >= tbx_row0, x1 = tbx && r1 >= tbx_row0;
#pragma unroll
        for (int j = 0; j < 4; ++j) { e0[j] = (v2u){0u, 0u}; e1[j] = (v2u){0u, 0u}; }
        if (x0) {
#pragma unroll
            for (int j = 0; j < 4; ++j) e0[j] = *(const v2u*)(tbx + (size_t)(row0 - tbx_row0) * DM + 4 * lane + 256 * j); }
        if (x1) {
#pragma unroll
            for (int j = 0; j < 4; ++j) e1[j] = *(const v2u*)(tbx + (size_t)(r1 - tbx_row0) * DM + 4 * lane + 256 * j); }
        float s0 = 0.f, s1 = 0.f;
#pragma unroll
        for (int j = 0; j < 4; ++j) { const f32x4 ga = *(const f32x4*)(g0 + 256 * j), gb = *(const f32x4*)(g1 + 256 * j);
            v0[j] = v0[j] + ga * ((f32x4){bflo(u0[j][0]), bfhi(u0[j][0]), bflo(u0[j][1]), bfhi(u0[j][1])} + (f32x4){bflo(e0[j][0]), bfhi(e0[j][0]), bflo(e0[j][1]), bfhi(e0[j][1])});
            v1[j] = v1[j] + gb * ((f32x4){bflo(u1[j][0]), bfhi(u1[j][0]), bflo(u1[j][1]), bfhi(u1[j][1])} + (f32x4){bflo(e1[j][0]), bfhi(e1[j][0]), bflo(e1[j][1]), bfhi(e1[j][1])});
            s0 += (v0[j].x * v0[j].x + v0[j].y * v0[j].y) + (v0[j].z * v0[j].z + v0[j].w * v0[j].w); s1 += (v1[j].x * v1[j].x + v1[j].y * v1[j].y) + (v1[j].z * v1[j].z + v1[j].w * v1[j].w); }
        const float rs0 = 1.0f / sqrtf(wave_sum(s0) * (1.0f / DM) + 1e-6f), rs1 = 1.0f / sqrtf(wave_sum(s1) * (1.0f / DM) + 1e-6f);
#pragma unroll
        for (int k = 0; k < 2; ++k) {
            if (k == 1 && !has1) break;
            const int row = k ? row1 : row0; const float rstd = k ? rs1 : rs0;
            if (x1out) { float* o = x1out + (size_t)row * DM + 4 * lane;
#pragma unroll
                for (int j = 0; j < 4; ++j) *(f32x4*)(o + 256 * j) = (k ? v1[j] : v0[j]); }
            if (MODE == 0) {
                const int mv = mod_index(row);
                const float* sc = mod_scale + (size_t)mv * 6144 + 4 * lane; const float* sh = mod_shift + (size_t)mv * 6144 + 4 * lane;
                unsigned long long* o8 = (unsigned long long*)(obf + (size_t)row * DM) + lane;
#pragma unroll
                for (int j = 0; j < 4; ++j) { const f32x4 scv = *(const f32x4*)(sc + 256 * j), shv = *(const f32x4*)(sh + 256 * j);
                    const f32x4 y = (k ? v1[j] : v0[j]) * rstd * wv[j] * (scv + 1.0f) + shv;
                    o8[64 * j] = (unsigned long long)pk2(y.x, y.y) | ((unsigned long long)pk2(y.z, y.w) << 32); }
            } else {
                float* o = of32 + (size_t)row * DM + 4 * lane;
#pragma unroll
                for (int j = 0; j < 4; ++j) *(f32x4*)(o + 256 * j) = (k ? v1[j] : v0[j]) * rstd * wv[j];
            }
        }
    }
}
constexpr int RS = 288;
constexpr int REG = 128 * RS;
constexpr int XCS = 1056;
#define MFMA16(a, b, c) __builtin_amdgcn_mfma_f32_16x16x32_bf16((a), (b), (c), 0, 0, 0)

__device__ __forceinline__ void mm128(f32x4 (&acc)[8], const LAS unsigned char* Aimg, const LAS unsigned char* Bimg, int wave, int c, int q) {
#pragma unroll
    for (int s = 0; s < 4; ++s) {
        const bf16x8 af = *(const LAS bf16x8*)(Aimg + (16 * wave + c) * RS + (32 * s + 8 * q) * 2);
        bf16x8 bfr[8];
#pragma unroll
        for (int t = 0; t < 8; ++t) bfr[t] = *(const LAS bf16x8*)(Bimg + (16 * t + c) * RS + (32 * s + 8 * q) * 2);
        __builtin_amdgcn_s_setprio(1);
#pragma unroll
        for (int t = 0; t < 8; ++t) acc[t] = MFMA16(bfr[t], af, acc[t]);
        __builtin_amdgcn_s_setprio(0);
    }
}
__device__ __forceinline__ void mm128x2(f32x4 (&acc1)[8], f32x4 (&acc2)[8], const LAS unsigned char* Aimg, const LAS unsigned char* B1, const LAS unsigned char* B2, int wave, int c, int q) {
#pragma unroll
    for (int s = 0; s < 4; ++s) {
        const bf16x8 af = *(const LAS bf16x8*)(Aimg + (16 * wave + c) * RS + (32 * s + 8 * q) * 2);
#pragma unroll
        for (int t = 0; t < 8; ++t) { const bf16x8 b1 = *(const LAS bf16x8*)(B1 + (16 * t + c) * RS + (32 * s + 8 * q) * 2); acc1[t] = MFMA16(b1, af, acc1[t]);
                                      const bf16x8 b2 = *(const LAS bf16x8*)(B2 + (16 * t + c) * RS + (32 * s + 8 * q) * 2); acc2[t] = MFMA16(b2, af, acc2[t]); }
    }
}
__device__ __forceinline__ void load_rm(LAS unsigned char* img, const bf16* g, int pitch, int tid) {
#pragma unroll
    for (int i = 0; i < 4; ++i) { const int p = tid + 512 * i, row = p >> 4, cp = p & 15; const v4u v = *(const v4u*)(g + (size_t)row * pitch + cp * 8); *(LAS v4u*)(img + row * RS + cp * 16) = v; }
}
__device__ __forceinline__ void load_tiled(LAS unsigned char* img, const bf16* g, int tid) {
#pragma unroll
    for (int i = 0; i < 4; ++i) { const int p = tid + 512 * i, cp = p >> 7, row = p & 127; const v4u v = *(const v4u*)(g + (size_t)p * 8); *(LAS v4u*)(img + row * RS + cp * 16) = v; }
}
#define HW(v, e) (((e) & 1) ? ((v)[(e) >> 1] >> 16) : ((v)[(e) >> 1] & 0xffffu))
__device__ __forceinline__ void load_tr(LAS unsigned char* img, const bf16* g, int pitch, int wave, int lane) {
#pragma unroll
    for (int it = 0; it < 2; ++it) { const int dg = wave + 8 * it;
        const v4u a = *(const v4u*)(g + (size_t)(2 * lane) * pitch + dg * 8), b = *(const v4u*)(g + (size_t)(2 * lane + 1) * pitch + dg * 8);
#pragma unroll
        for (int e = 0; e < 8; ++e) { const unsigned lo = HW(a, e), hi = HW(b, e); *(LAS unsigned*)(img + (dg * 8 + e) * RS + lane * 4) = lo | (hi << 16); } }
}
__device__ __forceinline__ float log_sigmoid_(float x) { return -log1pf(__expf(-x)); }

template <int PASS>
__device__ __forceinline__ void ret_item(const Args& a, LAS unsigned char* lds, int ci, int h, int tid, int wave, int lane) {
    unsigned char* ws = a.ws;
    const int c = lane & 15, q = lane >> 4;
    const bf16* PROJ = (const bf16*)(ws + WS_PROJ);
    const size_t rowbase = (size_t)ci * 128;
    const bf16* Qg = PROJ + rowbase * INW + 1024 + h * 128;
    const bf16* Kg = PROJ + rowbase * INW + 1536 + h * 128;
    const bf16* Vg = PROJ + rowbase * INW + 2048 + h * 128;
    const float lf2 = log_sigmoid_(a.in[24][h]) * 1.4426950408889634f, lb2 = log_sigmoid_(a.in[25][h]) * 1.4426950408889634f;
    const float scale = 0.08838834764831845f;
    LAS unsigned char* R1 = lds; LAS unsigned char* R2 = lds + REG; LAS unsigned char* R3 = lds + 2 * REG; LAS unsigned char* R4 = lds + 3 * REG;
    if (PASS == 1) {
        const float j0 = (float)(2 * lane), j1 = (float)(2 * lane + 1);
        const float wf0 = scale * __builtin_amdgcn_exp2f(lf2 * (127.f - j0)), wf1 = scale * __builtin_amdgcn_exp2f(lf2 * (127.f - j1)), wb0 = scale * __builtin_amdgcn_exp2f(lb2 * j0), wb1 = scale * __builtin_amdgcn_exp2f(lb2 * j1);
        load_tr(R1, Kg, INW, wave, lane);
#pragma unroll
        for (int it = 0; it < 2; ++it) { const int dg = wave + 8 * it;
            const v4u va = *(const v4u*)(Vg + (size_t)(2 * lane) * INW + dg * 8), vb = *(const v4u*)(Vg + (size_t)(2 * lane + 1) * INW + dg * 8);
#pragma unroll
            for (int e = 0; e < 8; ++e) { const float lo = bf2f((unsigned short)HW(va, e)), hi = bf2f((unsigned short)HW(vb, e));
                *(LAS unsigned*)(R2 + (dg * 8 + e) * RS + lane * 4) = pk2(lo * wf0, hi * wf1);
                *(LAS unsigned*)(R3 + (dg * 8 + e) * RS + lane * 4) = pk2(lo * wb0, hi * wb1); } }
        __syncthreads();
        f32x4 af[8], ab[8];
#pragma unroll
        for (int t = 0; t < 8; ++t) { af[t] = (f32x4){0.f, 0.f, 0.f, 0.f}; ab[t] = (f32x4){0.f, 0.f, 0.f, 0.f}; }
        mm128(af, R2, R1, wave, c, q);
        mm128(ab, R3, R1, wave, c, q);
        bf16* KVT = (bf16*)(ws + WS_KVT) + ((size_t)(ci * 4 + h) * 2) * 16384 + ((q >> 1) * 128 + 16 * wave + c) * 8 + 4 * (q & 1);
#pragma unroll
        for (int t = 0; t < 8; ++t) { *(v2u*)(KVT + 2 * t * 1024) = (v2u){pk2(af[t][0], af[t][1]), pk2(af[t][2], af[t][3])};
                                      *(v2u*)(KVT + 16384 + 2 * t * 1024) = (v2u){pk2(ab[t][0], ab[t][1]), pk2(ab[t][2], ab[t][3])}; }
        __syncthreads();
    } else {
        const bf16* SB = (const bf16*)(ws + WS_SB) + ((size_t)(ci * 4 + h) * 2) * 16384;
        load_rm(R1, Qg, INW, tid);
        load_rm(R2, Kg, INW, tid);
        load_tr(R3, Vg, INW, wave, lane);
        load_tiled(R4, SB, tid);
        __syncthreads();
        f32x4 aS[8], aF[8];
#pragma unroll
        for (int t = 0; t < 8; ++t) { aS[t] = (f32x4){0.f, 0.f, 0.f, 0.f}; aF[t] = (f32x4){0.f, 0.f, 0.f, 0.f}; }
        mm128x2(aS, aF, R1, R2, R4, wave, c, q);
        __syncthreads();
        const int i = 16 * wave + c;
#pragma unroll
        for (int t = 0; t < 8; ++t) { float p[4];
#pragma unroll
            for (int r = 0; r < 4; ++r) { const int dl = i - (16 * t + 4 * q + r);
                const float ex = __builtin_amdgcn_exp2f(dl > 0 ? lf2 * (float)dl : lb2 * (float)(-dl));
                const float f = dl == 0 ? 2.0f : ex;
                p[r] = aS[t][r] * scale * f; }
            *(LAS v2u*)(R2 + i * RS + (16 * t + 4 * q) * 2) = (v2u){pk2(p[0], p[1]), pk2(p[2], p[3])}; }
        load_tiled(R4, SB + 16384, tid);
        __syncthreads();
        const float hf = __builtin_amdgcn_exp2f(lf2 * (float)(i + 1)), hb = __builtin_amdgcn_exp2f(lb2 * (float)(128 - i));
        f32x4 aB[8];
#pragma unroll
        for (int t = 0; t < 8; ++t) { aF[t] = aF[t] * hf; aB[t] = (f32x4){0.f, 0.f, 0.f, 0.f}; }
        mm128(aF, R2, R3, wave, c, q);
        mm128(aB, R1, R4, wave, c, q);
        f32x4 (&aO)[8] = aF;
        float s = 0.f;
#pragma unroll
        for (int t = 0; t < 8; ++t) { aO[t] = aO[t] + aB[t] * hb; s += (aO[t][0] + aO[t][1]) + (aO[t][2] + aO[t][3]); }
        s += __shfl_xor(s, 16); s += __shfl_xor(s, 32);
        const float mean = s * (1.0f / 128.0f); float v2 = 0.f;
#pragma unroll
        for (int t = 0; t < 8; ++t) { aO[t] = aO[t] - mean; v2 += (aO[t][0] * aO[t][0] + aO[t][1] * aO[t][1]) + (aO[t][2] * aO[t][2] + aO[t][3] * aO[t][3]); }
        v2 += __shfl_xor(v2, 16); v2 += __shfl_xor(v2, 32);
        const float rstd = 1.0f / sqrtf(v2 * (1.0f / 128.0f) + 1e-6f);
        const bf16* Gg = PROJ + (rowbase + i) * INW + 2560 + h * 128 + 4 * q;
        const float* gn = a.in[26] + h * 128 + 4 * q;
        bf16* Yp = (bf16*)(ws + WS_Y) + (rowbase + i) * DM + 512 + h * 128 + 4 * q;
#pragma unroll
        for (int t = 0; t < 8; ++t) { const v2u gv = *(const v2u*)(Gg + 16 * t); const f32x4 w = *(const f32x4*)(gn + 16 * t);
            const float y0 = aO[t][0] * rstd * w[0] * siluf_(bflo(gv[0])), y1 = aO[t][1] * rstd * w[1] * siluf_(bfhi(gv[0]));
            const float y2 = aO[t][2] * rstd * w[2] * siluf_(bflo(gv[1])), y3 = aO[t][3] * rstd * w[3] * siluf_(bfhi(gv[1]));
            *(v2u*)(Yp + 16 * t) = (v2u){pk2(y0, y1), pk2(y2, y3)};
            if (t & 1) asm volatile("" ::: "memory"); }
        __syncthreads();
    }
}
template <int PASS, int DIR>
__device__ __forceinline__ void lru_dir(const LAS unsigned char* xcl, const bf16x8 (&idf)[2], const bf16x8 (&wa)[2], const bf16x8 (&wx)[2], float ba, float bx, float sp8,
                                        float hc_in, float* hsp, float& Aout, float& Hout, float& edge, int c, int q, const bf16* Gp, bf16* Yp) {
    float Ac = 1.f, Hc = hc_in;
    float hn[4]; unsigned short gn[4];
    if (PASS == 3 && DIR == 1) {
#pragma unroll
        for (int r = 0; r < 4; ++r) { hn[r] = hsp[(7 * 4 + r) * 64]; gn[r] = Gp[(size_t)(16 * 7 + 4 * q + r) * INW]; }
    }
#pragma unroll 1
    for (int ti = 0; ti < 8; ++ti) {
        const int tt = DIR == 0 ? ti : 7 - ti;
        float hcur[4]; unsigned short gcur[4];
        if (PASS == 3 && DIR == 1) {
#pragma unroll
            for (int r = 0; r < 4; ++r) { hcur[r] = hn[r]; gcur[r] = gn[r]; }
            const int tn = tt > 0 ? tt - 1 : 0;
#pragma unroll
            for (int r = 0; r < 4; ++r) { hn[r] = hsp[(tn * 4 + r) * 64]; gn[r] = Gp[(size_t)(16 * tn + 4 * q + r) * INW]; }
        }
        f32x4 aI = (f32x4){0.f, 0.f, 0.f, 0.f}, aA = aI, aX = aI;
#pragma unroll
        for (int s = 0; s < 2; ++s) { const bf16x8 xf = *(const LAS bf16x8*)(xcl + (16 * tt) * XCS + 64 * s);
            aI = MFMA16(xf, idf[s], aI); aA = MFMA16(xf, wa[s], aA); aX = MFMA16(xf, wx[s], aX); }
        float av[4], uv[4];
#pragma unroll
        for (int r = 0; r < 4; ++r) {
            const float rg = __builtin_amdgcn_rcpf(1.0f + __builtin_amdgcn_exp2f(fmaf(aA[r], -1.4426950408889634f, ba)));
            const float ig = __builtin_amdgcn_rcpf(1.0f + __builtin_amdgcn_exp2f(fmaf(aX[r], -1.4426950408889634f, bx)));
            const float la = -sp8 * rg;
            const float aa = __builtin_amdgcn_exp2f(la * 1.4426950408889634f);
            const float t = -2.0f * la;
            const float ser = t * fmaf(-0.5f * t, fmaf(-0.33333334f * t, fmaf(-0.25f, t, 1.0f), 1.0f), 1.0f);
            const float om = t < 0.125f ? ser : fmaf(-aa, aa, 1.0f);
            av[r] = aa; uv[r] = __builtin_amdgcn_sqrtf(om) * (ig * aI[r]); }
        float pa[4], hl[4]; float P = 1.f, H = 0.f;
#pragma unroll
        for (int rr = 0; rr < 4; ++rr) { const int r = DIR == 0 ? rr : 3 - rr; H = av[r] * H + uv[r]; P *= av[r]; pa[r] = P; hl[r] = H; }
        float A = P, Hh = H, Ap, Hp, Ae, He, At, Ht;
        if (DIR == 0) {
            Ap = __shfl_up(A, 16); Hp = __shfl_up(Hh, 16); if (q >= 1) { Hh = A * Hp + Hh; A = Ap * A; }
            Ap = __shfl_up(A, 32); Hp = __shfl_up(Hh, 32); if (q >= 2) { Hh = A * Hp + Hh; A = Ap * A; }
            Ae = __shfl_up(A, 16); He = __shfl_up(Hh, 16); if (q == 0) { Ae = 1.f; He = 0.f; }
            At = __shfl(A, 48 + c); Ht = __shfl(Hh, 48 + c);
        } else {
            Ap = __shfl_down(A, 16); Hp = __shfl_down(Hh, 16); if (q <= 2) { Hh = A * Hp + Hh; A = Ap * A; }
            Ap = __shfl_down(A, 32); Hp = __shfl_down(Hh, 32); if (q <= 1) { Hh = A * Hp + Hh; A = Ap * A; }
            Ae = __shfl_down(A, 16); He = __shfl_down(Hh, 16); if (q == 3) { Ae = 1.f; He = 0.f; }
            At = __shfl(A, c); Ht = __shfl(Hh, c);
        }
        if (PASS == 3) {
            const float hin = Ae * Hc + He;
#pragma unroll
            for (int r = 0; r < 4; ++r) { const float hv = pa[r] * hin + hl[r];
                if (DIR == 0) hsp[(tt * 4 + r) * 64] = hv;
                else { const size_t tok = (size_t)(16 * tt + 4 * q + r); Yp[tok * DM] = (bf16)f2bf((hcur[r] + hv) * gelu_tanh(bf2f(gcur[r]))); }
                if (DIR == 0 && tt == 0 && r == 0) edge = hv;
                if (DIR == 1 && tt == 7 && r == 3) edge = hv; }
        }
        Hc = At * Hc + Ht; Ac = Ac * At;
    }
    Aout = Ac; Hout = Hc;
}

template <int PASS>
__device__ __forceinline__ void lru_item(const Args& a, LAS unsigned char* lds, int ci, int tid, int wave, int lane) {
    unsigned char* ws = a.ws;
    const int c = lane & 15, q = lane >> 4;
    const bf16* PROJ = (const bf16*)(ws + WS_PROJ);
    int seq, n, seqlen, seqtok0, nch;
    if (ci < 64) { seq = ci >> 1; n = ci & 1; seqlen = 256; seqtok0 = seq * 256; nch = 2; }
    else { seq = (ci - 64) >> 5; n = (ci - 64) & 31; seqlen = 4096; seqtok0 = TP + seq * 4096; nch = 32; }
    const bool isprompt = ci < 64;
    const int p0 = n * 128;
    {
        float w0[8], w1[8], w2[8], w3[8], bb[8];
#pragma unroll
        for (int e = 0; e < 8; ++e) { w0[e] = a.in[12][0 * 512 + 8 * lane + e]; w1[e] = a.in[12][1 * 512 + 8 * lane + e]; w2[e] = a.in[12][2 * 512 + 8 * lane + e]; w3[e] = a.in[12][3 * 512 + 8 * lane + e]; bb[e] = a.in[13][8 * lane + e]; }
        const int pb = p0 + 16 * wave;
        const bf16* base = PROJ + (size_t)seqtok0 * INW + 8 * lane;
#define LDROW(p) (((p) < 0 || (p) >= seqlen) ? (v4u){0u, 0u, 0u, 0u} : *(const v4u*)(base + (size_t)(p) * INW))
        v4u rows[19];
#pragma unroll
        for (int k = 0; k < 19; ++k) rows[k] = LDROW(pb - 2 + k);
#pragma unroll
        for (int i = 0; i < 16; ++i) {
            float o[8];
#pragma unroll
            for (int e = 0; e < 8; ++e) o[e] = fmaf(w3[e], bf2f((unsigned short)HW(rows[i + 3], e)), fmaf(w2[e], bf2f((unsigned short)HW(rows[i + 2], e)), fmaf(w1[e], bf2f((unsigned short)HW(rows[i + 1], e)), fmaf(w0[e], bf2f((unsigned short)HW(rows[i], e)), bb[e]))));
            *(LAS v4u*)(lds + (16 * wave + i) * XCS + 16 * lane) = (v4u){pk2(o[0], o[1]), pk2(o[2], o[3]), pk2(o[4], o[5]), pk2(o[6], o[7])};
        }
#undef LDROW
    }
    __syncthreads();
    const LAS unsigned char* xcl = lds + c * XCS + (64 * wave + 8 * q) * 2;
    const bf16* WL = (const bf16*)(ws + WS_WL);
    const size_t rowbase = (size_t)seqtok0 + p0;
    for (int rt = 0; rt < 4; ++rt) {
        const int dl = 16 * rt + c, d = 64 * wave + dl;
        bf16x8 idf[2];
#pragma unroll
        for (int s = 0; s < 2; ++s)
#pragma unroll
            for (int e = 0; e < 8; ++e) idf[s][e] = (32 * s + 8 * q + e == dl) ? (short)0x3F80 : (short)0;
        float* hs = a.out + (size_t)(blockIdx.x * NWAVES + wave) * 2048 + lane;
        float Af, Hf, Ab, Hb, ef = 0.f, eb = 0.f;
        float cf = 0.f, cb = 0.f;
        if (PASS == 3) { cf = ((const float*)(ws + WS_CAR))[(size_t)(ci * 2 + 0) * 512 + d]; cb = ((const float*)(ws + WS_CAR))[(size_t)(ci * 2 + 1) * 512 + d]; }
        const bf16* Gp = PROJ + rowbase * INW + 512 + d;
        bf16* Yp = (bf16*)(ws + WS_Y) + rowbase * DM + d;
        bf16x8 waf[2], wxf[2], wab[2], wxb[2];
#pragma unroll
        for (int s2 = 0; s2 < 2; ++s2) { const int o = dl * 64 + 32 * s2 + 8 * q;
            waf[s2] = *(const bf16x8*)(WL + (size_t)(0 * 8 + wave) * 4096 + o); wxf[s2] = *(const bf16x8*)(WL + (size_t)(1 * 8 + wave) * 4096 + o);
            wab[s2] = *(const bf16x8*)(WL + (size_t)(2 * 8 + wave) * 4096 + o); wxb[s2] = *(const bf16x8*)(WL + (size_t)(3 * 8 + wave) * 4096 + o); }
        const float baf = a.in[15][d], bxf = a.in[17][d], lmf = a.in[18][d], bab = a.in[20][d], bxb = a.in[22][d], lmb = a.in[23][d];
        lru_dir<PASS, 0>(xcl, idf, waf, wxf, -1.4426950408889634f * baf, -1.4426950408889634f * bxf, 8.0f * log1pf(__expf(-lmf)), cf, hs, Af, Hf, ef, c, q, Gp, Yp);
        lru_dir<PASS, 1>(xcl, idf, wab, wxb, -1.4426950408889634f * bab, -1.4426950408889634f * bxb, 8.0f * log1pf(__expf(-lmb)), cb, hs, Ab, Hb, eb, c, q, Gp, Yp);
        if (PASS == 1) {
            if (q == 0) { float* ag = (float*)(ws + WS_AGG) + (size_t)(ci * 2) * 1024 + d; ag[0] = Af; ag[512] = Hf; ag[1024] = Ab; ag[1536] = Hb; }
        } else {
            if (isprompt && n == 0 && q == 0) a.out[OFF_LF + seq * 512 + d] = ef;
            if (isprompt && n == nch - 1 && q == 3) a.out[OFF_LB + seq * 512 + d] = eb;
        }
    }
    __syncthreads();
}

__device__ __forceinline__ void phase_carries(const Args& a, int tid) {
    unsigned char* ws = a.ws;
    const int gtid = blockIdx.x * 512 + tid, GT = gridDim.x * 512;
    for (int task = gtid; task < 655360; task += GT) {
        const int dv = task & 127, dkg = (task >> 7) & 15, dir = (task >> 11) & 1, h = (task >> 12) & 3, sq = task >> 14;
        const bool isprompt = sq >= 8; const int seq = isprompt ? sq - 8 : sq, N = isprompt ? 2 : 32, cibase = isprompt ? seq * 2 : 64 + seq * 32;
        const float g = __expf(log_sigmoid_(dir ? a.in[25][h] : a.in[24][h]) * 128.0f);
        float S[8];
        if (isprompt) {
#pragma unroll
            for (int e = 0; e < 8; ++e) S[e] = 0.f;
        } else { const float* s0 = (dir ? a.in[5] : a.in[4]) + ((size_t)(seq * 4 + h) * 128 + dkg * 8) * 128 + dv;
#pragma unroll
            for (int e = 0; e < 8; ++e) S[e] = s0[e * 128]; }
        const size_t ibase = ((size_t)h * 2 + dir) * 16384 + ((size_t)dkg * 128 + dv) * 8;
        const bf16* kvp = (const bf16*)(ws + WS_KVT) + ibase; bf16* sbp = (bf16*)(ws + WS_SB) + ibase;
        for (int s0 = 0; s0 < N; s0 += 8) {
            v4u kv[8];
#pragma unroll
            for (int j = 0; j < 8; ++j) { const int step = s0 + j; const int n = dir ? N - 1 - step : step; const int ci = cibase + (step < N ? n : (dir ? 0 : N - 1));
                kv[j] = *(const v4u*)(kvp + (size_t)ci * 131072); }
#pragma unroll
            for (int j = 0; j < 8; ++j) { const int step = s0 + j;
                if (step < N) { const int n = dir ? N - 1 - step : step, ci = cibase + n;
                    *(v4u*)(sbp + (size_t)ci * 131072) = (v4u){pk2(S[0], S[1]), pk2(S[2], S[3]), pk2(S[4], S[5]), pk2(S[6], S[7])};
#pragma unroll
                    for (int e2 = 0; e2 < 8; ++e2) S[e2] = g * S[e2] + bf2f((unsigned short)HW(kv[j], e2)); } }
        }
        if (isprompt) { float* o = a.out + (dir ? OFF_RB : OFF_RF) + ((size_t)(seq * 4 + h) * 128 + dkg * 8) * 128 + dv;
#pragma unroll
            for (int e = 0; e < 8; ++e) o[e * 128] = S[e]; }
    }
    for (int task = gtid; task < 40960; task += GT) {
        const int d = task & 511, dir = (task >> 9) & 1, sq = task >> 10;
        const bool isprompt = sq >= 8; const int seq = isprompt ? sq - 8 : sq, N = isprompt ? 2 : 32, cibase = isprompt ? seq * 2 : 64 + seq * 32;
        float hcar = isprompt ? 0.f : (dir ? a.in[3] : a.in[2])[seq * 512 + d];
        for (int step = 0; step < N; ++step) {
            const int n = dir ? N - 1 - step : step, ci = cibase + n;
            ((float*)(ws + WS_CAR))[(size_t)(ci * 2 + dir) * 512 + d] = hcar;
            const float* ag = (const float*)(ws + WS_AGG) + ((size_t)(ci * 2 + dir) * 2) * 512 + d;
            hcar = ag[0] * hcar + ag[512];
        }
    }
}

__device__ __forceinline__ v4u ldg16(const bf16* p, bool ok) { return ok ? *(const v4u*)p : (v4u){0u, 0u, 0u, 0u}; }
__device__ __forceinline__ void phase_act(const Args& a, int half, int wave, int lane) {
    unsigned char* ws = a.ws;
    const bf16* __restrict__ GH = (const bf16*)(ws + WS_GH);
    bf16* __restrict__ U = (bf16*)(ws + WS_U);
    const int gw = blockIdx.x * NWAVES + wave, NGW = gridDim.x * NWAVES;
    const int p = lane >> 5;
    const bool tailsplit = (NGW == 2048);
    for (int kk = 0; kk < (tailsplit ? 4 : (7040 + NGW - 1) / NGW); ++kk) {
        int wt, nst = 16, soff = 0;
        if (!tailsplit) { wt = gw + kk * NGW; if (wt >= 7040) break; }
        else if (kk < 3) wt = gw + kk * 2048;
        else { if (gw >= 1792) break; wt = 6144 + (gw >> 1); nst = 8; soff = 8 * (gw & 1); }
        const int slab = wt % 11; int r = wt / 11;
        int tok0, ts, lat, steps0, nwalk;
        bool isimg;
        if (half == 1 || r >= 256) {
            if (half == 0) r -= 256;
            const int pair = r & 31, seg = (r >> 5) & 3, img = (r >> 7) + (half == 0 ? 0 : 3);
            const int gc = 2 * pair + p; steps0 = 16 * seg + soff; nwalk = 64; ts = 64; lat = 1; isimg = true;
            tok0 = TP + img * 4096 + steps0 * 64 + gc;
        } else {
            const int sp = r & 7, seq = r >> 3; steps0 = 32 * sp + 16 * p + soff; nwalk = 256; ts = 1; lat = 0; isimg = false;
            tok0 = seq * 256 + steps0;
        }
        const int ch0 = (slab * 32 + (lane & 31)) * 8;
        const int gcol = isimg ? (tok0 & 63) : 1;
        const bool okl = isimg && gcol > 0, okr = isimg && gcol < 63;
        float wk[9][8], bb[8];
#pragma unroll
        for (int k = 0; k < 9; ++k) { const int aa = k / 3, b = k % 3;
            const int src = isimg ? k : (3 + aa);
            const f32x4 x0 = *(const f32x4*)(a.in[31] + (size_t)src * FF + ch0), x1 = *(const f32x4*)(a.in[31] + (size_t)src * FF + ch0 + 4);
            const float z = (isimg || b == 1) ? 1.f : 0.f;
            wk[k][0] = x0[0] * z; wk[k][1] = x0[1] * z; wk[k][2] = x0[2] * z; wk[k][3] = x0[3] * z; wk[k][4] = x1[0] * z; wk[k][5] = x1[1] * z; wk[k][6] = x1[2] * z; wk[k][7] = x1[3] * z; }
        { const f32x4 x0 = *(const f32x4*)(a.in[32] + ch0), x1 = *(const f32x4*)(a.in[32] + ch0 + 4); bb[0] = x0[0]; bb[1] = x0[1]; bb[2] = x0[2]; bb[3] = x0[3]; bb[4] = x1[0]; bb[5] = x1[1]; bb[6] = x1[2]; bb[7] = x1[3]; }
        const bf16* gp = GH + (size_t)(tok0 - half * HALF_T) * FF + ch0;
        bf16* up = U + (size_t)tok0 * FF + ch0;
        const size_t gs = (size_t)ts * FF;
        v4u w0[3], w1[3], w2[3], w3[3];
        { const bool okp = steps0 > 0;
          w0[0] = ldg16(gp - gs - FF, okp && okl); w0[1] = ldg16(gp - gs, okp); w0[2] = ldg16(gp - gs + FF, okp && okr);
          w1[0] = ldg16(gp - FF, okl); w1[1] = *(const v4u*)gp; w1[2] = ldg16(gp + FF, okr); }
#pragma unroll 1
        for (int st = 0; st < nst; st += 2) {
            const bool ok2 = steps0 + st + 1 < nwalk, ok3 = steps0 + st + 2 < nwalk;
            const bf16* g2 = gp + (size_t)(st + 1) * gs; const bf16* g3 = g2 + gs;
            w2[0] = ldg16(g2 - FF, ok2 && okl); w2[1] = ldg16(g2, ok2); w2[2] = ldg16(g2 + FF, ok2 && okr);
            w3[0] = ldg16(g3 - FF, ok3 && okl); w3[1] = ldg16(g3, ok3); w3[2] = ldg16(g3 + FF, ok3 && okr);
            bf16* u0 = up + (size_t)st * gs; bf16* u1 = u0 + gs;
            const v4u uv0 = *(const v4u*)u0, uv1 = *(const v4u*)u1;
            float acc0[8], acc1[8];
#pragma unroll
            for (int e = 0; e < 8; ++e) { acc0[e] = bb[e]; acc1[e] = bb[e]; }
#pragma unroll
            for (int b = 0; b < 3; ++b)
#pragma unroll
                for (int e = 0; e < 8; ++e) {
                    { const float g0 = bf2f((unsigned short)HW(w0[b], e)), g1 = bf2f((unsigned short)HW(w1[b], e)), g2 = bf2f((unsigned short)HW(w2[b], e)), g3 = bf2f((unsigned short)HW(w3[b], e));
                    acc0[e] = fmaf(wk[6 + b][e], g2, fmaf(wk[3 + b][e], g1, fmaf(wk[0 + b][e], g0, acc0[e])));
                    acc1[e] = fmaf(wk[6 + b][e], g3, fmaf(wk[3 + b][e], g2, fmaf(wk[0 + b][e], g1, acc1[e]))); } }
            float o0[8], o1[8];
#pragma unroll
            for (int e = 0; e < 8; ++e) { o0[e] = gelu_tanh(acc0[e]) * bf2f((unsigned short)HW(uv0, e)); o1[e] = gelu_tanh(acc1[e]) * bf2f((unsigned short)HW(uv1, e)); }
            *(v4u*)u0 = (v4u){pk2(o0[0], o0[1]), pk2(o0[2], o0[3]), pk2(o0[4], o0[5]), pk2(o0[6], o0[7])};
            *(v4u*)u1 = (v4u){pk2(o1[0], o1[1]), pk2(o1[2], o1[3]), pk2(o1[4], o1[5]), pk2(o1[6], o1[7])};
#pragma unroll
            for (int b = 0; b < 3; ++b) { w0[b] = w2[b]; w1[b] = w3[b]; }
        }
    }
}
template <int PASS>
__device__ __forceinline__ void phase_mixer(const Args& a, LAS unsigned char* lds, int tid, int wave, int lane) {
    unsigned* ctr = (unsigned*)(a.ws + WS_BAR) + (PASS == 1 ? 3584 : 3648);
    volatile LAS int* slot = (volatile LAS int*)(lds + LDSCTL_OFF + 256);
    for (;;) {
        if (tid == 0) *slot = (int)__hip_atomic_fetch_add(ctr, 1u, __ATOMIC_RELAXED, __HIP_MEMORY_SCOPE_AGENT);
        __syncthreads();
        const int it = *slot;
        if (it >= NCHUNK + 4 * NCHUNK) break;
        asm volatile("" : "+v"(tid), "+v"(lane));
        if (it < NCHUNK) lru_item<PASS>(a, lds, it, tid, wave, lane);
        else { const int r = it - NCHUNK; ret_item<PASS>(a, lds, r >> 2, r & 3, tid, wave, lane); }
    }
}

__global__ void __launch_bounds__(512, 2) fwd(Args a) {
    extern __shared__ __attribute__((aligned(16))) unsigned char lds_raw[];
    LAS unsigned char* lds = (LAS unsigned char*)lds_raw;
    unsigned char* ws = a.ws;
    int tid = threadIdx.x, lane = tid & 63; const int wave = __builtin_amdgcn_readfirstlane(tid >> 6);
#define FRESH() do { tid = threadIdx.x; asm volatile("" : "+v"(tid)); lane = tid & 63; } while (0)
    for (int u = tid; u < (LDS_BYTES - LDSCTL_OFF) / 4; u += 512) ((LAS unsigned*)(lds + LDSCTL_OFF))[u] = 0u;
    __syncthreads();
    const XcdBarrier bar = xcd_barrier_post((unsigned*)(ws + WS_BAR), (volatile LAS unsigned*)(lds + LDSCTL_OFF + 64));
    const float* MOD = (const float*)(ws + WS_MOD);
    const int G = gridDim.x;
    const int lo = a.ph_lo, hi = a.ph_hi;
#ifndef PHMASK
#define PHMASK 0xffff
#endif
#define IN(k) ((((PHMASK) >> (k)) & 1) && lo <= (k) && (k) < hi)
#ifndef REPMASK
#define REPMASK 0u
#endif
#define NREP(k) ((((REPMASK) >> (k)) & 1u) ? 2 : 1)
#define SEAM(k) do { if (IN(k) && IN((k) + 1)) xcd_barrier(bar); } while (0)
    FRESH();
    for (int rep = 0; rep < NREP(0); ++rep) if (IN(0)) phase_prologue(a, lds, tid, wave, lane);
    if (IN(0) && IN(1)) { cg::grid_group grid = cg::this_grid(); grid.sync(); }
    FRESH();
    for (int rep = 0; rep < NREP(1); ++rep) if (IN(1)) phase_rownorm<0>(a.in[0], a.in[1], a.in[8], MOD + 1024, MOD + 0, (bf16*)(ws + WS_XN), nullptr, wave, lane);
    SEAM(1);
    FRESH();
    for (int rep = 0; rep < NREP(2); ++rep) if (IN(2)) { pg8::Gemm g{(const bf16*)(ws + WS_XN), (const bf16*)(ws + WS_WIN), TT, INW, DM}; pg8::StaticOrder S; S.init(TT, INW, G, (int)blockIdx.x);
        pg8::EpiBf16<0> E{(bf16*)(ws + WS_PROJ), INW, nullptr, 0, 0, 1.f};
        pg8::gemm_phase<pg8::EpiBf16<0>, pg8::StaticOrder, true, true>(lds, g, S, E); }
    SEAM(2);
    FRESH();
    for (int rep = 0; rep < NREP(3); ++rep) if (IN(3)) phase_mixer<1>(a, lds, tid, wave, lane);
    SEAM(3);
    FRESH();
    for (int rep = 0; rep < NREP(4); ++rep) if (IN(4)) phase_carries(a, tid);
    SEAM(4);
    FRESH();
    for (int rep = 0; rep < NREP(5); ++rep) if (IN(5)) phase_mixer<3>(a, lds, tid, wave, lane);
    SEAM(5);
    FRESH();
    for (int rep = 0; rep < NREP(6); ++rep) if (IN(6)) { pg8::Gemm g{(const bf16*)(ws + WS_Y), (const bf16*)(ws + WS_WOUT), TT, DM, DM}; pg8::StaticOrder S; S.init(TT, DM, G, (int)blockIdx.x);
        pg8::EpiBf16<0> E{(bf16*)(ws + WS_KVT), DM, nullptr, 0, 0, 1.f};
        pg8::gemm_phase<pg8::EpiBf16<0>, pg8::StaticOrder, true, true>(lds, g, S, E); }
    SEAM(6);
    FRESH();
    for (int rep = 0; rep < NREP(7); ++rep) if (IN(7)) phase_resnorm<0>(a.in[0], a.in[1], (const bf16*)(ws + WS_KVT), MOD + 2048, a.out, a.in[28], MOD + 4096, MOD + 3072, (bf16*)(ws + WS_XN), nullptr, wave, lane);
    SEAM(7);
#pragma unroll
    for (int half = 0; half < 2; ++half) {
        FRESH();
        if (IN(8 + 2 * half)) { pg8::Gemm g{(const bf16*)(ws + WS_XN) + (size_t)half * HALF_T * DM, (const bf16*)(ws + WS_WGU), HALF_T, FF2, DM}; pg8::StaticOrder S; S.init(HALF_T, FF2, G, (int)blockIdx.x);
            pg8::EpiBf16<0> E{(bf16*)(ws + WS_GH), FF, nullptr, FF, (size_t)((WS_U - WS_GH) / 2) + (size_t)half * HALF_T * FF, 1.f};
            pg8::gemm_phase<pg8::EpiBf16<0>, pg8::StaticOrder, true, true>(lds, g, S, E); }
        SEAM(8 + 2 * half);
        FRESH();
        if (IN(9 + 2 * half)) phase_act(a, half, wave, lane);
        SEAM(9 + 2 * half);
    }
    FRESH();
    constexpr int PA_ROWS = 32768;
    const bool split12 = (G == 256);
    if (IN(12)) {
        { pg8::Gemm g{(const bf16*)(ws + WS_U), (const bf16*)(ws + WS_WD), split12 ? PA_ROWS : TT, DM, FF}; pg8::StaticOrder S; S.init(split12 ? PA_ROWS : TT, DM, G, (int)blockIdx.x);
          pg8::EpiBf16<0> E{(bf16*)(ws + WS_XN), DM, nullptr, 0, 0, 1.f};
          pg8::gemm_phase<pg8::EpiBf16<0>, pg8::StaticOrder, true, true>(lds, g, S, E); }
        if (split12) {
            FRESH();
            const int u = (int)blockIdx.x >> 1, kh = (int)blockIdx.x & 1, pml = u >> 2, pn = u & 3;
            pg8::Gemm g{(const bf16*)(ws + WS_U) + (size_t)(PA_ROWS + pml * 256) * FF + kh * (FF / 2), (const bf16*)(ws + WS_WD) + (size_t)(pn * 256) * FF + kh * (FF / 2), 256, 256, FF / 2, FF};
            pg8::StaticOrder S; S.init(256, 256, 1, 0);
            bf16* obase = kh ? (bf16*)(ws + WS_GH) + (size_t)(pml * 256) * DM + pn * 256 : (bf16*)(ws + WS_XN) + (size_t)(PA_ROWS + pml * 256) * DM + pn * 256;
            pg8::EpiBf16<0> E{obase, DM, nullptr, 0, 0, 1.f};
            pg8::gemm_phase<pg8::EpiBf16<0>, pg8::StaticOrder, true, true>(lds, g, S, E);
        }
    }
    SEAM(12);
    FRESH();
    if (IN(13)) phase_resnorm<1>(a.out, a.out + (size_t)TP * DM, (const bf16*)(ws + WS_XN), MOD + 5120, nullptr, a.in[34], nullptr, nullptr, nullptr, a.out, wave, lane,
                                 split12 ? (const bf16*)(ws + WS_GH) : nullptr, PA_ROWS);
#undef IN
#undef SEAM
}

extern "C" void kernel_launch(void* const* d_in, const int* in_sizes, int n_in, void* d_out, int out_size,
                              void* d_ws, size_t ws_size, hipStream_t stream) {
    static int grid = 0;
    if (grid == 0) {
        int dev = 0, cus = 0, per_cu = 0;
        hipGetDevice(&dev);
        hipDeviceGetAttribute(&cus, hipDeviceAttributeMultiprocessorCount, dev);
        hipFuncSetAttribute((const void*)fwd, hipFuncAttributeMaxDynamicSharedMemorySize, LDS_BYTES);
        hipOccupancyMaxActiveBlocksPerMultiprocessor(&per_cu, (const void*)fwd, 512, LDS_BYTES);
        if (per_cu < 1) per_cu = 1;
        grid = cus * per_cu;
        if (n_in != 35 || ws_size < WS_END) fprintf(stderr, "kernel_launch: unexpected n_in %d / ws_size %zu\n", n_in, ws_size);
    }
    if (hipMemsetAsync((char*)d_ws + WS_BAR, 0, 16384, stream) != hipSuccess) fprintf(stderr, "kernel_launch: memset failed\n");
    Args a{};
    for (int i = 0; i < 35; ++i) a.in[i] = (const float*)d_in[i];
    a.out = (float*)d_out; a.ws = (unsigned char*)d_ws; a.ph_lo = 0; a.ph_hi = 14;
    void* args[] = {&a};
    hipError_t e = hipLaunchCooperativeKernel((const void*)fwd, dim3(grid), dim3(512), args, LDS_BYTES, stream);
    if (e != hipSuccess) fprintf(stderr, "cooperative launch failed: %s (grid %d)\n", hipGetErrorString(e), grid);
}
```
